# Optimizing an MI355X kernel written in HIP

```python
import jax, jax.numpy as jnp
from jax import lax
import numpy as np

D_MODEL = 1024
BATCH = 16
SEQ = 4096
DEPTH = 1

HEAD_DIM = 64
N_FOX_HEADS = 8
N_DIL_HEADS = 8
FOX_WIDTH = N_FOX_HEADS * HEAD_DIM
DIL_WIDTH = N_DIL_HEADS * HEAD_DIM
IN_COLS = 3 * FOX_WIDTH + N_FOX_HEADS + 3 * DIL_WIDTH
Q_BLOCK = 128
DILATED_BRANCHES = ((128, 1), (512, 4), (2048, 16))
T5_NUM_BUCKETS = 32
T5_MAX_DISTANCE = 2048
N_EXPERTS = 256
TOP_K = 8
N_EXPERT_GROUPS = 8
TOP_K_GROUPS = 4
EXPERT_HIDDEN = 256
SHARED_HIDDEN = 256
ROUTED_SCALE = 2.5
DISPATCH_BLOCK = 128
N_MOD = 6
EPS = 1e-6

kernel_name = "hybrid_fox_dilated_moe_adaln"


def rmsnorm(x):
    xf = x.astype(jnp.float32)
    return (xf * lax.rsqrt(jnp.mean(xf * xf, axis=-1, keepdims=True) + EPS)).astype(x.dtype)


def _t5_bucket(dist):
    max_exact = T5_NUM_BUCKETS // 2
    d = np.maximum(dist, 1).astype(np.float32)
    large = max_exact + (np.log(d / max_exact) / np.log(T5_MAX_DISTANCE / max_exact)
                         * (T5_NUM_BUCKETS - max_exact)).astype(np.int32)
    large = np.minimum(large, T5_NUM_BUCKETS - 1)
    return np.where(dist < max_exact, dist, large).astype(np.int32)


def fox_attention(q, k, v, f_logit, b_forget):
    B, S, H, E = q.shape
    log_f = jax.nn.log_sigmoid(f_logit.astype(jnp.float32) + b_forget.astype(jnp.float32))
    F = jnp.cumsum(log_f, axis=1).transpose(0, 2, 1)
    scale = HEAD_DIM ** -0.5
    outs = []
    for i in range(S // Q_BLOCK):
        q0, q1 = i * Q_BLOCK, (i + 1) * Q_BLOCK
        s = jnp.einsum('bqhe,bkhe->bhqk', q[:, q0:q1], k[:, :q1]).astype(jnp.float32) * scale
        s = s + F[:, :, q0:q1, None] - F[:, :, None, :q1]
        causal = np.arange(q0, q1)[:, None] >= np.arange(q1)[None, :]
        p = jax.nn.softmax(jnp.where(causal, s, -jnp.inf), axis=-1)
        outs.append(jnp.einsum('bhqk,bkhe->bqhe', p.astype(v.dtype), v[:, :q1]))
    return jnp.concatenate(outs, axis=1)


def dilated_branch(q, k, v, rel_bias, window, dilation):
    B, S, H, E = q.shape
    blk = window // dilation
    span = blk * dilation
    L = -(-S // span) * span
    nb = L // span

    def to_blocks(t):
        t = jnp.pad(t, ((0, 0), (0, L - S), (0, 0), (0, 0)))
        t = t.reshape(B, L // dilation, dilation, H, E).transpose(0, 2, 1, 3, 4)
        return t.reshape(B, dilation, nb, blk, H, E)

    def with_prev(t):
        prev = jnp.pad(t[:, :, :-1], ((0, 0), (0, 0), (1, 0), (0, 0), (0, 0), (0, 0)))
        return jnp.concatenate([prev, t], axis=3)

    qb = to_blocks(q)
    kk = with_prev(to_blocks(k))
    vv = with_prev(to_blocks(v))
    rel = np.arange(blk)[:, None] + blk - np.arange(2 * blk)[None, :]
    band = (rel >= 0) & (rel <= blk)
    key_ok = (np.arange(nb)[:, None] * blk + np.arange(2 * blk)[None, :] - blk) >= 0
    mask = (band[None] & key_ok[:, None, :])[None, None, :, None]
    bucket = _t5_bucket(np.clip(rel, 0, blk) * dilation)
    bias = rel_bias[bucket].astype(jnp.float32).transpose(2, 0, 1)
    s = jnp.einsum('brnqhe,brnkhe->brnhqk', qb, kk).astype(jnp.float32) * (HEAD_DIM ** -0.5) + bias
    s = jnp.where(mask, s, -jnp.inf)
    lse = jax.nn.logsumexp(s, axis=-1)
    p = jnp.exp(s - lse[..., None])
    o = jnp.einsum('brnhqk,brnkhe->brnqhe', p.astype(vv.dtype), vv)
    o = o.reshape(B, dilation, L // dilation, H, E).transpose(0, 2, 1, 3, 4).reshape(B, L, H, E)[:, :S]
    lse = lse.transpose(0, 1, 2, 4, 3).reshape(B, dilation, L // dilation, H)
    lse = lse.transpose(0, 2, 1, 3).reshape(B, L, H)[:, :S]
    return o, lse


def dilated_mixture(q, k, v, rel_bias):
    outs, lses = [], []
    for window, dilation in DILATED_BRANCHES:
        o, lse = dilated_branch(q, k, v, rel_bias, window, dilation)
        outs.append(o)
        lses.append(lse)
    w = jax.nn.softmax(jnp.stack(lses, axis=-1), axis=-1)
    o = jnp.stack(outs, axis=-1)
    return jnp.sum(o * w[:, :, :, None, :].astype(o.dtype), axis=-1)


def hybrid_mixer(h, w_in, b_forget, g_fox_out, g_dil_out, w_out, rel_bias):
    B, S, _ = h.shape
    proj = h @ w_in
    o1, o2, o3, o4 = FOX_WIDTH, 2 * FOX_WIDTH, 3 * FOX_WIDTH, 3 * FOX_WIDTH + N_FOX_HEADS
    heads = lambda t, n: t.reshape(B, S, n, HEAD_DIM)
    q_f = heads(proj[..., :o1], N_FOX_HEADS)
    k_f = heads(proj[..., o1:o2], N_FOX_HEADS)
    v_f = heads(proj[..., o2:o3], N_FOX_HEADS)
    f_logit = proj[..., o3:o4]
    q_d = heads(proj[..., o4:o4 + DIL_WIDTH], N_DIL_HEADS)
    k_d = heads(proj[..., o4 + DIL_WIDTH:o4 + 2 * DIL_WIDTH], N_DIL_HEADS)
    v_d = heads(proj[..., o4 + 2 * DIL_WIDTH:], N_DIL_HEADS)
    y_fox = fox_attention(q_f, k_f, v_f, f_logit, b_forget).reshape(B, S, FOX_WIDTH)
    y_dil = dilated_mixture(q_d, k_d, v_d, rel_bias).reshape(B, S, DIL_WIDTH)
    merged = jnp.concatenate([rmsnorm(y_fox) * g_fox_out, rmsnorm(y_dil) * g_dil_out], axis=-1)
    return merged @ w_out


def swiglu(x, w_gate, w_up, w_down):
    return (jax.nn.silu(x @ w_gate) * (x @ w_up)) @ w_down


def moe(h, w_router, router_bias, w_exp_gate, w_exp_up, w_exp_down, w_sh_gate, w_sh_up, w_sh_down):
    B, S, D = h.shape
    N = B * S
    hf = h.reshape(N, D)
    scores = jax.nn.sigmoid((hf @ w_router).astype(jnp.float32))
    sel = scores + router_bias.astype(jnp.float32)
    grp = lax.top_k(sel.reshape(N, N_EXPERT_GROUPS, N_EXPERTS // N_EXPERT_GROUPS), 2)[0].sum(-1)
    _, gidx = lax.top_k(grp, TOP_K_GROUPS)
    gmask = jax.nn.one_hot(gidx, N_EXPERT_GROUPS, dtype=jnp.float32).sum(1) > 0
    emask = jnp.repeat(gmask, N_EXPERTS // N_EXPERT_GROUPS, axis=1)
    _, eidx = lax.top_k(jnp.where(emask, sel, -jnp.inf), TOP_K)
    wts = jnp.take_along_axis(scores, eidx, axis=1)
    wts = wts / jnp.sum(wts, axis=-1, keepdims=True) * ROUTED_SCALE

    NK = N * TOP_K
    flat_e = eidx.reshape(NK).astype(jnp.int32)
    flat_tok = (jnp.arange(NK, dtype=jnp.int32) // TOP_K)
    flat_w = wts.reshape(NK)
    order = jnp.argsort(flat_e)
    se, stok, sw = flat_e[order], flat_tok[order], flat_w[order]
    counts = jnp.bincount(flat_e, length=N_EXPERTS).astype(jnp.int32)
    padded = (counts + DISPATCH_BLOCK - 1) // DISPATCH_BLOCK * DISPATCH_BLOCK
    start = jnp.cumsum(counts) - counts
    pend = jnp.cumsum(padded)
    pstart = pend - padded
    dest = pstart[se] + (jnp.arange(NK, dtype=jnp.int32) - start[se])
    R = NK + N_EXPERTS * DISPATCH_BLOCK
    nblk = R // DISPATCH_BLOCK
    row_tok = jnp.full((R,), N, dtype=jnp.int32).at[dest].set(stok)
    row_w = jnp.zeros((R,), jnp.float32).at[dest].set(sw)
    block_e = jnp.minimum(jnp.searchsorted(pend, jnp.arange(nblk, dtype=jnp.int32) * DISPATCH_BLOCK,
                                           side='right'), N_EXPERTS - 1).astype(jnp.int32)
    h_pad = jnp.concatenate([hf, jnp.zeros((1, D), hf.dtype)], axis=0)

    def step(acc, blk):
        tok, w, e = blk
        xb = h_pad[tok]
        y = swiglu(xb, w_exp_gate[e], w_exp_up[e], w_exp_down[e])
        return acc.at[tok].add((y * w[:, None]).astype(acc.dtype)), None

    acc, _ = lax.scan(step, jnp.zeros((N + 1, D), hf.dtype),
                      (row_tok.reshape(nblk, DISPATCH_BLOCK), row_w.reshape(nblk, DISPATCH_BLOCK), block_e))
    routed = acc[:N]
    shared = swiglu(hf, w_sh_gate, w_sh_up, w_sh_down)
    return (routed + shared).reshape(B, S, D)


def setup_inputs(seed: int = 0) -> dict:
    key = jax.random.key(seed)
    ks = jax.random.split(key, 20)
    D, E, Hd = D_MODEL, N_EXPERTS, EXPERT_HIDDEN
    nrm = lambda k, shape, fan: jax.random.normal(k, shape, jnp.float32) * (fan ** -0.5)
    b_forget = (jnp.linspace(1.0, 6.0, N_FOX_HEADS, dtype=jnp.float32)[None, :]
                + 0.1 * jax.random.normal(ks[3], (DEPTH, N_FOX_HEADS), jnp.float32))
    return {
        "x": jax.random.normal(ks[0], (BATCH, SEQ, D), jnp.float32),
        "c": jax.random.normal(ks[1], (BATCH, D), jnp.float32),
        "w_in": nrm(ks[2], (DEPTH, D, IN_COLS), D),
        "b_forget": b_forget,
        "g_fox_out": 1.0 + 0.02 * jax.random.normal(ks[4], (DEPTH, FOX_WIDTH), jnp.float32),
        "g_dil_out": 1.0 + 0.02 * jax.random.normal(ks[5], (DEPTH, DIL_WIDTH), jnp.float32),
        "w_out": nrm(ks[6], (DEPTH, FOX_WIDTH + DIL_WIDTH, D), FOX_WIDTH + DIL_WIDTH),
        "w_ada": 0.5 * nrm(ks[7], (DEPTH, D, N_MOD * D), D),
        "b_ada": 0.02 * jax.random.normal(ks[8], (DEPTH, N_MOD * D), jnp.float32),
        "w_router": nrm(ks[9], (DEPTH, D, E), D),
        "router_bias": 0.01 * jax.random.normal(ks[10], (DEPTH, E), jnp.float32),
        "w_exp_gate": nrm(ks[11], (DEPTH, E, D, Hd), D),
        "w_exp_up": nrm(ks[12], (DEPTH, E, D, Hd), D),
        "w_exp_down": nrm(ks[13], (DEPTH, E, Hd, D), Hd),
        "w_sh_gate": nrm(ks[14], (DEPTH, D, SHARED_HIDDEN), D),
        "w_sh_up": nrm(ks[15], (DEPTH, D, SHARED_HIDDEN), D),
        "w_sh_down": nrm(ks[16], (DEPTH, SHARED_HIDDEN, D), SHARED_HIDDEN),
        "rel_bias": 0.5 * jax.random.normal(ks[17], (T5_NUM_BUCKETS, N_DIL_HEADS), jnp.float32),
        "g_final": 1.0 + 0.02 * jax.random.normal(ks[18], (D,), jnp.float32),
    }


def reference(x, c, w_in, b_forget, g_fox_out, g_dil_out, w_out, w_ada, b_ada, w_router, router_bias,
              w_exp_gate, w_exp_up, w_exp_down, w_sh_gate, w_sh_up, w_sh_down, rel_bias, g_final):
    c_act = jax.nn.silu(c)
    for l in range(DEPTH):
        mod = c_act @ w_ada[l] + b_ada[l]
        shift1, scale1, gate1, shift2, scale2, gate2 = [m[:, None, :] for m in jnp.split(mod, N_MOD, axis=-1)]
        h = rmsnorm(x) * (1.0 + scale1) + shift1
        x = x + gate1 * hybrid_mixer(h, w_in[l], b_forget[l], g_fox_out[l], g_dil_out[l], w_out[l], rel_bias)
        h = rmsnorm(x) * (1.0 + scale2) + shift2
        x = x + gate2 * moe(h, w_router[l], router_bias[l], w_exp_gate[l], w_exp_up[l], w_exp_down[l],
                            w_sh_gate[l], w_sh_up[l], w_sh_down[l])
    return rmsnorm(x) * g_final
```

```cpp
#include <hip/hip_runtime.h>
#include <hip/hip_bf16.h>
#include <cstdio>
#include <cstdint>

#ifndef DUP_MASK
#define DUP_MASK 0
#endif
#ifndef HOIST_SD
#define HOIST_SD false
#endif
#ifndef HOIST_G1
#define HOIST_G1 false
#endif
#ifndef HOIST_G2
#define HOIST_G2 true
#endif
#ifndef PROBE_G1
#define PROBE_G1 0
#endif
#ifndef PROBE_G2
#define PROBE_G2 0
#endif
#define DUPN(k) (((DUP_MASK >> (k)) & 1) ? 2 : 1)
#ifndef MK_N_LAUNCHES
#define MK_N_LAUNCHES 1
#endif

#define GAS __attribute__((address_space(1)))
#define LAS __attribute__((address_space(3)))

constexpr int BATCH = 16, SEQ = 4096, DM = 1024, M = BATCH * SEQ;
constexpr int NH = 8, HD = 64, HW = NH * HD;
constexpr int INC = 3080;
constexpr int NEXP = 256, TOPK = 8, EH = 256;
constexpr int NMOD = 6 * DM;
constexpr int LCAP = 65536;
constexpr float LOG2E = 1.4426950408889634f;
constexpr float EPS = 1e-6f;
constexpr float FOX_SKIP_LOG2 = 80.f;
constexpr float YSCALE = 16.f;
constexpr int NWAVES = 8;
constexpr int NPHASE = 11;
constexpr int N_LAUNCHES = MK_N_LAUNCHES;

constexpr size_t MiB = 1u << 20;
constexpr size_t WS_CTL = 0, CTL_ZERO_BYTES = 1 * MiB;
constexpr size_t WS_DUMP = 512 * 1024;
constexpr size_t WS_MOD = 1 * MiB;
constexpr size_t WS_LF = 2 * MiB;
constexpr size_t WS_KB = 4 * MiB;
constexpr size_t WS_LSE = 6 * MiB;
constexpr size_t WS_WIN = 12 * MiB;
constexpr size_t WS_WOUT = 18 * MiB;
constexpr size_t WS_WR = 20 * MiB;
constexpr size_t WS_WSHGU = WS_WR + MiB / 2;
constexpr size_t WS_WSHD = WS_WSHGU + MiB;
constexpr size_t WS_WTS = 22 * MiB;
constexpr size_t WS_SS0 = WS_MOD + MiB / 2;
constexpr size_t WS_T0 = WS_MOD + MiB / 2 + 65536;
constexpr size_t WS_WD = 24 * MiB;
constexpr size_t WS_WGU = 88 * MiB;
constexpr size_t WS_LIST = 216 * MiB;
constexpr size_t WS_O3 = WS_LIST;
constexpr size_t WS_H = 280 * MiB;
constexpr size_t WS_H8 = 408 * MiB;
constexpr size_t WS_QKV = 472 * MiB;
constexpr size_t WS_ACT = 856 * MiB;
constexpr size_t WS_YSH = 792 * MiB;
constexpr size_t WS_X1A = 728 * MiB;
constexpr size_t WS_X1B = 1000 * MiB;
constexpr size_t WS_END = 1000 * MiB, WS_NEED = 1064 * MiB;
constexpr size_t WS_YBUF = WS_LIST;
constexpr size_t WS_EX = WS_LSE + 4 * MiB;
constexpr size_t WS_POSE = WS_LSE;
constexpr size_t WS_OF = WS_QKV;
constexpr size_t WS_O1 = WS_H, WS_O2 = WS_H + 64 * MiB;
constexpr size_t WS_YM = WS_QKV + 64 * MiB;
constexpr size_t WS_LOGITS = WS_QKV;
constexpr size_t WS_ACTSH = WS_QKV + 64 * MiB;
static_assert(WS_ACT + (size_t)(M * TOPK + NEXP * 256) * EH <= WS_END, "act fits");
static_assert(WS_YBUF + (size_t)M * TOPK * DM <= WS_X1A && WS_X1A + 64 * MiB <= WS_YSH && WS_YSH + (size_t)M * DM <= WS_ACT && WS_X1B + 64 * MiB <= WS_NEED, "ybuf (unpadded rows), x1, ysh fit below act");
static_assert(WS_QKV + 6 * 64 * MiB <= WS_ACT, "qkv below act");
constexpr int CW_TMO = 0, CW_BAR = 4096, CW_CNT = 8192, CW_X1 = 12288;

constexpr int RING_BYTES = 131072;
constexpr int PHASE_LDS = 158720;
constexpr int LDSCTL_OFF = PHASE_LDS, MISC_OFF = LDSCTL_OFF + 320;
constexpr int TAB_OFF = MISC_OFF + 128;
constexpr int RLIST_OFF = RING_BYTES + 2304 * 2;
constexpr int MT2E_OFF = RING_BYTES;
constexpr int LDS_BYTES = 163840;
static_assert(TAB_OFF + 800 * 4 <= LDS_BYTES, "LDS map");

typedef unsigned short bf16_t;
typedef short bf16x8 __attribute__((ext_vector_type(8)));
typedef float f32x4 __attribute__((ext_vector_type(4)));
typedef float f32x2 __attribute__((ext_vector_type(2)));
typedef unsigned u32x4 __attribute__((ext_vector_type(4)));
typedef unsigned u32x2 __attribute__((ext_vector_type(2)));
typedef GAS unsigned gu32;
typedef int v4i_t __attribute__((ext_vector_type(4)));
typedef int v8i_t __attribute__((ext_vector_type(8)));
#define RLX_AGENT __ATOMIC_RELAXED, __HIP_MEMORY_SCOPE_AGENT

__device__ __forceinline__ unsigned cvt_pk_bf16(float lo, float hi) { unsigned r; asm volatile("v_cvt_pk_bf16_f32 %0, %1, %2" : "=v"(r) : "v"(lo), "v"(hi)); return r; }
__device__ __forceinline__ float bf_lo(unsigned w) { return __uint_as_float(w << 16); }
__device__ __forceinline__ float bf_hi(unsigned w) { return __uint_as_float(w & 0xffff0000u); }
__device__ __forceinline__ bf16_t* x1_row(unsigned char* ws, size_t m) { return (bf16_t*)(ws + (m < 32768 ? WS_X1A + m * 2048 : WS_X1B + (m - 32768) * 2048)); }
#define DPPF_(x, ctrl, rm) __int_as_float(__builtin_amdgcn_update_dpp(0, __float_as_int(x), ctrl, rm, 0xF, false))
__device__ __forceinline__ float wave_sum(float v) {
    v += DPPF_(v, 0xB1, 0xF); v += DPPF_(v, 0x4E, 0xF); v += DPPF_(v, 0x141, 0xF); v += DPPF_(v, 0x140, 0xF);
    v += DPPF_(v, 0x142, 0xA); v += DPPF_(v, 0x143, 0xC);
    return __int_as_float(__builtin_amdgcn_readlane(__float_as_int(v), 63));
}
__device__ __forceinline__ float reduce8_heads(const float (&f)[8], int lane) {
    float a[4], b[2];
#pragma unroll
    for (int i = 0; i < 4; ++i) { auto rr = __builtin_amdgcn_permlane32_swap(__float_as_uint(f[i]), __float_as_uint(f[i + 4]), false, false); a[i] = __uint_as_float(rr[0]) + __uint_as_float(rr[1]); }
#pragma unroll
    for (int i = 0; i < 2; ++i) { auto rr = __builtin_amdgcn_permlane16_swap(__float_as_uint(a[i]), __float_as_uint(a[i + 2]), false, false); b[i] = __uint_as_float(rr[0]) + __uint_as_float(rr[1]); }
    const bool b3 = (lane & 8) != 0; const float mine = b3 ? b[1] : b[0], give = b3 ? b[0] : b[1];
    float v = mine + DPPF_(give, 0x128, 0xF);
    v += DPPF_(v, 0xB1, 0xF); v += DPPF_(v, 0x4E, 0xF); v += DPPF_(v, 0x141, 0xF);
    return v;
}

__device__ const unsigned char T5B[3][132] = {
 {0,1,2,3,4,5,6,7,8,9,10,11,12,13,14,15,16,16,16,16,16,16,17,17,17,17,17,17,17,17,18,18,18,18,18,18,18,18,18,18,19,19,19,19,19,19,19,19,19,19,19,19,19,19,20,20,20,20,20,20,20,20,20,20,20,20,20,20,20,20,20,20,20,21,21,21,21,21,21,21,21,21,21,21,21,21,21,21,21,21,21,21,21,21,21,21,21,21,21,22,22,22,22,22,22,22,22,22,22,22,22,22,22,22,22,22,22,22,22,22,22,22,22,22,22,22,22,22,22,0,0,0},
 {0,4,8,12,16,16,17,17,18,18,19,19,19,19,20,20,20,20,20,21,21,21,21,21,21,22,22,22,22,22,22,22,22,22,23,23,23,23,23,23,23,23,23,23,23,23,24,24,24,24,24,24,24,24,24,24,24,24,24,24,24,24,25,25,25,25,25,25,25,25,25,25,25,25,25,25,25,25,25,25,25,25,25,26,26,26,26,26,26,26,26,26,26,26,26,26,26,26,26,26,26,26,26,26,26,26,26,26,26,26,26,26,26,27,27,27,27,27,27,27,27,27,27,27,27,27,27,27,27,0,0,0},
 {0,16,18,19,20,21,21,22,22,23,23,23,24,24,24,24,25,25,25,25,25,26,26,26,26,26,26,26,26,27,27,27,27,27,27,27,27,27,27,28,28,28,28,28,28,28,28,28,28,28,28,28,29,29,29,29,29,29,29,29,29,29,29,29,29,29,29,29,29,29,30,30,30,30,30,30,30,30,30,30,30,30,30,30,30,30,30,30,30,30,30,30,30,30,30,31,31,31,31,31,31,31,31,31,31,31,31,31,31,31,31,31,31,31,31,31,31,31,31,31,31,31,31,31,31,31,31,31,31,0,0,0}};

namespace pg8 {
constexpr int BM = 256, BK = 64, HALF = 128, HTB = HALF * BK * 2, STAGE_BYTES = 8 * HTB, NXCD = 8, WGM = 8;
__host__ __device__ __forceinline__ int lds_byte(int r, int c) { const int st = (r >> 4) * 2 + (c >> 5), rr = r & 15, cc = c & 31, ob = rr * 64 + cc * 2; return st * 1024 + (ob ^ (((ob >> 9) & 1) << 5)); }
__host__ __device__ __forceinline__ void stage_rc(int b, int& R, int& C) { const int st = b / 1024, sb = b % 1024, swz = sb ^ (((sb >> 9) & 1) << 5); R = (st >> 1) * 16 + swz / 64; C = (st & 1) * 32 + (swz % 64) / 2; }
__host__ __device__ __forceinline__ int perm32(int rho) { const int n = rho >> 4, i = rho & 15; return 8 * (i >> 2) + 4 * n + (i & 3); }

struct Unit { int pm, pn, pb, e, tile, cnt, yrow; };
struct Gemm { const bf16_t* A; const bf16_t* Bt; int K; const unsigned* list; };

struct StaticOrder {
    int nM, nN, nwg, G, c;
    __device__ void init(int Mr, int N, int G_, int c_) { nM = Mr / BM; nN = N / BM; nwg = nM * nN; G = G_; c = c_; }
    __device__ bool next(int i, Unit& u) const {
        const int L = i * G + c; if (L >= nwg) return false;
        int wgid = L; { const int q = nwg / NXCD, r = nwg % NXCD, xcd = wgid % NXCD, off = wgid / NXCD; wgid = (xcd < r ? xcd * (q + 1) : r * (q + 1) + (xcd - r) * q) + off; }
        const int nig = WGM * nN, gid = wgid / nig, fm = gid * WGM, gsz = (nM - fm) < WGM ? (nM - fm) : WGM;
        u.pm = fm + ((wgid % nig) % gsz); u.pn = (wgid % nig) / gsz; u.pb = u.pn; u.e = 0; u.tile = 0; u.cnt = 1 << 30; u.yrow = u.pm * BM; return true;
    }
};
struct GroupedOrder {
    const LAS unsigned* tp; const LAS unsigned* cn; int NT, G, c, NTB, pn0, total;
    const LAS unsigned short* mt2e;
    __device__ bool next(int i, Unit& u) const {
        const int L = i * G + c; if (L >= total) return false;
        const int mt = L / NT; u.pn = L % NT;
        const int lo = __builtin_amdgcn_readfirstlane((int)mt2e[mt]);
        u.e = lo; u.pm = mt; u.tile = mt - __builtin_amdgcn_readfirstlane((int)tp[lo]); u.pb = lo * NTB + pn0 + u.pn; u.cnt = __builtin_amdgcn_readfirstlane((int)cn[lo]); u.yrow = __builtin_amdgcn_readfirstlane((int)cn[256 + lo]) + u.tile * BM; return true;
    }
};

struct EpiQKV {
    static constexpr bool PERM = true; static constexpr int NVM = 16;
    bf16_t* O; size_t split_stride; float scale0;
    __device__ __forceinline__ void operator()(const f32x4 (&acc)[2][2][4][2], const Unit& u, int wr, int wc, int fr, int fq) const {
        const int row0 = u.pm * BM + wr * 64 + fr; int colt = u.pn * BM; const int t = colt / 512; bf16_t* base = O + (size_t)t * split_stride; colt -= t * 512;
        const float sc = (t == 0 || t == 3) ? scale0 : 1.f;
        const int col0 = colt + wc * 32 + 8 * fq;
#pragma unroll
        for (int ai = 0; ai < 2; ++ai)
#pragma unroll
            for (int m = 0; m < 4; ++m) { bf16_t* rowp = base + (size_t)(row0 + ai * HALF + m * 16) * 512 + col0;
#pragma unroll
                for (int bj = 0; bj < 2; ++bj) { const f32x4 v0 = acc[ai][bj][m][0] * sc, v1 = acc[ai][bj][m][1] * sc;
                    u32x4 w; w.x = cvt_pk_bf16(v0[0], v0[1]); w.y = cvt_pk_bf16(v0[2], v0[3]); w.z = cvt_pk_bf16(v1[0], v1[1]); w.w = cvt_pk_bf16(v1[2], v1[3]);
                    *(u32x4*)(rowp + bj * HALF) = w; } }
    }
};
struct EpiSwiglu {
    static constexpr bool PERM = true; static constexpr int NVM = 8;
    bf16_t* O;
    __device__ __forceinline__ void operator()(const f32x4 (&acc)[2][2][4][2], const Unit& u, int wr, int wc, int fr, int fq) const {
        const int row0 = u.pm * BM + wr * 64 + fr; const int col0 = u.pn * HALF + wc * 32 + 8 * fq;
#pragma unroll
        for (int ai = 0; ai < 2; ++ai)
#pragma unroll
            for (int m = 0; m < 4; ++m) { bf16_t* rowp = O + (size_t)(row0 + ai * HALF + m * 16) * EH + col0; float r[8];
#pragma unroll
                for (int n = 0; n < 2; ++n)
#pragma unroll
                    for (int i = 0; i < 4; ++i) { const float g = acc[ai][0][m][n][i], up = acc[ai][1][m][n][i]; r[n * 4 + i] = g * __builtin_amdgcn_rcpf(1.f + __expf(-g)) * up; }
                u32x4 w; w.x = cvt_pk_bf16(r[0], r[1]); w.y = cvt_pk_bf16(r[2], r[3]); w.z = cvt_pk_bf16(r[4], r[5]); w.w = cvt_pk_bf16(r[6], r[7]);
                *(u32x4*)rowp = w; }
    }
};
struct EpiSwiglu8 {
    static constexpr bool PERM = true; static constexpr int NVM = 4;
    unsigned char* O;
    __device__ __forceinline__ void operator()(const f32x4 (&acc)[2][2][4][2], const Unit& u, int wr, int wc, int fr, int fq) const {
        const size_t row0 = (size_t)u.pm * BM + wr * 64 + fr + (fq & 1) * HALF; const int col0 = u.pn * HALF + wc * 32 + 8 * (fq & 2);
#pragma unroll
        for (int m = 0; m < 4; ++m) { unsigned w[2][2];
#pragma unroll
            for (int ai = 0; ai < 2; ++ai) { float r[8];
#pragma unroll
                for (int n = 0; n < 2; ++n)
#pragma unroll
                    for (int i = 0; i < 4; ++i) { const float g = acc[ai][0][m][n][i], up = acc[ai][1][m][n][i]; r[n * 4 + i] = g * __builtin_amdgcn_rcpf(1.f + __expf(-g)) * up; }
                int w0 = __builtin_amdgcn_cvt_pk_fp8_f32(r[0], r[1], 0, false); w0 = __builtin_amdgcn_cvt_pk_fp8_f32(r[2], r[3], w0, true);
                int w1 = __builtin_amdgcn_cvt_pk_fp8_f32(r[4], r[5], 0, false); w1 = __builtin_amdgcn_cvt_pk_fp8_f32(r[6], r[7], w1, true);
                w[ai][0] = (unsigned)w0; w[ai][1] = (unsigned)w1; }
            const auto s0 = __builtin_amdgcn_permlane16_swap(w[0][0], w[1][0], false, false); const auto s1 = __builtin_amdgcn_permlane16_swap(w[0][1], w[1][1], false, false);
            u32x4 o; o.x = s0[0]; o.y = s1[0]; o.z = s0[1]; o.w = s1[1];
            *(u32x4*)(O + (row0 + m * 16) * EH + col0) = o; }
    }
};
struct EpiRes {
    static constexpr bool PERM = true; static constexpr int NVM = 0;
    const float* base; float* out; const float* gate;
    __device__ __forceinline__ void operator()(const f32x4 (&acc)[2][2][4][2], const Unit& u, int wr, int wc, int fr, int fq) const {
        const int b = u.pm >> 4; const int col0 = u.pn * BM + wc * 32 + 8 * fq; f32x4 gv[2][2];
#pragma unroll
        for (int bj = 0; bj < 2; ++bj)
#pragma unroll
            for (int n = 0; n < 2; ++n) gv[bj][n] = *(const f32x4*)(gate + (size_t)b * NMOD + col0 + bj * HALF + n * 4);
#pragma unroll
        for (int ai = 0; ai < 2; ++ai)
#pragma unroll
            for (int m = 0; m < 4; ++m) { const size_t off = (size_t)(u.pm * BM + ai * HALF + wr * 64 + m * 16 + fr) * DM + col0;
#pragma unroll
                for (int bj = 0; bj < 2; ++bj)
#pragma unroll
                    for (int n = 0; n < 2; ++n) { const f32x4 bs = *(const f32x4*)(base + off + bj * HALF + n * 4); *(f32x4*)(out + off + bj * HALF + n * 4) = bs + gv[bj][n] * acc[ai][bj][m][n]; } }
    }
};
struct EpiX1 {
    static constexpr bool PERM = true; static constexpr int NVM = 8;
    const float* base; unsigned char* ws; const float* gate;
    __device__ __forceinline__ void operator()(const f32x4 (&acc)[2][2][4][2], const Unit& u, int wr, int wc, int fr, int fq) const {
        const int b = u.pm >> 4; const int col0 = u.pn * BM + wc * 32 + 8 * fq; f32x4 gv[2][2];
#pragma unroll
        for (int bj = 0; bj < 2; ++bj)
#pragma unroll
            for (int n = 0; n < 2; ++n) gv[bj][n] = *(const f32x4*)(gate + (size_t)b * NMOD + col0 + bj * HALF + n * 4);
#pragma unroll
        for (int ai = 0; ai < 2; ++ai) { f32x4 pre[4][2][2];
#pragma unroll
            for (int m = 0; m < 4; ++m) { const size_t off = ((size_t)u.pm * BM + ai * HALF + wr * 64 + m * 16 + fr) * DM + col0;
#pragma unroll
                for (int bj = 0; bj < 2; ++bj) { pre[m][bj][0] = *(const f32x4*)(base + off + bj * HALF); pre[m][bj][1] = *(const f32x4*)(base + off + bj * HALF + 4); } }
            asm volatile("" ::: "memory");
#pragma unroll
            for (int m = 0; m < 4; ++m) { const size_t row = (size_t)u.pm * BM + ai * HALF + wr * 64 + m * 16 + fr; bf16_t* orow = x1_row(ws, row) + col0;
#pragma unroll
                for (int bj = 0; bj < 2; ++bj) { const f32x4 v0 = pre[m][bj][0] + gv[bj][0] * acc[ai][bj][m][0], v1 = pre[m][bj][1] + gv[bj][1] * acc[ai][bj][m][1];
                    u32x4 w; w.x = cvt_pk_bf16(v0[0], v0[1]); w.y = cvt_pk_bf16(v0[2], v0[3]); w.z = cvt_pk_bf16(v1[0], v1[1]); w.w = cvt_pk_bf16(v1[2], v1[3]);
                    *(u32x4*)(orow + bj * HALF) = w; } }
            asm volatile("" ::: "memory"); }
    }
};
struct EpiX1N {
    static constexpr bool PERM = true; static constexpr int NVM = 0;
    const float* base; unsigned char* ws; const float* mod; LAS unsigned char* lds; float* ex; unsigned* cnt;
    __device__ __forceinline__ void operator()(f32x4 (&acc)[2][2][4][2], const Unit& u, int wr, int wc, int fr, int fq) const {
        const int b = u.pm >> 4; const int col0 = u.pn * BM + wc * 32 + 8 * fq; const float* mb = mod + (size_t)b * NMOD;
        LAS float* red = (LAS float*)(lds + RING_BYTES); LAS float* rr = red + 4 * BM;
        float ss[2][4];
        { f32x4 gv[2][2];
#pragma unroll
          for (int bj = 0; bj < 2; ++bj)
#pragma unroll
            for (int n = 0; n < 2; ++n) gv[bj][n] = *(const f32x4*)(mb + 2 * DM + col0 + bj * HALF + n * 4);
#pragma unroll
          for (int am = 0; am < 4; ++am) { const int ai = am >> 1, m0 = (am & 1) * 2; f32x4 pre[2][2][2];
#pragma unroll
            for (int mm = 0; mm < 2; ++mm) { const size_t off = ((size_t)u.pm * BM + ai * HALF + wr * 64 + (m0 + mm) * 16 + fr) * DM + col0;
#pragma unroll
                for (int bj = 0; bj < 2; ++bj) { pre[mm][bj][0] = *(const f32x4*)(base + off + bj * HALF); pre[mm][bj][1] = *(const f32x4*)(base + off + bj * HALF + 4); } }
            asm volatile("" ::: "memory");
#pragma unroll
            for (int mm = 0; mm < 2; ++mm) { const int m = m0 + mm; const size_t row = (size_t)u.pm * BM + ai * HALF + wr * 64 + m * 16 + fr; bf16_t* orow = x1_row(ws, row) + col0; float s2 = 0.f;
#pragma unroll
                for (int bj = 0; bj < 2; ++bj) { const f32x4 v0 = pre[mm][bj][0] + gv[bj][0] * acc[ai][bj][m][0], v1 = pre[mm][bj][1] + gv[bj][1] * acc[ai][bj][m][1];
                    acc[ai][bj][m][0] = v0; acc[ai][bj][m][1] = v1;
                    s2 += ((v0[0] * v0[0] + v0[1] * v0[1]) + (v0[2] * v0[2] + v0[3] * v0[3])) + ((v1[0] * v1[0] + v1[1] * v1[1]) + (v1[2] * v1[2] + v1[3] * v1[3]));
                    u32x4 w; w.x = cvt_pk_bf16(v0[0], v0[1]); w.y = cvt_pk_bf16(v0[2], v0[3]); w.z = cvt_pk_bf16(v1[0], v1[1]); w.w = cvt_pk_bf16(v1[2], v1[3]);
                    *(u32x4*)(orow + bj * HALF) = w; }
                s2 += __shfl_xor(s2, 16); s2 += __shfl_xor(s2, 32); ss[ai][m] = s2; }
            asm volatile("" ::: "memory"); } }
        if (fq == 0) {
#pragma unroll
            for (int ai = 0; ai < 2; ++ai)
#pragma unroll
                for (int m = 0; m < 4; ++m) red[wc * BM + ai * HALF + wr * 64 + m * 16 + fr] = ss[ai][m]; }
        __syncthreads();
        const int tid = threadIdx.x; unsigned* slot = (unsigned*)ex + ((size_t)u.pm * 4) * BM;
        if (tid < BM) { const float tot = (red[tid] + red[BM + tid]) + (red[2 * BM + tid] + red[3 * BM + tid]);
            __hip_atomic_store(slot + u.pn * BM + tid, __float_as_uint(tot), __ATOMIC_RELAXED, __HIP_MEMORY_SCOPE_AGENT); }
        asm volatile("s_waitcnt vmcnt(0)" ::: "memory");
        __syncthreads();
        if (tid == 0) { (void)__hip_atomic_fetch_add(cnt + u.pm, 1u, __ATOMIC_RELAXED, __HIP_MEMORY_SCOPE_AGENT); unsigned sp = 0;
            while (__hip_atomic_load(cnt + u.pm, __ATOMIC_RELAXED, __HIP_MEMORY_SCOPE_AGENT) < 4u) { __builtin_amdgcn_s_sleep(1); if (++sp > (1u << 22)) break; } }
        __syncthreads();
        if (tid < BM) { float t4 = 0.f;
#pragma unroll
            for (int q = 0; q < 4; ++q) t4 += __uint_as_float(__hip_atomic_load(slot + q * BM + tid, __ATOMIC_RELAXED, __HIP_MEMORY_SCOPE_AGENT));
            rr[tid] = 1.f / sqrtf(t4 * (1.f / DM) + EPS); }
        __syncthreads();
        f32x4 sc[2][2], sh[2][2];
#pragma unroll
        for (int bj = 0; bj < 2; ++bj)
#pragma unroll
            for (int n = 0; n < 2; ++n) { sc[bj][n] = *(const f32x4*)(mb + 4 * DM + col0 + bj * HALF + n * 4) + 1.f; sh[bj][n] = *(const f32x4*)(mb + 3 * DM + col0 + bj * HALF + n * 4); }
        bf16_t* H2 = (bf16_t*)(ws + WS_H); unsigned char* H8 = ws + WS_H8;
        const int col8 = u.pn * BM + (fq & 1) * HALF + wc * 32 + 8 * (fq & 2);
#pragma unroll
        for (int ai = 0; ai < 2; ++ai)
#pragma unroll
            for (int m = 0; m < 4; ++m) { const int rl = ai * HALF + wr * 64 + m * 16 + fr; const size_t row = (size_t)u.pm * BM + rl; const float r = rr[rl]; unsigned w8[2][2];
#pragma unroll
                for (int bj = 0; bj < 2; ++bj) { const f32x4 h0 = acc[ai][bj][m][0] * r * sc[bj][0] + sh[bj][0], h1 = acc[ai][bj][m][1] * r * sc[bj][1] + sh[bj][1];
                    u32x4 w; w.x = cvt_pk_bf16(h0[0], h0[1]); w.y = cvt_pk_bf16(h0[2], h0[3]); w.z = cvt_pk_bf16(h1[0], h1[1]); w.w = cvt_pk_bf16(h1[2], h1[3]);
                    *(u32x4*)(H2 + row * DM + col0 + bj * HALF) = w;
                    int q0 = __builtin_amdgcn_cvt_pk_fp8_f32(h0[0], h0[1], 0, false); q0 = __builtin_amdgcn_cvt_pk_fp8_f32(h0[2], h0[3], q0, true);
                    int q1 = __builtin_amdgcn_cvt_pk_fp8_f32(h1[0], h1[1], 0, false); q1 = __builtin_amdgcn_cvt_pk_fp8_f32(h1[2], h1[3], q1, true);
                    w8[bj][0] = (unsigned)q0; w8[bj][1] = (unsigned)q1; }
                const auto s0 = __builtin_amdgcn_permlane16_swap(w8[0][0], w8[1][0], false, false); const auto s1 = __builtin_amdgcn_permlane16_swap(w8[0][1], w8[1][1], false, false);
                u32x4 o; o.x = s0[0]; o.y = s1[0]; o.z = s0[1]; o.w = s1[1];
                *(u32x4*)(H8 + row * DM + col8) = o; }
    }
};
struct EpiF32 {
    static constexpr bool PERM = false; static constexpr int NVM = 16;
    float* out; int ldc;
    __device__ __forceinline__ void operator()(const f32x4 (&acc)[2][2][4][2], const Unit& u, int wr, int wc, int fr, int fq) const {
        const int col0 = u.pn * BM + wc * 32 + 4 * fq;
#pragma unroll
        for (int ai = 0; ai < 2; ++ai)
#pragma unroll
            for (int m = 0; m < 4; ++m) { const size_t off = (size_t)(u.pm * BM + ai * HALF + wr * 64 + m * 16 + fr) * ldc + col0;
#pragma unroll
                for (int bj = 0; bj < 2; ++bj)
#pragma unroll
                    for (int n = 0; n < 2; ++n) *(f32x4*)(out + off + bj * HALF + n * 16) = acc[ai][bj][m][n]; }
    }
};
struct EpiYbuf {
    static constexpr bool PERM = true; static constexpr int NVM = 8;
    unsigned char* Y; unsigned char* dump;
    __device__ __forceinline__ void operator()(const f32x4 (&acc)[2][2][4][2], const Unit& u, int wr, int wc, int fr, int fq) const {
        const int colb = u.pn * BM + wc * 64 + (fq & 1) * 32 + 8 * (fq & 2);
#pragma unroll
        for (int ai = 0; ai < 2; ++ai)
#pragma unroll
            for (int m = 0; m < 4; ++m) { const int rl = ai * HALF + wr * 64 + m * 16 + fr; const size_t row = (size_t)u.yrow + rl; const bool live = u.tile * BM + rl < u.cnt;
                unsigned w[2][2];
#pragma unroll
                for (int bj = 0; bj < 2; ++bj) { f32x4 v0 = acc[ai][bj][m][0] * YSCALE, v1 = acc[ai][bj][m][1] * YSCALE;
#pragma unroll
                    for (int i = 0; i < 4; ++i) { v0[i] = __builtin_amdgcn_fmed3f(v0[i], -440.f, 440.f); v1[i] = __builtin_amdgcn_fmed3f(v1[i], -440.f, 440.f); }
                    int w0 = __builtin_amdgcn_cvt_pk_fp8_f32(v0[0], v0[1], 0, false); w0 = __builtin_amdgcn_cvt_pk_fp8_f32(v0[2], v0[3], w0, true);
                    int w1 = __builtin_amdgcn_cvt_pk_fp8_f32(v1[0], v1[1], 0, false); w1 = __builtin_amdgcn_cvt_pk_fp8_f32(v1[2], v1[3], w1, true);
                    w[bj][0] = (unsigned)w0; w[bj][1] = (unsigned)w1; }
                const auto s0 = __builtin_amdgcn_permlane16_swap(w[0][0], w[1][0], false, false); const auto s1 = __builtin_amdgcn_permlane16_swap(w[0][1], w[1][1], false, false);
                u32x4 o; o.x = s0[0]; o.y = s1[0]; o.z = s0[1]; o.w = s1[1];
                *(u32x4*)(live ? Y + row * DM + colb : dump + (size_t)rl * DM + colb) = o; }
    }
};

template <class Epi, class Sched, bool GATHER, bool FP8 = false, bool SHORTK = false, int VAR = 0, bool HOIST = false>
__device__ __forceinline__ void gemm_phase(LAS unsigned char* lds, const Gemm g, const Sched& S, const Epi& E) {
    int tid_ = threadIdx.x; asm volatile("" : "+v"(tid_));
    const int tid = tid_, wid = __builtin_amdgcn_readfirstlane(tid >> 6), lane = tid & 63, wr = wid >> 2, wc = wid & 3, fr = lane & 15, fq = lane >> 4;
    int K_ = g.K; if constexpr (SHORTK) asm volatile("" : "+s"(K_));
    const int K = K_, nt = K / BK;
    unsigned voffA[2], voffB[2];
#pragma unroll
    for (int i = 0; i < 2; ++i) { int R, C; stage_rc(tid * 16 + i * 8192, R, C); const int Rb = Epi::PERM ? ((R & ~31) + perm32(R & 31)) : R;
        voffA[i] = (unsigned)(R * K + C) * 2u; voffB[i] = (unsigned)(Rb * K + C) * 2u; }
    const size_t kstep = (size_t)(BK * 2);
    const size_t hstep = (size_t)HALF * K * 2;
    const size_t tstep = 2 * hstep;
    const unsigned ldsw = (unsigned)wid * 1024u;
    const int aoff = lds_byte(wr * 64 + fr, fq * 8), boff = lds_byte(wc * 32 + fr, fq * 8);
#define PG8_SA(b, h) (((b) * 2 + (h)) * HTB)
#define PG8_SB(b, h) ((4 + (b) * 2 + (h)) * HTB)
#define PG8_GLDS(src, bufoff, i) if constexpr (!(VAR & 1)) __builtin_amdgcn_global_load_lds((const unsigned*)(src), (LAS unsigned*)(lds + (bufoff) + ldsw + (i) * 8192), 16, 0, 0)
#define PG8_STAGE(bufoff, gbase, voff) do { _Pragma("unroll") for (int _i = 0; _i < 2; ++_i) PG8_GLDS((const char*)(gbase) + (voff)[_i], bufoff, _i); } while (0)
#define PG8_STA(bufoff, aptr, h, SEL) do { if constexpr (GATHER) { const unsigned _p = (SEL) ? gvn[h] : gvc[h]; _Pragma("unroll") for (int _i = 0; _i < 2; ++_i) { unsigned _c = voffB[_i]; asm volatile("" : "+v"(_c)); \
            const unsigned _o = ((_i ? (_p >> 16) : (_p & 0xffffu)) * (unsigned)(K * 2)) + (_c & (unsigned)(K * 2 - 1)); PG8_GLDS((const char*)(aptr) + _o, bufoff, _i); } } \
        else { PG8_STAGE(bufoff, (const char*)(aptr) + (h) * hstep, voffA); } } while (0)
#define PG8_LDA(dst, b, h) do { _Pragma("unroll") for (int m = 0; m < 4; ++m) _Pragma("unroll") for (int k = 0; k < 2; ++k) dst[m][k] = *(const LAS bf16x8*)(lds + PG8_SA(b, h) + aoff + m * 2048 + k * 1024); } while (0)
#define PG8_LDB(dst, b, h) do { _Pragma("unroll") for (int n = 0; n < 2; ++n) _Pragma("unroll") for (int k = 0; k < 2; ++k) dst[n][k] = *(const LAS bf16x8*)(lds + PG8_SB(b, h) + boff + n * 2048 + k * 1024); } while (0)
#define PG8_CAT8(lo, hi) ({ const v4i_t a_ = __builtin_bit_cast(v4i_t, lo), b_ = __builtin_bit_cast(v4i_t, hi); (v8i_t){a_.x, a_.y, a_.z, a_.w, b_.x, b_.y, b_.z, b_.w}; })
#define PG8_MMA(ai, bj, At, Bt) do { __builtin_amdgcn_s_setprio(1); if constexpr (VAR & 2) { asm volatile("" :: "v"(At[0][0]), "v"(At[3][1]), "v"(Bt[0][0]), "v"(Bt[1][1])); } else if constexpr (FP8) { _Pragma("unroll") for (int m = 0; m < 4; ++m) _Pragma("unroll") for (int n = 0; n < 2; ++n) \
        acc[ai][bj][m][n] = __builtin_amdgcn_mfma_scale_f32_16x16x128_f8f6f4(PG8_CAT8(Bt[n][0], Bt[n][1]), PG8_CAT8(At[m][0], At[m][1]), acc[ai][bj][m][n], 0, 0, 0, 0x7F7F7F7F, 0, 0x7F7F7F7F); } \
      else { _Pragma("unroll") for (int m = 0; m < 4; ++m) _Pragma("unroll") for (int n = 0; n < 2; ++n) _Pragma("unroll") for (int k = 0; k < 2; ++k) \
        acc[ai][bj][m][n] = __builtin_amdgcn_mfma_f32_16x16x32_bf16(Bt[n][k], At[m][k], acc[ai][bj][m][n], 0, 0, 0); } \
      if constexpr (SHORTK) { _Pragma("unroll") for (int m = 0; m < 4; ++m) _Pragma("unroll") for (int n = 0; n < 2; ++n) asm volatile("" : "+v"(acc[ai][bj][m][n])); }     \
      __builtin_amdgcn_s_setprio(0); } while (0)
#define PG8_WAIT_V(n) asm volatile("s_waitcnt vmcnt(" #n ")" ::: "memory")
#define PG8_WAIT_VF() do { if (fst) asm volatile("s_waitcnt vmcnt(%0)" :: "n"(8 + NQ) : "memory"); else asm volatile("s_waitcnt vmcnt(8)" ::: "memory"); } while (0)
#define PG8_WAIT_L(n) asm volatile("s_waitcnt lgkmcnt(" #n ")" ::: "memory")
#define PG8_BAR __builtin_amdgcn_s_barrier()
#define PG8_SCHED __builtin_amdgcn_sched_barrier(0)
#define PG8_ROWS_LOAD(u, ld) do { _Pragma("unroll") for (int _h = 0; _h < 2; ++_h) _Pragma("unroll") for (int _i = 0; _i < 2; ++_i) { int _R, _C; stage_rc(tid * 16 + _i * 8192, _R, _C); const int _idx = (u).tile * BM + _h * HALF + _R; \
            const int _ic = _idx < (u).cnt ? _idx : (u).cnt - 1; ld[_h][_i] = g.list[(size_t)(u).e * LCAP + _ic]; } } while (0)
#define PG8_ROWS_USE(u, ld, gv) do { asm volatile("" : "+v"(ld[0][0]), "+v"(ld[0][1]), "+v"(ld[1][0]), "+v"(ld[1][1])); \
        _Pragma("unroll") for (int _h = 0; _h < 2; ++_h) { unsigned _t2[2]; _Pragma("unroll") for (int _i = 0; _i < 2; ++_i) { int _R, _C; stage_rc(tid * 16 + _i * 8192, _R, _C); const int _idx = (u).tile * BM + _h * HALF + _R; \
            _t2[_i] = (_idx < (u).cnt) ? (ld[_h][_i] & 0xffffu) : 0u; } gv[_h] = _t2[0] | (_t2[1] << 16); } } while (0)
    constexpr int NQ = Epi::NVM + (GATHER ? 1 : 0);
#define PG8_ROWS_DMA(u) __builtin_amdgcn_global_load_lds((const unsigned*)(g.list + (size_t)(u).e * LCAP + (u).tile * BM + (wid & 3) * 64 + lane), (LAS unsigned*)(lds + RLIST_OFF + (wid & 3) * 256), 4, 0, 0)
#define PG8_ROWS_USE_LDS(u, gv) do { _Pragma("unroll") for (int _h = 0; _h < 2; ++_h) { unsigned _t2[2]; _Pragma("unroll") for (int _i = 0; _i < 2; ++_i) { int _R, _C; stage_rc(tid * 16 + _i * 8192, _R, _C); const int _idx = (u).tile * BM + _h * HALF + _R; \
            const unsigned _v = *(const LAS unsigned*)(lds + RLIST_OFF + (_h * HALF + _R) * 4); _t2[_i] = (_idx < (u).cnt) ? (_v & 0xffffu) : 0u; } gv[_h] = _t2[0] | (_t2[1] << 16); } } while (0)
    Unit cur, nxt; int ui = 0;
    if (!S.next(0, cur)) return;
    f32x4 acc[2][2][4][2];
#pragma unroll
    for (int a = 0; a < 2; ++a)
#pragma unroll
        for (int b = 0; b < 2; ++b)
#pragma unroll
            for (int m = 0; m < 4; ++m)
#pragma unroll
                for (int n = 0; n < 2; ++n) acc[a][b][m][n] = (f32x4){0.f, 0.f, 0.f, 0.f};
    bf16x8 At[4][2], B0[2][2], B1[2][2];
    unsigned gvc[2] = {0u, 0u}, gvn[2] = {0u, 0u};
    if constexpr (GATHER) { unsigned rld[2][2]; PG8_ROWS_LOAD(cur, rld); PG8_ROWS_USE(cur, rld, gvc); }
    const char* cA = GATHER ? (const char*)g.A : (const char*)g.A + (size_t)cur.pm * tstep; const char* cB = (const char*)g.Bt + (size_t)cur.pb * tstep;
    PG8_STAGE(PG8_SB(0, 0), cB, voffB); PG8_STAGE(PG8_SB(0, 1), cB + hstep, voffB); PG8_STA(PG8_SA(0, 0), cA, 0, false); PG8_STA(PG8_SA(0, 1), cA, 1, false);
    if (wr == 1) PG8_BAR;
    PG8_WAIT_V(2); PG8_BAR;
    PG8_STAGE(PG8_SB(1, 0), cB + kstep, voffB); PG8_STA(PG8_SA(1, 0), cA + kstep, 0, false); PG8_STAGE(PG8_SB(1, 1), cB + hstep + kstep, voffB);
    PG8_WAIT_V(6); PG8_BAR;
    for (;;) {
        const bool has_next = S.next(ui + 1, nxt);
        const char* nA = has_next ? (GATHER ? (const char*)g.A : (const char*)g.A + (size_t)nxt.pm * tstep) : cA; const char* nB = has_next ? (const char*)g.Bt + (size_t)nxt.pb * tstep : cB;
        if constexpr (GATHER) { if (!has_next) { nxt = cur; gvn[0] = gvc[0]; gvn[1] = gvc[1]; } PG8_ROWS_DMA(nxt); }
        int t = 0;
        do {
            const bool last = (t == nt - 2);
            const bool fst = HOIST && (t == 0) && (ui > 0);
            if constexpr (GATHER) { if (last && has_next) { PG8_ROWS_USE_LDS(nxt, gvn); } }
            const char* a1 = cA + (size_t)(t + 1) * kstep;
            const char* a2 = last ? nA : cA + (size_t)(t + 2) * kstep; const char* b2 = last ? nB : cB + (size_t)(t + 2) * kstep;
            const char* a3 = a2 + kstep; const char* b3 = b2 + kstep;
            PG8_LDB(B0, 0, 0); PG8_LDB(B1, 0, 1); PG8_SCHED; PG8_LDA(At, 0, 0); if (!fst) PG8_STA(PG8_SA(1, 1), a1, 1, false);
            PG8_WAIT_VF(); PG8_WAIT_L(0); PG8_BAR; PG8_MMA(0, 0, At, B0); PG8_MMA(0, 1, At, B1); PG8_BAR; PG8_SCHED;
            PG8_LDA(At, 0, 1); PG8_STAGE(PG8_SB(0, 0), b2, voffB); PG8_STAGE(PG8_SB(0, 1), b2 + hstep, voffB); PG8_STA(PG8_SA(0, 0), a2, 0, last);
            PG8_WAIT_VF(); PG8_WAIT_L(0); PG8_BAR; PG8_MMA(1, 0, At, B0); PG8_MMA(1, 1, At, B1); PG8_BAR; PG8_SCHED;
            PG8_LDB(B0, 1, 0); PG8_LDB(B1, 1, 1); PG8_SCHED; PG8_LDA(At, 1, 0); PG8_STA(PG8_SA(0, 1), a2, 1, last);
            PG8_WAIT_VF(); PG8_WAIT_L(0); PG8_BAR; PG8_MMA(0, 0, At, B0); PG8_MMA(0, 1, At, B1); PG8_BAR; PG8_SCHED;
            PG8_LDA(At, 1, 1); PG8_STAGE(PG8_SB(1, 0), b3, voffB); PG8_STAGE(PG8_SB(1, 1), b3 + hstep, voffB); PG8_STA(PG8_SA(1, 0), a3, 0, last);
            PG8_WAIT_V(8); PG8_WAIT_L(0); PG8_BAR; PG8_MMA(1, 0, At, B0); PG8_MMA(1, 1, At, B1); PG8_BAR; PG8_SCHED;
            t += 2;
        } while (t < nt);
        if constexpr (HOIST) PG8_STA(PG8_SA(1, 1), nA + kstep, 1, true);
        if (wr == 0) PG8_BAR;
        { int te_ = threadIdx.x; asm volatile("" : "+v"(te_)); int fr_ = te_ & 15, fq_ = (te_ >> 4) & 3; asm volatile("" : "+v"(fr_), "+v"(fq_));
          if constexpr (!(VAR & 4)) E(acc, cur, wr, wc, fr_, fq_); else { _Pragma("unroll") for (int a = 0; a < 2; ++a) _Pragma("unroll") for (int b = 0; b < 2; ++b) _Pragma("unroll") for (int m = 0; m < 4; ++m) _Pragma("unroll") for (int n = 0; n < 2; ++n) asm volatile("" :: "v"(acc[a][b][m][n])); } }
        if (!has_next) break;
#pragma unroll
        for (int a = 0; a < 2; ++a)
#pragma unroll
            for (int b = 0; b < 2; ++b)
#pragma unroll
                for (int m = 0; m < 4; ++m)
#pragma unroll
                    for (int n = 0; n < 2; ++n) acc[a][b][m][n] = (f32x4){0.f, 0.f, 0.f, 0.f};
        cur = nxt; cA = nA; cB = nB; ++ui;
        if constexpr (GATHER) { gvc[0] = gvn[0]; gvc[1] = gvn[1]; }
        if (wr == 1) PG8_BAR;
    }
    PG8_WAIT_V(0);
    PG8_BAR;
#undef PG8_SA
#undef PG8_SB
#undef PG8_GLDS
#undef PG8_STAGE
#undef PG8_STA
#undef PG8_LDA
#undef PG8_LDB
#undef PG8_MMA
#undef PG8_CAT8
#undef PG8_WAIT_V
#undef PG8_WAIT_VF
#undef PG8_WAIT_L
#undef PG8_BAR
#undef PG8_SCHED
#undef PG8_ROWS_LOAD
#undef PG8_ROWS_USE
#undef PG8_ROWS_DMA
#undef PG8_ROWS_USE_LDS
}
}

namespace attn_body {
using bf16 = __hip_bfloat16;
using s16x4 = __attribute__((ext_vector_type(4))) short;
using f32x16 = __attribute__((ext_vector_type(16))) float;
constexpr int D = 64, NW = 8, QBLK = 32, QB = QBLK * NW, KVBLK = 64;
__device__ __forceinline__ int crow(int r, int hi) { return (r & 3) + 8 * (r >> 2) + 4 * hi; }
#define SBAR() __builtin_amdgcn_sched_barrier(0)
__device__ __forceinline__ void cmask(f32x16& p0, f32x16& p1, int jb, int qrel, int hi) {
  const float NEG = -INFINITY; int kb = 64 * jb + 4 * hi;
  #pragma unroll
  for (int r = 0; r < 16; ++r) { int kv = kb + (r & 3) + 8 * (r >> 2); if (kv > qrel) p0[r] = NEG; if (kv + 32 > qrel) p1[r] = NEG; }
}
constexpr int NSLOT = 3, SLOTB = 8192;
constexpr int LDS_K = 0, LDS_V = NSLOT * SLOTB, LDS_WS = 2 * NSLOT * SLOTB, LDS_OST = LDS_WS + NW * 64 * 4, LDS_BYTES = LDS_OST + NW * 4096;
constexpr int LDS_KBT = LDS_BYTES;
constexpr int LDS_TREV = LDS_KBT + 16384;
constexpr int LDS_TOTAL = LDS_TREV + 3072;
constexpr float C2 = 0.125f * 1.4426950408889634f;
__device__ __forceinline__ void glds16(const void* gsrc, unsigned lds_dst) { unsigned keep;
  asm volatile("s_mov_b32 %0, m0\n\ts_mov_b32 m0, %2\n\ts_nop 0\n\tglobal_load_lds_dwordx4 %1, off\n\ts_mov_b32 m0, %0" : "=&s"(keep) : "v"(gsrc), "s"(lds_dst) : "memory"); }
__device__ __forceinline__ float max3f(float a, float b, float c) { float r; asm("v_max3_f32 %0, %1, %2, %3" : "=v"(r) : "v"(a), "v"(b), "v"(c)); return r; }
__device__ __forceinline__ float max2f(float a, float b) { float r; asm("v_max_f32_e32 %0, %1, %2" : "=v"(r) : "v"(a), "v"(b)); return r; }
__device__ __forceinline__ float fadd_s(float a, float b) { float r; asm("v_add_f32_e32 %0, %1, %2" : "=v"(r) : "v"(a), "v"(b)); return r; }
__device__ __forceinline__ float fsub_s(float a, float b) { float r; asm("v_sub_f32_e32 %0, %1, %2" : "=v"(r) : "v"(a), "v"(b)); return r; }
typedef float f32x2_t __attribute__((ext_vector_type(2))); typedef __bf16 bf16x2_t __attribute__((ext_vector_type(2)));
__device__ __forceinline__ unsigned cvtpk_s(float lo, float hi) { f32x2_t v = {lo, hi}; bf16x2_t b = __builtin_convertvector(v, bf16x2_t); return __builtin_bit_cast(unsigned, b); }
#define WAIT_BAR(N) asm volatile("s_waitcnt vmcnt(" #N ") lgkmcnt(0)\n\ts_barrier" ::: "memory")

__device__ __forceinline__ void qkt(f32x16& p0, f32x16& p1, const char* Kslot, const bf16x8* qr, int r32, int hi) {
  const char* kb = Kslot + hi * 1024 + r32 * 16;
  #pragma unroll
  for (int d0 = 0; d0 < 4; ++d0) {
    const bf16x8 b0 = *reinterpret_cast<const bf16x8*>(kb + d0 * 2048);
    const bf16x8 b1 = *reinterpret_cast<const bf16x8*>(kb + d0 * 2048 + 512);
    p0 = __builtin_amdgcn_mfma_f32_32x32x16_bf16(b0, qr[d0], p0, 0, 0, 0); p1 = __builtin_amdgcn_mfma_f32_32x32x16_bf16(b1, qr[d0], p1, 0, 0, 0); }
}
typedef __attribute__((address_space(3))) const char* lds_cptr;
typedef short v4i16_t __attribute__((ext_vector_type(4)));
__device__ __forceinline__ void kload8(bf16x8* kf, lds_cptr kp) {
  kf[0] = *(const LAS bf16x8*)(kp);        kf[1] = *(const LAS bf16x8*)(kp + 512);
  kf[2] = *(const LAS bf16x8*)(kp + 2048); kf[3] = *(const LAS bf16x8*)(kp + 2560);
  kf[4] = *(const LAS bf16x8*)(kp + 4096); kf[5] = *(const LAS bf16x8*)(kp + 4608);
  kf[6] = *(const LAS bf16x8*)(kp + 6144); kf[7] = *(const LAS bf16x8*)(kp + 6656);
}
__device__ __forceinline__ void kload2(bf16x8* kf, lds_cptr kp, int j) { kf[2 * j] = *(const LAS bf16x8*)(kp + j * 2048); kf[2 * j + 1] = *(const LAS bf16x8*)(kp + j * 2048 + 512); }
__device__ __forceinline__ s16x4 vtr(lds_cptr p) { return __builtin_bit_cast(s16x4, __builtin_amdgcn_ds_read_tr16_b64_v4i16((LAS v4i16_t*)p)); }
__device__ __forceinline__ float rowmax(const f32x16& p0, const f32x16& p1) {
  float a = max3f(p0[0], p0[1], p1[0]), b = max3f(p0[2], p0[3], p1[1]); a = max3f(a, p1[2], p1[3]);
  #pragma unroll
  for (int r = 4; r < 16; r += 4) { a = max3f(a, p0[r], p0[r + 1]); b = max3f(b, p0[r + 2], p0[r + 3]); a = max3f(a, p1[r], p1[r + 1]); b = max3f(b, p1[r + 2], p1[r + 3]); }
  const float m = max2f(a, b);
  auto rr = __builtin_amdgcn_permlane32_swap(__float_as_uint(m), __float_as_uint(m), false, false);
  return max2f(__uint_as_float(rr[0]), __uint_as_float(rr[1]));
}
__device__ __forceinline__ void pv(f32x16* o, int vb, bf16x8 pa0, bf16x8 pa1, bf16x8 pa2, bf16x8 pa3) {
  #pragma unroll
  for (int d0 = 0; d0 < 2; ++d0) { s16x4 lo[4], hi[4];
    #pragma unroll
    for (int ks = 0; ks < 4; ++ks) {
      asm volatile("ds_read_b64_tr_b16 %0,%1 offset:%c2" : "=&v"(lo[ks]) : "v"(vb), "i"(d0 * 4096 + ks * 1024) : "memory");
      asm volatile("ds_read_b64_tr_b16 %0,%1 offset:%c2" : "=&v"(hi[ks]) : "v"(vb), "i"(d0 * 4096 + ks * 1024 + 512) : "memory"); }
    asm volatile("s_waitcnt lgkmcnt(0)" ::: "memory"); SBAR();
    #define PK(k) (bf16x8){lo[k][0], lo[k][1], lo[k][2], lo[k][3], hi[k][0], hi[k][1], hi[k][2], hi[k][3]}
    o[d0] = __builtin_amdgcn_mfma_f32_32x32x16_bf16(pa0, PK(0), o[d0], 0, 0, 0);
    o[d0] = __builtin_amdgcn_mfma_f32_32x32x16_bf16(pa1, PK(1), o[d0], 0, 0, 0);
    o[d0] = __builtin_amdgcn_mfma_f32_32x32x16_bf16(pa2, PK(2), o[d0], 0, 0, 0);
    o[d0] = __builtin_amdgcn_mfma_f32_32x32x16_bf16(pa3, PK(3), o[d0], 0, 0, 0);
    #undef PK
  }
}
#define ATTN_STORE16(p, v) (*(u32x4*)(p) = (v))
template <int THRL, int MODE> __device__ __forceinline__ void attn_unit(const bf16* Qp, const bf16* __restrict__ Kp, const bf16* __restrict__ Vp, bf16* Op, long RS, long ORS, int q0, int T0, int NT, int off,
                                                                        float* lsep, long lse_stride, char* shm, const float* kbsrc, const float* relb, int dsel) {
  int tid_ = threadIdx.x; asm volatile("" : "+v"(tid_));
  const int tid = tid_, lane = tid & 63, r32 = lane & 31, hi = lane >> 5; const int wid = __builtin_amdgcn_readfirstlane(tid >> 6);
  const bf16* Qw = Qp + (long)(q0 + wid * QBLK) * RS;
  const bf16* Kh = Kp + (long)T0 * KVBLK * RS, *Vh = Vp + (long)T0 * KVBLK * RS;
  const unsigned lds0 = (unsigned)(uintptr_t)shm;
  float* wsf = (float*)(shm + LDS_WS) + wid * 64;
  const int qrel = wid * QBLK + r32;
  const LAS float* tbase;
  if (MODE == 0) { LAS float* kbt = (LAS float*)(shm + LDS_KBT); const int nk = q0 + QB;
    for (int i = 64 * T0 + tid * 4; i < nk; i += 2048) *(LAS f32x4*)(kbt + i) = *(const f32x4*)(kbsrc + i);
    tbase = kbt + 4 * hi + 64 * T0;
  } else { LAS float* tr = (LAS float*)(shm + LDS_TREV);
    for (int u = tid; u < 768; u += 512) { const int j = 383 - u; float v = -INFINITY; if (j >= 0 && j <= 128) v = relb[(int)T5B[dsel][j] * NH] * LOG2E; tr[u] = v; }
    tbase = tr + (383 - off - qrel + 4 * hi);
  }
  const bf16* ksrc = Kh + (long)lane * RS + wid * 8;
  const bf16* vsrc = Vh + (long)(16 * (wid & 3) + (lane >> 2)) * RS + (wid >> 2) * 32 + (lane & 3) * 8;
  const unsigned kdst = lds0 + LDS_K + wid * 1024, vdst = lds0 + LDS_V + wid * 1024;
  #define DMA_K(t, slot) glds16(ksrc + (long)(t) * KVBLK * RS, (unsigned)__builtin_amdgcn_readfirstlane(kdst + (slot)))
  #define DMA_V(t, slot) glds16(vsrc + (long)(t) * KVBLK * RS, (unsigned)__builtin_amdgcn_readfirstlane(vdst + (slot)))
  const int vb0 = (int)(lds0 + LDS_V) + ((lane >> 4) & 1) * 32 + (lane & 3) * 8 + (4 * hi + ((lane & 15) >> 2)) * 64;
  const char* Kbase = shm + LDS_K; bf16x8 kf[8];
  const lds_cptr shm3 = (lds_cptr)shm; const lds_cptr kp0 = shm3 + LDS_K + hi * 1024 + r32 * 16; const lds_cptr vp0 = shm3 + LDS_V + ((lane >> 4) & 1) * 32 + (lane & 3) * 8 + (4 * hi + ((lane & 15) >> 2)) * 64;
  DMA_K(0, 0); DMA_V(0, 0); DMA_K(1, SLOTB);
  bf16x8 qr[4];
  #pragma unroll
  for (int d0 = 0; d0 < 4; ++d0) qr[d0] = *reinterpret_cast<const bf16x8*>(&Qw[(long)r32 * RS + d0 * 16 + hi * 8]);
  float mhat = 0.f, l_reg = 0.f; f32x16 o[2]; o[0] = f32x16{}; o[1] = f32x16{};
  #define BLOAD(P0, P1, t) do { const LAS float* tb_ = tbase + 64 * (t); \
      if (MODE == 0) { _Pragma("unroll") for (int g_ = 0; g_ < 4; ++g_) { const f32x4 b0_ = *(const LAS f32x4*)(tb_ + 8 * g_), b1_ = *(const LAS f32x4*)(tb_ + 32 + 8 * g_); \
          _Pragma("unroll") for (int i_ = 0; i_ < 4; ++i_) { P0[4 * g_ + i_] = b0_[i_]; P1[4 * g_ + i_] = b1_[i_]; } } } \
      else { _Pragma("unroll") for (int r_ = 0; r_ < 16; ++r_) { P0[r_] = tb_[(r_ & 3) + 8 * (r_ >> 2)]; P1[r_] = tb_[32 + (r_ & 3) + 8 * (r_ >> 2)]; } } } while (0)
  #define CMASK(P0, P1, t) do { if (MODE == 0) { int jb_ = (t) - (NT - 4); if (jb_ >= 0) cmask(P0, P1, jb_, qrel, hi); } } while (0)
  bool resc = false;
  #define START(P0, P1) do { const float rm = rowmax(P0, P1); resc = false; mhat = max2f(rm, -1000.f); \
    _Pragma("unroll") for (int r = 0; r < 16; ++r) P0[r] = __builtin_amdgcn_exp2f(fsub_s(P0[r], mhat)); } while (0)
  #define RESC() do { if (resc) { asm volatile("s_waitcnt lgkmcnt(0)" ::: "memory"); \
      _Pragma("unroll") for (int d_ = 0; d_ < 2; ++d_) _Pragma("unroll") for (int r = 0; r < 16; ++r) o[d_][r] *= wsf[crow(r, hi)]; } } while (0)
  f32x16 pA0, pA1, pB0, pB1;
  int sl_prev = 0, sl_cur = 0, sl_next = SLOTB;
  #define ROT() do { sl_prev = sl_cur; sl_cur = sl_next; sl_next = (sl_next == (NSLOT - 1) * SLOTB) ? 0 : sl_next + SLOTB; } while (0)
  DMA_K(2, 2 * SLOTB);
  WAIT_BAR(3);
  BLOAD(pA0, pA1, 0);
  qkt(pA0, pA1, Kbase, qr, r32, hi); asm volatile("s_nop 15\n\ts_nop 7" : "+v"(pA0), "+v"(pA1)); CMASK(pA0, pA1, 0);
  START(pA0, pA1);
  _Pragma("unroll") for (int r = 0; r < 16; ++r) pA1[r] = __builtin_amdgcn_exp2f(fsub_s(pA1[r], mhat));
  BLOAD(pB0, pB1, 1);
  WAIT_BAR(0);
  DMA_K(3, 0); DMA_V(1, SLOTB);
  ROT();
  kload8(kf, kp0 + sl_cur);
  WAIT_BAR(2);
  s16x4 vlo[8], vhi[8]; u32x4 pw0, pw1, pw2, pw3;
  #define PKW(P, B) cvtpk_s(P[B], P[B + 1])
  #define PAF(k) __builtin_bit_cast(bf16x8, pw##k)
  #define VFR(i) (bf16x8){vlo[i][0], vlo[i][1], vlo[i][2], vlo[i][3], vhi[i][0], vhi[i][1], vhi[i][2], vhi[i][3]}
  #define PIN(x) asm volatile("" : "+v"(x))
  #define MX3(a, b, c) __builtin_fmaxf(__builtin_fmaxf((a), (b)), (c))
  #define GAPA(MF, A0, A1, A2, A3, W0, W1, PW) do { MF; sacc += A0; sacc += A1; sacc += A2; sacc += A3; PIN(sacc); W0; W1; PIN(PW); SBAR(); } while (0)
  #define EX(v) __builtin_amdgcn_exp2f(v)
  #define GAPB(MF, X, B) do { MF; X[B] = EX(X[B] - mhat); X[B + 1] = EX(X[B + 1] - mhat); X[B + 2] = EX(X[B + 2] - mhat); X[B + 3] = EX(X[B + 3] - mhat); PIN(X); SBAR(); } while (0)
  #define VRD(i) do { vlo[i] = vtr(vp_ + (((i) >> 2) * 4096 + ((i) & 3) * 1024)); vhi[i] = vtr(vp_ + (((i) >> 2) * 4096 + ((i) & 3) * 1024 + 512)); } while (0)
  #define KRD(G, j) do { if (G) { kload2(kf, kp0 + sl_next, j); SBAR(); } } while (0)
  #define STEP(C0, C1, P0, P1, t, GK, GV, GL) do { SBAR(); \
    const lds_cptr vp_ = vp0 + sl_prev; \
    VRD(0); SBAR(); float sacc = (P0[0] + P0[1]); \
    GAPA(C0 = __builtin_amdgcn_mfma_f32_32x32x16_bf16(kf[0], qr[0], C0, 0, 0, 0), P0[2], P0[3], P0[4], P0[5],     pw0[0] = PKW(P0, 0), pw0[1] = PKW(P0, 2), pw0); \
    VRD(4); SBAR(); GAPA(C1 = __builtin_amdgcn_mfma_f32_32x32x16_bf16(kf[1], qr[0], C1, 0, 0, 0), P0[6], P0[7], P0[8], P0[9],     pw0[2] = PKW(P0, 4), pw0[3] = PKW(P0, 6), pw0); \
    VRD(1); SBAR(); GAPA(C0 = __builtin_amdgcn_mfma_f32_32x32x16_bf16(kf[2], qr[1], C0, 0, 0, 0),   P0[10], P0[11], P0[12], P0[13], pw1[0] = PKW(P0, 8), pw1[1] = PKW(P0, 10), pw1); \
    VRD(5); SBAR(); GAPA(C1 = __builtin_amdgcn_mfma_f32_32x32x16_bf16(kf[3], qr[1], C1, 0, 0, 0),   P0[14], P0[15], P1[0], P1[1],   pw1[2] = PKW(P0, 12), pw1[3] = PKW(P0, 14), pw1); \
    VRD(2); SBAR(); GAPA(C0 = __builtin_amdgcn_mfma_f32_32x32x16_bf16(kf[4], qr[2], C0, 0, 0, 0),   P1[2], P1[3], P1[4], P1[5],     pw2[0] = PKW(P1, 0), pw2[1] = PKW(P1, 2), pw2); \
    VRD(6); SBAR(); GAPA(C1 = __builtin_amdgcn_mfma_f32_32x32x16_bf16(kf[5], qr[2], C1, 0, 0, 0),   P1[6], P1[7], P1[8], P1[9],     pw2[2] = PKW(P1, 4), pw2[3] = PKW(P1, 6), pw2); \
    VRD(3); SBAR(); GAPA(C0 = __builtin_amdgcn_mfma_f32_32x32x16_bf16(kf[6], qr[3], C0, 0, 0, 0),   P1[10], P1[11], P1[12], P1[13], pw3[0] = PKW(P1, 8), pw3[1] = PKW(P1, 10), pw3); \
    VRD(7); SBAR(); GAPA(C1 = __builtin_amdgcn_mfma_f32_32x32x16_bf16(kf[7], qr[3], C1, 0, 0, 0),   P1[14], P1[15], 0.f, 0.f,       pw3[2] = PKW(P1, 12), pw3[3] = PKW(P1, 14), pw3); \
    l_reg += sacc; \
    if (GK) { DMA_K((t) + 3, sl_cur); } if (GV) { DMA_V((t) + 1, sl_next); } \
    CMASK(C0, C1, t); \
    { float a = MX3(C0[0], C0[1], C1[0]), b = MX3(C0[2], C0[3], C1[1]); a = MX3(a, C1[2], C1[3]); \
      _Pragma("unroll") for (int r = 4; r < 16; r += 4) { a = MX3(a, C0[r], C0[r + 1]); b = MX3(b, C0[r + 2], C0[r + 3]); a = MX3(a, C1[r], C1[r + 1]); b = MX3(b, C1[r + 2], C1[r + 3]); } \
      float rm = __builtin_fmaxf(a, b); { auto rr = __builtin_amdgcn_permlane32_swap(__float_as_uint(rm), __float_as_uint(rm), false, false); rm = __builtin_fmaxf(__uint_as_float(rr[0]), __uint_as_float(rr[1])); } \
      rm -= mhat; resc = false; \
      if (__builtin_expect(__any(rm > (float)THRL), 0)) { const float dl = __builtin_fmaxf(rm, 0.f); mhat += dl; \
        const float f = __builtin_amdgcn_exp2f(-dl); l_reg *= f; if (hi == 0) wsf[r32] = f; resc = true; } } \
    SBAR(); \
    if ((t) + 1 < NT) { BLOAD(P0, P1, (t) + 1); SBAR(); }        \
    GAPB(o[0] = __builtin_amdgcn_mfma_f32_32x32x16_bf16(PAF(0), VFR(0), o[0], 0, 0, 0), C0, 0); \
    GAPB(o[1] = __builtin_amdgcn_mfma_f32_32x32x16_bf16(PAF(0), VFR(4), o[1], 0, 0, 0), C0, 4); \
    KRD(GL, 0); GAPB(o[0] = __builtin_amdgcn_mfma_f32_32x32x16_bf16(PAF(1), VFR(1), o[0], 0, 0, 0), C0, 8); \
    KRD(GL, 1); GAPB(o[1] = __builtin_amdgcn_mfma_f32_32x32x16_bf16(PAF(1), VFR(5), o[1], 0, 0, 0), C0, 12); \
    KRD(GL, 2); GAPB(o[0] = __builtin_amdgcn_mfma_f32_32x32x16_bf16(PAF(2), VFR(2), o[0], 0, 0, 0), C1, 0); \
    KRD(GL, 3); GAPB(o[1] = __builtin_amdgcn_mfma_f32_32x32x16_bf16(PAF(2), VFR(6), o[1], 0, 0, 0), C1, 4); \
    GAPB(o[0] = __builtin_amdgcn_mfma_f32_32x32x16_bf16(PAF(3), VFR(3), o[0], 0, 0, 0), C1, 8); \
    GAPB(o[1] = __builtin_amdgcn_mfma_f32_32x32x16_bf16(PAF(3), VFR(7), o[1], 0, 0, 0), C1, 12); \
    } while (0)
  int t = 1;
  for (; t + 5 < NT; t += 2) {
    STEP(pB0, pB1, pA0, pA1, t, true, true, true);     WAIT_BAR(2); RESC(); ROT();
    STEP(pA0, pA1, pB0, pB1, t + 1, true, true, true); WAIT_BAR(2); RESC(); ROT();
  }
  #define ENDW(tt) do { if ((tt) + 3 < NT) { WAIT_BAR(2); } else if ((tt) + 2 < NT) { WAIT_BAR(1); } else { WAIT_BAR(0); } } while (0)
  for (; t + 1 < NT; t += 2) {
    STEP(pB0, pB1, pA0, pA1, t, (t + 3 < NT), (t + 1 < NT), (t + 1 < NT));     ENDW(t);     RESC(); ROT();
    STEP(pA0, pA1, pB0, pB1, t + 1, (t + 4 < NT), (t + 2 < NT), (t + 2 < NT)); ENDW(t + 1); RESC(); ROT();
  }
  STEP(pB0, pB1, pA0, pA1, NT - 1, false, false, false); RESC();
  { float sacc = pB0[0] + pB0[1]; _Pragma("unroll") for (int r = 2; r < 16; ++r) sacc += pB0[r]; _Pragma("unroll") for (int r = 0; r < 16; ++r) sacc += pB1[r]; l_reg += sacc;
    pw0 = (u32x4){PKW(pB0, 0), PKW(pB0, 2), PKW(pB0, 4), PKW(pB0, 6)}; pw1 = (u32x4){PKW(pB0, 8), PKW(pB0, 10), PKW(pB0, 12), PKW(pB0, 14)}; pw2 = (u32x4){PKW(pB1, 0), PKW(pB1, 2), PKW(pB1, 4), PKW(pB1, 6)}; pw3 = (u32x4){PKW(pB1, 8), PKW(pB1, 10), PKW(pB1, 12), PKW(pB1, 14)};
    SBAR(); pv(o, vb0 + sl_cur, PAF(0), PAF(1), PAF(2), PAF(3)); }
  #undef PKW
  #undef PAF
  #undef VFR
  #undef PIN
  #undef MX3
  #undef GAPA
  #undef GAPB
  #undef EX
  #undef VRD
  #undef KRD
  #undef STEP
  #undef ENDW
  { auto rr = __builtin_amdgcn_permlane32_swap(__float_as_uint(l_reg), __float_as_uint(l_reg), false, false); l_reg = __uint_as_float(rr[0]) + __uint_as_float(rr[1]); }
  if (lsep != nullptr && hi == 0) lsep[(long)(q0 + qrel) * lse_stride] = mhat + __log2f(l_reg);
  if (hi == 0) wsf[32 + r32] = l_reg; asm volatile("s_waitcnt lgkmcnt(0)" ::: "memory");
  float rli[16];
  #pragma unroll
  for (int r = 0; r < 16; ++r) rli[r] = __builtin_amdgcn_rcpf(wsf[32 + crow(r, hi)]);
  bf16* Ow = Op + (long)(q0 + wid * QBLK) * ORS;
  { bf16* stg = (bf16*)(shm + LDS_OST) + wid * 2048;
    #pragma unroll
    for (int r = 0; r < 16; ++r) { const int orow = crow(r, hi);
      #pragma unroll
      for (int d0 = 0; d0 < 2; ++d0) stg[orow * 64 + d0 * 32 + r32] = __float2bfloat16(o[d0][r] * rli[r]); }
    asm volatile("s_waitcnt lgkmcnt(0)" ::: "memory");
    #pragma unroll
    for (int i = 0; i < 4; ++i) { const int row = i * 8 + (lane >> 3), ch = lane & 7; const u32x4 v = *(const u32x4*)(stg + row * 64 + ch * 8); ATTN_STORE16(Ow + (long)row * ORS + ch * 8, v); } }
  asm volatile("s_waitcnt lgkmcnt(0)\n\ts_barrier" ::: "memory");
  #undef DMA_K
  #undef DMA_V
  #undef CMASK
  #undef BLOAD
  #undef START
  #undef RESC
  #undef ROT
}

constexpr int DL_K = 0, DL_KB = 49152, DL_V = 98304, DL_VPAD = 147456, DL_ZEND = 153600, DL_WS = 153600, DL_TREV = 155648, DL_TOTAL = DL_TREV + 3072;
static_assert(DL_WS + NW * 256 <= DL_TREV, "dilated LDS map");
struct DilSrc { const bf16* K; const bf16* V; long RS; int q0; int first; };
__device__ __forceinline__ void dil_issue_k(const DilSrc& u, unsigned lds0, int kbuf, int lane, int wid) {
  const long kr0 = (long)u.q0 - 128; const bf16* ksrc = u.K + (kr0 + lane) * u.RS + wid * 8; const unsigned kdst = lds0 + kbuf + wid * 1024;
  #pragma unroll
  for (int i = 0; i < 6; ++i) if (i >= 2 || !u.first) glds16(ksrc + (long)i * KVBLK * u.RS, (unsigned)__builtin_amdgcn_readfirstlane(kdst + i * 8192));
}
__device__ __forceinline__ void dil_issue_v(const DilSrc& u, unsigned lds0, int lane, int wid) {
  const long kr0 = (long)u.q0 - 128; const bf16* vsrc = u.V + (kr0 + 16 * (wid & 3) + (lane >> 2)) * u.RS + (wid >> 2) * 32 + (lane & 3) * 8; const unsigned vdst = lds0 + DL_V + wid * 1024;
  #pragma unroll
  for (int i = 0; i < 6; ++i) if (i >= 2 || !u.first) glds16(vsrc + (long)i * KVBLK * u.RS, (unsigned)__builtin_amdgcn_readfirstlane(vdst + i * 8192));
}
template <int THRL> __device__ __forceinline__ void dil_unit(const bf16* Qp, const DilSrc cur, int kb, bool issued, const DilSrc nxt, bool has_next, bf16* Op,
                                                             float* lsep, long lse_stride, char* shm, const float* relb, int dsel, bool build_tab) {
  int tid_ = threadIdx.x; asm volatile("" : "+v"(tid_));
  const int tid = tid_, lane = tid & 63, r32 = lane & 31, hi = lane >> 5; const int wid = __builtin_amdgcn_readfirstlane(tid >> 6);
  const unsigned lds0 = (unsigned)(uintptr_t)shm;
  const long RS = cur.RS; const int q0 = cur.q0; const bool first = cur.first != 0;
  float* wsf = (float*)(shm + DL_WS) + wid * 64;
  LAS float* tr = (LAS float*)(shm + DL_TREV);
  if (build_tab) { for (int u = tid; u < 768; u += 512) { const int j = 383 - u; float v = -INFINITY; if (j >= 0 && j <= 128) v = relb[(int)T5B[dsel][j] * NH] * LOG2E; tr[u] = v; } }
  const LAS float* tbase = tr + (255 - r32 + 4 * hi);
  if (!issued) { dil_issue_k(cur, lds0, kb, lane, wid); dil_issue_v(cur, lds0, lane, wid); }
  const bf16* Qw = Qp + (long)(q0 + wid * QBLK) * RS;
  bf16x8 qr[4];
  #pragma unroll
  for (int d0 = 0; d0 < 4; ++d0) qr[d0] = *reinterpret_cast<const bf16x8*>(&Qw[(long)r32 * RS + d0 * 16 + hi * 8]);
  asm volatile("s_waitcnt vmcnt(0) lgkmcnt(0)\n\ts_barrier" ::: "memory");
  if (has_next) dil_issue_k(nxt, lds0, kb ^ DL_KB, lane, wid);
  const int g = wid;
  const lds_cptr shm3 = (lds_cptr)shm;
  const lds_cptr kl = shm3 + kb + hi * 1024 + r32 * 16;
  const lds_cptr vl = shm3 + DL_V + ((lane >> 4) & 1) * 32 + (lane & 3) * 8 + (4 * hi + ((lane & 15) >> 2)) * 64;
  #define KBO(blk) ((((blk)) >> 1) * 8192 + (((blk)) & 1) * 512)
  #define VBO(blk) ((((blk)) >> 1) * 8192 + (((blk)) & 1) * 2048)
  #define DKLOAD2(s_, j_) do { const int b0_ = g + 2 * (s_); kf[2 * (j_)] = *(const LAS bf16x8*)(kl + KBO(b0_) + (j_) * 2048); kf[2 * (j_) + 1] = *(const LAS bf16x8*)(kl + KBO(b0_ + 1) + (j_) * 2048); } while (0)
  float mhat = 0.f, l_reg = 0.f; f32x16 o[2]; o[0] = f32x16{}; o[1] = f32x16{};
  bf16x8 kf[8];
  #define BLOAD(P0, P1, t) do { const LAS float* tb_ = tbase + 64 * (t); \
      _Pragma("unroll") for (int r_ = 0; r_ < 16; ++r_) { P0[r_] = tb_[(r_ & 3) + 8 * (r_ >> 2)]; P1[r_] = tb_[32 + (r_ & 3) + 8 * (r_ >> 2)]; } } while (0)
  #define PMASK(P0, P1, t) do { if (first && (32 * g + 64 * (t)) < 128) { const int kb_ = 32 * g + 64 * (t) + 4 * hi - 128; \
      _Pragma("unroll") for (int r_ = 0; r_ < 16; ++r_) { const int kp_ = kb_ + (r_ & 3) + 8 * (r_ >> 2); if (kp_ < 0) P0[r_] = -INFINITY; if (kp_ + 32 < 0) P1[r_] = -INFINITY; } } } while (0)
  bool resc = false;
  #define RESC() do { if (resc) { asm volatile("s_waitcnt lgkmcnt(0)" ::: "memory"); \
      _Pragma("unroll") for (int d_ = 0; d_ < 2; ++d_) _Pragma("unroll") for (int r = 0; r < 16; ++r) o[d_][r] *= wsf[crow(r, hi)]; } } while (0)
  f32x16 pA0, pA1, pB0, pB1;
  BLOAD(pA0, pA1, 0);
  DKLOAD2(0, 0); DKLOAD2(0, 1); DKLOAD2(0, 2); DKLOAD2(0, 3);
  #pragma unroll
  for (int d0 = 0; d0 < 4; ++d0) { pA0 = __builtin_amdgcn_mfma_f32_32x32x16_bf16(kf[2 * d0], qr[d0], pA0, 0, 0, 0); pA1 = __builtin_amdgcn_mfma_f32_32x32x16_bf16(kf[2 * d0 + 1], qr[d0], pA1, 0, 0, 0); }
  asm volatile("s_nop 15\n\ts_nop 7" : "+v"(pA0), "+v"(pA1)); PMASK(pA0, pA1, 0);
  asm volatile("s_nop 3" : "+v"(pA0), "+v"(pA1));
  { const float rm = rowmax(pA0, pA1); mhat = max2f(rm, -1000.f);
    _Pragma("unroll") for (int r = 0; r < 16; ++r) pA0[r] = __builtin_amdgcn_exp2f(fsub_s(pA0[r], mhat));
    _Pragma("unroll") for (int r = 0; r < 16; ++r) pA1[r] = __builtin_amdgcn_exp2f(fsub_s(pA1[r], mhat)); }
  BLOAD(pB0, pB1, 1);
  DKLOAD2(1, 0); DKLOAD2(1, 1); DKLOAD2(1, 2); DKLOAD2(1, 3);
  s16x4 vlo[8], vhi[8]; u32x4 pw0, pw1, pw2, pw3;
  #define PKW(P, B) cvtpk_s(P[B], P[B + 1])
  #define PAF(k) __builtin_bit_cast(bf16x8, pw##k)
  #define VFR(i) (bf16x8){vlo[i][0], vlo[i][1], vlo[i][2], vlo[i][3], vhi[i][0], vhi[i][1], vhi[i][2], vhi[i][3]}
  #define PIN(x) asm volatile("" : "+v"(x))
  #define MX3(a, b, c) __builtin_fmaxf(__builtin_fmaxf((a), (b)), (c))
  #define GAPA(MF, A0, A1, A2, A3, W0, W1, PW) do { MF; sacc += A0; sacc += A1; sacc += A2; sacc += A3; PIN(sacc); W0; W1; PIN(PW); SBAR(); } while (0)
  #define EX(v) __builtin_amdgcn_exp2f(v)
  #define GAPB(MF, X, B) do { MF; X[B] = EX(X[B] - mhat); X[B + 1] = EX(X[B + 1] - mhat); X[B + 2] = EX(X[B + 2] - mhat); X[B + 3] = EX(X[B + 3] - mhat); PIN(X); SBAR(); } while (0)
  #define VRD(i) do { const lds_cptr va_ = vl + VBO(g + 2 * tv_ + (((i) & 3) >> 1)) + ((i) >> 2) * 4096 + ((i) & 1) * 1024; vlo[i] = vtr(va_); vhi[i] = vtr(va_ + 512); } while (0)
  #define KRD(G, j) do { if (G) { DKLOAD2(tk_, j); SBAR(); } } while (0)
  #define STEP(C0, C1, P0, P1, t, GL) do { SBAR(); const int tv_ = (t) - 1, tk_ = (t) + 1; \
    VRD(0); SBAR(); float sacc = (P0[0] + P0[1]); \
    GAPA(C0 = __builtin_amdgcn_mfma_f32_32x32x16_bf16(kf[0], qr[0], C0, 0, 0, 0), P0[2], P0[3], P0[4], P0[5],     pw0[0] = PKW(P0, 0), pw0[1] = PKW(P0, 2), pw0); \
    VRD(4); SBAR(); GAPA(C1 = __builtin_amdgcn_mfma_f32_32x32x16_bf16(kf[1], qr[0], C1, 0, 0, 0), P0[6], P0[7], P0[8], P0[9],     pw0[2] = PKW(P0, 4), pw0[3] = PKW(P0, 6), pw0); \
    VRD(1); SBAR(); GAPA(C0 = __builtin_amdgcn_mfma_f32_32x32x16_bf16(kf[2], qr[1], C0, 0, 0, 0),   P0[10], P0[11], P0[12], P0[13], pw1[0] = PKW(P0, 8), pw1[1] = PKW(P0, 10), pw1); \
    VRD(5); SBAR(); GAPA(C1 = __builtin_amdgcn_mfma_f32_32x32x16_bf16(kf[3], qr[1], C1, 0, 0, 0),   P0[14], P0[15], P1[0], P1[1],   pw1[2] = PKW(P0, 12), pw1[3] = PKW(P0, 14), pw1); \
    VRD(2); SBAR(); GAPA(C0 = __builtin_amdgcn_mfma_f32_32x32x16_bf16(kf[4], qr[2], C0, 0, 0, 0),   P1[2], P1[3], P1[4], P1[5],     pw2[0] = PKW(P1, 0), pw2[1] = PKW(P1, 2), pw2); \
    VRD(6); SBAR(); GAPA(C1 = __builtin_amdgcn_mfma_f32_32x32x16_bf16(kf[5], qr[2], C1, 0, 0, 0),   P1[6], P1[7], P1[8], P1[9],     pw2[2] = PKW(P1, 4), pw2[3] = PKW(P1, 6), pw2); \
    VRD(3); SBAR(); GAPA(C0 = __builtin_amdgcn_mfma_f32_32x32x16_bf16(kf[6], qr[3], C0, 0, 0, 0),   P1[10], P1[11], P1[12], P1[13], pw3[0] = PKW(P1, 8), pw3[1] = PKW(P1, 10), pw3); \
    VRD(7); SBAR(); GAPA(C1 = __builtin_amdgcn_mfma_f32_32x32x16_bf16(kf[7], qr[3], C1, 0, 0, 0),   P1[14], P1[15], 0.f, 0.f,       pw3[2] = PKW(P1, 12), pw3[3] = PKW(P1, 14), pw3); \
    l_reg += sacc; \
    PMASK(C0, C1, t); \
    { float a = MX3(C0[0], C0[1], C1[0]), b = MX3(C0[2], C0[3], C1[1]); a = MX3(a, C1[2], C1[3]); \
      _Pragma("unroll") for (int r = 4; r < 16; r += 4) { a = MX3(a, C0[r], C0[r + 1]); b = MX3(b, C0[r + 2], C0[r + 3]); a = MX3(a, C1[r], C1[r + 1]); b = MX3(b, C1[r + 2], C1[r + 3]); } \
      float rm = __builtin_fmaxf(a, b); { auto rr = __builtin_amdgcn_permlane32_swap(__float_as_uint(rm), __float_as_uint(rm), false, false); rm = __builtin_fmaxf(__uint_as_float(rr[0]), __uint_as_float(rr[1])); } \
      rm -= mhat; resc = false; \
      if (__builtin_expect(__any(rm > (float)THRL), 0)) { const float dl = __builtin_fmaxf(rm, 0.f); mhat += dl; \
        const float f = __builtin_amdgcn_exp2f(-dl); l_reg *= f; if (hi == 0) wsf[r32] = f; resc = true; } } \
    SBAR(); \
    if ((t) + 1 < 3) { BLOAD(P0, P1, (t) + 1); SBAR(); } \
    GAPB(o[0] = __builtin_amdgcn_mfma_f32_32x32x16_bf16(PAF(0), VFR(0), o[0], 0, 0, 0), C0, 0); \
    GAPB(o[1] = __builtin_amdgcn_mfma_f32_32x32x16_bf16(PAF(0), VFR(4), o[1], 0, 0, 0), C0, 4); \
    KRD(GL, 0); GAPB(o[0] = __builtin_amdgcn_mfma_f32_32x32x16_bf16(PAF(1), VFR(1), o[0], 0, 0, 0), C0, 8); \
    KRD(GL, 1); GAPB(o[1] = __builtin_amdgcn_mfma_f32_32x32x16_bf16(PAF(1), VFR(5), o[1], 0, 0, 0), C0, 12); \
    KRD(GL, 2); GAPB(o[0] = __builtin_amdgcn_mfma_f32_32x32x16_bf16(PAF(2), VFR(2), o[0], 0, 0, 0), C1, 0); \
    KRD(GL, 3); GAPB(o[1] = __builtin_amdgcn_mfma_f32_32x32x16_bf16(PAF(2), VFR(6), o[1], 0, 0, 0), C1, 4); \
    GAPB(o[0] = __builtin_amdgcn_mfma_f32_32x32x16_bf16(PAF(3), VFR(3), o[0], 0, 0, 0), C1, 8); \
    GAPB(o[1] = __builtin_amdgcn_mfma_f32_32x32x16_bf16(PAF(3), VFR(7), o[1], 0, 0, 0), C1, 12); \
    } while (0)
  STEP(pB0, pB1, pA0, pA1, 1, true);  RESC();
  STEP(pA0, pA1, pB0, pB1, 2, false); RESC();
  { float sacc = pA0[0] + pA0[1]; _Pragma("unroll") for (int r = 2; r < 16; ++r) sacc += pA0[r]; _Pragma("unroll") for (int r = 0; r < 16; ++r) sacc += pA1[r]; l_reg += sacc;
    pw0 = (u32x4){PKW(pA0, 0), PKW(pA0, 2), PKW(pA0, 4), PKW(pA0, 6)}; pw1 = (u32x4){PKW(pA0, 8), PKW(pA0, 10), PKW(pA0, 12), PKW(pA0, 14)}; pw2 = (u32x4){PKW(pA1, 0), PKW(pA1, 2), PKW(pA1, 4), PKW(pA1, 6)}; pw3 = (u32x4){PKW(pA1, 8), PKW(pA1, 10), PKW(pA1, 12), PKW(pA1, 14)};
    SBAR(); const int tv_ = 2;
    VRD(0); VRD(1); VRD(2); VRD(3); VRD(4); VRD(5); VRD(6); VRD(7);
    o[0] = __builtin_amdgcn_mfma_f32_32x32x16_bf16(PAF(0), VFR(0), o[0], 0, 0, 0); o[1] = __builtin_amdgcn_mfma_f32_32x32x16_bf16(PAF(0), VFR(4), o[1], 0, 0, 0);
    o[0] = __builtin_amdgcn_mfma_f32_32x32x16_bf16(PAF(1), VFR(1), o[0], 0, 0, 0); o[1] = __builtin_amdgcn_mfma_f32_32x32x16_bf16(PAF(1), VFR(5), o[1], 0, 0, 0);
    o[0] = __builtin_amdgcn_mfma_f32_32x32x16_bf16(PAF(2), VFR(2), o[0], 0, 0, 0); o[1] = __builtin_amdgcn_mfma_f32_32x32x16_bf16(PAF(2), VFR(6), o[1], 0, 0, 0);
    o[0] = __builtin_amdgcn_mfma_f32_32x32x16_bf16(PAF(3), VFR(3), o[0], 0, 0, 0); o[1] = __builtin_amdgcn_mfma_f32_32x32x16_bf16(PAF(3), VFR(7), o[1], 0, 0, 0); }
  #undef PKW
  #undef PAF
  #undef VFR
  #undef PIN
  #undef MX3
  #undef GAPA
  #undef GAPB
  #undef EX
  #undef VRD
  #undef KRD
  #undef STEP
  const int qrel = wid * QBLK + r32;
  { auto rr = __builtin_amdgcn_permlane32_swap(__float_as_uint(l_reg), __float_as_uint(l_reg), false, false); l_reg = __uint_as_float(rr[0]) + __uint_as_float(rr[1]); }
  if (hi == 0) lsep[(long)(q0 + qrel) * lse_stride] = mhat + __log2f(l_reg);
  if (hi == 0) wsf[32 + r32] = l_reg; asm volatile("s_waitcnt lgkmcnt(0)" ::: "memory");
  float rli[16];
  #pragma unroll
  for (int r = 0; r < 16; ++r) rli[r] = __builtin_amdgcn_rcpf(wsf[32 + crow(r, hi)]);
  asm volatile("s_waitcnt lgkmcnt(0)\n\ts_barrier" ::: "memory");
  if (has_next) dil_issue_v(nxt, lds0, lane, wid);
  bf16* Ow = Op + (long)(q0 + wid * QBLK) * RS;
  { bf16* stg = (bf16*)(shm + kb) + wid * 2048;
    #pragma unroll
    for (int r = 0; r < 16; ++r) { const int orow = crow(r, hi);
      #pragma unroll
      for (int d0 = 0; d0 < 2; ++d0) stg[orow * 64 + d0 * 32 + r32] = __float2bfloat16(o[d0][r] * rli[r]); }
    asm volatile("s_waitcnt lgkmcnt(0)" ::: "memory");
    #pragma unroll
    for (int i = 0; i < 4; ++i) { const int row = i * 8 + (lane >> 3), ch = lane & 7; const u32x4 v = *(const u32x4*)(stg + row * 64 + ch * 8); ATTN_STORE16(Ow + (long)row * RS + ch * 8, v); } }
  if (!has_next) asm volatile("s_waitcnt lgkmcnt(0)\n\ts_barrier" ::: "memory");
  #undef KBO
  #undef VBO
  #undef DKLOAD2
  #undef BLOAD
  #undef PMASK
  #undef RESC
}
#undef SBAR
#undef WAIT_BAR
}
static_assert(attn_body::LDS_TOTAL <= RING_BYTES && attn_body::DL_TOTAL <= PHASE_LDS, "attention LDS");

#define XB_TMO      128
#define XB_XCNT(j)  (256  + 64 * (j))
#define XB_XSUB(j)  (1280 + 64 * (j))
#define XB_XGEN(j)  (2304 + 64 * (j))
#define XB_TOP      3328
#define XB_TOPGEN   3392
#define XCD_BAR_WORDS 3456
#define XB_SPIN_CAP (1u << 18)
__device__ __forceinline__ unsigned xb_ld(unsigned* p)              { return __hip_atomic_load(p, __ATOMIC_RELAXED, __HIP_MEMORY_SCOPE_AGENT); }
__device__ __forceinline__ unsigned xb_add(unsigned* p, unsigned v) { return __hip_atomic_fetch_add(p, v, __ATOMIC_RELAXED, __HIP_MEMORY_SCOPE_AGENT); }
__device__ __forceinline__ unsigned xb_xcc_id() { return (unsigned)__builtin_amdgcn_s_getreg((3 << 11) | 20) & 0xFu; }
#define XB_SPIN(cond, bar) do { unsigned _sp = 0; while (cond) { __builtin_amdgcn_s_sleep(1); \
    if ((++_sp & 255u) == 0u) { if (xb_ld(&(bar)[XB_TMO])) break; if (_sp > XB_SPIN_CAP) { atomicAdd(&(bar)[XB_TMO], 1u); break; } } } } while (0)
struct XcdBarrier { unsigned* bar; unsigned x; volatile LAS unsigned* st; };
__device__ __forceinline__ XcdBarrier xcd_barrier_post(unsigned* bar, volatile LAS unsigned* st) {
    XcdBarrier b; b.bar = bar; b.x = xb_xcc_id(); b.st = st;
    if (threadIdx.x == 0) (void)xb_add(&bar[XB_XCNT(b.x)], 1u);
    return b;
}
__device__ __forceinline__ void xcd_barrier_complete(unsigned* bar, unsigned x, unsigned& nloc, unsigned& nx) {
    const unsigned G = gridDim.x * gridDim.y * gridDim.z;
    unsigned sum, cnt, mine, sp = 0u;
    for (;;) {
        sum = 0u; cnt = 0u; mine = 0u;
#pragma unroll
        for (unsigned j = 0; j < 16; ++j) { const unsigned c = xb_ld(&bar[XB_XCNT(j)]); sum += c; cnt += (c > 0u) ? 1u : 0u; mine = (j == x) ? c : mine; }
        if (sum == G) break;
        __builtin_amdgcn_s_sleep(1);
        if ((++sp & 255u) == 0u) { if (xb_ld(&bar[XB_TMO])) break; if (sp > XB_SPIN_CAP) { atomicAdd(&bar[XB_TMO], 1u); break; } }
    }
    nloc = mine > 0u ? mine : 1u; nx = cnt > 0u ? cnt : 1u;
}
__device__ __forceinline__ void xcd_barrier(const XcdBarrier& b) {
    asm volatile("s_waitcnt vmcnt(0)" ::: "memory");
    __syncthreads();
    if (threadIdx.x == 0) {
        unsigned* bar = b.bar;
        __builtin_amdgcn_s_waitcnt(0);
        unsigned nloc = b.st[0], nx = b.st[1];
        if (nloc == 0u) { xcd_barrier_complete(bar, b.x, nloc, nx); b.st[0] = nloc; b.st[1] = nx; }
        const unsigned old = xb_add(&bar[XB_XSUB(b.x)], 1u);
        const unsigned gen = old / nloc;
        if (old + 1u == (gen + 1u) * nloc) {
            __builtin_amdgcn_fence(__ATOMIC_RELEASE, "agent");
            asm volatile("s_waitcnt vmcnt(0)" ::: "memory");
            const unsigned og = xb_add(&bar[XB_TOP], 1u);
            const unsigned tg = og / nx;
            if (og + 1u == (tg + 1u) * nx) xb_add(&bar[XB_TOPGEN], 1u);
            else XB_SPIN(xb_ld(&bar[XB_TOPGEN]) == tg, bar);
            __builtin_amdgcn_fence(__ATOMIC_ACQUIRE, "agent");
            xb_add(&bar[XB_XGEN(b.x)], 1u);
            asm volatile("s_waitcnt vmcnt(0)" ::: "memory");
        } else {
            XB_SPIN(xb_ld(&bar[XB_XGEN(b.x)]) == gen, bar);
            __builtin_amdgcn_fence(__ATOMIC_ACQUIRE, "agent");
            asm volatile("s_waitcnt vmcnt(0)" ::: "memory");
        }
    }
    __syncthreads();
}

struct Frame {
    LAS unsigned char* lds;
    volatile LAS unsigned* MISC;
    gu32* ctl;
    int tid, lane, wave;
    int vcu, G;
    unsigned char* ws;
    float* out;
};
#define LDS_WAIT() asm volatile("s_waitcnt lgkmcnt(0)" ::: "memory")

__device__ __forceinline__ void p0_mod(Frame& F, const float* c, const float* w_ada, const float* b_ada, float* mod) {
    LAS float* sc = (LAS float*)F.lds;
    LAS float* part = (LAS float*)(F.lds + 65536);
    __syncthreads();
    for (int cg = blockIdx.x; cg < NMOD / 64; cg += F.G) {
        for (int i = F.tid; i < BATCH * DM; i += NWAVES * 64) { const float v = c[i]; sc[i] = v / (1.f + __expf(-v)); }
        __syncthreads();
        const int n = cg * 64 + F.lane; float acc[BATCH];
#pragma unroll
        for (int b = 0; b < BATCH; ++b) acc[b] = 0.f;
        const int kb = F.wave * 128;
        for (int k0 = kb; k0 < kb + 128; k0 += 32) { float wv[32];
#pragma unroll
            for (int i = 0; i < 32; ++i) wv[i] = w_ada[(size_t)(k0 + i) * NMOD + n];
#pragma unroll
            for (int i = 0; i < 32; ++i)
#pragma unroll
                for (int b = 0; b < BATCH; ++b) acc[b] += sc[b * DM + k0 + i] * wv[i]; }
#pragma unroll
        for (int b = 0; b < BATCH; ++b) part[(F.wave * BATCH + b) * 64 + F.lane] = acc[b];
        __syncthreads();
        for (int o = F.tid; o < BATCH * 64; o += NWAVES * 64) { const int b = o >> 6, l = o & 63; float s = b_ada[cg * 64 + l];
#pragma unroll
            for (int w = 0; w < NWAVES; ++w) s += part[(w * BATCH + b) * 64 + l];
            mod[(size_t)b * NMOD + cg * 64 + l] = s; }
        __syncthreads();
    }
}
__device__ __forceinline__ int gu_row(int c, int up) { return (c >> 7) * 256 + up * 128 + (c & 127); }
__device__ __forceinline__ int dn_row(int c) { const int cc = c & 255; return (c & ~255) + ((cc >> 5) & 1) * 128 + (cc >> 6) * 32 + (cc & 31); }
struct P0Ptrs { const float *w_in, *w_out, *w_router, *w_eg, *w_eu, *w_ed, *w_sg, *w_su, *w_sd; };
struct TrItem { const float* src; unsigned char* dst; int ldw, Kd, f8; };
__device__ __forceinline__ TrItem tr_make(const float* W, int ldw, int k0, int c0, void* WT, int drow0, int Kd, int f8 = 0) { TrItem t; t.src = W + (size_t)k0 * ldw + c0; t.dst = (unsigned char*)WT + ((size_t)drow0 * Kd + k0) * (f8 ? 1 : 2); t.ldw = ldw; t.Kd = Kd; t.f8 = f8; return t; }
__device__ __forceinline__ TrItem p0_decode(const P0Ptrs& P, unsigned char* ws, int it) {
    bf16_t* WIN = (bf16_t*)(ws + WS_WIN); bf16_t* WOUT = (bf16_t*)(ws + WS_WOUT); bf16_t* WR = (bf16_t*)(ws + WS_WR);
    bf16_t* WSHGU = (bf16_t*)(ws + WS_WSHGU); bf16_t* WSHD = (bf16_t*)(ws + WS_WSHD); unsigned char* WD = ws + WS_WD; unsigned char* WGU = ws + WS_WGU;
    constexpr int I_EXP = NEXP * 384, I_IN = 768, I_OUT = 512, I_S = 128;
    int r = it;
    if (r < I_EXP) { const int e = r / 384, q = r % 384;
        if (q < 256) { const int up = q >> 7, qq = q & 127, kb = qq >> 3, nb = qq & 7;
            return tr_make((up ? P.w_eu : P.w_eg) + (size_t)e * DM * EH, EH, 64 * kb, 32 * nb, WGU + (size_t)e * 512 * DM, gu_row(32 * nb, up), DM, 1); }
        const int qq = q - 256, kb = qq >> 5, nb = qq & 31;
        return tr_make(P.w_ed + (size_t)e * EH * DM, DM, 64 * kb, 32 * nb, WD + (size_t)e * DM * EH, dn_row(32 * nb), EH, 1); }
    r -= I_EXP;
    if (r < I_IN) { const int kb = r / 48, nb = r % 48; return tr_make(P.w_in, INC, 64 * kb, 32 * nb, WIN, 32 * nb, DM); } r -= I_IN;
    if (r < I_IN) { const int kb = r / 48, nb = r % 48; return tr_make(P.w_in, INC, 64 * kb, 1544 + 32 * nb, WIN, 1536 + 32 * nb, DM); } r -= I_IN;
    if (r < I_OUT) { const int kb = r >> 5, nb = r & 31; return tr_make(P.w_out, DM, 64 * kb, 32 * nb, WOUT, 32 * nb, DM); } r -= I_OUT;
    if (r < I_S) { const int kb = r >> 3, nb = r & 7; return tr_make(P.w_router, NEXP, 64 * kb, 32 * nb, WR, 32 * nb, DM); } r -= I_S;
    if (r < I_S) { const int kb = r >> 3, nb = r & 7; return tr_make(P.w_sg, EH, 64 * kb, 32 * nb, WSHGU, gu_row(32 * nb, 0), DM); } r -= I_S;
    if (r < I_S) { const int kb = r >> 3, nb = r & 7; return tr_make(P.w_su, EH, 64 * kb, 32 * nb, WSHGU, gu_row(32 * nb, 1), DM); } r -= I_S;
    { const int kb = r >> 5, nb = r & 31; return tr_make(P.w_sd, DM, 64 * kb, 32 * nb, WSHD, dn_row(32 * nb), EH); }
}
__device__ __forceinline__ void tr_load(const TrItem& t, int lane, f32x4 (&v)[8]) {
    const float* p = t.src + (size_t)(lane >> 3) * t.ldw + (lane & 7) * 4;
#pragma unroll
    for (int i = 0; i < 8; ++i) v[i] = *(const GAS f32x4*)(p + (size_t)(8 * i) * t.ldw);
}
__device__ __forceinline__ void tr_store(const TrItem& t, int lane, const f32x4 (&v)[8], LAS float* scr) {
    LAS float* w = scr + (lane >> 3) * 33 + (lane & 7) * 4;
#pragma unroll
    for (int i = 0; i < 8; ++i) { w[(8 * i) * 33 + 0] = v[i].x; w[(8 * i) * 33 + 1] = v[i].y; w[(8 * i) * 33 + 2] = v[i].z; w[(8 * i) * 33 + 3] = v[i].w; }
    LDS_WAIT(); asm volatile("" ::: "memory");
    const int c = lane & 7;
#pragma unroll
    for (int j = 0; j < 4; ++j) { const int n = (lane >> 3) + 8 * j; const LAS float* s = scr + (8 * c) * 33 + n;
        if (t.f8) { int w0 = __builtin_amdgcn_cvt_pk_fp8_f32(s[0 * 33], s[1 * 33], 0, false); w0 = __builtin_amdgcn_cvt_pk_fp8_f32(s[2 * 33], s[3 * 33], w0, true);
            int w1 = __builtin_amdgcn_cvt_pk_fp8_f32(s[4 * 33], s[5 * 33], 0, false); w1 = __builtin_amdgcn_cvt_pk_fp8_f32(s[6 * 33], s[7 * 33], w1, true);
            u32x2 o; o.x = (unsigned)w0; o.y = (unsigned)w1; *(GAS u32x2*)(t.dst + (size_t)n * t.Kd + 8 * c) = o; }
        else { u32x4 o; o.x = cvt_pk_bf16(s[0 * 33], s[1 * 33]); o.y = cvt_pk_bf16(s[2 * 33], s[3 * 33]); o.z = cvt_pk_bf16(s[4 * 33], s[5 * 33]); o.w = cvt_pk_bf16(s[6 * 33], s[7 * 33]);
            *(GAS u32x4*)(t.dst + ((size_t)n * t.Kd + 8 * c) * 2) = o; } }
    LDS_WAIT(); asm volatile("" ::: "memory");
}
__device__ __forceinline__ void p0_weights(Frame& F, const P0Ptrs& P) {
    LAS float* scr = (LAS float*)(F.lds + F.wave * 16384);
    const int gw = F.vcu * NWAVES + F.wave, NGW = F.G * NWAVES;
    constexpr int NITEMS = NEXP * 384 + 2 * 768 + 512 + 4 * 128;
    int it = gw; if (it >= NITEMS) return;
    TrItem cur = p0_decode(P, F.ws, it); f32x4 v[8]; tr_load(cur, F.lane, v);
    for (;;) {
        const int nit = it + NGW; const bool more = nit < NITEMS;
        TrItem nx = cur; f32x4 nv[8];
        if (more) { nx = p0_decode(P, F.ws, nit); tr_load(nx, F.lane, nv); }
        tr_store(cur, F.lane, v, scr);
        if (!more) break;
        cur = nx; it = nit;
#pragma unroll
        for (int i = 0; i < 8; ++i) v[i] = nv[i];
    }
}
template <bool FL> __device__ __forceinline__ void norm_rows(Frame& F, const float* src  , bf16_t* dst, const float* mod, int shift_off, int scale_off, const float* w_in, const float* b_forget, float* lf, unsigned char* dst8) {
    LAS float* wf = (LAS float*)F.lds;
    if (FL) { for (int i = F.tid; i < DM * NH; i += NWAVES * 64) wf[(i & 7) * DM + (i >> 3)] = w_in[(size_t)(i >> 3) * INC + 1536 + (i & 7)]; __syncthreads(); }
    const int gw = F.vcu * NWAVES + F.wave, NGW = F.G * NWAVES;
    constexpr int CH = 32;
#define NR_ROW(i_) (rowb + 128 * (i_))
#define NR_LD(dst_, row_, j_) do { if (FL) dst_ = ((const GAS f32x4*)(src + (size_t)(row_) * DM) + F.lane)[64 * (j_)]; \
        else { const u32x2 t_ = ((const GAS u32x2*)x1_row(F.ws, (size_t)(row_)) + F.lane)[64 * (j_)]; dst_ = (f32x4){bf_lo(t_.x), bf_hi(t_.x), bf_lo(t_.y), bf_hi(t_.y)}; } } while (0)
    for (int ch = gw; ch < M / CH; ch += NGW) {
        const int b = ch >> 7, rowb = b * SEQ + (ch & 127);
        f32x4 sc[4], sh[4];
#pragma unroll
        for (int j = 0; j < 4; ++j) { sc[j] = *(const f32x4*)(mod + (size_t)b * NMOD + scale_off + 256 * j + 4 * F.lane) + 1.f; sh[j] = *(const f32x4*)(mod + (size_t)b * NMOD + shift_off + 256 * j + 4 * F.lane); }
        f32x4 nv[2][4];
#pragma unroll
        for (int q = 0; q < 2; ++q)
#pragma unroll
            for (int j = 0; j < 4; ++j) NR_LD(nv[q][j], NR_ROW(q), j);
        for (int mm = 0; mm < CH; mm += 2) {
            f32x4 vv[2][4];
#pragma unroll
            for (int q = 0; q < 2; ++q)
#pragma unroll
                for (int j = 0; j < 4; ++j) vv[q][j] = nv[q][j];
            if (mm + 2 < CH) {
#pragma unroll
                for (int q = 0; q < 2; ++q)
#pragma unroll
                    for (int j = 0; j < 4; ++j) NR_LD(nv[q][j], NR_ROW(mm + 2 + q), j); }
#pragma unroll
            for (int q = 0; q < 2; ++q) { const int m = NR_ROW(mm + q); f32x4 (&v)[4] = vv[q];
            float s2 = 0.f;
#pragma unroll
            for (int j = 0; j < 4; ++j) s2 += (v[j].x * v[j].x + v[j].y * v[j].y) + (v[j].z * v[j].z + v[j].w * v[j].w);
            const float r = 1.f / sqrtf(wave_sum(s2) * (1.f / DM) + EPS);
#pragma unroll
            for (int j = 0; j < 4; ++j) v[j] = v[j] * r * sc[j] + sh[j];
            GAS u32x2* o8 = (GAS u32x2*)(dst + (size_t)m * DM) + F.lane;
#pragma unroll
            for (int j = 0; j < 4; ++j) { u32x2 w; w.x = cvt_pk_bf16(v[j].x, v[j].y); w.y = cvt_pk_bf16(v[j].z, v[j].w); o8[64 * j] = w; }
            if (!FL) { GAS unsigned* o4 = (GAS unsigned*)(dst8 + (size_t)m * DM) + F.lane;
#pragma unroll
                for (int j = 0; j < 4; ++j) { int w = __builtin_amdgcn_cvt_pk_fp8_f32(v[j].x, v[j].y, 0, false); w = __builtin_amdgcn_cvt_pk_fp8_f32(v[j].z, v[j].w, w, true); o4[64 * j] = (unsigned)w; } }
            if (FL) { float fl[NH];
#pragma unroll
                for (int h = 0; h < NH; ++h) fl[h] = 0.f;
#pragma unroll
                for (int j = 0; j < 4; ++j)
#pragma unroll
                    for (int h = 0; h < NH; ++h) { const f32x4 w4 = *(const LAS f32x4*)(wf + h * DM + 256 * j + 4 * F.lane); fl[h] += (v[j].x * w4.x + v[j].y * w4.y) + (v[j].z * w4.z + v[j].w * w4.w); }
                const float mine = reduce8_heads(fl, F.lane); const int hh = F.lane >> 3;
                if ((F.lane & 7) == 0) { const float z = mine + b_forget[hh]; const float ls = fminf(z, 0.f) - log1pf(__expf(-fabsf(z))); lf[((size_t)b * NH + hh) * SEQ + (m & (SEQ - 1))] = ls; } }
            }
        }
    }
}
#undef NR_ROW
#undef NR_LD
__device__ __forceinline__ void scan_rows(Frame& F, const float* lf, float* kb, int* t0tab) {
    LAS float* wt = (LAS float*)F.lds; LAS float* kl = wt + 16;
    for (int s = blockIdx.x; s < BATCH * NH; s += F.G) {
        const float* src = lf + (size_t)s * SEQ + F.tid * 8; float v[8];
        { const f32x4 a = *(const f32x4*)src, b2 = *(const f32x4*)(src + 4); v[0] = a.x; v[1] = a.y; v[2] = a.z; v[3] = a.w; v[4] = b2.x; v[5] = b2.y; v[6] = b2.z; v[7] = b2.w; }
#pragma unroll
        for (int i = 1; i < 8; ++i) v[i] += v[i - 1];
        float incl = v[7];
#pragma unroll
        for (int o = 1; o < 64; o <<= 1) { const float t = __shfl_up(incl, o); if (F.lane >= o) incl += t; }
        if (F.lane == 63) wt[F.wave] = incl;
        __syncthreads();
        float base = incl - v[7];
        for (int w = 0; w < F.wave; ++w) base += wt[w];
        float* dst = kb + (size_t)s * SEQ + F.tid * 8;
        f32x4 a, b2; a.x = -(v[0] + base) * LOG2E; a.y = -(v[1] + base) * LOG2E; a.z = -(v[2] + base) * LOG2E; a.w = -(v[3] + base) * LOG2E;
        b2.x = -(v[4] + base) * LOG2E; b2.y = -(v[5] + base) * LOG2E; b2.z = -(v[6] + base) * LOG2E; b2.w = -(v[7] + base) * LOG2E;
        *(f32x4*)dst = a; *(f32x4*)(dst + 4) = b2;
        *(LAS f32x4*)(kl + F.tid * 8) = a; *(LAS f32x4*)(kl + F.tid * 8 + 4) = b2;
        __syncthreads();
        if (F.tid < 16) { const int q0 = 256 * F.tid; const float target = kl[q0] - FOX_SKIP_LOG2; int lo = 0, hi = q0;
            while (lo < hi) { const int mid = (lo + hi) >> 1; if (kl[mid] <= target) lo = mid + 1; else hi = mid; }
            t0tab[s * 16 + F.tid] = (lo >> 6) & ~1; }
        __syncthreads();
    }
}
__device__ __forceinline__ void unpack8(const u32x4 w, float* f) { f[0] = bf_lo(w.x); f[1] = bf_hi(w.x); f[2] = bf_lo(w.y); f[3] = bf_hi(w.y); f[4] = bf_lo(w.z); f[5] = bf_hi(w.z); f[6] = bf_lo(w.w); f[7] = bf_hi(w.w); }
__device__ __forceinline__ void merge_rows(Frame& F, const float* g_fox, const float* g_dil) {
    const bf16_t* OF = (const bf16_t*)(F.ws + WS_OF); const bf16_t* O1 = (const bf16_t*)(F.ws + WS_O1); const bf16_t* O2 = (const bf16_t*)(F.ws + WS_O2); const bf16_t* O3 = (const bf16_t*)(F.ws + WS_O3);
    const float* LSE = (const float*)(F.ws + WS_LSE); bf16_t* YM = (bf16_t*)(F.ws + WS_YM);
    const int gw = F.vcu * NWAVES + F.wave, NGW = F.G * NWAVES;
    float gf[8], gd[8];
    { const f32x4 a = *(const f32x4*)(g_fox + 8 * F.lane), b = *(const f32x4*)(g_fox + 8 * F.lane + 4), c = *(const f32x4*)(g_dil + 8 * F.lane), d = *(const f32x4*)(g_dil + 8 * F.lane + 4);
      gf[0] = a.x; gf[1] = a.y; gf[2] = a.z; gf[3] = a.w; gf[4] = b.x; gf[5] = b.y; gf[6] = b.z; gf[7] = b.w; gd[0] = c.x; gd[1] = c.y; gd[2] = c.z; gd[3] = c.w; gd[4] = d.x; gd[5] = d.y; gd[6] = d.z; gd[7] = d.w; }
    struct Row { u32x4 wf, w1, w2, w3; float l1, l2, l3; };
    const int hd = F.lane >> 3;
#define MR_LOAD(R, m_) do { const size_t eo_ = (size_t)(m_) * HW + 8 * F.lane; R.wf = *(const GAS u32x4*)(OF + eo_); R.w1 = *(const GAS u32x4*)(O1 + eo_); R.w2 = *(const GAS u32x4*)(O2 + eo_); R.w3 = *(const GAS u32x4*)(O3 + eo_); \
        R.l1 = LSE[(size_t)(m_) * NH + hd]; R.l2 = LSE[(size_t)M * NH + (size_t)(m_) * NH + hd]; R.l3 = LSE[(size_t)2 * M * NH + (size_t)(m_) * NH + hd]; } while (0)
    for (int ch = gw; ch < M / 32; ch += NGW) {
        const size_t rowb = (size_t)(ch >> 7) * SEQ + (ch & 127);
        Row nr[2]; MR_LOAD(nr[0], rowb); MR_LOAD(nr[1], rowb + 128);
        for (int mm = 0; mm < 32; mm += 2) {
            Row cr[2]; cr[0] = nr[0]; cr[1] = nr[1];
            if (mm + 2 < 32) { MR_LOAD(nr[0], rowb + 128 * (mm + 2)); MR_LOAD(nr[1], rowb + 128 * (mm + 3)); }
#pragma unroll
            for (int q = 0; q < 2; ++q) { const size_t m = rowb + 128 * (mm + q); const Row& R = cr[q];
            const float mx = fmaxf(R.l1, fmaxf(R.l2, R.l3)); float e1 = __builtin_amdgcn_exp2f(R.l1 - mx), e2 = __builtin_amdgcn_exp2f(R.l2 - mx), e3 = __builtin_amdgcn_exp2f(R.l3 - mx);
            const float inv = 1.f / (e1 + e2 + e3); e1 *= inv; e2 *= inv; e3 *= inv;
            float yf[8], a1[8], a2[8], a3[8], yd[8]; unpack8(R.wf, yf); unpack8(R.w1, a1); unpack8(R.w2, a2); unpack8(R.w3, a3);
            float sf = 0.f, sd = 0.f;
#pragma unroll
            for (int i = 0; i < 8; ++i) { yd[i] = e1 * a1[i] + e2 * a2[i] + e3 * a3[i]; sf += yf[i] * yf[i]; sd += yd[i] * yd[i]; }
            const float rf = 1.f / sqrtf(wave_sum(sf) * (1.f / HW) + EPS), rd = 1.f / sqrtf(wave_sum(sd) * (1.f / HW) + EPS);
            u32x4 of, od;
            of.x = cvt_pk_bf16(yf[0] * rf * gf[0], yf[1] * rf * gf[1]); of.y = cvt_pk_bf16(yf[2] * rf * gf[2], yf[3] * rf * gf[3]); of.z = cvt_pk_bf16(yf[4] * rf * gf[4], yf[5] * rf * gf[5]); of.w = cvt_pk_bf16(yf[6] * rf * gf[6], yf[7] * rf * gf[7]);
            od.x = cvt_pk_bf16(yd[0] * rd * gd[0], yd[1] * rd * gd[1]); od.y = cvt_pk_bf16(yd[2] * rd * gd[2], yd[3] * rd * gd[3]); od.z = cvt_pk_bf16(yd[4] * rd * gd[4], yd[5] * rd * gd[5]); od.w = cvt_pk_bf16(yd[6] * rd * gd[6], yd[7] * rd * gd[7]);
            *(GAS u32x4*)(YM + m * DM + 8 * F.lane) = of; *(GAS u32x4*)(YM + m * DM + HW + 8 * F.lane) = od; }
        }
    }
#undef MR_LOAD
}
__device__ __forceinline__ void route_rows(Frame& F, int pm, const float* logits, const float* rbias, unsigned* list, float* wts, unsigned* pose) {
    LAS unsigned* lcount = (LAS unsigned*)F.lds;
    LAS unsigned* lbase = lcount + 256;
    LAS unsigned* lsel = lbase + 256;
    LAS unsigned* lwt = lsel + 2048;
    if (F.tid < 256) lcount[F.tid] = 0u;
    __syncthreads();
    const f32x4 rb = *(const f32x4*)(rbias + 4 * F.lane);
#define DPPF(x, ctrl) __int_as_float(__builtin_amdgcn_update_dpp(0, __float_as_int(x), ctrl, 0xF, 0xF, false))
#define DPPUMAX(v, ctrl, rm) v = max(v, (unsigned)__builtin_amdgcn_update_dpp(0, (int)v, ctrl, rm, 0xF, false))
    f32x4 lgn = *(const GAS f32x4*)(logits + ((size_t)pm * 256 + F.wave * 32) * NEXP + 4 * F.lane);
    for (int i = 0; i < 32; ++i) { const int rl = F.wave * 32 + i; const size_t row = (size_t)pm * 256 + rl;
        const f32x4 lg = lgn;
        if (i + 1 < 32) lgn = *(const GAS f32x4*)(logits + (row + 1) * NEXP + 4 * F.lane);
        float s[4], sel[4];
#pragma unroll
        for (int q = 0; q < 4; ++q) { s[q] = 1.f / (1.f + __expf(-lg[q])); sel[q] = s[q] + rb[q]; }
        float m1 = -INFINITY, m2 = -INFINITY;
#pragma unroll
        for (int q = 0; q < 4; ++q) { if (sel[q] > m1) { m2 = m1; m1 = sel[q]; } else if (sel[q] > m2) m2 = sel[q]; }
        { float b1 = DPPF(m1, 0xB1), b2 = DPPF(m2, 0xB1); float n1 = fmaxf(m1, b1), n2 = fmaxf(fminf(m1, b1), fmaxf(m2, b2)); m1 = n1; m2 = n2;
          b1 = DPPF(m1, 0x4E); b2 = DPPF(m2, 0x4E); n1 = fmaxf(m1, b1); n2 = fmaxf(fminf(m1, b1), fmaxf(m2, b2)); m1 = n1; m2 = n2;
          b1 = DPPF(m1, 0x141); b2 = DPPF(m2, 0x141); n1 = fmaxf(m1, b1); n2 = fmaxf(fminf(m1, b1), fmaxf(m2, b2)); m1 = n1; m2 = n2; }
        const float gs = m1 + m2; const int g = F.lane >> 3; int rank = 0;
#pragma unroll
        for (int gg = 0; gg < 8; ++gg) { const float og = __int_as_float(__builtin_amdgcn_readlane(__float_as_int(gs), gg * 8)); rank += (og > gs || (og == gs && gg < g)) ? 1 : 0; }
        const bool gsel = rank < 4;
        unsigned key[4];
#pragma unroll
        for (int q = 0; q < 4; ++q) { const unsigned bq = __float_as_uint(sel[q]); key[q] = gsel ? (bq ^ ((bq >> 31) ? 0xffffffffu : 0x80000000u)) : 0u; }
        int myE = 0; float myS = 0.f, ssum = 0.f;
#pragma unroll 1
        for (int k = 0; k < TOPK; ++k) {
            unsigned v = max(max(key[0], key[1]), max(key[2], key[3]));
            DPPUMAX(v, 0xB1, 0xF); DPPUMAX(v, 0x4E, 0xF); DPPUMAX(v, 0x141, 0xF); DPPUMAX(v, 0x140, 0xF); DPPUMAX(v, 0x142, 0xA); DPPUMAX(v, 0x143, 0xC);
            const unsigned best = (unsigned)__builtin_amdgcn_readlane((int)v, 63);
            const int myq = (key[0] == best) ? 0 : (key[1] == best) ? 1 : (key[2] == best) ? 2 : (key[3] == best) ? 3 : 4;
            const unsigned long long bal = __ballot(myq < 4);
            const int L = __builtin_amdgcn_readfirstlane((int)__ffsll((long long)bal) - 1);
            const int q = __builtin_amdgcn_readlane(myq, L);
            const float mys = (q == 0) ? s[0] : (q == 1) ? s[1] : (q == 2) ? s[2] : s[3];
            const float sk = __int_as_float(__builtin_amdgcn_readlane(__float_as_int(mys), L));
            if (F.lane == L) {
#pragma unroll
                for (int qq = 0; qq < 4; ++qq) if (qq == q) key[qq] = 0u; }
            if (F.lane == k) { myE = 4 * L + q; myS = sk; }
            ssum += sk;
        }
        if (F.lane < TOPK) { const unsigned lp = atomicAdd((unsigned*)(lcount + myE), 1u); lsel[rl * 8 + F.lane] = (unsigned)myE | (lp << 8); lwt[rl * 8 + F.lane] = __float_as_uint(myS / ssum * 2.5f); }
    }
#undef DPPF
#undef DPPUMAX
    __syncthreads();
    if (F.tid < 256) { const unsigned n = lcount[F.tid]; lbase[F.tid] = n ? __hip_atomic_fetch_add((unsigned*)(F.ctl + CW_CNT + F.tid), n, RLX_AGENT) : 0u; }
    __syncthreads();
    for (int a = F.tid; a < 2048; a += NWAVES * 64) { const unsigned se = lsel[a]; const unsigned e = se & 255u, lp = se >> 8; const unsigned pos = lbase[e] + lp; const unsigned tok = (unsigned)(pm * 256 + (a >> 3));
        wts[(size_t)tok * TOPK + (a & 7)] = __uint_as_float(lwt[a]); pose[(size_t)tok * TOPK + (a & 7)] = (e << 16) | (pos & 0xffffu);
        if (pos < (unsigned)LCAP) list[(size_t)e * LCAP + pos] = tok | ((unsigned)(a & 7) << 16); }
    __syncthreads();
}
__device__ __forceinline__ void build_tables(Frame& F) {
    LAS unsigned* tp = (LAS unsigned*)(F.lds + TAB_OFF); LAS unsigned* cn = tp + 260; LAS unsigned* cp = cn + 256; LAS unsigned* wt = cp + 256;
    __syncthreads();
    unsigned cnt = 0u, tiles = 0u, incl = 0u, cincl = 0u;
    if (F.tid < 256) { cnt = __hip_atomic_load((unsigned*)(F.ctl + CW_CNT + F.tid), RLX_AGENT); if (cnt > (unsigned)LCAP) cnt = LCAP; tiles = (cnt + 255u) >> 8; incl = tiles; cincl = cnt;
#pragma unroll
        for (int o = 1; o < 64; o <<= 1) { const unsigned t = __shfl_up(incl, o), t2 = __shfl_up(cincl, o); if (F.lane >= o) { incl += t; cincl += t2; } }
        if (F.lane == 63) { wt[F.wave] = incl; wt[8 + F.wave] = cincl; } }
    __syncthreads();
    if (F.tid < 256) { unsigned base = 0u, cbase = 0u; for (int w = 0; w < F.wave; ++w) { base += wt[w]; cbase += wt[8 + w]; } tp[F.tid + 1] = base + incl; cn[F.tid] = cnt; cp[F.tid] = cbase + cincl - cnt; if (F.tid == 0) tp[0] = 0u;
        LAS unsigned short* mt2e = (LAS unsigned short*)(F.lds + MT2E_OFF); const unsigned t0 = base + incl - tiles; for (unsigned t = 0; t < tiles; ++t) mt2e[t0 + t] = (unsigned short)F.tid; }
    __syncthreads();
}
__device__ __forceinline__ void combine_rows(Frame& F, const float* gate2, const float* g_final, float* dst) {
    const unsigned char* Y = (const unsigned char*)(F.ws + WS_YBUF); const float* WT = (const float*)(F.ws + WS_WTS); const unsigned* PE = (const unsigned*)(F.ws + WS_POSE);
    const LAS unsigned* cp = (const LAS unsigned*)(F.lds + TAB_OFF) + 260 + 256;
    const int gw = F.vcu * NWAVES + F.wave, NGW = F.G * NWAVES; const int c0 = 16 * F.lane;
    const unsigned char* YS = (const unsigned char*)(F.ws + WS_YSH);
    struct CRow { u32x4 yv[8]; u32x4 ys, xb[2]; f32x4 w0, w1; };
#define CR_PE(q_) ({ const size_t tq_ = rowb + 128 * (size_t)((q_) * 8 + (F.lane >> 3)); PE[tq_ * TOPK + (F.lane & 7)]; })
#define CR_CONV(pe_) ((unsigned)(cp[(pe_) >> 16] + ((pe_) & 0xffffu)))
#define CR_LOAD(R, m_, iv_, lb_) do { const size_t mq_ = (size_t)(m_); \
        _Pragma("unroll") for (int k = 0; k < 8; ++k) { const size_t yr_ = (size_t)(unsigned)__builtin_amdgcn_readlane((int)(iv_), (lb_) + k); R.yv[k] = *(const GAS u32x4*)(Y + yr_ * DM + c0); } \
        R.ys = *(const GAS u32x4*)(YS + mq_ * DM + c0); const GAS u32x4* or_ = (const GAS u32x4*)(x1_row(F.ws, mq_) + c0); R.xb[0] = or_[0]; R.xb[1] = or_[1]; R.w0 = *(const GAS f32x4*)(WT + mq_ * TOPK); R.w1 = *(const GAS f32x4*)(WT + mq_ * TOPK + 4); } while (0)
#define CR_COMPUTE(R, m_) do { const size_t mo_ = (size_t)(m_); \
            const float wk[8] = {R.w0.x, R.w0.y, R.w0.z, R.w0.w, R.w1.x, R.w1.y, R.w1.z, R.w1.w}; \
            f32x4 acc[4]; \
            _Pragma("unroll") for (int j = 0; j < 4; ++j) { const int wv = (int)R.ys[j]; const f32x2 lo = __builtin_amdgcn_cvt_pk_f32_fp8(wv, false), hi = __builtin_amdgcn_cvt_pk_f32_fp8(wv, true); f32x4 a = (f32x4){lo.x, lo.y, hi.x, hi.y}; \
                _Pragma("unroll") for (int k = 0; k < 8; ++k) { const int wk_ = (int)R.yv[k][j]; const f32x2 l2 = __builtin_amdgcn_cvt_pk_f32_fp8(wk_, false), h2 = __builtin_amdgcn_cvt_pk_f32_fp8(wk_, true); \
                    a.x += wk[k] * l2.x; a.y += wk[k] * l2.y; a.z += wk[k] * h2.x; a.w += wk[k] * h2.y; } \
                acc[j] = a; __builtin_amdgcn_sched_barrier(0); } \
            float s2 = 0.f; f32x4 v[4]; \
            _Pragma("unroll") for (int j = 0; j < 4; ++j) { const unsigned xa = R.xb[j >> 1][(j & 1) * 2], xc = R.xb[j >> 1][(j & 1) * 2 + 1]; const f32x4 xj = (f32x4){bf_lo(xa), bf_hi(xa), bf_lo(xc), bf_hi(xc)}; v[j] = xj + g2[j] * acc[j]; s2 += (v[j].x * v[j].x + v[j].y * v[j].y) + (v[j].z * v[j].z + v[j].w * v[j].w); } \
            const float r = 1.f / sqrtf(wave_sum(s2) * (1.f / DM) + EPS); \
            GAS f32x4* orow = (GAS f32x4*)(dst + mo_ * DM + c0); \
            _Pragma("unroll") for (int j = 0; j < 4; ++j) orow[j] = v[j] * r * gf[j]; } while (0)
    f32x4 gf[4];
#pragma unroll
    for (int j = 0; j < 4; ++j) gf[j] = *(const f32x4*)(g_final + c0 + 4 * j);
    for (int ch = gw; ch < M / 32; ch += NGW) {
        const int b = ch >> 7; const size_t rowb = (size_t)b * SEQ + (ch & 127);
        f32x4 g2[4];
#pragma unroll
        for (int j = 0; j < 4; ++j) g2[j] = *(const f32x4*)(gate2 + (size_t)b * NMOD + c0 + 4 * j) * (1.f / YSCALE);
        unsigned pe_nxt = CR_PE(0); unsigned idx_cur = CR_CONV(pe_nxt), idx_nxt = idx_cur;
        CRow A, B; CR_LOAD(A, rowb, idx_cur, 0);
        for (int q = 0; q < 4; ++q) { const int qn = q < 3 ? q + 1 : 3;
            pe_nxt = CR_PE(qn);
            for (int t = 0; t < 8; t += 2) { const size_t m = rowb + 128 * (size_t)(q * 8 + t);
                CR_LOAD(B, m + 128, idx_cur, (t + 1) * 8);
                CR_COMPUTE(A, m);
                { const bool wrap = (t == 6); const unsigned src = wrap ? idx_nxt : idx_cur; const int lb = wrap ? 0 : (t + 2) * 8; const size_t mn = wrap ? rowb + 128 * (size_t)(qn * 8) : m + 256; CR_LOAD(A, mn, src, lb); }
                CR_COMPUTE(B, m + 128);
                { unsigned pt_ = pe_nxt; asm volatile("" : "+v"(pt_)); idx_nxt = CR_CONV(pt_); } }
            idx_cur = idx_nxt; }
    }
#undef CR_PE
#undef CR_CONV
#undef CR_COMPUTE
#undef CR_LOAD
}

struct Args { const float* in[19]; float* out; unsigned char* ws; int ph_lo, ph_hi, li, pad; };
__global__ void __launch_bounds__(NWAVES * 64, 2) fwd_kernel(Args args) {
    extern __shared__ __attribute__((aligned(16))) unsigned char lds[];
    Frame F;
    F.lds = (LAS unsigned char*)lds;
    F.MISC = (volatile LAS unsigned*)(F.lds + MISC_OFF);
    F.tid = threadIdx.x; F.lane = F.tid & 63; F.wave = __builtin_amdgcn_readfirstlane(F.tid >> 6);
    F.G = gridDim.x; { const int bx = blockIdx.x; F.vcu = (F.G % 8 == 0) ? (bx % 8) * (F.G / 8) + bx / 8 : bx; }
    F.ws = args.ws; F.out = args.out; F.ctl = (gu32*)(args.ws + WS_CTL);
    unsigned char* ws = args.ws;
    typedef const __attribute__((address_space(4))) Args* KArgP;
#define KA(i) ({ KArgP p_ = (KArgP)__builtin_amdgcn_kernarg_segment_ptr(); asm volatile("" : "+s"(p_)); p_->in[i]; })
#define MOD ((float*)(ws + WS_MOD))
#define LF ((float*)(ws + WS_LF))
#define KB ((float*)(ws + WS_KB))
#define LSE ((float*)(ws + WS_LSE))
#define HB ((bf16_t*)(ws + WS_H))
#define QKV ((bf16_t*)(ws + WS_QKV))
#define LIST ((unsigned*)(ws + WS_LIST))
    for (int u = F.tid; u < (LDS_BYTES - LDSCTL_OFF) / 4; u += NWAVES * 64) ((LAS unsigned*)(F.lds + LDSCTL_OFF))[u] = 0u;
    __syncthreads();
    XcdBarrier bar; bar.bar = (unsigned*)(F.ctl + CW_BAR); bar.x = 0; bar.st = nullptr;
    if (N_LAUNCHES == 1) bar = xcd_barrier_post((unsigned*)(F.ctl + CW_BAR), F.MISC + 8);
#define GRID_BAR() do { if (N_LAUNCHES == 1) xcd_barrier(bar); } while (0)
#define REFRESH() do { int t_ = threadIdx.x; asm volatile("" : "+v"(t_)); F.tid = t_; F.lane = t_ & 63; } while (0)
    const int lo = args.ph_lo, hi = args.ph_hi;
#ifndef ONLY_PHASE
#define ONLY_PHASE -1
#endif
#define IN(k) ((ONLY_PHASE < 0 || ONLY_PHASE == (k)) && lo <= (k) && (k) < hi)
#define BOTH(k) (IN(k) && IN((k) + 1))

    if (IN(0)) {
        REFRESH();
        _Pragma("unroll") for (int rep_ = 0; rep_ < DUPN(0); ++rep_) {
        p0_mod(F, KA(1), KA(7), KA(8), MOD);
        P0Ptrs P{KA(2), KA(6), KA(9), KA(11), KA(12), KA(13), KA(14), KA(15), KA(16)};
        p0_weights(F, P); }
        if (BOTH(0)) GRID_BAR();
    }
    if (IN(1)) {
        REFRESH();
        _Pragma("unroll") for (int rep_ = 0; rep_ < DUPN(1); ++rep_) norm_rows<true>(F, KA(0), HB, MOD, 0, DM, KA(2), KA(3), LF, nullptr);
        if (BOTH(1)) GRID_BAR();
    }
    if (IN(2)) {
        REFRESH();
        _Pragma("unroll") for (int rep_ = 0; rep_ < DUPN(2); ++rep_) {
        scan_rows(F, LF, KB, (int*)(ws + WS_T0));
        pg8::Gemm g{HB, (const bf16_t*)(ws + WS_WIN), DM, nullptr}; pg8::StaticOrder S; S.init(M, 3072, F.G, (int)blockIdx.x);
        pg8::EpiQKV E{QKV, (size_t)M * HW, attn_body::C2};
        pg8::gemm_phase<pg8::EpiQKV, pg8::StaticOrder, false>(F.lds, g, S, E); }
        if (BOTH(2)) GRID_BAR();
    }
    if (IN(3)) {
        REFRESH();
        using attn_body::bf16; const float* rel_bias = KA(17);
        const bf16* Qf = (const bf16*)QKV; const bf16* Kf = Qf + (size_t)M * HW; const bf16* Vf = Kf + (size_t)M * HW;
        const bf16* Qd = Vf + (size_t)M * HW; const bf16* Kd = Qd + (size_t)M * HW; const bf16* Vd = Kd + (size_t)M * HW;
        bf16* OF = (bf16*)(ws + WS_OF);
        for (int cu = F.vcu; cu < 16 * BATCH; cu += F.G) {
            const int b = cu >> 4, j = cu & 15;
            for (int h = 0; h < NH; ++h) { const int q = (j + 4 * (h >> 1)) & 15; const int qb = (h & 1) ? 15 - q : q; const int bh = b * NH + h;
                const size_t hb = (size_t)b * SEQ * HW + h * HD; const int T0 = ((const int*)(ws + WS_T0))[bh * 16 + qb];
                if (DUPN(3) == 2) attn_body::attn_unit<8, 0>(Qf + hb, Kf + hb, Vf + hb, (bf16*)(ws + WS_SS0), (long)HW, 0L, qb * 256, T0, 4 * qb + 4 - T0, 0, nullptr, 0, (char*)lds, KB + (size_t)bh * SEQ, nullptr, 0);
                attn_body::attn_unit<8, 0>(Qf + hb, Kf + hb, Vf + hb, OF + hb, (long)HW, (long)HW, qb * 256, T0, 4 * qb + 4 - T0, 0, nullptr, 0, (char*)lds, KB + (size_t)bh * SEQ, nullptr, 0); }
        }
        for (int job = F.vcu; job < 2 * BATCH * NH; job += F.G) {
            const int bh = job >> 1, sub = job & 1, b = bh >> 3, h = bh & 7;
            const size_t hb = (size_t)b * SEQ * HW + h * HD;
            const int nd = sub ? 25 : 23; int tabkey = -1;
            { __syncthreads(); for (int i = F.tid; i < attn_body::DL_ZEND / 16; i += NWAVES * 64) *(LAS f32x4*)(F.lds + i * 16) = (f32x4){0.f, 0.f, 0.f, 0.f}; __syncthreads(); }
#define DIL_PARAMS(i_, dsel_, d_, r_, qb_) do { if ((i_) < 16) { if (sub == 0) { dsel_ = 0; d_ = 1; r_ = 0; qb_ = (i_); } else { dsel_ = 1; d_ = 4; r_ = (i_) >> 2; qb_ = (i_) & 3; } } \
                else { dsel_ = 2; d_ = 16; r_ = ((i_) - 16) + (sub ? 7 : 0); qb_ = 0; } } while (0)
            for (int i = 0; i < nd; ++i) {
                int dsel, d, r, qb; DIL_PARAMS(i, dsel, d, r, qb);
                int dseln = 0, dn = 1, rn = 0, qbn = 0; const bool has_next = (i + 1 < nd); if (has_next) DIL_PARAMS(i + 1, dseln, dn, rn, qbn);
                bf16* OB = (bf16*)(ws + (dsel == 0 ? WS_O1 : dsel == 1 ? WS_O2 : WS_O3));
                const size_t sb = hb + (size_t)r * HW, sbn = hb + (size_t)rn * HW;
                float* lsep = LSE + (size_t)dsel * M * NH + ((size_t)b * SEQ + r) * NH + h;
                const bool bt = (tabkey != dsel); tabkey = dsel;
                const attn_body::DilSrc cu{Kd + sb, Vd + sb, (long)d * HW, qb * 256, qb == 0}, nx{Kd + sbn, Vd + sbn, (long)dn * HW, qbn * 256, qbn == 0};
                _Pragma("unroll") for (int rep_ = 0; rep_ < DUPN(3); ++rep_)
                attn_body::dil_unit<8>(Qd + sb, cu, (i & 1) ? attn_body::DL_KB : attn_body::DL_K, i > 0 && DUPN(3) == 1, nx, has_next && DUPN(3) == 1, OB + sb, lsep, (long)d * NH, (char*)lds, rel_bias + h, dsel, bt); }
#undef DIL_PARAMS
        }
        if (BOTH(3)) GRID_BAR();
    }
    if (IN(4)) {
        REFRESH();
        _Pragma("unroll") for (int rep_ = 0; rep_ < DUPN(4); ++rep_) merge_rows(F, KA(4), KA(5));
        if (BOTH(4)) GRID_BAR();
    }
    if (IN(5)) {
        REFRESH();
        _Pragma("unroll") for (int rep_ = 0; rep_ < DUPN(5); ++rep_) {
        pg8::Gemm g{(const bf16_t*)(ws + WS_YM), (const bf16_t*)(ws + WS_WOUT), DM, nullptr}; pg8::StaticOrder S; S.init(M, DM, F.G, (int)blockIdx.x);
        pg8::EpiX1N E{KA(0), ws, MOD, F.lds, (float*)(ws + WS_EX), (unsigned*)(F.ctl + CW_X1)};
        pg8::gemm_phase<pg8::EpiX1N, pg8::StaticOrder, false>(F.lds, g, S, E); }
        if (BOTH(5)) GRID_BAR();
    }
    if (IN(6)) {
        REFRESH();
        (void)0;
    }
    if (IN(7)) {
        REFRESH();
        float* LOGITS = (float*)(ws + WS_LOGITS); const float* rbias_ = KA(10);
        { pg8::Gemm g{HB, (const bf16_t*)(ws + WS_WR), DM, nullptr}; pg8::StaticOrder S; S.init(M, NEXP, F.G, (int)blockIdx.x);
          pg8::EpiF32 E{LOGITS, NEXP};
          pg8::gemm_phase<pg8::EpiF32, pg8::StaticOrder, false>(F.lds, g, S, E);
          asm volatile("s_waitcnt vmcnt(0)" ::: "memory"); __syncthreads();
          pg8::Unit u; for (int i = 0; S.next(i, u); ++i) route_rows(F, u.pm, LOGITS, rbias_, LIST, (float*)(ws + WS_WTS), (unsigned*)(ws + WS_POSE)); }
        _Pragma("unroll") for (int rep_ = 0; rep_ < DUPN(7); ++rep_)
        { pg8::Gemm g{HB, (const bf16_t*)(ws + WS_WSHGU), DM, nullptr}; pg8::StaticOrder S; S.init(M, 512, F.G, (int)blockIdx.x);
          pg8::EpiSwiglu E{(bf16_t*)(ws + WS_ACTSH)};
          pg8::gemm_phase<pg8::EpiSwiglu, pg8::StaticOrder, false>(F.lds, g, S, E); }
        if (BOTH(7)) GRID_BAR();
    }
    if (IN(8)) {
        REFRESH();
        { pg8::Gemm g{(const bf16_t*)(ws + WS_ACTSH), (const bf16_t*)(ws + WS_WSHD), EH, nullptr}; pg8::StaticOrder S; S.init(M, DM, F.G, (int)blockIdx.x);
          pg8::EpiYbuf E{ws + WS_YSH, ws + WS_DUMP};
          pg8::gemm_phase<pg8::EpiYbuf, pg8::StaticOrder, false, false, true, 0, HOIST_SD>(F.lds, g, S, E); }
        build_tables(F);
#if PROBE_G1
        { pg8::Gemm g{(const bf16_t*)(ws + WS_H8), (const bf16_t*)(ws + WS_WGU), DM / 2, LIST};
          pg8::GroupedOrder S{(const LAS unsigned*)(F.lds + TAB_OFF), (const LAS unsigned*)(F.lds + TAB_OFF) + 260, 2, F.G, F.vcu, 2, 0, 0, (const LAS unsigned short*)(F.lds + MT2E_OFF)}; S.total = __builtin_amdgcn_readfirstlane((int)S.tp[256]) * 2;
          pg8::EpiSwiglu8 E{ws + WS_ACT};
          pg8::gemm_phase<pg8::EpiSwiglu8, pg8::GroupedOrder, true, true, true, PROBE_G1>(F.lds, g, S, E); }
#endif
        _Pragma("unroll") for (int rep_ = 0; rep_ < DUPN(8); ++rep_)
        { pg8::Gemm g{(const bf16_t*)(ws + WS_H8), (const bf16_t*)(ws + WS_WGU), DM / 2, LIST};
          pg8::GroupedOrder S{(const LAS unsigned*)(F.lds + TAB_OFF), (const LAS unsigned*)(F.lds + TAB_OFF) + 260, 2, F.G, F.vcu, 2, 0, 0, (const LAS unsigned short*)(F.lds + MT2E_OFF)}; S.total = __builtin_amdgcn_readfirstlane((int)S.tp[256]) * 2;
          pg8::EpiSwiglu8 E{ws + WS_ACT};
          pg8::gemm_phase<pg8::EpiSwiglu8, pg8::GroupedOrder, true, true, true, 0, HOIST_G1>(F.lds, g, S, E); }
        if (BOTH(8)) GRID_BAR();
    }
    if (IN(9)) {
        REFRESH();
        build_tables(F);
#if PROBE_G2
        { pg8::Gemm g{(const bf16_t*)(ws + WS_ACT), (const bf16_t*)(ws + WS_WD), EH / 2, LIST};
          pg8::GroupedOrder S{(const LAS unsigned*)(F.lds + TAB_OFF), (const LAS unsigned*)(F.lds + TAB_OFF) + 260, 4, F.G, F.vcu, 4, 0, 0, (const LAS unsigned short*)(F.lds + MT2E_OFF)}; S.total = __builtin_amdgcn_readfirstlane((int)S.tp[256]) * 4;
          pg8::EpiYbuf E{(unsigned char*)(ws + WS_YBUF), ws + WS_DUMP};
          pg8::gemm_phase<pg8::EpiYbuf, pg8::GroupedOrder, false, true, true, PROBE_G2>(F.lds, g, S, E); }
#endif
        _Pragma("unroll") for (int rep_ = 0; rep_ < DUPN(9); ++rep_)
        { pg8::Gemm g{(const bf16_t*)(ws + WS_ACT), (const bf16_t*)(ws + WS_WD), EH / 2, LIST};
          pg8::GroupedOrder S{(const LAS unsigned*)(F.lds + TAB_OFF), (const LAS unsigned*)(F.lds + TAB_OFF) + 260, 4, F.G, F.vcu, 4, 0, 0, (const LAS unsigned short*)(F.lds + MT2E_OFF)}; S.total = __builtin_amdgcn_readfirstlane((int)S.tp[256]) * 4;
          pg8::EpiYbuf E{(unsigned char*)(ws + WS_YBUF), ws + WS_DUMP};
          pg8::gemm_phase<pg8::EpiYbuf, pg8::GroupedOrder, false, true, true, 0, HOIST_G2>(F.lds, g, S, E); }
        if (BOTH(9)) GRID_BAR();
    }
    if (IN(10)) {
        REFRESH();
        build_tables(F);
        if (DUPN(10) == 2) combine_rows(F, MOD + 5 * DM, KA(18), (float*)(ws + WS_ACT));
        combine_rows(F, MOD + 5 * DM, KA(18), F.out);
    }
#undef KA
#undef MOD
#undef LF
#undef KB
#undef LSE
#undef HB
#undef QKV
#undef LIST
#undef REFRESH
#undef IN
#undef BOTH
#undef GRID_BAR
}

extern "C" void kernel_launch(void* const* d_in, const int* in_sizes, int n_in, void* d_out, int out_size, void* d_ws, size_t ws_size, hipStream_t stream) {
    static int grid = 0;
    if (grid == 0) {
        if (n_in != 19 || in_sizes[0] != M * DM || out_size != M * DM || ws_size < WS_NEED) {
            fprintf(stderr, "kernel_launch: unexpected shapes: n_in %d in0 %d out %d ws %zu (need %zu); nothing launched\n", n_in, n_in > 0 ? in_sizes[0] : -1, out_size, ws_size, (size_t)WS_NEED); grid = -1; return; }
        int dev = 0, cus = 0, per_cu = 0;
        if (hipGetDevice(&dev) != hipSuccess || hipDeviceGetAttribute(&cus, hipDeviceAttributeMultiprocessorCount, dev) != hipSuccess) { fprintf(stderr, "kernel_launch: device query failed\n"); grid = -1; return; }
        if (hipFuncSetAttribute((const void*)fwd_kernel, hipFuncAttributeMaxDynamicSharedMemorySize, LDS_BYTES) != hipSuccess) { fprintf(stderr, "kernel_launch: hipFuncSetAttribute failed\n"); grid = -1; return; }
        if (hipOccupancyMaxActiveBlocksPerMultiprocessor(&per_cu, (const void*)fwd_kernel, NWAVES * 64, LDS_BYTES) != hipSuccess || per_cu < 1)
            fprintf(stderr, "kernel_launch: note: occupancy query reports %d workgroups per CU\n", per_cu);
        (void)hipGetLastError();
        grid = cus;
    }
    if (grid < 0) return;
    if (hipMemsetAsync((char*)d_ws + WS_CTL, 0, CTL_ZERO_BYTES, stream) != hipSuccess) { fprintf(stderr, "kernel_launch: memset failed\n"); return; }
    Args a{};
    for (int i = 0; i < 19; ++i) a.in[i] = (const float*)d_in[i];
    a.out = (float*)d_out; a.ws = (unsigned char*)d_ws; a.pad = 0;
    for (int li = 0; li < N_LAUNCHES; ++li) {
        a.ph_lo = (N_LAUNCHES == 1) ? 0 : li; a.ph_hi = (N_LAUNCHES == 1) ? NPHASE : li + 1; a.li = li;
        hipLaunchKernelGGL(fwd_kernel, dim3(grid), dim3(NWAVES * 64), LDS_BYTES, stream, a);
        const hipError_t le = hipPeekAtLastError();
        if (le != hipSuccess) { fprintf(stderr, "kernel_launch: launch %d failed: %s\n", li, hipGetErrorName(le)); break; }
    }
}
```

```cpp
#include <hip/hip_runtime.h>
#include <hip/hip_bf16.h>
#include <cstdio>
#include <cstdint>

#ifndef DUP_MASK
#define DUP_MASK 0
#endif
#ifndef HOIST_SD
#define HOIST_SD false
#endif
#ifndef HOIST_G1
#define HOIST_G1 false
#endif
#ifndef HOIST_G2
#define HOIST_G2 true
#endif
#ifndef PROBE_G1
#define PROBE_G1 0
#endif
#ifndef PROBE_G2
#define PROBE_G2 0
#endif
#define DUPN(k) (((DUP_MASK >> (k)) & 1) ? 2 : 1)
#ifndef MK_N_LAUNCHES
#define MK_N_LAUNCHES 1
#endif

#define GAS __attribute__((address_space(1)))
#define LAS __attribute__((address_space(3)))

constexpr int BATCH = 16, SEQ = 4096, DM = 1024, M = BATCH * SEQ;
constexpr int NH = 8, HD = 64, HW = NH * HD;
constexpr int INC = 3080;
constexpr int NEXP = 256, TOPK = 8, EH = 256;
constexpr int NMOD = 6 * DM;
constexpr int LCAP = 65536;
constexpr float LOG2E = 1.4426950408889634f;
constexpr float EPS = 1e-6f;
constexpr float FOX_SKIP_LOG2 = 80.f;
constexpr float YSCALE = 16.f;
constexpr int NWAVES = 8;
constexpr int NPHASE = 11;
constexpr int N_LAUNCHES = MK_N_LAUNCHES;

constexpr size_t MiB = 1u << 20;
constexpr size_t WS_CTL = 0, CTL_ZERO_BYTES = 1 * MiB;
constexpr size_t WS_DUMP = 512 * 1024;
constexpr size_t WS_MOD = 1 * MiB;
constexpr size_t WS_LF = 2 * MiB;
constexpr size_t WS_KB = 4 * MiB;
constexpr size_t WS_LSE = 6 * MiB;
constexpr size_t WS_WIN = 12 * MiB;
constexpr size_t WS_WOUT = 18 * MiB;
constexpr size_t WS_WR = 20 * MiB;
constexpr size_t WS_WSHGU = WS_WR + MiB / 2;
constexpr size_t WS_WSHD = WS_WSHGU + MiB;
constexpr size_t WS_WTS = 22 * MiB;
constexpr size_t WS_SS0 = WS_MOD + MiB / 2;
constexpr size_t WS_T0 = WS_MOD + MiB / 2 + 65536;
constexpr size_t WS_WD = 24 * MiB;
constexpr size_t WS_WGU = 88 * MiB;
constexpr size_t WS_LIST = 216 * MiB;
constexpr size_t WS_O3 = WS_LIST;
constexpr size_t WS_H = 280 * MiB;
constexpr size_t WS_H8 = 408 * MiB;
constexpr size_t WS_QKV = 472 * MiB;
constexpr size_t WS_ACT = 856 * MiB;
constexpr size_t WS_YSH = 792 * MiB;
constexpr size_t WS_X1A = 728 * MiB;
constexpr size_t WS_X1B = 1000 * MiB;
constexpr size_t WS_END = 1000 * MiB, WS_NEED = 1064 * MiB;
constexpr size_t WS_YBUF = WS_LIST;
constexpr size_t WS_EX = WS_LSE + 4 * MiB;
constexpr size_t WS_POSE = WS_LSE;
constexpr size_t WS_OF = WS_QKV;
constexpr size_t WS_O1 = WS_H, WS_O2 = WS_H + 64 * MiB;
constexpr size_t WS_YM = WS_QKV + 64 * MiB;
constexpr size_t WS_LOGITS = WS_QKV;
constexpr size_t WS_ACTSH = WS_QKV + 64 * MiB;
static_assert(WS_ACT + (size_t)(M * TOPK + NEXP * 256) * EH <= WS_END, "act fits");
static_assert(WS_YBUF + (size_t)M * TOPK * DM <= WS_X1A && WS_X1A + 64 * MiB <= WS_YSH && WS_YSH + (size_t)M * DM <= WS_ACT && WS_X1B + 64 * MiB <= WS_NEED, "ybuf (unpadded rows), x1, ysh fit below act");
static_assert(WS_QKV + 6 * 64 * MiB <= WS_ACT, "qkv below act");
constexpr int CW_TMO = 0, CW_BAR = 4096, CW_CNT = 8192, CW_X1 = 12288;

constexpr int RING_BYTES = 131072;
constexpr int PHASE_LDS = 158720;
constexpr int LDSCTL_OFF = PHASE_LDS, MISC_OFF = LDSCTL_OFF + 320;
constexpr int TAB_OFF = MISC_OFF + 128;
constexpr int RLIST_OFF = RING_BYTES + 2304 * 2;
constexpr int MT2E_OFF = RING_BYTES;
constexpr int LDS_BYTES = 163840;
static_assert(TAB_OFF + 800 * 4 <= LDS_BYTES, "LDS map");

typedef unsigned short bf16_t;
typedef short bf16x8 __attribute__((ext_vector_type(8)));
typedef float f32x4 __attribute__((ext_vector_type(4)));
typedef float f32x2 __attribute__((ext_vector_type(2)));
typedef unsigned u32x4 __attribute__((ext_vector_type(4)));
typedef unsigned u32x2 __attribute__((ext_vector_type(2)));
typedef GAS unsigned gu32;
typedef int v4i_t __attribute__((ext_vector_type(4)));
typedef int v8i_t __attribute__((ext_vector_type(8)));
#define RLX_AGENT __ATOMIC_RELAXED, __HIP_MEMORY_SCOPE_AGENT

__device__ __forceinline__ unsigned cvt_pk_bf16(float lo, float hi) { unsigned r; asm volatile("v_cvt_pk_bf16_f32 %0, %1, %2" : "=v"(r) : "v"(lo), "v"(hi)); return r; }
__device__ __forceinline__ float bf_lo(unsigned w) { return __uint_as_float(w << 16); }
__device__ __forceinline__ float bf_hi(unsigned w) { return __uint_as_float(w & 0xffff0000u); }
__device__ __forceinline__ bf16_t* x1_row(unsigned char* ws, size_t m) { return (bf16_t*)(ws + (m < 32768 ? WS_X1A + m * 2048 : WS_X1B + (m - 32768) * 2048)); }
#define DPPF_(x, ctrl, rm) __int_as_float(__builtin_amdgcn_update_dpp(0, __float_as_int(x), ctrl, rm, 0xF, false))
__device__ __forceinline__ float wave_sum(float v) {
    v += DPPF_(v, 0xB1, 0xF); v += DPPF_(v, 0x4E, 0xF); v += DPPF_(v, 0x141, 0xF); v += DPPF_(v, 0x140, 0xF);
    v += DPPF_(v, 0x142, 0xA); v += DPPF_(v, 0x143, 0xC);
    return __int_as_float(__builtin_amdgcn_readlane(__float_as_int(v), 63));
}
__device__ __forceinline__ float reduce8_heads(const float (&f)[8], int lane) {
    float a[4], b[2];
#pragma unroll
    for (int i = 0; i < 4; ++i) { auto rr = __builtin_amdgcn_permlane32_swap(__float_as_uint(f[i]), __float_as_uint(f[i + 4]), false, false); a[i] = __uint_as_float(rr[0]) + __uint_as_float(rr[1]); }
#pragma unroll
    for (int i = 0; i < 2; ++i) { auto rr = __builtin_amdgcn_permlane16_swap(__float_as_uint(a[i]), __float_as_uint(a[i + 2]), false, false); b[i] = __uint_as_float(rr[0]) + __uint_as_float(rr[1]); }
    const bool b3 = (lane & 8) != 0; const float mine = b3 ? b[1] : b[0], give = b3 ? b[0] : b[1];
    float v = mine + DPPF_(give, 0x128, 0xF);
    v += DPPF_(v, 0xB1, 0xF); v += DPPF_(v, 0x4E, 0xF); v += DPPF_(v, 0x141, 0xF);
    return v;
}

__device__ const unsigned char T5B[3][132] = {
 {0,1,2,3,4,5,6,7,8,9,10,11,12,13,14,15,16,16,16,16,16,16,17,17,17,17,17,17,17,17,18,18,18,18,18,18,18,18,18,18,19,19,19,19,19,19,19,19,19,19,19,19,19,19,20,20,20,20,20,20,20,20,20,20,20,20,20,20,20,20,20,20,20,21,21,21,21,21,21,21,21,21,21,21,21,21,21,21,21,21,21,21,21,21,21,21,21,21,21,22,22,22,22,22,22,22,22,22,22,22,22,22,22,22,22,22,22,22,22,22,22,22,22,22,22,22,22,22,22,0,0,0},
 {0,4,8,12,16,16,17,17,18,18,19,19,19,19,20,20,20,20,20,21,21,21,21,21,21,22,22,22,22,22,22,22,22,22,23,23,23,23,23,23,23,23,23,23,23,23,24,24,24,24,24,24,24,24,24,24,24,24,24,24,24,24,25,25,25,25,25,25,25,25,25,25,25,25,25,25,25,25,25,25,25,25,25,26,26,26,26,26,26,26,26,26,26,26,26,26,26,26,26,26,26,26,26,26,26,26,26,26,26,26,26,26,26,27,27,27,27,27,27,27,27,27,27,27,27,27,27,27,27,0,0,0},
 {0,16,18,19,20,21,21,22,22,23,23,23,24,24,24,24,25,25,25,25,25,26,26,26,26,26,26,26,26,27,27,27,27,27,27,27,27,27,27,28,28,28,28,28,28,28,28,28,28,28,28,28,29,29,29,29,29,29,29,29,29,29,29,29,29,29,29,29,29,29,30,30,30,30,30,30,30,30,30,30,30,30,30,30,30,30,30,30,30,30,30,30,30,30,30,31,31,31,31,31,31,31,31,31,31,31,31,31,31,31,31,31,31,31,31,31,31,31,31,31,31,31,31,31,31,31,31,31,31,0,0,0}};

namespace pg8 {
constexpr int BM = 256, BK = 64, HALF = 128, HTB = HALF * BK * 2, STAGE_BYTES = 8 * HTB, NXCD = 8, WGM = 8;
__host__ __device__ __forceinline__ int lds_byte(int r, int c) { const int st = (r >> 4) * 2 + (c >> 5), rr = r & 15, cc = c & 31, ob = rr * 64 + cc * 2; return st * 1024 + (ob ^ (((ob >> 9) & 1) << 5)); }
__host__ __device__ __forceinline__ void stage_rc(int b, int& R, int& C) { const int st = b / 1024, sb = b % 1024, swz = sb ^ (((sb >> 9) & 1) << 5); R = (st >> 1) * 16 + swz / 64; C = (st & 1) * 32 + (swz % 64) / 2; }
__host__ __device__ __forceinline__ int perm32(int rho) { const int n = rho >> 4, i = rho & 15; return 8 * (i >> 2) + 4 * n + (i & 3); }

struct Unit { int pm, pn, pb, e, tile, cnt, yrow; };
struct Gemm { const bf16_t* A; const bf16_t* Bt; int K; const unsigned* list; };

struct StaticOrder {
    int nM, nN, nwg, G, c;
    __device__ void init(int Mr, int N, int G_, int c_) { nM = Mr / BM; nN = N / BM; nwg = nM * nN; G = G_; c = c_; }
    __device__ bool next(int i, Unit& u) const {
        const int L = i * G + c; if (L >= nwg) return false;
        int wgid = L; { const int q = nwg / NXCD, r = nwg % NXCD, xcd = wgid % NXCD, off = wgid / NXCD; wgid = (xcd < r ? xcd * (q + 1) : r * (q + 1) + (xcd - r) * q) + off; }
        const int nig = WGM * nN, gid = wgid / nig, fm = gid * WGM, gsz = (nM - fm) < WGM ? (nM - fm) : WGM;
        u.pm = fm + ((wgid % nig) % gsz); u.pn = (wgid % nig) / gsz; u.pb = u.pn; u.e = 0; u.tile = 0; u.cnt = 1 << 30; u.yrow = u.pm * BM; return true;
    }
};
struct GroupedOrder {
    const LAS unsigned* tp; const LAS unsigned* cn; int NT, G, c, NTB, pn0, total;
    const LAS unsigned short* mt2e;
    __device__ bool next(int i, Unit& u) const {
        const int L = i * G + c; if (L >= total) return false;
        const int mt = L / NT; u.pn = L % NT;
        const int lo = __builtin_amdgcn_readfirstlane((int)mt2e[mt]);
        u.e = lo; u.pm = mt; u.tile = mt - __builtin_amdgcn_readfirstlane((int)tp[lo]); u.pb = lo * NTB + pn0 + u.pn; u.cnt = __builtin_amdgcn_readfirstlane((int)cn[lo]); u.yrow = __builtin_amdgcn_readfirstlane((int)cn[256 + lo]) + u.tile * BM; return true;
    }
};

struct EpiQKV {
    static constexpr bool PERM = true; static constexpr int NVM = 16;
    bf16_t* O; size_t split_stride; float scale0;
    __device__ __forceinline__ void operator()(const f32x4 (&acc)[2][2][4][2], const Unit& u, int wr, int wc, int fr, int fq) const {
        const int row0 = u.pm * BM + wr * 64 + fr; int colt = u.pn * BM; const int t = colt / 512; bf16_t* base = O + (size_t)t * split_stride; colt -= t * 512;
        const float sc = (t == 0 || t == 3) ? scale0 : 1.f;
        const int col0 = colt + wc * 32 + 8 * fq;
#pragma unroll
        for (int ai = 0; ai < 2; ++ai)
#pragma unroll
            for (int m = 0; m < 4; ++m) { bf16_t* rowp = base + (size_t)(row0 + ai * HALF + m * 16) * 512 + col0;
#pragma unroll
                for (int bj = 0; bj < 2; ++bj) { const f32x4 v0 = acc[ai][bj][m][0] * sc, v1 = acc[ai][bj][m][1] * sc;
                    u32x4 w; w.x = cvt_pk_bf16(v0[0], v0[1]); w.y = cvt_pk_bf16(v0[2], v0[3]); w.z = cvt_pk_bf16(v1[0], v1[1]); w.w = cvt_pk_bf16(v1[2], v1[3]);
                    *(u32x4*)(rowp + bj * HALF) = w; } }
    }
};
struct EpiSwiglu {
    static constexpr bool PERM = true; static constexpr int NVM = 8;
    bf16_t* O;
    __device__ __forceinline__ void operator()(const f32x4 (&acc)[2][2][4][2], const Unit& u, int wr, int wc, int fr, int fq) const {
        const int row0 = u.pm * BM + wr * 64 + fr; const int col0 = u.pn * HALF + wc * 32 + 8 * fq;
#pragma unroll
        for (int ai = 0; ai < 2; ++ai)
#pragma unroll
            for (int m = 0; m < 4; ++m) { bf16_t* rowp = O + (size_t)(row0 + ai * HALF + m * 16) * EH + col0; float r[8];
#pragma unroll
                for (int n = 0; n < 2; ++n)
#pragma unroll
                    for (int i = 0; i < 4; ++i) { const float g = acc[ai][0][m][n][i], up = acc[ai][1][m][n][i]; r[n * 4 + i] = g * __builtin_amdgcn_rcpf(1.f + __expf(-g)) * up; }
                u32x4 w; w.x = cvt_pk_bf16(r[0], r[1]); w.y = cvt_pk_bf16(r[2], r[3]); w.z = cvt_pk_bf16(r[4], r[5]); w.w = cvt_pk_bf16(r[6], r[7]);
                *(u32x4*)rowp = w; }
    }
};
struct EpiSwiglu8 {
    static constexpr bool PERM = true; static constexpr int NVM = 4;
    unsigned char* O;
    __device__ __forceinline__ void operator()(const f32x4 (&acc)[2][2][4][2], const Unit& u, int wr, int wc, int fr, int fq) const {
        const size_t row0 = (size_t)u.pm * BM + wr * 64 + fr + (fq & 1) * HALF; const int col0 = u.pn * HALF + wc * 32 + 8 * (fq & 2);
#pragma unroll
        for (int m = 0; m < 4; ++m) { unsigned w[2][2];
#pragma unroll
            for (int ai = 0; ai < 2; ++ai) { float r[8];
#pragma unroll
                for (int n = 0; n < 2; ++n)
#pragma unroll
                    for (int i = 0; i < 4; ++i) { const float g = acc[ai][0][m][n][i], up = acc[ai][1][m][n][i]; r[n * 4 + i] = g * __builtin_amdgcn_rcpf(1.f + __expf(-g)) * up; }
                int w0 = __builtin_amdgcn_cvt_pk_fp8_f32(r[0], r[1], 0, false); w0 = __builtin_amdgcn_cvt_pk_fp8_f32(r[2], r[3], w0, true);
                int w1 = __builtin_amdgcn_cvt_pk_fp8_f32(r[4], r[5], 0, false); w1 = __builtin_amdgcn_cvt_pk_fp8_f32(r[6], r[7], w1, true);
                w[ai][0] = (unsigned)w0; w[ai][1] = (unsigned)w1; }
            const auto s0 = __builtin_amdgcn_permlane16_swap(w[0][0], w[1][0], false, false); const auto s1 = __builtin_amdgcn_permlane16_swap(w[0][1], w[1][1], false, false);
            u32x4 o; o.x = s0[0]; o.y = s1[0]; o.z = s0[1]; o.w = s1[1];
            *(u32x4*)(O + (row0 + m * 16) * EH + col0) = o; }
    }
};
struct EpiRes {
    static constexpr bool PERM = true; static constexpr int NVM = 0;
    const float* base; float* out; const float* gate;
    __device__ __forceinline__ void operator()(const f32x4 (&acc)[2][2][4][2], const Unit& u, int wr, int wc, int fr, int fq) const {
        const int b = u.pm >> 4; const int col0 = u.pn * BM + wc * 32 + 8 * fq; f32x4 gv[2][2];
#pragma unroll
        for (int bj = 0; bj < 2; ++bj)
#pragma unroll
            for (int n = 0; n < 2; ++n) gv[bj][n] = *(const f32x4*)(gate + (size_t)b * NMOD + col0 + bj * HALF + n * 4);
#pragma unroll
        for (int ai = 0; ai < 2; ++ai)
#pragma unroll
            for (int m = 0; m < 4; ++m) { const size_t off = (size_t)(u.pm * BM + ai * HALF + wr * 64 + m * 16 + fr) * DM + col0;
#pragma unroll
                for (int bj = 0; bj < 2; ++bj)
#pragma unroll
                    for (int n = 0; n < 2; ++n) { const f32x4 bs = *(const f32x4*)(base + off + bj * HALF + n * 4); *(f32x4*)(out + off + bj * HALF + n * 4) = bs + gv[bj][n] * acc[ai][bj][m][n]; } }
    }
};
struct EpiX1 {
    static constexpr bool PERM = true; static constexpr int NVM = 8;
    const float* base; unsigned char* ws; const float* gate;
    __device__ __forceinline__ void operator()(const f32x4 (&acc)[2][2][4][2], const Unit& u, int wr, int wc, int fr, int fq) const {
        const int b = u.pm >> 4; const int col0 = u.pn * BM + wc * 32 + 8 * fq; f32x4 gv[2][2];
#pragma unroll
        for (int bj = 0; bj < 2; ++bj)
#pragma unroll
            for (int n = 0; n < 2; ++n) gv[bj][n] = *(const f32x4*)(gate + (size_t)b * NMOD + col0 + bj * HALF + n * 4);
#pragma unroll
        for (int ai = 0; ai < 2; ++ai) { f32x4 pre[4][2][2];
#pragma unroll
            for (int m = 0; m < 4; ++m) { const size_t off = ((size_t)u.pm * BM + ai * HALF + wr * 64 + m * 16 + fr) * DM + col0;
#pragma unroll
                for (int bj = 0; bj < 2; ++bj) { pre[m][bj][0] = *(const f32x4*)(base + off + bj * HALF); pre[m][bj][1] = *(const f32x4*)(base + off + bj * HALF + 4); } }
            asm volatile("" ::: "memory");
#pragma unroll
            for (int m = 0; m < 4; ++m) { const size_t row = (size_t)u.pm * BM + ai * HALF + wr * 64 + m * 16 + fr; bf16_t* orow = x1_row(ws, row) + col0;
#pragma unroll
                for (int bj = 0; bj < 2; ++bj) { const f32x4 v0 = pre[m][bj][0] + gv[bj][0] * acc[ai][bj][m][0], v1 = pre[m][bj][1] + gv[bj][1] * acc[ai][bj][m][1];
                    u32x4 w; w.x = cvt_pk_bf16(v0[0], v0[1]); w.y = cvt_pk_bf16(v0[2], v0[3]); w.z = cvt_pk_bf16(v1[0], v1[1]); w.w = cvt_pk_bf16(v1[2], v1[3]);
                    *(u32x4*)(orow + bj * HALF) = w; } }
            asm volatile("" ::: "memory"); }
    }
};
struct EpiX1N {
    static constexpr bool PERM = true; static constexpr int NVM = 0;
    const float* base; unsigned char* ws; const float* mod; LAS unsigned char* lds; float* ex; unsigned* cnt;
    __device__ __forceinline__ void operator()(f32x4 (&acc)[2][2][4][2], const Unit& u, int wr, int wc, int fr, int fq) const {
        const int b = u.pm >> 4; const int col0 = u.pn * BM + wc * 32 + 8 * fq; const float* mb = mod + (size_t)b * NMOD;
        LAS float* red = (LAS float*)(lds + RING_BYTES); LAS float* rr = red + 4 * BM;
        float ss[2][4];
        { f32x4 gv[2][2];
#pragma unroll
          for (int bj = 0; bj < 2; ++bj)
#pragma unroll
            for (int n = 0; n < 2; ++n) gv[bj][n] = *(const f32x4*)(mb + 2 * DM + col0 + bj * HALF + n * 4);
#pragma unroll
          for (int am = 0; am < 4; ++am) { const int ai = am >> 1, m0 = (am & 1) * 2; f32x4 pre[2][2][2];
#pragma unroll
            for (int mm = 0; mm < 2; ++mm) { const size_t off = ((size_t)u.pm * BM + ai * HALF + wr * 64 + (m0 + mm) * 16 + fr) * DM + col0;
#pragma unroll
                for (int bj = 0; bj < 2; ++bj) { pre[mm][bj][0] = *(const f32x4*)(base + off + bj * HALF); pre[mm][bj][1] = *(const f32x4*)(base + off + bj * HALF + 4); } }
            asm volatile("" ::: "memory");
#pragma unroll
            for (int mm = 0; mm < 2; ++mm) { const int m = m0 + mm; const size_t row = (size_t)u.pm * BM + ai * HALF + wr * 64 + m * 16 + fr; bf16_t* orow = x1_row(ws, row) + col0; float s2 = 0.f;
#pragma unroll
                for (int bj = 0; bj < 2; ++bj) { const f32x4 v0 = pre[mm][bj][0] + gv[bj][0] * acc[ai][bj][m][0], v1 = pre[mm][bj][1] + gv[bj][1] * acc[ai][bj][m][1];
                    acc[ai][bj][m][0] = v0; acc[ai][bj][m][1] = v1;
                    s2 += ((v0[0] * v0[0] + v0[1] * v0[1]) + (v0[2] * v0[2] + v0[3] * v0[3])) + ((v1[0] * v1[0] + v1[1] * v1[1]) + (v1[2] * v1[2] + v1[3] * v1[3]));
                    u32x4 w; w.x = cvt_pk_bf16(v0[0], v0[1]); w.y = cvt_pk_bf16(v0[2], v0[3]); w.z = cvt_pk_bf16(v1[0], v1[1]); w.w = cvt_pk_bf16(v1[2], v1[3]);
                    *(u32x4*)(orow + bj * HALF) = w; }
                s2 += __shfl_xor(s2, 16); s2 += __shfl_xor(s2, 32); ss[ai][m] = s2; }
            asm volatile("" ::: "memory"); } }
        if (fq == 0) {
#pragma unroll
            for (int ai = 0; ai < 2; ++ai)
#pragma unroll
                for (int m = 0; m < 4; ++m) red[wc * BM + ai * HALF + wr * 64 + m * 16 + fr] = ss[ai][m]; }
        __syncthreads();
        const int tid = threadIdx.x; unsigned* slot = (unsigned*)ex + ((size_t)u.pm * 4) * BM;
        if (tid < BM) { const float tot = (red[tid] + red[BM + tid]) + (red[2 * BM + tid] + red[3 * BM + tid]);
            __hip_atomic_store(slot + u.pn * BM + tid, __float_as_uint(tot), __ATOMIC_RELAXED, __HIP_MEMORY_SCOPE_AGENT); }
        asm volatile("s_waitcnt vmcnt(0)" ::: "memory");
        __syncthreads();
        if (tid == 0) { (void)__hip_atomic_fetch_add(cnt + u.pm, 1u, __ATOMIC_RELAXED, __HIP_MEMORY_SCOPE_AGENT); unsigned sp = 0;
            while (__hip_atomic_load(cnt + u.pm, __ATOMIC_RELAXED, __HIP_MEMORY_SCOPE_AGENT) < 4u) { __builtin_amdgcn_s_sleep(1); if (++sp > (1u << 22)) break; } }
        __syncthreads();
        if (tid < BM) { float t4 = 0.f;
#pragma unroll
            for (int q = 0; q < 4; ++q) t4 += __uint_as_float(__hip_atomic_load(slot + q * BM + tid, __ATOMIC_RELAXED, __HIP_MEMORY_SCOPE_AGENT));
            rr[tid] = 1.f / sqrtf(t4 * (1.f / DM) + EPS); }
        __syncthreads();
        f32x4 sc[2][2], sh[2][2];
#pragma unroll
        for (int bj = 0; bj < 2; ++bj)
#pragma unroll
            for (int n = 0; n < 2; ++n) { sc[bj][n] = *(const f32x4*)(mb + 4 * DM + col0 + bj * HALF + n * 4) + 1.f; sh[bj][n] = *(const f32x4*)(mb + 3 * DM + col0 + bj * HALF + n * 4); }
        bf16_t* H2 = (bf16_t*)(ws + WS_H); unsigned char* H8 = ws + WS_H8;
        const int col8 = u.pn * BM + (fq & 1) * HALF + wc * 32 + 8 * (fq & 2);
#pragma unroll
        for (int ai = 0; ai < 2; ++ai)
#pragma unroll
            for (int m = 0; m < 4; ++m) { const int rl = ai * HALF + wr * 64 + m * 16 + fr; const size_t row = (size_t)u.pm * BM + rl; const float r = rr[rl]; unsigned w8[2][2];
#pragma unroll
                for (int bj = 0; bj < 2; ++bj) { const f32x4 h0 = acc[ai][bj][m][0] * r * sc[bj][0] + sh[bj][0], h1 = acc[ai][bj][m][1] * r * sc[bj][1] + sh[bj][1];
                    u32x4 w; w.x = cvt_pk_bf16(h0[0], h0[1]); w.y = cvt_pk_bf16(h0[2], h0[3]); w.z = cvt_pk_bf16(h1[0], h1[1]); w.w = cvt_pk_bf16(h1[2], h1[3]);
                    *(u32x4*)(H2 + row * DM + col0 + bj * HALF) = w;
                    int q0 = __builtin_amdgcn_cvt_pk_fp8_f32(h0[0], h0[1], 0, false); q0 = __builtin_amdgcn_cvt_pk_fp8_f32(h0[2], h0[3], q0, true);
                    int q1 = __builtin_amdgcn_cvt_pk_fp8_f32(h1[0], h1[1], 0, false); q1 = __builtin_amdgcn_cvt_pk_fp8_f32(h1[2], h1[3], q1, true);
                    w8[bj][0] = (unsigned)q0; w8[bj][1] = (unsigned)q1; }
                const auto s0 = __builtin_amdgcn_permlane16_swap(w8[0][0], w8[1][0], false, false); const auto s1 = __builtin_amdgcn_permlane16_swap(w8[0][1], w8[1][1], false, false);
                u32x4 o; o.x = s0[0]; o.y = s1[0]; o.z = s0[1]; o.w = s1[1];
                *(u32x4*)(H8 + row * DM + col8) = o; }
    }
};
struct EpiF32 {
    static constexpr bool PERM = false; static constexpr int NVM = 16;
    float* out; int ldc;
    __device__ __forceinline__ void operator()(const f32x4 (&acc)[2][2][4][2], const Unit& u, int wr, int wc, int fr, int fq) const {
        const int col0 = u.pn * BM + wc * 32 + 4 * fq;
#pragma unroll
        for (int ai = 0; ai < 2; ++ai)
#pragma unroll
            for (int m = 0; m < 4; ++m) { const size_t off = (size_t)(u.pm * BM + ai * HALF + wr * 64 + m * 16 + fr) * ldc + col0;
#pragma unroll
                for (int bj = 0; bj < 2; ++bj)
#pragma unroll
                    for (int n = 0; n < 2; ++n) *(f32x4*)(out + off + bj * HALF + n * 16) = acc[ai][bj][m][n]; }
    }
};
struct EpiYbuf {
    static constexpr bool PERM = true; static constexpr int NVM = 8;
    unsigned char* Y; unsigned char* dump;
    __device__ __forceinline__ void operator()(const f32x4 (&acc)[2][2][4][2], const Unit& u, int wr, int wc, int fr, int fq) const {
        const int colb = u.pn * BM + wc * 64 + (fq & 1) * 32 + 8 * (fq & 2);
#pragma unroll
        for (int ai = 0; ai < 2; ++ai)
#pragma unroll
            for (int m = 0; m < 4; ++m) { const int rl = ai * HALF + wr * 64 + m * 16 + fr; const size_t row = (size_t)u.yrow + rl; const bool live = u.tile * BM + rl < u.cnt;
                unsigned w[2][2];
#pragma unroll
                for (int bj = 0; bj < 2; ++bj) { f32x4 v0 = acc[ai][bj][m][0] * YSCALE, v1 = acc[ai][bj][m][1] * YSCALE;
#pragma unroll
                    for (int i = 0; i < 4; ++i) { v0[i] = __builtin_amdgcn_fmed3f(v0[i], -440.f, 440.f); v1[i] = __builtin_amdgcn_fmed3f(v1[i], -440.f, 440.f); }
                    int w0 = __builtin_amdgcn_cvt_pk_fp8_f32(v0[0], v0[1], 0, false); w0 = __builtin_amdgcn_cvt_pk_fp8_f32(v0[2], v0[3], w0, true);
                    int w1 = __builtin_amdgcn_cvt_pk_fp8_f32(v1[0], v1[1], 0, false); w1 = __builtin_amdgcn_cvt_pk_fp8_f32(v1[2], v1[3], w1, true);
                    w[bj][0] = (unsigned)w0; w[bj][1] = (unsigned)w1; }
                const auto s0 = __builtin_amdgcn_permlane16_swap(w[0][0], w[1][0], false, false); const auto s1 = __builtin_amdgcn_permlane16_swap(w[0][1], w[1][1], false, false);
                u32x4 o; o.x = s0[0]; o.y = s1[0]; o.z = s0[1]; o.w = s1[1];
                *(u32x4*)(live ? Y + row * DM + colb : dump + (size_t)rl * DM + colb) = o; }
    }
};

template <class Epi, class Sched, bool GATHER, bool FP8 = false, bool SHORTK = false, int VAR = 0, bool HOIST = false>
__device__ __forceinline__ void gemm_phase(LAS unsigned char* lds, const Gemm g, const Sched& S, const Epi& E) {
    int tid_ = threadIdx.x; asm volatile("" : "+v"(tid_));
    const int tid = tid_, wid = __builtin_amdgcn_readfirstlane(tid >> 6), lane = tid & 63, wr = wid >> 2, wc = wid & 3, fr = lane & 15, fq = lane >> 4;
    int K_ = g.K; if constexpr (SHORTK) asm volatile("" : "+s"(K_));
    const int K = K_, nt = K / BK;
    unsigned voffA[2], voffB[2];
#pragma unroll
    for (int i = 0; i < 2; ++i) { int R, C; stage_rc(tid * 16 + i * 8192, R, C); const int Rb = Epi::PERM ? ((R & ~31) + perm32(R & 31)) : R;
        voffA[i] = (unsigned)(R * K + C) * 2u; voffB[i] = (unsigned)(Rb * K + C) * 2u; }
    const size_t kstep = (size_t)(BK * 2);
    const size_t hstep = (size_t)HALF * K * 2;
    const size_t tstep = 2 * hstep;
    const unsigned ldsw = (unsigned)wid * 1024u;
    const int aoff = lds_byte(wr * 64 + fr, fq * 8), boff = lds_byte(wc * 32 + fr, fq * 8);
#define PG8_SA(b, h) (((b) * 2 + (h)) * HTB)
#define PG8_SB(b, h) ((4 + (b) * 2 + (h)) * HTB)
#define PG8_GLDS(src, bufoff, i) if constexpr (!(VAR & 1)) __builtin_amdgcn_global_load_lds((const unsigned*)(src), (LAS unsigned*)(lds + (bufoff) + ldsw + (i) * 8192), 16, 0, 0)
#define PG8_STAGE(bufoff, gbase, voff) do { _Pragma("unroll") for (int _i = 0; _i < 2; ++_i) PG8_GLDS((const char*)(gbase) + (voff)[_i], bufoff, _i); } while (0)
#define PG8_STA(bufoff, aptr, h, SEL) do { if constexpr (GATHER) { const unsigned _p = (SEL) ? gvn[h] : gvc[h]; _Pragma("unroll") for (int _i = 0; _i < 2; ++_i) { unsigned _c = voffB[_i]; asm volatile("" : "+v"(_c)); \
            const unsigned _o = ((_i ? (_p >> 16) : (_p & 0xffffu)) * (unsigned)(K * 2)) + (_c & (unsigned)(K * 2 - 1)); PG8_GLDS((const char*)(aptr) + _o, bufoff, _i); } } \
        else { PG8_STAGE(bufoff, (const char*)(aptr) + (h) * hstep, voffA); } } while (0)
#define PG8_LDA(dst, b, h) do { _Pragma("unroll") for (int m = 0; m < 4; ++m) _Pragma("unroll") for (int k = 0; k < 2; ++k) dst[m][k] = *(const LAS bf16x8*)(lds + PG8_SA(b, h) + aoff + m * 2048 + k * 1024); } while (0)
#define PG8_LDB(dst, b, h) do { _Pragma("unroll") for (int n = 0; n < 2; ++n) _Pragma("unroll") for (int k = 0; k < 2; ++k) dst[n][k] = *(const LAS bf16x8*)(lds + PG8_SB(b, h) + boff + n * 2048 + k * 1024); } while (0)
#define PG8_CAT8(lo, hi) ({ const v4i_t a_ = __builtin_bit_cast(v4i_t, lo), b_ = __builtin_bit_cast(v4i_t, hi); (v8i_t){a_.x, a_.y, a_.z, a_.w, b_.x, b_.y, b_.z, b_.w}; })
#define PG8_MMA(ai, bj, At, Bt) do { __builtin_amdgcn_s_setprio(1); if constexpr (VAR & 2) { asm volatile("" :: "v"(At[0][0]), "v"(At[3][1]), "v"(Bt[0][0]), "v"(Bt[1][1])); } else if constexpr (FP8) { _Pragma("unroll") for (int m = 0; m < 4; ++m) _Pragma("unroll") for (int n = 0; n < 2; ++n) \
        acc[ai][bj][m][n] = __builtin_amdgcn_mfma_scale_f32_16x16x128_f8f6f4(PG8_CAT8(Bt[n][0], Bt[n][1]), PG8_CAT8(At[m][0], At[m][1]), acc[ai][bj][m][n], 0, 0, 0, 0x7F7F7F7F, 0, 0x7F7F7F7F); } \
      else { _Pragma("unroll") for (int m = 0; m < 4; ++m) _Pragma("unroll") for (int n = 0; n < 2; ++n) _Pragma("unroll") for (int k = 0; k < 2; ++k) \
        acc[ai][bj][m][n] = __builtin_amdgcn_mfma_f32_16x16x32_bf16(Bt[n][k], At[m][k], acc[ai][bj][m][n], 0, 0, 0); } \
      if constexpr (SHORTK) { _Pragma("unroll") for (int m = 0; m < 4; ++m) _Pragma("unroll") for (int n = 0; n < 2; ++n) asm volatile("" : "+v"(acc[ai][bj][m][n])); }     \
      __builtin_amdgcn_s_setprio(0); } while (0)
#define PG8_WAIT_V(n) asm volatile("s_waitcnt vmcnt(" #n ")" ::: "memory")
#define PG8_WAIT_VF() do { if (fst) asm volatile("s_waitcnt vmcnt(%0)" :: "n"(8 + NQ) : "memory"); else asm volatile("s_waitcnt vmcnt(8)" ::: "memory"); } while (0)
#define PG8_WAIT_L(n) asm volatile("s_waitcnt lgkmcnt(" #n ")" ::: "memory")
#define PG8_BAR __builtin_amdgcn_s_barrier()
#define PG8_SCHED __builtin_amdgcn_sched_barrier(0)
#define PG8_ROWS_LOAD(u, ld) do { _Pragma("unroll") for (int _h = 0; _h < 2; ++_h) _Pragma("unroll") for (int _i = 0; _i < 2; ++_i) { int _R, _C; stage_rc(tid * 16 + _i * 8192, _R, _C); const int _idx = (u).tile * BM + _h * HALF + _R; \
            const int _ic = _idx < (u).cnt ? _idx : (u).cnt - 1; ld[_h][_i] = g.list[(size_t)(u).e * LCAP + _ic]; } } while (0)
#define PG8_ROWS_USE(u, ld, gv) do { asm volatile("" : "+v"(ld[0][0]), "+v"(ld[0][1]), "+v"(ld[1][0]), "+v"(ld[1][1])); \
        _Pragma("unroll") for (int _h = 0; _h < 2; ++_h) { unsigned _t2[2]; _Pragma("unroll") for (int _i = 0; _i < 2; ++_i) { int _R, _C; stage_rc(tid * 16 + _i * 8192, _R, _C); const int _idx = (u).tile * BM + _h * HALF + _R; \
            _t2[_i] = (_idx < (u).cnt) ? (ld[_h][_i] & 0xffffu) : 0u; } gv[_h] = _t2[0] | (_t2[1] << 16); } } while (0)
    constexpr int NQ = Epi::NVM + (GATHER ? 1 : 0);
#define PG8_ROWS_DMA(u) __builtin_amdgcn_global_load_lds((const unsigned*)(g.list + (size_t)(u).e * LCAP + (u).tile * BM + (wid & 3) * 64 + lane), (LAS unsigned*)(lds + RLIST_OFF + (wid & 3) * 256), 4, 0, 0)
#define PG8_ROWS_USE_LDS(u, gv) do { _Pragma("unroll") for (int _h = 0; _h < 2; ++_h) { unsigned _t2[2]; _Pragma("unroll") for (int _i = 0; _i < 2; ++_i) { int _R, _C; stage_rc(tid * 16 + _i * 8192, _R, _C); const int _idx = (u).tile * BM + _h * HALF + _R; \
            const unsigned _v = *(const LAS unsigned*)(lds + RLIST_OFF + (_h * HALF + _R) * 4); _t2[_i] = (_idx < (u).cnt) ? (_v & 0xffffu) : 0u; } gv[_h] = _t2[0] | (_t2[1] << 16); } } while (0)
    Unit cur, nxt; int ui = 0;
    if (!S.next(0, cur)) return;
    f32x4 acc[2][2][4][2];
#pragma unroll
    for (int a = 0; a < 2; ++a)
#pragma unroll
        for (int b = 0; b < 2; ++b)
#pragma unroll
            for (int m = 0; m < 4; ++m)
#pragma unroll
                for (int n = 0; n < 2; ++n) acc[a][b][m][n] = (f32x4){0.f, 0.f, 0.f, 0.f};
    bf16x8 At[4][2], B0[2][2], B1[2][2];
    unsigned gvc[2] = {0u, 0u}, gvn[2] = {0u, 0u};
    if constexpr (GATHER) { unsigned rld[2][2]; PG8_ROWS_LOAD(cur, rld); PG8_ROWS_USE(cur, rld, gvc); }
    const char* cA = GATHER ? (const char*)g.A : (const char*)g.A + (size_t)cur.pm * tstep; const char* cB = (const char*)g.Bt + (size_t)cur.pb * tstep;
    PG8_STAGE(PG8_SB(0, 0), cB, voffB); PG8_STAGE(PG8_SB(0, 1), cB + hstep, voffB); PG8_STA(PG8_SA(0, 0), cA, 0, false); PG8_STA(PG8_SA(0, 1), cA, 1, false);
    if (wr == 1) PG8_BAR;
    PG8_WAIT_V(2); PG8_BAR;
    PG8_STAGE(PG8_SB(1, 0), cB + kstep, voffB); PG8_STA(PG8_SA(1, 0), cA + kstep, 0, false); PG8_STAGE(PG8_SB(1, 1), cB + hstep + kstep, voffB);
    PG8_WAIT_V(6); PG8_BAR;
    for (;;) {
        const bool has_next = S.next(ui + 1, nxt);
        const char* nA = has_next ? (GATHER ? (const char*)g.A : (const char*)g.A + (size_t)nxt.pm * tstep) : cA; const char* nB = has_next ? (const char*)g.Bt + (size_t)nxt.pb * tstep : cB;
        if constexpr (GATHER) { if (!has_next) { nxt = cur; gvn[0] = gvc[0]; gvn[1] = gvc[1]; } PG8_ROWS_DMA(nxt); }
        int t = 0;
        do {
            const bool last = (t == nt - 2);
            const bool fst = HOIST && (t == 0) && (ui > 0);
            if constexpr (GATHER) { if (last && has_next) { PG8_ROWS_USE_LDS(nxt, gvn); } }
            const char* a1 = cA + (size_t)(t + 1) * kstep;
            const char* a2 = last ? nA : cA + (size_t)(t + 2) * kstep; const char* b2 = last ? nB : cB + (size_t)(t + 2) * kstep;
            const char* a3 = a2 + kstep; const char* b3 = b2 + kstep;
            PG8_LDB(B0, 0, 0); PG8_LDB(B1, 0, 1); PG8_SCHED; PG8_LDA(At, 0, 0); if (!fst) PG8_STA(PG8_SA(1, 1), a1, 1, false);
            PG8_WAIT_VF(); PG8_WAIT_L(0); PG8_BAR; PG8_MMA(0, 0, At, B0); PG8_MMA(0, 1, At, B1); PG8_BAR; PG8_SCHED;
            PG8_LDA(At, 0, 1); PG8_STAGE(PG8_SB(0, 0), b2, voffB); PG8_STAGE(PG8_SB(0, 1), b2 + hstep, voffB); PG8_STA(PG8_SA(0, 0), a2, 0, last);
            PG8_WAIT_VF(); PG8_WAIT_L(0); PG8_BAR; PG8_MMA(1, 0, At, B0); PG8_MMA(1, 1, At, B1); PG8_BAR; PG8_SCHED;
            PG8_LDB(B0, 1, 0); PG8_LDB(B1, 1, 1); PG8_SCHED; PG8_LDA(At, 1, 0); PG8_STA(PG8_SA(0, 1), a2, 1, last);
            PG8_WAIT_VF(); PG8_WAIT_L(0); PG8_BAR; PG8_MMA(0, 0, At, B0); PG8_MMA(0, 1, At, B1); PG8_BAR; PG8_SCHED;
            PG8_LDA(At, 1, 1); PG8_STAGE(PG8_SB(1, 0), b3, voffB); PG8_STAGE(PG8_SB(1, 1), b3 + hstep, voffB); PG8_STA(PG8_SA(1, 0), a3, 0, last);
            PG8_WAIT_V(8); PG8_WAIT_L(0); PG8_BAR; PG8_MMA(1, 0, At, B0); PG8_MMA(1, 1, At, B1); PG8_BAR; PG8_SCHED;
            t += 2;
        } while (t < nt);
        if constexpr (HOIST) PG8_STA(PG8_SA(1, 1), nA + kstep, 1, true);
        if (wr == 0) PG8_BAR;
        { int te_ = threadIdx.x; asm volatile("" : "+v"(te_)); int fr_ = te_ & 15, fq_ = (te_ >> 4) & 3; asm volatile("" : "+v"(fr_), "+v"(fq_));
          if constexpr (!(VAR & 4)) E(acc, cur, wr, wc, fr_, fq_); else { _Pragma("unroll") for (int a = 0; a < 2; ++a) _Pragma("unroll") for (int b = 0; b < 2; ++b) _Pragma("unroll") for (int m = 0; m < 4; ++m) _Pragma("unroll") for (int n = 0; n < 2; ++n) asm volatile("" :: "v"(acc[a][b][m][n])); } }
        if (!has_next) break;
#pragma unroll
        for (int a = 0; a < 2; ++a)
#pragma unroll
            for (int b = 0; b < 2; ++b)
#pragma unroll
                for (int m = 0; m < 4; ++m)
#pragma unroll
                    for (int n = 0; n < 2; ++n) acc[a][b][m][n] = (f32x4){0.f, 0.f, 0.f, 0.f};
        cur = nxt; cA = nA; cB = nB; ++ui;
        if constexpr (GATHER) { gvc[0] = gvn[0]; gvc[1] = gvn[1]; }
        if (wr == 1) PG8_BAR;
    }
    PG8_WAIT_V(0);
    PG8_BAR;
#undef PG8_SA
#undef PG8_SB
#undef PG8_GLDS
#undef PG8_STAGE
#undef PG8_STA
#undef PG8_LDA
#undef PG8_LDB
#undef PG8_MMA
#undef PG8_CAT8
#undef PG8_WAIT_V
#undef PG8_WAIT_VF
#undef PG8_WAIT_L
#undef PG8_BAR
#undef PG8_SCHED
#undef PG8_ROWS_LOAD
#undef PG8_ROWS_USE
#undef PG8_ROWS_DMA
#undef PG8_ROWS_USE_LDS
}
}

namespace attn_body {
using bf16 = __hip_bfloat16;
using s16x4 = __attribute__((ext_vector_type(4))) short;
using f32x16 = __attribute__((ext_vector_type(16))) float;
constexpr int D = 64, NW = 8, QBLK = 32, QB = QBLK * NW, KVBLK = 64;
__device__ __forceinline__ int crow(int r, int hi) { return (r & 3) + 8 * (r >> 2) + 4 * hi; }
#define SBAR() __builtin_amdgcn_sched_barrier(0)
__device__ __forceinline__ void cmask(f32x16& p0, f32x16& p1, int jb, int qrel, int hi) {
  const float NEG = -INFINITY; int kb = 64 * jb + 4 * hi;
  #pragma unroll
  for (int r = 0; r < 16; ++r) { int kv = kb + (r & 3) + 8 * (r >> 2); if (kv > qrel) p0[r] = NEG; if (kv + 32 > qrel) p1[r] = NEG; }
}
constexpr int NSLOT = 3, SLOTB = 8192;
constexpr int LDS_K = 0, LDS_V = NSLOT * SLOTB, LDS_WS = 2 * NSLOT * SLOTB, LDS_OST = LDS_WS + NW * 64 * 4, LDS_BYTES = LDS_OST + NW * 4096;
constexpr int LDS_KBT = LDS_BYTES;
constexpr int LDS_TREV = LDS_KBT + 16384;
constexpr int LDS_TOTAL = LDS_TREV + 3072;
constexpr float C2 = 0.125f * 1.4426950408889634f;
__device__ __forceinline__ void glds16(const void* gsrc, unsigned lds_dst) { unsigned keep;
  asm volatile("s_mov_b32 %0, m0\n\ts_mov_b32 m0, %2\n\ts_nop 0\n\tglobal_load_lds_dwordx4 %1, off\n\ts_mov_b32 m0, %0" : "=&s"(keep) : "v"(gsrc), "s"(lds_dst) : "memory"); }
__device__ __forceinline__ float max3f(float a, float b, float c) { float r; asm("v_max3_f32 %0, %1, %2, %3" : "=v"(r) : "v"(a), "v"(b), "v"(c)); return r; }
__device__ __forceinline__ float max2f(float a, float b) { float r; asm("v_max_f32_e32 %0, %1, %2" : "=v"(r) : "v"(a), "v"(b)); return r; }
__device__ __forceinline__ float fadd_s(float a, float b) { float r; asm("v_add_f32_e32 %0, %1, %2" : "=v"(r) : "v"(a), "v"(b)); return r; }
__device__ __forceinline__ float fsub_s(float a, float b) { float r; asm("v_sub_f32_e32 %0, %1, %2" : "=v"(r) : "v"(a), "v"(b)); return r; }
typedef float f32x2_t __attribute__((ext_vector_type(2))); typedef __bf16 bf16x2_t __attribute__((ext_vector_type(2)));
__device__ __forceinline__ unsigned cvtpk_s(float lo, float hi) { f32x2_t v = {lo, hi}; bf16x2_t b = __builtin_convertvector(v, bf16x2_t); return __builtin_bit_cast(unsigned, b); }
#define WAIT_BAR(N) asm volatile("s_waitcnt vmcnt(" #N ") lgkmcnt(0)\n\ts_barrier" ::: "memory")

__device__ __forceinline__ void qkt(f32x16& p0, f32x16& p1, const char* Kslot, const bf16x8* qr, int r32, int hi) {
  const char* kb = Kslot + hi * 1024 + r32 * 16;
  #pragma unroll
  for (int d0 = 0; d0 < 4; ++d0) {
    const bf16x8 b0 = *reinterpret_cast<const bf16x8*>(kb + d0 * 2048);
    const bf16x8 b1 = *reinterpret_cast<const bf16x8*>(kb + d0 * 2048 + 512);
    p0 = __builtin_amdgcn_mfma_f32_32x32x16_bf16(b0, qr[d0], p0, 0, 0, 0); p1 = __builtin_amdgcn_mfma_f32_32x32x16_bf16(b1, qr[d0], p1, 0, 0, 0); }
}
typedef __attribute__((address_space(3))) const char* lds_cptr;
typedef short v4i16_t __attribute__((ext_vector_type(4)));
__device__ __forceinline__ void kload8(bf16x8* kf, lds_cptr kp) {
  kf[0] = *(const LAS bf16x8*)(kp);        kf[1] = *(const LAS bf16x8*)(kp + 512);
  kf[2] = *(const LAS bf16x8*)(kp + 2048); kf[3] = *(const LAS bf16x8*)(kp + 2560);
  kf[4] = *(const LAS bf16x8*)(kp + 4096); kf[5] = *(const LAS bf16x8*)(kp + 4608);
  kf[6] = *(const LAS bf16x8*)(kp + 6144); kf[7] = *(const LAS bf16x8*)(kp + 6656);
}
__device__ __forceinline__ void kload2(bf16x8* kf, lds_cptr kp, int j) { kf[2 * j] = *(const LAS bf16x8*)(kp + j * 2048); kf[2 * j + 1] = *(const LAS bf16x8*)(kp + j * 2048 + 512); }
__device__ __forceinline__ s16x4 vtr(lds_cptr p) { return __builtin_bit_cast(s16x4, __builtin_amdgcn_ds_read_tr16_b64_v4i16((LAS v4i16_t*)p)); }
__device__ __forceinline__ float rowmax(const f32x16& p0, const f32x16& p1) {
  float a = max3f(p0[0], p0[1], p1[0]), b = max3f(p0[2], p0[3], p1[1]); a = max3f(a, p1[2], p1[3]);
  #pragma unroll
  for (int r = 4; r < 16; r += 4) { a = max3f(a, p0[r], p0[r + 1]); b = max3f(b, p0[r + 2], p0[r + 3]); a = max3f(a, p1[r], p1[r + 1]); b = max3f(b, p1[r + 2], p1[r + 3]); }
  const float m = max2f(a, b);
  auto rr = __builtin_amdgcn_permlane32_swap(__float_as_uint(m), __float_as_uint(m), false, false);
  return max2f(__uint_as_float(rr[0]), __uint_as_float(rr[1]));
}
__device__ __forceinline__ void pv(f32x16* o, int vb, bf16x8 pa0, bf16x8 pa1, bf16x8 pa2, bf16x8 pa3) {
  #pragma unroll
  for (int d0 = 0; d0 < 2; ++d0) { s16x4 lo[4], hi[4];
    #pragma unroll
    for (int ks = 0; ks < 4; ++ks) {
      asm volatile("ds_read_b64_tr_b16 %0,%1 offset:%c2" : "=&v"(lo[ks]) : "v"(vb), "i"(d0 * 4096 + ks * 1024) : "memory");
      asm volatile("ds_read_b64_tr_b16 %0,%1 offset:%c2" : "=&v"(hi[ks]) : "v"(vb), "i"(d0 * 4096 + ks * 1024 + 512) : "memory"); }
    asm volatile("s_waitcnt lgkmcnt(0)" ::: "memory"); SBAR();
    #define PK(k) (bf16x8){lo[k][0], lo[k][1], lo[k][2], lo[k][3], hi[k][0], hi[k][1], hi[k][2], hi[k][3]}
    o[d0] = __builtin_amdgcn_mfma_f32_32x32x16_bf16(pa0, PK(0), o[d0], 0, 0, 0);
    o[d0] = __builtin_amdgcn_mfma_f32_32x32x16_bf16(pa1, PK(1), o[d0], 0, 0, 0);
    o[d0] = __builtin_amdgcn_mfma_f32_32x32x16_bf16(pa2, PK(2), o[d0], 0, 0, 0);
    o[d0] = __builtin_amdgcn_mfma_f32_32x32x16_bf16(pa3, PK(3), o[d0], 0, 0, 0);
    #undef PK
  }
}
#define ATTN_STORE16(p, v) (*(u32x4*)(p) = (v))
template <int THRL, int MODE> __device__ __forceinline__ void attn_unit(const bf16* Qp, const bf16* __restrict__ Kp, const bf16* __restrict__ Vp, bf16* Op, long RS, long ORS, int q0, int T0, int NT, int off,
                                                                        float* lsep, long lse_stride, char* shm, const float* kbsrc, const float* relb, int dsel) {
  int tid_ = threadIdx.x; asm volatile("" : "+v"(tid_));
  const int tid = tid_, lane = tid & 63, r32 = lane & 31, hi = lane >> 5; const int wid = __builtin_amdgcn_readfirstlane(tid >> 6);
  const bf16* Qw = Qp + (long)(q0 + wid * QBLK) * RS;
  const bf16* Kh = Kp + (long)T0 * KVBLK * RS, *Vh = Vp + (long)T0 * KVBLK * RS;
  const unsigned lds0 = (unsigned)(uintptr_t)shm;
  float* wsf = (float*)(shm + LDS_WS) + wid * 64;
  const int qrel = wid * QBLK + r32;
  const LAS float* tbase;
  if (MODE == 0) { LAS float* kbt = (LAS float*)(shm + LDS_KBT); const int nk = q0 + QB;
    for (int i = 64 * T0 + tid * 4; i < nk; i += 2048) *(LAS f32x4*)(kbt + i) = *(const f32x4*)(kbsrc + i);
    tbase = kbt + 4 * hi + 64 * T0;
  } else { LAS float* tr = (LAS float*)(shm + LDS_TREV);
    for (int u = tid; u < 768; u += 512) { const int j = 383 - u; float v = -INFINITY; if (j >= 0 && j <= 128) v = relb[(int)T5B[dsel][j] * NH] * LOG2E; tr[u] = v; }
    tbase = tr + (383 - off - qrel + 4 * hi);
  }
  const bf16* ksrc = Kh + (long)lane * RS + wid * 8;
  const bf16* vsrc = Vh + (long)(16 * (wid & 3) + (lane >> 2)) * RS + (wid >> 2) * 32 + (lane & 3) * 8;
  const unsigned kdst = lds0 + LDS_K + wid * 1024, vdst = lds0 + LDS_V + wid * 1024;
  #define DMA_K(t, slot) glds16(ksrc + (long)(t) * KVBLK * RS, (unsigned)__builtin_amdgcn_readfirstlane(kdst + (slot)))
  #define DMA_V(t, slot) glds16(vsrc + (long)(t) * KVBLK * RS, (unsigned)__builtin_amdgcn_readfirstlane(vdst + (slot)))
  const int vb0 = (int)(lds0 + LDS_V) + ((lane >> 4) & 1) * 32 + (lane & 3) * 8 + (4 * hi + ((lane & 15) >> 2)) * 64;
  const char* Kbase = shm + LDS_K; bf16x8 kf[8];
  const lds_cptr shm3 = (lds_cptr)shm; const lds_cptr kp0 = shm3 + LDS_K + hi * 1024 + r32 * 16; const lds_cptr vp0 = shm3 + LDS_V + ((lane >> 4) & 1) * 32 + (lane & 3) * 8 + (4 * hi + ((lane & 15) >> 2)) * 64;
  DMA_K(0, 0); DMA_V(0, 0); DMA_K(1, SLOTB);
  bf16x8 qr[4];
  #pragma unroll
  for (int d0 = 0; d0 < 4; ++d0) qr[d0] = *reinterpret_cast<const bf16x8*>(&Qw[(long)r32 * RS + d0 * 16 + hi * 8]);
  float mhat = 0.f, l_reg = 0.f; f32x16 o[2]; o[0] = f32x16{}; o[1] = f32x16{};
  #define BLOAD(P0, P1, t) do { const LAS float* tb_ = tbase + 64 * (t); \
      if (MODE == 0) { _Pragma("unroll") for (int g_ = 0; g_ < 4; ++g_) { const f32x4 b0_ = *(const LAS f32x4*)(tb_ + 8 * g_), b1_ = *(const LAS f32x4*)(tb_ + 32 + 8 * g_); \
          _Pragma("unroll") for (int i_ = 0; i_ < 4; ++i_) { P0[4 * g_ + i_] = b0_[i_]; P1[4 * g_ + i_] = b1_[i_]; } } } \
      else { _Pragma("unroll") for (int r_ = 0; r_ < 16; ++r_) { P0[r_] = tb_[(r_ & 3) + 8 * (r_ >> 2)]; P1[r_] = tb_[32 + (r_ & 3) + 8 * (r_ >> 2)]; } } } while (0)
  #define CMASK(P0, P1, t) do { if (MODE == 0) { int jb_ = (t) - (NT - 4); if (jb_ >= 0) cmask(P0, P1, jb_, qrel, hi); } } while (0)
  bool resc = false;
  #define START(P0, P1) do { const float rm = rowmax(P0, P1); resc = false; mhat = max2f(rm, -1000.f); \
    _Pragma("unroll") for (int r = 0; r < 16; ++r) P0[r] = __builtin_amdgcn_exp2f(fsub_s(P0[r], mhat)); } while (0)
  #define RESC() do { if (resc) { asm volatile("s_waitcnt lgkmcnt(0)" ::: "memory"); \
      _Pragma("unroll") for (int d_ = 0; d_ < 2; ++d_) _Pragma("unroll") for (int r = 0; r < 16; ++r) o[d_][r] *= wsf[crow(r, hi)]; } } while (0)
  f32x16 pA0, pA1, pB0, pB1;
  int sl_prev = 0, sl_cur = 0, sl_next = SLOTB;
  #define ROT() do { sl_prev = sl_cur; sl_cur = sl_next; sl_next = (sl_next == (NSLOT - 1) * SLOTB) ? 0 : sl_next + SLOTB; } while (0)
  DMA_K(2, 2 * SLOTB);
  WAIT_BAR(3);
  BLOAD(pA0, pA1, 0);
  qkt(pA0, pA1, Kbase, qr, r32, hi); asm volatile("s_nop 15\n\ts_nop 7" : "+v"(pA0), "+v"(pA1)); CMASK(pA0, pA1, 0);
  START(pA0, pA1);
  _Pragma("unroll") for (int r = 0; r < 16; ++r) pA1[r] = __builtin_amdgcn_exp2f(fsub_s(pA1[r], mhat));
  BLOAD(pB0, pB1, 1);
  WAIT_BAR(0);
  DMA_K(3, 0); DMA_V(1, SLOTB);
  ROT();
  kload8(kf, kp0 + sl_cur);
  WAIT_BAR(2);
  s16x4 vlo[8], vhi[8]; u32x4 pw0, pw1, pw2, pw3;
  #define PKW(P, B) cvtpk_s(P[B], P[B + 1])
  #define PAF(k) __builtin_bit_cast(bf16x8, pw##k)
  #define VFR(i) (bf16x8){vlo[i][0], vlo[i][1], vlo[i][2], vlo[i][3], vhi[i][0], vhi[i][1], vhi[i][2], vhi[i][3]}
  #define PIN(x) asm volatile("" : "+v"(x))
  #define MX3(a, b, c) __builtin_fmaxf(__builtin_fmaxf((a), (b)), (c))
  #define GAPA(MF, A0, A1, A2, A3, W0, W1, PW) do { MF; sacc += A0; sacc += A1; sacc += A2; sacc += A3; PIN(sacc); W0; W1; PIN(PW); SBAR(); } while (0)
  #define EX(v) __builtin_amdgcn_exp2f(v)
  #define GAPB(MF, X, B) do { MF; X[B] = EX(X[B] - mhat); X[B + 1] = EX(X[B + 1] - mhat); X[B + 2] = EX(X[B + 2] - mhat); X[B + 3] = EX(X[B + 3] - mhat); PIN(X); SBAR(); } while (0)
  #define VRD(i) do { vlo[i] = vtr(vp_ + (((i) >> 2) * 4096 + ((i) & 3) * 1024)); vhi[i] = vtr(vp_ + (((i) >> 2) * 4096 + ((i) & 3) * 1024 + 512)); } while (0)
  #define KRD(G, j) do { if (G) { kload2(kf, kp0 + sl_next, j); SBAR(); } } while (0)
  #define STEP(C0, C1, P0, P1, t, GK, GV, GL) do { SBAR(); \
    const lds_cptr vp_ = vp0 + sl_prev; \
    VRD(0); SBAR(); float sacc = (P0[0] + P0[1]); \
    GAPA(C0 = __builtin_amdgcn_mfma_f32_32x32x16_bf16(kf[0], qr[0], C0, 0, 0, 0), P0[2], P0[3], P0[4], P0[5],     pw0[0] = PKW(P0, 0), pw0[1] = PKW(P0, 2), pw0); \
    VRD(4); SBAR(); GAPA(C1 = __builtin_amdgcn_mfma_f32_32x32x16_bf16(kf[1], qr[0], C1, 0, 0, 0), P0[6], P0[7], P0[8], P0[9],     pw0[2] = PKW(P0, 4), pw0[3] = PKW(P0, 6), pw0); \
    VRD(1); SBAR(); GAPA(C0 = __builtin_amdgcn_mfma_f32_32x32x16_bf16(kf[2], qr[1], C0, 0, 0, 0),   P0[10], P0[11], P0[12], P0[13], pw1[0] = PKW(P0, 8), pw1[1] = PKW(P0, 10), pw1); \
    VRD(5); SBAR(); GAPA(C1 = __builtin_amdgcn_mfma_f32_32x32x16_bf16(kf[3], qr[1], C1, 0, 0, 0),   P0[14], P0[15], P1[0], P1[1],   pw1[2] = PKW(P0, 12), pw1[3] = PKW(P0, 14), pw1); \
    VRD(2); SBAR(); GAPA(C0 = __builtin_amdgcn_mfma_f32_32x32x16_bf16(kf[4], qr[2], C0, 0, 0, 0),   P1[2], P1[3], P1[4], P1[5],     pw2[0] = PKW(P1, 0), pw2[1] = PKW(P1, 2), pw2); \
    VRD(6); SBAR(); GAPA(C1 = __builtin_amdgcn_mfma_f32_32x32x16_bf16(kf[5], qr[2], C1, 0, 0, 0),   P1[6], P1[7], P1[8], P1[9],     pw2[2] = PKW(P1, 4), pw2[3] = PKW(P1, 6), pw2); \
    VRD(3); SBAR(); GAPA(C0 = __builtin_amdgcn_mfma_f32_32x32x16_bf16(kf[6], qr[3], C0, 0, 0, 0),   P1[10], P1[11], P1[12], P1[13], pw3[0] = PKW(P1, 8), pw3[1] = PKW(P1, 10), pw3); \
    VRD(7); SBAR(); GAPA(C1 = __builtin_amdgcn_mfma_f32_32x32x16_bf16(kf[7], qr[3], C1, 0, 0, 0),   P1[14], P1[15], 0.f, 0.f,       pw3[2] = PKW(P1, 12), pw3[3] = PKW(P1, 14), pw3); \
    l_reg += sacc; \
    if (GK) { DMA_K((t) + 3, sl_cur); } if (GV) { DMA_V((t) + 1, sl_next); } \
    CMASK(C0, C1, t); \
    { float a = MX3(C0[0], C0[1], C1[0]), b = MX3(C0[2], C0[3], C1[1]); a = MX3(a, C1[2], C1[3]); \
      _Pragma("unroll") for (int r = 4; r < 16; r += 4) { a = MX3(a, C0[r], C0[r + 1]); b = MX3(b, C0[r + 2], C0[r + 3]); a = MX3(a, C1[r], C1[r + 1]); b = MX3(b, C1[r + 2], C1[r + 3]); } \
      float rm = __builtin_fmaxf(a, b); { auto rr = __builtin_amdgcn_permlane32_swap(__float_as_uint(rm), __float_as_uint(rm), false, false); rm = __builtin_fmaxf(__uint_as_float(rr[0]), __uint_as_float(rr[1])); } \
      rm -= mhat; resc = false; \
      if (__builtin_expect(__any(rm > (float)THRL), 0)) { const float dl = __builtin_fmaxf(rm, 0.f); mhat += dl; \
        const float f = __builtin_amdgcn_exp2f(-dl); l_reg *= f; if (hi == 0) wsf[r32] = f; resc = true; } } \
    SBAR(); \
    if ((t) + 1 < NT) { BLOAD(P0, P1, (t) + 1); SBAR(); }        \
    GAPB(o[0] = __builtin_amdgcn_mfma_f32_32x32x16_bf16(PAF(0), VFR(0), o[0], 0, 0, 0), C0, 0); \
    GAPB(o[1] = __builtin_amdgcn_mfma_f32_32x32x16_bf16(PAF(0), VFR(4), o[1], 0, 0, 0), C0, 4); \
    KRD(GL, 0); GAPB(o[0] = __builtin_amdgcn_mfma_f32_32x32x16_bf16(PAF(1), VFR(1), o[0], 0, 0, 0), C0, 8); \
    KRD(GL, 1); GAPB(o[1] = __builtin_amdgcn_mfma_f32_32x32x16_bf16(PAF(1), VFR(5), o[1], 0, 0, 0), C0, 12); \
    KRD(GL, 2); GAPB(o[0] = __builtin_amdgcn_mfma_f32_32x32x16_bf16(PAF(2), VFR(2), o[0], 0, 0, 0), C1, 0); \
    KRD(GL, 3); GAPB(o[1] = __builtin_amdgcn_mfma_f32_32x32x16_bf16(PAF(2), VFR(6), o[1], 0, 0, 0), C1, 4); \
    GAPB(o[0] = __builtin_amdgcn_mfma_f32_32x32x16_bf16(PAF(3), VFR(3), o[0], 0, 0, 0), C1, 8); \
    GAPB(o[1] = __builtin_amdgcn_mfma_f32_32x32x16_bf16(PAF(3), VFR(7), o[1], 0, 0, 0), C1, 12); \
    } while (0)
  int t = 1;
  for (; t + 5 < NT; t += 2) {
    STEP(pB0, pB1, pA0, pA1, t, true, true, true);     WAIT_BAR(2); RESC(); ROT();
    STEP(pA0, pA1, pB0, pB1, t + 1, true, true, true); WAIT_BAR(2); RESC(); ROT();
  }
  #define ENDW(tt) do { if ((tt) + 3 < NT) { WAIT_BAR(2); } else if ((tt) + 2 < NT) { WAIT_BAR(1); } else { WAIT_BAR(0); } } while (0)
  for (; t + 1 < NT; t += 2) {
    STEP(pB0, pB1, pA0, pA1, t, (t + 3 < NT), (t + 1 < NT), (t + 1 < NT));     ENDW(t);     RESC(); ROT();
    STEP(pA0, pA1, pB0, pB1, t + 1, (t + 4 < NT), (t + 2 < NT), (t + 2 < NT)); ENDW(t + 1); RESC(); ROT();
  }
  STEP(pB0, pB1, pA0, pA1, NT - 1, false, false, false); RESC();
  { float sacc = pB0[0] + pB0[1]; _Pragma("unroll") for (int r = 2; r < 16; ++r) sacc += pB0[r]; _Pragma("unroll") for (int r = 0; r < 16; ++r) sacc += pB1[r]; l_reg += sacc;
    pw0 = (u32x4){PKW(pB0, 0), PKW(pB0, 2), PKW(pB0, 4), PKW(pB0, 6)}; pw1 = (u32x4){PKW(pB0, 8), PKW(pB0, 10), PKW(pB0, 12), PKW(pB0, 14)}; pw2 = (u32x4){PKW(pB1, 0), PKW(pB1, 2), PKW(pB1, 4), PKW(pB1, 6)}; pw3 = (u32x4){PKW(pB1, 8), PKW(pB1, 10), PKW(pB1, 12), PKW(pB1, 14)};
    SBAR(); pv(o, vb0 + sl_cur, PAF(0), PAF(1), PAF(2), PAF(3)); }
  #undef PKW
  #undef PAF
  #undef VFR
  #undef PIN
  #undef MX3
  #undef GAPA
  #undef GAPB
  #undef EX
  #undef VRD
  #undef KRD
  #undef STEP
  #undef ENDW
  { auto rr = __builtin_amdgcn_permlane32_swap(__float_as_uint(l_reg), __float_as_uint(l_reg), false, false); l_reg = __uint_as_float(rr[0]) + __uint_as_float(rr[1]); }
  if (lsep != nullptr && hi == 0) lsep[(long)(q0 + qrel) * lse_stride] = mhat + __log2f(l_reg);
  if (hi == 0) wsf[32 + r32] = l_reg; asm volatile("s_waitcnt lgkmcnt(0)" ::: "memory");
  float rli[16];
  #pragma unroll
  for (int r = 0; r < 16; ++r) rli[r] = __builtin_amdgcn_rcpf(wsf[32 + crow(r, hi)]);
  bf16* Ow = Op + (long)(q0 + wid * QBLK) * ORS;
  { bf16* stg = (bf16*)(shm + LDS_OST) + wid * 2048;
    #pragma unroll
    for (int r = 0; r < 16; ++r) { const int orow = crow(r, hi);
      #pragma unroll
      for (int d0 = 0; d0 < 2; ++d0) stg[orow * 64 + d0 * 32 + r32] = __float2bfloat16(o[d0][r] * rli[r]); }
    asm volatile("s_waitcnt lgkmcnt(0)" ::: "memory");
    #pragma unroll
    for (int i = 0; i < 4; ++i) { const int row = i * 8 + (lane >> 3), ch = lane & 7; const u32x4 v = *(const u32x4*)(stg + row * 64 + ch * 8); ATTN_STORE16(Ow + (long)row * ORS + ch * 8, v); } }
  asm volatile("s_waitcnt lgkmcnt(0)\n\ts_barrier" ::: "memory");
  #undef DMA_K
  #undef DMA_V
  #undef CMASK
  #undef BLOAD
  #undef START
  #undef RESC
  #undef ROT
}

constexpr int DL_K = 0, DL_KB = 49152, DL_V = 98304, DL_VPAD = 147456, DL_ZEND = 153600, DL_WS = 153600, DL_TREV = 155648, DL_TOTAL = DL_TREV + 3072;
static_assert(DL_WS + NW * 256 <= DL_TREV, "dilated LDS map");
struct DilSrc { const bf16* K; const bf16* V; long RS; int q0; int first; };
__device__ __forceinline__ void dil_issue_k(const DilSrc& u, unsigned lds0, int kbuf, int lane, int wid) {
  const long kr0 = (long)u.q0 - 128; const bf16* ksrc = u.K + (kr0 + lane) * u.RS + wid * 8; const unsigned kdst = lds0 + kbuf + wid * 1024;
  #pragma unroll
  for (int i = 0; i < 6; ++i) if (i >= 2 || !u.first) glds16(ksrc + (long)i * KVBLK * u.RS, (unsigned)__builtin_amdgcn_readfirstlane(kdst + i * 8192));
}
__device__ __forceinline__ void dil_issue_v(const DilSrc& u, unsigned lds0, int lane, int wid) {
  const long kr0 = (long)u.q0 - 128; const bf16* vsrc = u.V + (kr0 + 16 * (wid & 3) + (lane >> 2)) * u.RS + (wid >> 2) * 32 + (lane & 3) * 8; const unsigned vdst = lds0 + DL_V + wid * 1024;
  #pragma unroll
  for (int i = 0; i < 6; ++i) if (i >= 2 || !u.first) glds16(vsrc + (long)i * KVBLK * u.RS, (unsigned)__builtin_amdgcn_readfirstlane(vdst + i * 8192));
}
template <int THRL> __device__ __forceinline__ void dil_unit(const bf16* Qp, const DilSrc cur, int kb, bool issued, const DilSrc nxt, bool has_next, bf16* Op,
                                                             float* lsep, long lse_stride, char* shm, const float* relb, int dsel, bool build_tab) {
  int tid_ = threadIdx.x; asm volatile("" : "+v"(tid_));
  const int tid = tid_, lane = tid & 63, r32 = lane & 31, hi = lane >> 5; const int wid = __builtin_amdgcn_readfirstlane(tid >> 6);
  const unsigned lds0 = (unsigned)(uintptr_t)shm;
  const long RS = cur.RS; const int q0 = cur.q0; const bool first = cur.first != 0;
  float* wsf = (float*)(shm + DL_WS) + wid * 64;
  LAS float* tr = (LAS float*)(shm + DL_TREV);
  if (build_tab) { for (int u = tid; u < 768; u += 512) { const int j = 383 - u; float v = -INFINITY; if (j >= 0 && j <= 128) v = relb[(int)T5B[dsel][j] * NH] * LOG2E; tr[u] = v; } }
  const LAS float* tbase = tr + (255 - r32 + 4 * hi);
  if (!issued) { dil_issue_k(cur, lds0, kb, lane, wid); dil_issue_v(cur, lds0, lane, wid); }
  const bf16* Qw = Qp + (long)(q0 + wid * QBLK) * RS;
  bf16x8 qr[4];
  #pragma unroll
  for (int d0 = 0; d0 < 4; ++d0) qr[d0] = *reinterpret_cast<const bf16x8*>(&Qw[(long)r32 * RS + d0 * 16 + hi * 8]);
  asm volatile("s_waitcnt vmcnt(0) lgkmcnt(0)\n\ts_barrier" ::: "memory");
  if (has_next) dil_issue_k(nxt, lds0, kb ^ DL_KB, lane, wid);
  const int g = wid;
  const lds_cptr shm3 = (lds_cptr)shm;
  const lds_cptr kl = shm3 + kb + hi * 1024 + r32 * 16;
  const lds_cptr vl = shm3 + DL_V + ((lane >> 4) & 1) * 32 + (lane & 3) * 8 + (4 * hi + ((lane & 15) >> 2)) * 64;
  #define KBO(blk) ((((blk)) >> 1) * 8192 + (((blk)) & 1) * 512)
  #define VBO(blk) ((((blk)) >> 1) * 8192 + (((blk)) & 1) * 2048)
  #define DKLOAD2(s_, j_) do { const int b0_ = g + 2 * (s_); kf[2 * (j_)] = *(const LAS bf16x8*)(kl + KBO(b0_) + (j_) * 2048); kf[2 * (j_) + 1] = *(const LAS bf16x8*)(kl + KBO(b0_ + 1) + (j_) * 2048); } while (0)
  float mhat = 0.f, l_reg = 0.f; f32x16 o[2]; o[0] = f32x16{}; o[1] = f32x16{};
  bf16x8 kf[8];
  #define BLOAD(P0, P1, t) do { const LAS float* tb_ = tbase + 64 * (t); \
      _Pragma("unroll") for (int r_ = 0; r_ < 16; ++r_) { P0[r_] = tb_[(r_ & 3) + 8 * (r_ >> 2)]; P1[r_] = tb_[32 + (r_ & 3) + 8 * (r_ >> 2)]; } } while (0)
  #define PMASK(P0, P1, t) do { if (first && (32 * g + 64 * (t)) < 128) { const int kb_ = 32 * g + 64 * (t) + 4 * hi - 128; \
      _Pragma("unroll") for (int r_ = 0; r_ < 16; ++r_) { const int kp_ = kb_ + (r_ & 3) + 8 * (r_ >> 2); if (kp_ < 0) P0[r_] = -INFINITY; if (kp_ + 32 < 0) P1[r_] = -INFINITY; } } } while (0)
  bool resc = false;
  #define RESC() do { if (resc) { asm volatile("s_waitcnt lgkmcnt(0)" ::: "memory"); \
      _Pragma("unroll") for (int d_ = 0; d_ < 2; ++d_) _Pragma("unroll") for (int r = 0; r < 16; ++r) o[d_][r] *= wsf[crow(r, hi)]; } } while (0)
  f32x16 pA0, pA1, pB0, pB1;
  BLOAD(pA0, pA1, 0);
  DKLOAD2(0, 0); DKLOAD2(0, 1); DKLOAD2(0, 2); DKLOAD2(0, 3);
  #pragma unroll
  for (int d0 = 0; d0 < 4; ++d0) { pA0 = __builtin_amdgcn_mfma_f32_32x32x16_bf16(kf[2 * d0], qr[d0], pA0, 0, 0, 0); pA1 = __builtin_amdgcn_mfma_f32_32x32x16_bf16(kf[2 * d0 + 1], qr[d0], pA1, 0, 0, 0); }
  asm volatile("s_nop 15\n\ts_nop 7" : "+v"(pA0), "+v"(pA1)); PMASK(pA0, pA1, 0);
  asm volatile("s_nop 3" : "+v"(pA0), "+v"(pA1));
  { const float rm = rowmax(pA0, pA1); mhat = max2f(rm, -1000.f);
    _Pragma("unroll") for (int r = 0; r < 16; ++r) pA0[r] = __builtin_amdgcn_exp2f(fsub_s(pA0[r], mhat));
    _Pragma("unroll") for (int r = 0; r < 16; ++r) pA1[r] = __builtin_amdgcn_exp2f(fsub_s(pA1[r], mhat)); }
  BLOAD(pB0, pB1, 1);
  DKLOAD2(1, 0); DKLOAD2(1, 1); DKLOAD2(1, 2); DKLOAD2(1, 3);
  s16x4 vlo[8], vhi[8]; u32x4 pw0, pw1, pw2, pw3;
  #define PKW(P, B) cvtpk_s(P[B], P[B + 1])
  #define PAF(k) __builtin_bit_cast(bf16x8, pw##k)
  #define VFR(i) (bf16x8){vlo[i][0], vlo[i][1], vlo[i][2], vlo[i][3], vhi[i][0], vhi[i][1], vhi[i][2], vhi[i][3]}
  #define PIN(x) asm volatile("" : "+v"(x))
  #define MX3(a, b, c) __builtin_fmaxf(__builtin_fmaxf((a), (b)), (c))
  #define GAPA(MF, A0, A1, A2, A3, W0, W1, PW) do { MF; sacc += A0; sacc += A1; sacc += A2; sacc += A3; PIN(sacc); W0; W1; PIN(PW); SBAR(); } while (0)
  #define EX(v) __builtin_amdgcn_exp2f(v)
  #define GAPB(MF, X, B) do { MF; X[B] = EX(X[B] - mhat); X[B + 1] = EX(X[B + 1] - mhat); X[B + 2] = EX(X[B + 2] - mhat); X[B + 3] = EX(X[B + 3] - mhat); PIN(X); SBAR(); } while (0)
  #define VRD(i) do { const lds_cptr va_ = vl + VBO(g + 2 * tv_ + (((i) & 3) >> 1)) + ((i) >> 2) * 4096 + ((i) & 1) * 1024; vlo[i] = vtr(va_); vhi[i] = vtr(va_ + 512); } while (0)
  #define KRD(G, j) do { if (G) { DKLOAD2(tk_, j); SBAR(); } } while (0)
  #define STEP(C0, C1, P0, P1, t, GL) do { SBAR(); const int tv_ = (t) - 1, tk_ = (t) + 1; \
    VRD(0); SBAR(); float sacc = (P0[0] + P0[1]); \
    GAPA(C0 = __builtin_amdgcn_mfma_f32_32x32x16_bf16(kf[0], qr[0], C0, 0, 0, 0), P0[2], P0[3], P0[4], P0[5],     pw0[0] = PKW(P0, 0), pw0[1] = PKW(P0, 2), pw0); \
    VRD(4); SBAR(); GAPA(C1 = __builtin_amdgcn_mfma_f32_32x32x16_bf16(kf[1], qr[0], C1, 0, 0, 0), P0[6], P0[7], P0[8], P0[9],     pw0[2] = PKW(P0, 4), pw0[3] = PKW(P0, 6), pw0); \
    VRD(1); SBAR(); GAPA(C0 = __builtin_amdgcn_mfma_f32_32x32x16_bf16(kf[2], qr[1], C0, 0, 0, 0),   P0[10], P0[11], P0[12], P0[13], pw1[0] = PKW(P0, 8), pw1[1] = PKW(P0, 10), pw1); \
    VRD(5); SBAR(); GAPA(C1 = __builtin_amdgcn_mfma_f32_32x32x16_bf16(kf[3], qr[1], C1, 0, 0, 0),   P0[14], P0[15], P1[0], P1[1],   pw1[2] = PKW(P0, 12), pw1[3] = PKW(P0, 14), pw1); \
    VRD(2); SBAR(); GAPA(C0 = __builtin_amdgcn_mfma_f32_32x32x16_bf16(kf[4], qr[2], C0, 0, 0, 0),   P1[2], P1[3], P1[4], P1[5],     pw2[0] = PKW(P1, 0), pw2[1] = PKW(P1, 2), pw2); \
    VRD(6); SBAR(); GAPA(C1 = __builtin_amdgcn_mfma_f32_32x32x16_bf16(kf[5], qr[2], C1, 0, 0, 0),   P1[6], P1[7], P1[8], P1[9],     pw2[2] = PKW(P1, 4), pw2[3] = PKW(P1, 6), pw2); \
    VRD(3); SBAR(); GAPA(C0 = __builtin_amdgcn_mfma_f32_32x32x16_bf16(kf[6], qr[3], C0, 0, 0, 0),   P1[10], P1[11], P1[12], P1[13], pw3[0] = PKW(P1, 8), pw3[1] = PKW(P1, 10), pw3); \
    VRD(7); SBAR(); GAPA(C1 = __builtin_amdgcn_mfma_f32_32x32x16_bf16(kf[7], qr[3], C1, 0, 0, 0),   P1[14], P1[15], 0.f, 0.f,       pw3[2] = PKW(P1, 12), pw3[3] = PKW(P1, 14), pw3); \
    l_reg += sacc; \
    PMASK(C0, C1, t); \
    { float a = MX3(C0[0], C0[1], C1[0]), b = MX3(C0[2], C0[3], C1[1]); a = MX3(a, C1[2], C1[3]); \
      _Pragma("unroll") for (int r = 4; r < 16; r += 4) { a = MX3(a, C0[r], C0[r + 1]); b = MX3(b, C0[r + 2], C0[r + 3]); a = MX3(a, C1[r], C1[r + 1]); b = MX3(b, C1[r + 2], C1[r + 3]); } \
      float rm = __builtin_fmaxf(a, b); { auto rr = __builtin_amdgcn_permlane32_swap(__float_as_uint(rm), __float_as_uint(rm), false, false); rm = __builtin_fmaxf(__uint_as_float(rr[0]), __uint_as_float(rr[1])); } \
      rm -= mhat; resc = false; \
      if (__builtin_expect(__any(rm > (float)THRL), 0)) { const float dl = __builtin_fmaxf(rm, 0.f); mhat += dl; \
        const float f = __builtin_amdgcn_exp2f(-dl); l_reg *= f; if (hi == 0) wsf[r32] = f; resc = true; } } \
    SBAR(); \
    if ((t) + 1 < 3) { BLOAD(P0, P1, (t) + 1); SBAR(); } \
    GAPB(o[0] = __builtin_amdgcn_mfma_f32_32x32x16_bf16(PAF(0), VFR(0), o[0], 0, 0, 0), C0, 0); \
    GAPB(o[1] = __builtin_amdgcn_mfma_f32_32x32x16_bf16(PAF(0), VFR(4), o[1], 0, 0, 0), C0, 4); \
    KRD(GL, 0); GAPB(o[0] = __builtin_amdgcn_mfma_f32_32x32x16_bf16(PAF(1), VFR(1), o[0], 0, 0, 0), C0, 8); \
    KRD(GL, 1); GAPB(o[1] = __builtin_amdgcn_mfma_f32_32x32x16_bf16(PAF(1), VFR(5), o[1], 0, 0, 0), C0, 12); \
    KRD(GL, 2); GAPB(o[0] = __builtin_amdgcn_mfma_f32_32x32x16_bf16(PAF(2), VFR(2), o[0], 0, 0, 0), C1, 0); \
    KRD(GL, 3); GAPB(o[1] = __builtin_amdgcn_mfma_f32_32x32x16_bf16(PAF(2), VFR(6), o[1], 0, 0, 0), C1, 4); \
    GAPB(o[0] = __builtin_amdgcn_mfma_f32_32x32x16_bf16(PAF(3), VFR(3), o[0], 0, 0, 0), C1, 8); \
    GAPB(o[1] = __builtin_amdgcn_mfma_f32_32x32x16_bf16(PAF(3), VFR(7), o[1], 0, 0, 0), C1, 12); \
    } while (0)
  STEP(pB0, pB1, pA0, pA1, 1, true);  RESC();
  STEP(pA0, pA1, pB0, pB1, 2, false); RESC();
  { float sacc = pA0[0] + pA0[1]; _Pragma("unroll") for (int r = 2; r < 16; ++r) sacc += pA0[r]; _Pragma("unroll") for (int r = 0; r < 16; ++r) sacc += pA1[r]; l_reg += sacc;
    pw0 = (u32x4){PKW(pA0, 0), PKW(pA0, 2), PKW(pA0, 4), PKW(pA0, 6)}; pw1 = (u32x4){PKW(pA0, 8), PKW(pA0, 10), PKW(pA0, 12), PKW(pA0, 14)}; pw2 = (u32x4){PKW(pA1, 0), PKW(pA1, 2), PKW(pA1, 4), PKW(pA1, 6)}; pw3 = (u32x4){PKW(pA1, 8), PKW(pA1, 10), PKW(pA1, 12), PKW(pA1, 14)};
    SBAR(); const int tv_ = 2;
    VRD(0); VRD(1); VRD(2); VRD(3); VRD(4); VRD(5); VRD(6); VRD(7);
    o[0] = __builtin_amdgcn_mfma_f32_32x32x16_bf16(PAF(0), VFR(0), o[0], 0, 0, 0); o[1] = __builtin_amdgcn_mfma_f32_32x32x16_bf16(PAF(0), VFR(4), o[1], 0, 0, 0);
    o[0] = __builtin_amdgcn_mfma_f32_32x32x16_bf16(PAF(1), VFR(1), o[0], 0, 0, 0); o[1] = __builtin_amdgcn_mfma_f32_32x32x16_bf16(PAF(1), VFR(5), o[1], 0, 0, 0);
    o[0] = __builtin_amdgcn_mfma_f32_32x32x16_bf16(PAF(2), VFR(2), o[0], 0, 0, 0); o[1] = __builtin_amdgcn_mfma_f32_32x32x16_bf16(PAF(2), VFR(6), o[1], 0, 0, 0);
    o[0] = __builtin_amdgcn_mfma_f32_32x32x16_bf16(PAF(3), VFR(3), o[0], 0, 0, 0); o[1] = __builtin_amdgcn_mfma_f32_32x32x16_bf16(PAF(3), VFR(7), o[1], 0, 0, 0); }
  #undef PKW
  #undef PAF
  #undef VFR
  #undef PIN
  #undef MX3
  #undef GAPA
  #undef GAPB
  #undef EX
  #undef VRD
  #undef KRD
  #undef STEP
  const int qrel = wid * QBLK + r32;
  { auto rr = __builtin_amdgcn_permlane32_swap(__float_as_uint(l_reg), __float_as_uint(l_reg), false, false); l_reg = __uint_as_float(rr[0]) + __uint_as_float(rr[1]); }
  if (hi == 0) lsep[(long)(q0 + qrel) * lse_stride] = mhat + __log2f(l_reg);
  if (hi == 0) wsf[32 + r32] = l_reg; asm volatile("s_waitcnt lgkmcnt(0)" ::: "memory");
  float rli[16];
  #pragma unroll
  for (int r = 0; r < 16; ++r) rli[r] = __builtin_amdgcn_rcpf(wsf[32 + crow(r, hi)]);
  asm volatile("s_waitcnt lgkmcnt(0)\n\ts_barrier" ::: "memory");
  if (has_next) dil_issue_v(nxt, lds0, lane, wid);
  bf16* Ow = Op + (long)(q0 + wid * QBLK) * RS;
  { bf16* stg = (bf16*)(shm + kb) + wid * 2048;
    #pragma unroll
    for (int r = 0; r < 16; ++r) { const int orow = crow(r, hi);
      #pragma unroll
      for (int d0 = 0; d0 < 2; ++d0) stg[orow * 64 + d0 * 32 + r32] = __float2bfloat16(o[d0][r] * rli[r]); }
    asm volatile("s_waitcnt lgkmcnt(0)" ::: "memory");
    #pragma unroll
    for (int i = 0; i < 4; ++i) { const int row = i * 8 + (lane >> 3), ch = lane & 7; const u32x4 v = *(const u32x4*)(stg + row * 64 + ch * 8); ATTN_STORE16(Ow + (long)row * RS + ch * 8, v); } }
  if (!has_next) asm volatile("s_waitcnt lgkmcnt(0)\n\ts_barrier" ::: "memory");
  #undef KBO
  #undef VBO
  #undef DKLOAD2
  #undef BLOAD
  #undef PMASK
  #undef RESC
}
#undef SBAR
#undef WAIT_BAR
}
static_assert(attn_body::LDS_TOTAL <= RING_BYTES && attn_body::DL_TOTAL <= PHASE_LDS, "attention LDS");

#define XB_TMO      128
#define XB_XCNT(j)  (256  + 64 * (j))
#define XB_XSUB(j)  (1280 + 64 * (j))
#define XB_XGEN(j)  (2304 + 64 * (j))
#define XB_TOP      3328
#define XB_TOPGEN   3392
#define XCD_BAR_WORDS 3456
#define XB_SPIN_CAP (1u << 18)
__device__ __forceinline__ unsigned xb_ld(unsigned* p)              { return __hip_atomic_load(p, __ATOMIC_RELAXED, __HIP_MEMORY_SCOPE_AGENT); }
__device__ __forceinline__ unsigned xb_add(unsigned* p, unsigned v) { return __hip_atomic_fetch_add(p, v, __ATOMIC_RELAXED, __HIP_MEMORY_SCOPE_AGENT); }
__device__ __forceinline__ unsigned xb_xcc_id() { return (unsigned)__builtin_amdgcn_s_getreg((3 << 11) | 20) & 0xFu; }
#define XB_SPIN(cond, bar) do { unsigned _sp = 0; while (cond) { __builtin_amdgcn_s_sleep(1); \
    if ((++_sp & 255u) == 0u) { if (xb_ld(&(bar)[XB_TMO])) break; if (_sp > XB_SPIN_CAP) { atomicAdd(&(bar)[XB_TMO], 1u); break; } } } } while (0)
struct XcdBarrier { unsigned* bar; unsigned x; volatile LAS unsigned* st; };
__device__ __forceinline__ XcdBarrier xcd_barrier_post(unsigned* bar, volatile LAS unsigned* st) {
    XcdBarrier b; b.bar = bar; b.x = xb_xcc_id(); b.st = st;
    if (threadIdx.x == 0) (void)xb_add(&bar[XB_XCNT(b.x)], 1u);
    return b;
}
__device__ __forceinline__ void xcd_barrier_complete(unsigned* bar, unsigned x, unsigned& nloc, unsigned& nx) {
    const unsigned G = gridDim.x * gridDim.y * gridDim.z;
    unsigned sum, cnt, mine, sp = 0u;
    for (;;) {
        sum = 0u; cnt = 0u; mine = 0u;
#pragma unroll
        for (unsigned j = 0; j < 16; ++j) { const unsigned c = xb_ld(&bar[XB_XCNT(j)]); sum += c; cnt += (c > 0u) ? 1u : 0u; mine = (j == x) ? c : mine; }
        if (sum == G) break;
        __builtin_amdgcn_s_sleep(1);
        if ((++sp & 255u) == 0u) { if (xb_ld(&bar[XB_TMO])) break; if (sp > XB_SPIN_CAP) { atomicAdd(&bar[XB_TMO], 1u); break; } }
    }
    nloc = mine > 0u ? mine : 1u; nx = cnt > 0u ? cnt : 1u;
}
__device__ __forceinline__ void xcd_barrier(const XcdBarrier& b) {
    asm volatile("s_waitcnt vmcnt(0)" ::: "memory");
    __syncthreads();
    if (threadIdx.x == 0) {
        unsigned* bar = b.bar;
        __builtin_amdgcn_s_waitcnt(0);
        unsigned nloc = b.st[0], nx = b.st[1];
        if (nloc == 0u) { xcd_barrier_complete(bar, b.x, nloc, nx); b.st[0] = nloc; b.st[1] = nx; }
        const unsigned old = xb_add(&bar[XB_XSUB(b.x)], 1u);
        const unsigned gen = old / nloc;
        if (old + 1u == (gen + 1u) * nloc) {
            __builtin_amdgcn_fence(__ATOMIC_RELEASE, "agent");
            asm volatile("s_waitcnt vmcnt(0)" ::: "memory");
            const unsigned og = xb_add(&bar[XB_TOP], 1u);
            const unsigned tg = og / nx;
            if (og + 1u == (tg + 1u) * nx) xb_add(&bar[XB_TOPGEN], 1u);
            else XB_SPIN(xb_ld(&bar[XB_TOPGEN]) == tg, bar);
            __builtin_amdgcn_fence(__ATOMIC_ACQUIRE, "agent");
            xb_add(&bar[XB_XGEN(b.x)], 1u);
            asm volatile("s_waitcnt vmcnt(0)" ::: "memory");
        } else {
            XB_SPIN(xb_ld(&bar[XB_XGEN(b.x)]) == gen, bar);
            __builtin_amdgcn_fence(__ATOMIC_ACQUIRE, "agent");
            asm volatile("s_waitcnt vmcnt(0)" ::: "memory");
        }
    }
    __syncthreads();
}

struct Frame {
    LAS unsigned char* lds;
    volatile LAS unsigned* MISC;
    gu32* ctl;
    int tid, lane, wave;
    int vcu, G;
    unsigned char* ws;
    float* out;
};
#define LDS_WAIT() asm volatile("s_waitcnt lgkmcnt(0)" ::: "memory")

__device__ __forceinline__ void p0_mod(Frame& F, const float* c, const float* w_ada, const float* b_ada, float* mod) {
    LAS float* sc = (LAS float*)F.lds;
    LAS float* part = (LAS float*)(F.lds + 65536);
    __syncthreads();
    for (int cg = blockIdx.x; cg < NMOD / 64; cg += F.G) {
        for (int i = F.tid; i < BATCH * DM; i += NWAVES * 64) { const float v = c[i]; sc[i] = v / (1.f + __expf(-v)); }
        __syncthreads();
        const int n = cg * 64 + F.lane; float acc[BATCH];
#pragma unroll
        for (int b = 0; b < BATCH; ++b) acc[b] = 0.f;
        const int kb = F.wave * 128;
        for (int k0 = kb; k0 < kb + 128; k0 += 32) { float wv[32];
#pragma unroll
            for (int i = 0; i < 32; ++i) wv[i] = w_ada[(size_t)(k0 + i) * NMOD + n];
#pragma unroll
            for (int i = 0; i < 32; ++i)
#pragma unroll
                for (int b = 0; b < BATCH; ++b) acc[b] += sc[b * DM + k0 + i] * wv[i]; }
#pragma unroll
        for (int b = 0; b < BATCH; ++b) part[(F.wave * BATCH + b) * 64 + F.lane] = acc[b];
        __syncthreads();
        for (int o = F.tid; o < BATCH * 64; o += NWAVES * 64) { const int b = o >> 6, l = o & 63; float s = b_ada[cg * 64 + l];
#pragma unroll
            for (int w = 0; w < NWAVES; ++w) s += part[(w * BATCH + b) * 64 + l];
            mod[(size_t)b * NMOD + cg * 64 + l] = s; }
        __syncthreads();
    }
}
__device__ __forceinline__ int gu_row(int c, int up) { return (c >> 7) * 256 + up * 128 + (c & 127); }
__device__ __forceinline__ int dn_row(int c) { const int cc = c & 255; return (c & ~255) + ((cc >> 5) & 1) * 128 + (cc >> 6) * 32 + (cc & 31); }
struct P0Ptrs { const float *w_in, *w_out, *w_router, *w_eg, *w_eu, *w_ed, *w_sg, *w_su, *w_sd; };
struct TrItem { const float* src; unsigned char* dst; int ldw, Kd, f8; };
__device__ __forceinline__ TrItem tr_make(const float* W, int ldw, int k0, int c0, void* WT, int drow0, int Kd, int f8 = 0) { TrItem t; t.src = W + (size_t)k0 * ldw + c0; t.dst = (unsigned char*)WT + ((size_t)drow0 * Kd + k0) * (f8 ? 1 : 2); t.ldw = ldw; t.Kd = Kd; t.f8 = f8; return t; }
__device__ __forceinline__ TrItem p0_decode(const P0Ptrs& P, unsigned char* ws, int it) {
    bf16_t* WIN = (bf16_t*)(ws + WS_WIN); bf16_t* WOUT = (bf16_t*)(ws + WS_WOUT); bf16_t* WR = (bf16_t*)(ws + WS_WR);
    bf16_t* WSHGU = (bf16_t*)(ws + WS_WSHGU); bf16_t* WSHD = (bf16_t*)(ws + WS_WSHD); unsigned char* WD = ws + WS_WD; unsigned char* WGU = ws + WS_WGU;
    constexpr int I_EXP = NEXP * 384, I_IN = 768, I_OUT = 512, I_S = 128;
    int r = it;
    if (r < I_EXP) { const int e = r / 384, q = r % 384;
        if (q < 256) { const int up = q >> 7, qq = q & 127, kb = qq >> 3, nb = qq & 7;
            return tr_make((up ? P.w_eu : P.w_eg) + (size_t)e * DM * EH, EH, 64 * kb, 32 * nb, WGU + (size_t)e * 512 * DM, gu_row(32 * nb, up), DM, 1); }
        const int qq = q - 256, kb = qq >> 5, nb = qq & 31;
        return tr_make(P.w_ed + (size_t)e * EH * DM, DM, 64 * kb, 32 * nb, WD + (size_t)e * DM * EH, dn_row(32 * nb), EH, 1); }
    r -= I_EXP;
    if (r < I_IN) { const int kb = r / 48, nb = r % 48; return tr_make(P.w_in, INC, 64 * kb, 32 * nb, WIN, 32 * nb, DM); } r -= I_IN;
    if (r < I_IN) { const int kb = r / 48, nb = r % 48; return tr_make(P.w_in, INC, 64 * kb, 1544 + 32 * nb, WIN, 1536 + 32 * nb, DM); } r -= I_IN;
    if (r < I_OUT) { const int kb = r >> 5, nb = r & 31; return tr_make(P.w_out, DM, 64 * kb, 32 * nb, WOUT, 32 * nb, DM); } r -= I_OUT;
    if (r < I_S) { const int kb = r >> 3, nb = r & 7; return tr_make(P.w_router, NEXP, 64 * kb, 32 * nb, WR, 32 * nb, DM); } r -= I_S;
    if (r < I_S) { const int kb = r >> 3, nb = r & 7; return tr_make(P.w_sg, EH, 64 * kb, 32 * nb, WSHGU, gu_row(32 * nb, 0), DM); } r -= I_S;
    if (r < I_S) { const int kb = r >> 3, nb = r & 7; return tr_make(P.w_su, EH, 64 * kb, 32 * nb, WSHGU, gu_row(32 * nb, 1), DM); } r -= I_S;
    { const int kb = r >> 5, nb = r & 31; return tr_make(P.w_sd, DM, 64 * kb, 32 * nb, WSHD, dn_row(32 * nb), EH); }
}
__device__ __forceinline__ void tr_load(const TrItem& t, int lane, f32x4 (&v)[8]) {
    const float* p = t.src + (size_t)(lane >> 3) * t.ldw + (lane & 7) * 4;
#pragma unroll
    for (int i = 0; i < 8; ++i) v[i] = *(const GAS f32x4*)(p + (size_t)(8 * i) * t.ldw);
}
__device__ __forceinline__ void tr_store(const TrItem& t, int lane, const f32x4 (&v)[8], LAS float* scr) {
    LAS float* w = scr + (lane >> 3) * 33 + (lane & 7) * 4;
#pragma unroll
    for (int i = 0; i < 8; ++i) { w[(8 * i) * 33 + 0] = v[i].x; w[(8 * i) * 33 + 1] = v[i].y; w[(8 * i) * 33 + 2] = v[i].z; w[(8 * i) * 33 + 3] = v[i].w; }
    LDS_WAIT(); asm volatile("" ::: "memory");
    const int c = lane & 7;
#pragma unroll
    for (int j = 0; j < 4; ++j) { const int n = (lane >> 3) + 8 * j; const LAS float* s = scr + (8 * c) * 33 + n;
        if (t.f8) { int w0 = __builtin_amdgcn_cvt_pk_fp8_f32(s[0 * 33], s[1 * 33], 0, false); w0 = __builtin_amdgcn_cvt_pk_fp8_f32(s[2 * 33], s[3 * 33], w0, true);
            int w1 = __builtin_amdgcn_cvt_pk_fp8_f32(s[4 * 33], s[5 * 33], 0, false); w1 = __builtin_amdgcn_cvt_pk_fp8_f32(s[6 * 33], s[7 * 33], w1, true);
            u32x2 o; o.x = (unsigned)w0; o.y = (unsigned)w1; *(GAS u32x2*)(t.dst + (size_t)n * t.Kd + 8 * c) = o; }
        else { u32x4 o; o.x = cvt_pk_bf16(s[0 * 33], s[1 * 33]); o.y = cvt_pk_bf16(s[2 * 33], s[3 * 33]); o.z = cvt_pk_bf16(s[4 * 33], s[5 * 33]); o.w = cvt_pk_bf16(s[6 * 33], s[7 * 33]);
            *(GAS u32x4*)(t.dst + ((size_t)n * t.Kd + 8 * c) * 2) = o; } }
    LDS_WAIT(); asm volatile("" ::: "memory");
}
__device__ __forceinline__ void p0_weights(Frame& F, const P0Ptrs& P, int it_lo, int it_hi) {
    LAS float* scr = (LAS float*)(F.lds + F.wave * 16384);
    const int gw = F.vcu * NWAVES + F.wave, NGW = F.G * NWAVES;
    int it = it_lo + gw; if (it >= it_hi) return;
    TrItem cur = p0_decode(P, F.ws, it); f32x4 v[8]; tr_load(cur, F.lane, v);
    for (;;) {
        const int nit = it + NGW; const bool more = nit < it_hi;
        f32x4 nv[8];
        const TrItem nx = p0_decode(P, F.ws, more ? nit : it); tr_load(nx, F.lane, nv);
        tr_store(cur, F.lane, v, scr);
        if (!more) break;
        cur = nx; it = nit;
#pragma unroll
        for (int i = 0; i < 8; ++i) v[i] = nv[i];
    }
}
constexpr int P0_EXPERT_ITEMS = NEXP * 384, P0_ALL_ITEMS = NEXP * 384 + 2 * 768 + 512 + 4 * 128;
struct CvItem { const float* src; unsigned char* dst; int ldw, Kd, rowbase, down, n0; };
__device__ __forceinline__ CvItem cv_decode(const P0Ptrs& P, unsigned char* ws, int it) {
    const int e = it / 48, q = it % 48; CvItem c;
    if (q < 32) { const int up = q >> 4, qq = q & 15, kb = qq >> 1, nb = qq & 1;
        c.src = (up ? P.w_eu : P.w_eg) + (size_t)e * DM * EH + (size_t)(128 * kb) * EH + 128 * nb; c.ldw = EH; c.dst = ws + WS_WGU + (size_t)e * 512 * DM + 128 * kb; c.Kd = DM; c.rowbase = nb * 256 + up * 128; c.down = 0; c.n0 = 128 * nb; }
    else { const int qq = q - 32, kb = qq >> 3, nb = qq & 7;
        c.src = P.w_ed + (size_t)e * EH * DM + (size_t)(128 * kb) * DM + 128 * nb; c.ldw = DM; c.dst = ws + WS_WD + (size_t)e * DM * EH + 128 * kb; c.Kd = EH; c.rowbase = 0; c.down = 1; c.n0 = 128 * nb; }
    return c;
}
__device__ __forceinline__ void cv_issue(Frame& F, const CvItem& c, int buf) {
    const float* g = c.src + (size_t)(16 * F.wave + (F.lane >> 5)) * c.ldw + (F.lane & 31) * 4;
#pragma unroll
    for (int i = 0; i < 8; ++i) __builtin_amdgcn_global_load_lds((const unsigned*)(g + (size_t)(2 * i) * c.ldw), (LAS unsigned*)(F.lds + buf * 65536 + (16 * F.wave + 2 * i) * 512), 16, 0, 0);
}
__device__ __forceinline__ void conv_experts(Frame& F, const P0Ptrs& P) {
    constexpr int NIT = NEXP * 48;
    int it = F.vcu; if (it >= NIT) return;
    int tid_ = threadIdx.x; asm volatile("" : "+v"(tid_)); const int tid = tid_;
    LAS unsigned char* Bb = F.lds + 131072;
    CvItem cur = cv_decode(P, F.ws, it); int buf = 0;
    cv_issue(F, cur, 0);
    for (;;) {
        const int nit = it + F.G; const bool more = nit < NIT;
        const CvItem nx = cv_decode(P, F.ws, more ? nit : it);
        cv_issue(F, nx, buf ^ 1);
        asm volatile("s_waitcnt vmcnt(8)" ::: "memory");
        __builtin_amdgcn_s_barrier(); asm volatile("" ::: "memory");
        { const int n = tid & 127, kq = tid >> 7; const LAS float* a = (const LAS float*)(F.lds + buf * 65536) + (32 * kq) * 128 + n; unsigned w[8];
#pragma unroll
          for (int j = 0; j < 8; ++j) { const float f0 = a[(4 * j) * 128], f1 = a[(4 * j + 1) * 128], f2 = a[(4 * j + 2) * 128], f3 = a[(4 * j + 3) * 128];
              int q0 = __builtin_amdgcn_cvt_pk_fp8_f32(f0, f1, 0, false); q0 = __builtin_amdgcn_cvt_pk_fp8_f32(f2, f3, q0, true); w[j] = (unsigned)q0; }
          LAS u32x4* o = (LAS u32x4*)(Bb + n * 144 + 32 * kq); o[0] = (u32x4){w[0], w[1], w[2], w[3]}; o[1] = (u32x4){w[4], w[5], w[6], w[7]}; }
        asm volatile("s_waitcnt lgkmcnt(0)" ::: "memory"); __builtin_amdgcn_s_barrier(); asm volatile("" ::: "memory");
#pragma unroll
        for (int j = 0; j < 2; ++j) { const int nl = (tid >> 3) + 64 * j, ch = tid & 7; const u32x4 v = *(const LAS u32x4*)(Bb + nl * 144 + 16 * ch);
            const int drow = cur.down ? dn_row(cur.n0 + nl) : cur.rowbase + nl;
            *(GAS u32x4*)(cur.dst + (size_t)drow * cur.Kd + 16 * ch) = v; }
        asm volatile("s_waitcnt lgkmcnt(0)" ::: "memory");
        if (!more) break;
        cur = nx; it = nit; buf ^= 1;
    }
    asm volatile("s_waitcnt vmcnt(0)" ::: "memory");
    __builtin_amdgcn_s_barrier();
}
template <bool FL> __device__ __forceinline__ void norm_rows(Frame& F, const float* src  , bf16_t* dst, const float* mod, int shift_off, int scale_off, const float* w_in, const float* b_forget, float* lf, unsigned char* dst8) {
    LAS float* wf = (LAS float*)F.lds;
    if (FL) { for (int i = F.tid; i < DM * NH; i += NWAVES * 64) wf[(i & 7) * DM + (i >> 3)] = w_in[(size_t)(i >> 3) * INC + 1536 + (i & 7)]; __syncthreads(); }
    const int gw = F.vcu * NWAVES + F.wave, NGW = F.G * NWAVES;
    constexpr int CH = 32;
#define NR_ROW(i_) (rowb + 128 * (i_))
#define NR_LD(dst_, row_, j_) do { if (FL) dst_ = ((const GAS f32x4*)(src + (size_t)(row_) * DM) + F.lane)[64 * (j_)]; \
        else { const u32x2 t_ = ((const GAS u32x2*)x1_row(F.ws, (size_t)(row_)) + F.lane)[64 * (j_)]; dst_ = (f32x4){bf_lo(t_.x), bf_hi(t_.x), bf_lo(t_.y), bf_hi(t_.y)}; } } while (0)
    for (int ch = gw; ch < M / CH; ch += NGW) {
        const int b = ch >> 7, rowb = b * SEQ + (ch & 127);
        f32x4 sc[4], sh[4];
#pragma unroll
        for (int j = 0; j < 4; ++j) { sc[j] = *(const f32x4*)(mod + (size_t)b * NMOD + scale_off + 256 * j + 4 * F.lane) + 1.f; sh[j] = *(const f32x4*)(mod + (size_t)b * NMOD + shift_off + 256 * j + 4 * F.lane); }
        f32x4 nv[2][4];
#pragma unroll
        for (int q = 0; q < 2; ++q)
#pragma unroll
            for (int j = 0; j < 4; ++j) NR_LD(nv[q][j], NR_ROW(q), j);
        for (int mm = 0; mm < CH; mm += 2) {
            f32x4 vv[2][4];
#pragma unroll
            for (int q = 0; q < 2; ++q)
#pragma unroll
                for (int j = 0; j < 4; ++j) vv[q][j] = nv[q][j];
            if (mm + 2 < CH) {
#pragma unroll
                for (int q = 0; q < 2; ++q)
#pragma unroll
                    for (int j = 0; j < 4; ++j) NR_LD(nv[q][j], NR_ROW(mm + 2 + q), j); }
#pragma unroll
            for (int q = 0; q < 2; ++q) { const int m = NR_ROW(mm + q); f32x4 (&v)[4] = vv[q];
            float s2 = 0.f;
#pragma unroll
            for (int j = 0; j < 4; ++j) s2 += (v[j].x * v[j].x + v[j].y * v[j].y) + (v[j].z * v[j].z + v[j].w * v[j].w);
            const float r = 1.f / sqrtf(wave_sum(s2) * (1.f / DM) + EPS);
#pragma unroll
            for (int j = 0; j < 4; ++j) v[j] = v[j] * r * sc[j] + sh[j];
            GAS u32x2* o8 = (GAS u32x2*)(dst + (size_t)m * DM) + F.lane;
#pragma unroll
            for (int j = 0; j < 4; ++j) { u32x2 w; w.x = cvt_pk_bf16(v[j].x, v[j].y); w.y = cvt_pk_bf16(v[j].z, v[j].w); o8[64 * j] = w; }
            if (!FL) { GAS unsigned* o4 = (GAS unsigned*)(dst8 + (size_t)m * DM) + F.lane;
#pragma unroll
                for (int j = 0; j < 4; ++j) { int w = __builtin_amdgcn_cvt_pk_fp8_f32(v[j].x, v[j].y, 0, false); w = __builtin_amdgcn_cvt_pk_fp8_f32(v[j].z, v[j].w, w, true); o4[64 * j] = (unsigned)w; } }
            if (FL) { float fl[NH];
#pragma unroll
                for (int h = 0; h < NH; ++h) fl[h] = 0.f;
#pragma unroll
                for (int j = 0; j < 4; ++j)
#pragma unroll
                    for (int h = 0; h < NH; ++h) { const f32x4 w4 = *(const LAS f32x4*)(wf + h * DM + 256 * j + 4 * F.lane); fl[h] += (v[j].x * w4.x + v[j].y * w4.y) + (v[j].z * w4.z + v[j].w * w4.w); }
                const float mine = reduce8_heads(fl, F.lane); const int hh = F.lane >> 3;
                if ((F.lane & 7) == 0) { const float z = mine + b_forget[hh]; const float ls = fminf(z, 0.f) - log1pf(__expf(-fabsf(z))); lf[((size_t)b * NH + hh) * SEQ + (m & (SEQ - 1))] = ls; } }
            }
        }
    }
}
#undef NR_ROW
#undef NR_LD
__device__ __forceinline__ void scan_rows(Frame& F, const float* lf, float* kb, int* t0tab) {
    LAS float* wt = (LAS float*)F.lds; LAS float* kl = wt + 16;
    for (int s = blockIdx.x; s < BATCH * NH; s += F.G) {
        const float* src = lf + (size_t)s * SEQ + F.tid * 8; float v[8];
        { const f32x4 a = *(const f32x4*)src, b2 = *(const f32x4*)(src + 4); v[0] = a.x; v[1] = a.y; v[2] = a.z; v[3] = a.w; v[4] = b2.x; v[5] = b2.y; v[6] = b2.z; v[7] = b2.w; }
#pragma unroll
        for (int i = 1; i < 8; ++i) v[i] += v[i - 1];
        float incl = v[7];
#pragma unroll
        for (int o = 1; o < 64; o <<= 1) { const float t = __shfl_up(incl, o); if (F.lane >= o) incl += t; }
        if (F.lane == 63) wt[F.wave] = incl;
        __syncthreads();
        float base = incl - v[7];
        for (int w = 0; w < F.wave; ++w) base += wt[w];
        float* dst = kb + (size_t)s * SEQ + F.tid * 8;
        f32x4 a, b2; a.x = -(v[0] + base) * LOG2E; a.y = -(v[1] + base) * LOG2E; a.z = -(v[2] + base) * LOG2E; a.w = -(v[3] + base) * LOG2E;
        b2.x = -(v[4] + base) * LOG2E; b2.y = -(v[5] + base) * LOG2E; b2.z = -(v[6] + base) * LOG2E; b2.w = -(v[7] + base) * LOG2E;
        *(f32x4*)dst = a; *(f32x4*)(dst + 4) = b2;
        *(LAS f32x4*)(kl + F.tid * 8) = a; *(LAS f32x4*)(kl + F.tid * 8 + 4) = b2;
        __syncthreads();
        if (F.tid < 16) { const int q0 = 256 * F.tid; const float target = kl[q0] - FOX_SKIP_LOG2; int lo = 0, hi = q0;
            while (lo < hi) { const int mid = (lo + hi) >> 1; if (kl[mid] <= target) lo = mid + 1; else hi = mid; }
            t0tab[s * 16 + F.tid] = (lo >> 6) & ~1; }
        __syncthreads();
    }
}
__device__ __forceinline__ void unpack8(const u32x4 w, float* f) { f[0] = bf_lo(w.x); f[1] = bf_hi(w.x); f[2] = bf_lo(w.y); f[3] = bf_hi(w.y); f[4] = bf_lo(w.z); f[5] = bf_hi(w.z); f[6] = bf_lo(w.w); f[7] = bf_hi(w.w); }
__device__ __forceinline__ void merge_rows(Frame& F, const float* g_fox, const float* g_dil) {
    const bf16_t* OF = (const bf16_t*)(F.ws + WS_OF); const bf16_t* O1 = (const bf16_t*)(F.ws + WS_O1); const bf16_t* O2 = (const bf16_t*)(F.ws + WS_O2); const bf16_t* O3 = (const bf16_t*)(F.ws + WS_O3);
    const float* LSE = (const float*)(F.ws + WS_LSE); bf16_t* YM = (bf16_t*)(F.ws + WS_YM);
    const int gw = F.vcu * NWAVES + F.wave, NGW = F.G * NWAVES;
    float gf[8], gd[8];
    { const f32x4 a = *(const f32x4*)(g_fox + 8 * F.lane), b = *(const f32x4*)(g_fox + 8 * F.lane + 4), c = *(const f32x4*)(g_dil + 8 * F.lane), d = *(const f32x4*)(g_dil + 8 * F.lane + 4);
      gf[0] = a.x; gf[1] = a.y; gf[2] = a.z; gf[3] = a.w; gf[4] = b.x; gf[5] = b.y; gf[6] = b.z; gf[7] = b.w; gd[0] = c.x; gd[1] = c.y; gd[2] = c.z; gd[3] = c.w; gd[4] = d.x; gd[5] = d.y; gd[6] = d.z; gd[7] = d.w; }
    struct Row { u32x4 wf, w1, w2, w3; float l1, l2, l3; };
    const int hd = F.lane >> 3;
#define MR_LOAD(R, m_) do { const size_t eo_ = (size_t)(m_) * HW + 8 * F.lane; R.wf = *(const GAS u32x4*)(OF + eo_); R.w1 = *(const GAS u32x4*)(O1 + eo_); R.w2 = *(const GAS u32x4*)(O2 + eo_); R.w3 = *(const GAS u32x4*)(O3 + eo_); \
        R.l1 = LSE[(size_t)(m_) * NH + hd]; R.l2 = LSE[(size_t)M * NH + (size_t)(m_) * NH + hd]; R.l3 = LSE[(size_t)2 * M * NH + (size_t)(m_) * NH + hd]; } while (0)
    for (int ch = gw; ch < M / 32; ch += NGW) {
        const size_t rowb = (size_t)(ch >> 7) * SEQ + (ch & 127);
        Row nr[2]; MR_LOAD(nr[0], rowb); MR_LOAD(nr[1], rowb + 128);
        for (int mm = 0; mm < 32; mm += 2) {
            Row cr[2]; cr[0] = nr[0]; cr[1] = nr[1];
            if (mm + 2 < 32) { MR_LOAD(nr[0], rowb + 128 * (mm + 2)); MR_LOAD(nr[1], rowb + 128 * (mm + 3)); }
#pragma unroll
            for (int q = 0; q < 2; ++q) { const size_t m = rowb + 128 * (mm + q); const Row& R = cr[q];
            const float mx = fmaxf(R.l1, fmaxf(R.l2, R.l3)); float e1 = __builtin_amdgcn_exp2f(R.l1 - mx), e2 = __builtin_amdgcn_exp2f(R.l2 - mx), e3 = __builtin_amdgcn_exp2f(R.l3 - mx);
            const float inv = 1.f / (e1 + e2 + e3); e1 *= inv; e2 *= inv; e3 *= inv;
            float yf[8], a1[8], a2[8], a3[8], yd[8]; unpack8(R.wf, yf); unpack8(R.w1, a1); unpack8(R.w2, a2); unpack8(R.w3, a3);
            float sf = 0.f, sd = 0.f;
#pragma unroll
            for (int i = 0; i < 8; ++i) { yd[i] = e1 * a1[i] + e2 * a2[i] + e3 * a3[i]; sf += yf[i] * yf[i]; sd += yd[i] * yd[i]; }
            const float rf = 1.f / sqrtf(wave_sum(sf) * (1.f / HW) + EPS), rd = 1.f / sqrtf(wave_sum(sd) * (1.f / HW) + EPS);
            u32x4 of, od;
            of.x = cvt_pk_bf16(yf[0] * rf * gf[0], yf[1] * rf * gf[1]); of.y = cvt_pk_bf16(yf[2] * rf * gf[2], yf[3] * rf * gf[3]); of.z = cvt_pk_bf16(yf[4] * rf * gf[4], yf[5] * rf * gf[5]); of.w = cvt_pk_bf16(yf[6] * rf * gf[6], yf[7] * rf * gf[7]);
            od.x = cvt_pk_bf16(yd[0] * rd * gd[0], yd[1] * rd * gd[1]); od.y = cvt_pk_bf16(yd[2] * rd * gd[2], yd[3] * rd * gd[3]); od.z = cvt_pk_bf16(yd[4] * rd * gd[4], yd[5] * rd * gd[5]); od.w = cvt_pk_bf16(yd[6] * rd * gd[6], yd[7] * rd * gd[7]);
            *(GAS u32x4*)(YM + m * DM + 8 * F.lane) = of; *(GAS u32x4*)(YM + m * DM + HW + 8 * F.lane) = od; }
        }
    }
#undef MR_LOAD
}
__device__ __forceinline__ void route_rows(Frame& F, int pm, const float* logits, const float* rbias, unsigned* list, float* wts, unsigned* pose) {
    LAS unsigned* lcount = (LAS unsigned*)F.lds;
    LAS unsigned* lbase = lcount + 256;
    LAS unsigned* lsel = lbase + 256;
    LAS unsigned* lwt = lsel + 2048;
    if (F.tid < 256) lcount[F.tid] = 0u;
    __syncthreads();
    const f32x4 rb = *(const f32x4*)(rbias + 4 * F.lane);
#define DPPF(x, ctrl) __int_as_float(__builtin_amdgcn_update_dpp(0, __float_as_int(x), ctrl, 0xF, 0xF, false))
#define DPPUMAX(v, ctrl, rm) v = max(v, (unsigned)__builtin_amdgcn_update_dpp(0, (int)v, ctrl, rm, 0xF, false))
    f32x4 lgn = *(const GAS f32x4*)(logits + ((size_t)pm * 256 + F.wave * 32) * NEXP + 4 * F.lane);
    for (int i = 0; i < 32; ++i) { const int rl = F.wave * 32 + i; const size_t row = (size_t)pm * 256 + rl;
        const f32x4 lg = lgn;
        if (i + 1 < 32) lgn = *(const GAS f32x4*)(logits + (row + 1) * NEXP + 4 * F.lane);
        float s[4], sel[4];
#pragma unroll
        for (int q = 0; q < 4; ++q) { s[q] = 1.f / (1.f + __expf(-lg[q])); sel[q] = s[q] + rb[q]; }
        float m1 = -INFINITY, m2 = -INFINITY;
#pragma unroll
        for (int q = 0; q < 4; ++q) { if (sel[q] > m1) { m2 = m1; m1 = sel[q]; } else if (sel[q] > m2) m2 = sel[q]; }
        { float b1 = DPPF(m1, 0xB1), b2 = DPPF(m2, 0xB1); float n1 = fmaxf(m1, b1), n2 = fmaxf(fminf(m1, b1), fmaxf(m2, b2)); m1 = n1; m2 = n2;
          b1 = DPPF(m1, 0x4E); b2 = DPPF(m2, 0x4E); n1 = fmaxf(m1, b1); n2 = fmaxf(fminf(m1, b1), fmaxf(m2, b2)); m1 = n1; m2 = n2;
          b1 = DPPF(m1, 0x141); b2 = DPPF(m2, 0x141); n1 = fmaxf(m1, b1); n2 = fmaxf(fminf(m1, b1), fmaxf(m2, b2)); m1 = n1; m2 = n2; }
        const float gs = m1 + m2; const int g = F.lane >> 3; int rank = 0;
#pragma unroll
        for (int gg = 0; gg < 8; ++gg) { const float og = __int_as_float(__builtin_amdgcn_readlane(__float_as_int(gs), gg * 8)); rank += (og > gs || (og == gs && gg < g)) ? 1 : 0; }
        const bool gsel = rank < 4;
        unsigned key[4];
#pragma unroll
        for (int q = 0; q < 4; ++q) { const unsigned bq = __float_as_uint(sel[q]); key[q] = gsel ? (bq ^ ((bq >> 31) ? 0xffffffffu : 0x80000000u)) : 0u; }
        int myE = 0; float myS = 0.f, ssum = 0.f;
#pragma unroll 1
        for (int k = 0; k < TOPK; ++k) {
            unsigned v = max(max(key[0], key[1]), max(key[2], key[3]));
            DPPUMAX(v, 0xB1, 0xF); DPPUMAX(v, 0x4E, 0xF); DPPUMAX(v, 0x141, 0xF); DPPUMAX(v, 0x140, 0xF); DPPUMAX(v, 0x142, 0xA); DPPUMAX(v, 0x143, 0xC);
            const unsigned best = (unsigned)__builtin_amdgcn_readlane((int)v, 63);
            const int myq = (key[0] == best) ? 0 : (key[1] == best) ? 1 : (key[2] == best) ? 2 : (key[3] == best) ? 3 : 4;
            const unsigned long long bal = __ballot(myq < 4);
            const int L = __builtin_amdgcn_readfirstlane((int)__ffsll((long long)bal) - 1);
            const int q = __builtin_amdgcn_readlane(myq, L);
            const float mys = (q == 0) ? s[0] : (q == 1) ? s[1] : (q == 2) ? s[2] : s[3];
            const float sk = __int_as_float(__builtin_amdgcn_readlane(__float_as_int(mys), L));
            if (F.lane == L) {
#pragma unroll
                for (int qq = 0; qq < 4; ++qq) if (qq == q) key[qq] = 0u; }
            if (F.lane == k) { myE = 4 * L + q; myS = sk; }
            ssum += sk;
        }
        if (F.lane < TOPK) { const unsigned lp = atomicAdd((unsigned*)(lcount + myE), 1u); lsel[rl * 8 + F.lane] = (unsigned)myE | (lp << 8); lwt[rl * 8 + F.lane] = __float_as_uint(myS / ssum * 2.5f); }
    }
#undef DPPF
#undef DPPUMAX
    __syncthreads();
    if (F.tid < 256) { const unsigned n = lcount[F.tid]; lbase[F.tid] = n ? __hip_atomic_fetch_add((unsigned*)(F.ctl + CW_CNT + F.tid), n, RLX_AGENT) : 0u; }
    __syncthreads();
    for (int a = F.tid; a < 2048; a += NWAVES * 64) { const unsigned se = lsel[a]; const unsigned e = se & 255u, lp = se >> 8; const unsigned pos = lbase[e] + lp; const unsigned tok = (unsigned)(pm * 256 + (a >> 3));
        wts[(size_t)tok * TOPK + (a & 7)] = __uint_as_float(lwt[a]); pose[(size_t)tok * TOPK + (a & 7)] = (e << 16) | (pos & 0xffffu);
        if (pos < (unsigned)LCAP) list[(size_t)e * LCAP + pos] = tok | ((unsigned)(a & 7) << 16); }
    __syncthreads();
}
__device__ __forceinline__ void build_tables(Frame& F) {
    LAS unsigned* tp = (LAS unsigned*)(F.lds + TAB_OFF); LAS unsigned* cn = tp + 260; LAS unsigned* cp = cn + 256; LAS unsigned* wt = cp + 256;
    __syncthreads();
    unsigned cnt = 0u, tiles = 0u, incl = 0u, cincl = 0u;
    if (F.tid < 256) { cnt = __hip_atomic_load((unsigned*)(F.ctl + CW_CNT + F.tid), RLX_AGENT); if (cnt > (unsigned)LCAP) cnt = LCAP; tiles = (cnt + 255u) >> 8; incl = tiles; cincl = cnt;
#pragma unroll
        for (int o = 1; o < 64; o <<= 1) { const unsigned t = __shfl_up(incl, o), t2 = __shfl_up(cincl, o); if (F.lane >= o) { incl += t; cincl += t2; } }
        if (F.lane == 63) { wt[F.wave] = incl; wt[8 + F.wave] = cincl; } }
    __syncthreads();
    if (F.tid < 256) { unsigned base = 0u, cbase = 0u; for (int w = 0; w < F.wave; ++w) { base += wt[w]; cbase += wt[8 + w]; } tp[F.tid + 1] = base + incl; cn[F.tid] = cnt; cp[F.tid] = cbase + cincl - cnt; if (F.tid == 0) tp[0] = 0u;
        LAS unsigned short* mt2e = (LAS unsigned short*)(F.lds + MT2E_OFF); const unsigned t0 = base + incl - tiles; for (unsigned t = 0; t < tiles; ++t) mt2e[t0 + t] = (unsigned short)F.tid; }
    __syncthreads();
}
__device__ __forceinline__ void combine_rows(Frame& F, const float* gate2, const float* g_final, float* dst) {
    const unsigned char* Y = (const unsigned char*)(F.ws + WS_YBUF); const float* WT = (const float*)(F.ws + WS_WTS); const unsigned* PE = (const unsigned*)(F.ws + WS_POSE);
    const LAS unsigned* cp = (const LAS unsigned*)(F.lds + TAB_OFF) + 260 + 256;
    const int gw = F.vcu * NWAVES + F.wave, NGW = F.G * NWAVES; const int c0 = 16 * F.lane;
    const unsigned char* YS = (const unsigned char*)(F.ws + WS_YSH);
    struct CRow { u32x4 yv[8]; u32x4 ys, xb[2]; f32x4 w0, w1; };
#define CR_LOAD(R, m_) do { const size_t mq_ = (size_t)(m_); const unsigned pe_ = PE[mq_ * TOPK + (F.lane & 7)]; const unsigned myrow_ = cp[pe_ >> 16] + (pe_ & 0xffffu); \
        _Pragma("unroll") for (int k = 0; k < 8; ++k) { const size_t yr_ = (size_t)(unsigned)__builtin_amdgcn_readlane((int)myrow_, k); R.yv[k] = *(const GAS u32x4*)(Y + yr_ * DM + c0); } \
        R.ys = *(const GAS u32x4*)(YS + mq_ * DM + c0); const GAS u32x4* or_ = (const GAS u32x4*)(x1_row(F.ws, mq_) + c0); R.xb[0] = or_[0]; R.xb[1] = or_[1]; R.w0 = *(const GAS f32x4*)(WT + mq_ * TOPK); R.w1 = *(const GAS f32x4*)(WT + mq_ * TOPK + 4); } while (0)
    f32x4 gf[4];
#pragma unroll
    for (int j = 0; j < 4; ++j) gf[j] = *(const f32x4*)(g_final + c0 + 4 * j);
    for (int ch = gw; ch < M / 32; ch += NGW) {
        const int b = ch >> 7; const size_t rowb = (size_t)b * SEQ + (ch & 127);
        f32x4 g2[4];
#pragma unroll
        for (int j = 0; j < 4; ++j) g2[j] = *(const f32x4*)(gate2 + (size_t)b * NMOD + c0 + 4 * j) * (1.f / YSCALE);
        CRow nr; CR_LOAD(nr, rowb);
        for (int mm = 0; mm < 32; ++mm) { const size_t m = rowb + 128 * mm;
            CRow R = nr;
            if (mm + 1 < 32) CR_LOAD(nr, m + 128);
            const float wk[8] = {R.w0.x, R.w0.y, R.w0.z, R.w0.w, R.w1.x, R.w1.y, R.w1.z, R.w1.w};
            f32x4 acc[4];
#pragma unroll
            for (int j = 0; j < 4; ++j) { const int wv = (int)R.ys[j]; const f32x2 lo = __builtin_amdgcn_cvt_pk_f32_fp8(wv, false), hi = __builtin_amdgcn_cvt_pk_f32_fp8(wv, true); f32x4 a = (f32x4){lo.x, lo.y, hi.x, hi.y};
#pragma unroll
                for (int k = 0; k < 8; ++k) { const int wk_ = (int)R.yv[k][j]; const f32x2 l2 = __builtin_amdgcn_cvt_pk_f32_fp8(wk_, false), h2 = __builtin_amdgcn_cvt_pk_f32_fp8(wk_, true);
                    a.x += wk[k] * l2.x; a.y += wk[k] * l2.y; a.z += wk[k] * h2.x; a.w += wk[k] * h2.y; }
                acc[j] = a; __builtin_amdgcn_sched_barrier(0); }
            float s2 = 0.f; f32x4 v[4];
#pragma unroll
            for (int j = 0; j < 4; ++j) { const unsigned xa = R.xb[j >> 1][(j & 1) * 2], xc = R.xb[j >> 1][(j & 1) * 2 + 1]; const f32x4 xj = (f32x4){bf_lo(xa), bf_hi(xa), bf_lo(xc), bf_hi(xc)}; v[j] = xj + g2[j] * acc[j]; s2 += (v[j].x * v[j].x + v[j].y * v[j].y) + (v[j].z * v[j].z + v[j].w * v[j].w); }
            const float r = 1.f / sqrtf(wave_sum(s2) * (1.f / DM) + EPS);
            GAS f32x4* orow = (GAS f32x4*)(dst + m * DM + c0);
#pragma unroll
            for (int j = 0; j < 4; ++j) orow[j] = v[j] * r * gf[j];
        }
    }
#undef CR_LOAD
}

struct Args { const float* in[19]; float* out; unsigned char* ws; int ph_lo, ph_hi, li, pad; };
__global__ void __launch_bounds__(NWAVES * 64, 2) fwd_kernel(Args args) {
    extern __shared__ __attribute__((aligned(16))) unsigned char lds[];
    Frame F;
    F.lds = (LAS unsigned char*)lds;
    F.MISC = (volatile LAS unsigned*)(F.lds + MISC_OFF);
    F.tid = threadIdx.x; F.lane = F.tid & 63; F.wave = __builtin_amdgcn_readfirstlane(F.tid >> 6);
    F.G = gridDim.x; { const int bx = blockIdx.x; F.vcu = (F.G % 8 == 0) ? (bx % 8) * (F.G / 8) + bx / 8 : bx; }
    F.ws = args.ws; F.out = args.out; F.ctl = (gu32*)(args.ws + WS_CTL);
    unsigned char* ws = args.ws;
    typedef const __attribute__((address_space(4))) Args* KArgP;
#define KA(i) ({ KArgP p_ = (KArgP)__builtin_amdgcn_kernarg_segment_ptr(); asm volatile("" : "+s"(p_)); p_->in[i]; })
#define MOD ((float*)(ws + WS_MOD))
#define LF ((float*)(ws + WS_LF))
#define KB ((float*)(ws + WS_KB))
#define LSE ((float*)(ws + WS_LSE))
#define HB ((bf16_t*)(ws + WS_H))
#define QKV ((bf16_t*)(ws + WS_QKV))
#define LIST ((unsigned*)(ws + WS_LIST))
    for (int u = F.tid; u < (LDS_BYTES - LDSCTL_OFF) / 4; u += NWAVES * 64) ((LAS unsigned*)(F.lds + LDSCTL_OFF))[u] = 0u;
    __syncthreads();
    XcdBarrier bar; bar.bar = (unsigned*)(F.ctl + CW_BAR); bar.x = 0; bar.st = nullptr;
    if (N_LAUNCHES == 1) bar = xcd_barrier_post((unsigned*)(F.ctl + CW_BAR), F.MISC + 8);
#define GRID_BAR() do { if (N_LAUNCHES == 1) xcd_barrier(bar); } while (0)
#define REFRESH() do { int t_ = threadIdx.x; asm volatile("" : "+v"(t_)); F.tid = t_; F.lane = t_ & 63; } while (0)
    const int lo = args.ph_lo, hi = args.ph_hi;
#ifndef ONLY_PHASE
#define ONLY_PHASE -1
#endif
#define IN(k) ((ONLY_PHASE < 0 || ONLY_PHASE == (k)) && lo <= (k) && (k) < hi)
#define BOTH(k) (IN(k) && IN((k) + 1))

    if (IN(0)) {
        REFRESH();
        _Pragma("unroll") for (int rep_ = 0; rep_ < DUPN(0); ++rep_) {
        p0_mod(F, KA(1), KA(7), KA(8), MOD);
        P0Ptrs P{KA(2), KA(6), KA(9), KA(11), KA(12), KA(13), KA(14), KA(15), KA(16)};
        p0_weights(F, P, P0_EXPERT_ITEMS, P0_ALL_ITEMS); }
        if (BOTH(0)) GRID_BAR();
    }
    if (IN(1)) {
        REFRESH();
        _Pragma("unroll") for (int rep_ = 0; rep_ < DUPN(1); ++rep_) norm_rows<true>(F, KA(0), HB, MOD, 0, DM, KA(2), KA(3), LF, nullptr);
        if (BOTH(1)) GRID_BAR();
    }
    if (IN(2)) {
        REFRESH();
        _Pragma("unroll") for (int rep_ = 0; rep_ < DUPN(2); ++rep_) {
        scan_rows(F, LF, KB, (int*)(ws + WS_T0));
        pg8::Gemm g{HB, (const bf16_t*)(ws + WS_WIN), DM, nullptr}; pg8::StaticOrder S; S.init(M, 3072, F.G, (int)blockIdx.x);
        pg8::EpiQKV E{QKV, (size_t)M * HW, attn_body::C2};
        pg8::gemm_phase<pg8::EpiQKV, pg8::StaticOrder, false>(F.lds, g, S, E); }
        if (BOTH(2)) GRID_BAR();
    }
    if (IN(3)) {
        REFRESH();
        using attn_body::bf16; const float* rel_bias = KA(17);
        const bf16* Qf = (const bf16*)QKV; const bf16* Kf = Qf + (size_t)M * HW; const bf16* Vf = Kf + (size_t)M * HW;
        const bf16* Qd = Vf + (size_t)M * HW; const bf16* Kd = Qd + (size_t)M * HW; const bf16* Vd = Kd + (size_t)M * HW;
        bf16* OF = (bf16*)(ws + WS_OF);
        bool conv_done = false;
        const P0Ptrs PW{KA(2), KA(6), KA(9), KA(11), KA(12), KA(13), KA(14), KA(15), KA(16)};
        for (int cu = F.vcu; cu < 16 * BATCH; cu += F.G) {
            const int b = cu >> 4, j = cu & 15;
            for (int h = 0; h < NH; ++h) { const int q = (j + 4 * (h >> 1)) & 15; const int qb = (h & 1) ? 15 - q : q; const int bh = b * NH + h;
                if (!conv_done && h == 2 * (F.vcu & 3)) { __syncthreads(); conv_experts(F, PW); __syncthreads(); conv_done = true; }
                const size_t hb = (size_t)b * SEQ * HW + h * HD; const int T0 = ((const int*)(ws + WS_T0))[bh * 16 + qb];
                if (DUPN(3) == 2) attn_body::attn_unit<8, 0>(Qf + hb, Kf + hb, Vf + hb, (bf16*)(ws + WS_SS0), (long)HW, 0L, qb * 256, T0, 4 * qb + 4 - T0, 0, nullptr, 0, (char*)lds, KB + (size_t)bh * SEQ, nullptr, 0);
                attn_body::attn_unit<8, 0>(Qf + hb, Kf + hb, Vf + hb, OF + hb, (long)HW, (long)HW, qb * 256, T0, 4 * qb + 4 - T0, 0, nullptr, 0, (char*)lds, KB + (size_t)bh * SEQ, nullptr, 0); }
        }
        if (!conv_done) { __syncthreads(); conv_experts(F, PW); __syncthreads(); }
        for (int job = F.vcu; job < 2 * BATCH * NH; job += F.G) {
            const int bh = job >> 1, sub = job & 1, b = bh >> 3, h = bh & 7;
            const size_t hb = (size_t)b * SEQ * HW + h * HD;
            const int nd = sub ? 25 : 23; int tabkey = -1;
            { __syncthreads(); for (int i = F.tid; i < attn_body::DL_ZEND / 16; i += NWAVES * 64) *(LAS f32x4*)(F.lds + i * 16) = (f32x4){0.f, 0.f, 0.f, 0.f}; __syncthreads(); }
#define DIL_PARAMS(i_, dsel_, d_, r_, qb_) do { if ((i_) < 16) { if (sub == 0) { dsel_ = 0; d_ = 1; r_ = 0; qb_ = (i_); } else { dsel_ = 1; d_ = 4; r_ = (i_) >> 2; qb_ = (i_) & 3; } } \
                else { dsel_ = 2; d_ = 16; r_ = ((i_) - 16) + (sub ? 7 : 0); qb_ = 0; } } while (0)
            for (int i = 0; i < nd; ++i) {
                int dsel, d, r, qb; DIL_PARAMS(i, dsel, d, r, qb);
                int dseln = 0, dn = 1, rn = 0, qbn = 0; const bool has_next = (i + 1 < nd); if (has_next) DIL_PARAMS(i + 1, dseln, dn, rn, qbn);
                bf16* OB = (bf16*)(ws + (dsel == 0 ? WS_O1 : dsel == 1 ? WS_O2 : WS_O3));
                const size_t sb = hb + (size_t)r * HW, sbn = hb + (size_t)rn * HW;
                float* lsep = LSE + (size_t)dsel * M * NH + ((size_t)b * SEQ + r) * NH + h;
                const bool bt = (tabkey != dsel); tabkey = dsel;
                const attn_body::DilSrc cu{Kd + sb, Vd + sb, (long)d * HW, qb * 256, qb == 0}, nx{Kd + sbn, Vd + sbn, (long)dn * HW, qbn * 256, qbn == 0};
                _Pragma("unroll") for (int rep_ = 0; rep_ < DUPN(3); ++rep_)
                attn_body::dil_unit<8>(Qd + sb, cu, (i & 1) ? attn_body::DL_KB : attn_body::DL_K, i > 0 && DUPN(3) == 1, nx, has_next && DUPN(3) == 1, OB + sb, lsep, (long)d * NH, (char*)lds, rel_bias + h, dsel, bt); }
#undef DIL_PARAMS
        }
        if (BOTH(3)) GRID_BAR();
    }
    if (IN(4)) {
        REFRESH();
        _Pragma("unroll") for (int rep_ = 0; rep_ < DUPN(4); ++rep_) merge_rows(F, KA(4), KA(5));
        if (BOTH(4)) GRID_BAR();
    }
    if (IN(5)) {
        REFRESH();
        _Pragma("unroll") for (int rep_ = 0; rep_ < DUPN(5); ++rep_) {
        pg8::Gemm g{(const bf16_t*)(ws + WS_YM), (const bf16_t*)(ws + WS_WOUT), DM, nullptr}; pg8::StaticOrder S; S.init(M, DM, F.G, (int)blockIdx.x);
        pg8::EpiX1N E{KA(0), ws, MOD, F.lds, (float*)(ws + WS_EX), (unsigned*)(F.ctl + CW_X1)};
        pg8::gemm_phase<pg8::EpiX1N, pg8::StaticOrder, false>(F.lds, g, S, E); }
        if (BOTH(5)) GRID_BAR();
    }
    if (IN(6)) {
        REFRESH();
        (void)0;
    }
    if (IN(7)) {
        REFRESH();
        float* LOGITS = (float*)(ws + WS_LOGITS); const float* rbias_ = KA(10);
        { pg8::Gemm g{HB, (const bf16_t*)(ws + WS_WR), DM, nullptr}; pg8::StaticOrder S; S.init(M, NEXP, F.G, (int)blockIdx.x);
          pg8::EpiF32 E{LOGITS, NEXP};
          pg8::gemm_phase<pg8::EpiF32, pg8::StaticOrder, false>(F.lds, g, S, E);
          asm volatile("s_waitcnt vmcnt(0)" ::: "memory"); __syncthreads();
          pg8::Unit u; for (int i = 0; S.next(i, u); ++i) route_rows(F, u.pm, LOGITS, rbias_, LIST, (float*)(ws + WS_WTS), (unsigned*)(ws + WS_POSE)); }
        _Pragma("unroll") for (int rep_ = 0; rep_ < DUPN(7); ++rep_)
        { pg8::Gemm g{HB, (const bf16_t*)(ws + WS_WSHGU), DM, nullptr}; pg8::StaticOrder S; S.init(M, 512, F.G, (int)blockIdx.x);
          pg8::EpiSwiglu E{(bf16_t*)(ws + WS_ACTSH)};
          pg8::gemm_phase<pg8::EpiSwiglu, pg8::StaticOrder, false>(F.lds, g, S, E); }
        if (BOTH(7)) GRID_BAR();
    }
    if (IN(8)) {
        REFRESH();
        { pg8::Gemm g{(const bf16_t*)(ws + WS_ACTSH), (const bf16_t*)(ws + WS_WSHD), EH, nullptr}; pg8::StaticOrder S; S.init(M, DM, F.G, (int)blockIdx.x);
          pg8::EpiYbuf E{ws + WS_YSH, ws + WS_DUMP};
          pg8::gemm_phase<pg8::EpiYbuf, pg8::StaticOrder, false, false, true, 0, HOIST_SD>(F.lds, g, S, E); }
        build_tables(F);
#if PROBE_G1
        { pg8::Gemm g{(const bf16_t*)(ws + WS_H8), (const bf16_t*)(ws + WS_WGU), DM / 2, LIST};
          pg8::GroupedOrder S{(const LAS unsigned*)(F.lds + TAB_OFF), (const LAS unsigned*)(F.lds + TAB_OFF) + 260, 2, F.G, F.vcu, 2, 0, 0, (const LAS unsigned short*)(F.lds + MT2E_OFF)}; S.total = __builtin_amdgcn_readfirstlane((int)S.tp[256]) * 2;
          pg8::EpiSwiglu8 E{ws + WS_ACT};
          pg8::gemm_phase<pg8::EpiSwiglu8, pg8::GroupedOrder, true, true, true, PROBE_G1>(F.lds, g, S, E); }
#endif
        _Pragma("unroll") for (int rep_ = 0; rep_ < DUPN(8); ++rep_)
        { pg8::Gemm g{(const bf16_t*)(ws + WS_H8), (const bf16_t*)(ws + WS_WGU), DM / 2, LIST};
          pg8::GroupedOrder S{(const LAS unsigned*)(F.lds + TAB_OFF), (const LAS unsigned*)(F.lds + TAB_OFF) + 260, 2, F.G, F.vcu, 2, 0, 0, (const LAS unsigned short*)(F.lds + MT2E_OFF)}; S.total = __builtin_amdgcn_readfirstlane((int)S.tp[256]) * 2;
          pg8::EpiSwiglu8 E{ws + WS_ACT};
          pg8::gemm_phase<pg8::EpiSwiglu8, pg8::GroupedOrder, true, true, true, 0, HOIST_G1>(F.lds, g, S, E); }
        if (BOTH(8)) GRID_BAR();
    }
    if (IN(9)) {
        REFRESH();
        build_tables(F);
#if PROBE_G2
        { pg8::Gemm g{(const bf16_t*)(ws + WS_ACT), (const bf16_t*)(ws + WS_WD), EH / 2, LIST};
          pg8::GroupedOrder S{(const LAS unsigned*)(F.lds + TAB_OFF), (const LAS unsigned*)(F.lds + TAB_OFF) + 260, 4, F.G, F.vcu, 4, 0, 0, (const LAS unsigned short*)(F.lds + MT2E_OFF)}; S.total = __builtin_amdgcn_readfirstlane((int)S.tp[256]) * 4;
          pg8::EpiYbuf E{(unsigned char*)(ws + WS_YBUF), ws + WS_DUMP};
          pg8::gemm_phase<pg8::EpiYbuf, pg8::GroupedOrder, false, true, true, PROBE_G2>(F.lds, g, S, E); }
#endif
        _Pragma("unroll") for (int rep_ = 0; rep_ < DUPN(9); ++rep_)
        { pg8::Gemm g{(const bf16_t*)(ws + WS_ACT), (const bf16_t*)(ws + WS_WD), EH / 2, LIST};
          pg8::GroupedOrder S{(const LAS unsigned*)(F.lds + TAB_OFF), (const LAS unsigned*)(F.lds + TAB_OFF) + 260, 4, F.G, F.vcu, 4, 0, 0, (const LAS unsigned short*)(F.lds + MT2E_OFF)}; S.total = __builtin_amdgcn_readfirstlane((int)S.tp[256]) * 4;
          pg8::EpiYbuf E{(unsigned char*)(ws + WS_YBUF), ws + WS_DUMP};
          pg8::gemm_phase<pg8::EpiYbuf, pg8::GroupedOrder, false, true, true, 0, HOIST_G2>(F.lds, g, S, E); }
        if (BOTH(9)) GRID_BAR();
    }
    if (IN(10)) {
        REFRESH();
        build_tables(F);
        if (DUPN(10) == 2) combine_rows(F, MOD + 5 * DM, KA(18), (float*)(ws + WS_ACT));
        combine_rows(F, MOD + 5 * DM, KA(18), F.out);
    }
#undef KA
#undef MOD
#undef LF
#undef KB
#undef LSE
#undef HB
#undef QKV
#undef LIST
#undef REFRESH
#undef IN
#undef BOTH
#undef GRID_BAR
}

extern "C" void kernel_launch(void* const* d_in, const int* in_sizes, int n_in, void* d_out, int out_size, void* d_ws, size_t ws_size, hipStream_t stream) {
    static int grid = 0;
    if (grid == 0) {
        if (n_in != 19 || in_sizes[0] != M * DM || out_size != M * DM || ws_size < WS_NEED) {
            fprintf(stderr, "kernel_launch: unexpected shapes: n_in %d in0 %d out %d ws %zu (need %zu); nothing launched\n", n_in, n_in > 0 ? in_sizes[0] : -1, out_size, ws_size, (size_t)WS_NEED); grid = -1; return; }
        int dev = 0, cus = 0, per_cu = 0;
        if (hipGetDevice(&dev) != hipSuccess || hipDeviceGetAttribute(&cus, hipDeviceAttributeMultiprocessorCount, dev) != hipSuccess) { fprintf(stderr, "kernel_launch: device query failed\n"); grid = -1; return; }
        if (hipFuncSetAttribute((const void*)fwd_kernel, hipFuncAttributeMaxDynamicSharedMemorySize, LDS_BYTES) != hipSuccess) { fprintf(stderr, "kernel_launch: hipFuncSetAttribute failed\n"); grid = -1; return; }
        if (hipOccupancyMaxActiveBlocksPerMultiprocessor(&per_cu, (const void*)fwd_kernel, NWAVES * 64, LDS_BYTES) != hipSuccess || per_cu < 1)
            fprintf(stderr, "kernel_launch: note: occupancy query reports %d workgroups per CU\n", per_cu);
        (void)hipGetLastError();
        grid = cus;
    }
    if (grid < 0) return;
    if (hipMemsetAsync((char*)d_ws + WS_CTL, 0, CTL_ZERO_BYTES, stream) != hipSuccess) { fprintf(stderr, "kernel_launch: memset failed\n"); return; }
    Args a{};
    for (int i = 0; i < 19; ++i) a.in[i] = (const float*)d_in[i];
    a.out = (float*)d_out; a.ws = (unsigned char*)d_ws; a.pad = 0;
    for (int li = 0; li < N_LAUNCHES; ++li) {
        a.ph_lo = (N_LAUNCHES == 1) ? 0 : li; a.ph_hi = (N_LAUNCHES == 1) ? NPHASE : li + 1; a.li = li;
        hipLaunchKernelGGL(fwd_kernel, dim3(grid), dim3(NWAVES * 64), LDS_BYTES, stream, a);
        const hipError_t le = hipPeekAtLastError();
        if (le != hipSuccess) { fprintf(stderr, "kernel_launch: launch %d failed: %s\n", li, hipGetErrorName(le)); break; }
    }
}
```

```cpp
#include <hip/hip_runtime.h>
#include <hip/hip_bf16.h>
#include <cstdio>
#include <cstdint>

#ifndef DUP_MASK
#define DUP_MASK 0
#endif
#ifndef CONV_PROBE
#define CONV_PROBE 0
#endif
#ifndef HOIST_SD
#define HOIST_SD false
#endif
#ifndef HOIST_G1
#define HOIST_G1 false
#endif
#ifndef HOIST_G2
#define HOIST_G2 true
#endif
#ifndef PROBE_G1
#define PROBE_G1 0
#endif
#ifndef PROBE_G2
#define PROBE_G2 0
#endif
#define DUPN(k) (((DUP_MASK >> (k)) & 1) ? 2 : 1)
#ifndef MK_N_LAUNCHES
#define MK_N_LAUNCHES 1
#endif

#define GAS __attribute__((address_space(1)))
#define LAS __attribute__((address_space(3)))

constexpr int BATCH = 16, SEQ = 4096, DM = 1024, M = BATCH * SEQ;
constexpr int NH = 8, HD = 64, HW = NH * HD;
constexpr int INC = 3080;
constexpr int NEXP = 256, TOPK = 8, EH = 256;
constexpr int NMOD = 6 * DM;
constexpr int LCAP = 65536;
constexpr float LOG2E = 1.4426950408889634f;
constexpr float EPS = 1e-6f;
constexpr float FOX_SKIP_LOG2 = 80.f;
constexpr float YSCALE = 16.f;
constexpr int NWAVES = 8;
constexpr int NPHASE = 11;
constexpr int N_LAUNCHES = MK_N_LAUNCHES;

constexpr size_t MiB = 1u << 20;
constexpr size_t WS_CTL = 0, CTL_ZERO_BYTES = 1 * MiB;
constexpr size_t WS_DUMP = 512 * 1024;
constexpr size_t WS_MOD = 1 * MiB;
constexpr size_t WS_LF = 2 * MiB;
constexpr size_t WS_KB = 4 * MiB;
constexpr size_t WS_LSE = 6 * MiB;
constexpr size_t WS_WIN = 12 * MiB;
constexpr size_t WS_WOUT = 18 * MiB;
constexpr size_t WS_WR = 20 * MiB;
constexpr size_t WS_WSHGU = WS_WR + MiB / 2;
constexpr size_t WS_WSHD = WS_WSHGU + MiB;
constexpr size_t WS_WTS = 22 * MiB;
constexpr size_t WS_SS0 = WS_MOD + MiB / 2;
constexpr size_t WS_T0 = WS_MOD + MiB / 2 + 65536;
constexpr size_t WS_WD = 24 * MiB;
constexpr size_t WS_WGU = 88 * MiB;
constexpr size_t WS_LIST = 216 * MiB;
constexpr size_t WS_O3 = WS_LIST;
constexpr size_t WS_H = 280 * MiB;
constexpr size_t WS_H8 = 408 * MiB;
constexpr size_t WS_QKV = 472 * MiB;
constexpr size_t WS_ACT = 856 * MiB;
constexpr size_t WS_YSH = 792 * MiB;
constexpr size_t WS_X1A = 728 * MiB;
constexpr size_t WS_X1B = 1000 * MiB;
constexpr size_t WS_END = 1000 * MiB, WS_NEED = 1064 * MiB;
constexpr size_t WS_YBUF = WS_LIST;
constexpr size_t WS_EX = WS_LSE + 4 * MiB;
constexpr size_t WS_POSE = WS_LSE;
constexpr size_t WS_OF = WS_QKV;
constexpr size_t WS_O1 = WS_H, WS_O2 = WS_H + 64 * MiB;
constexpr size_t WS_YM = WS_QKV + 64 * MiB;
constexpr size_t WS_LOGITS = WS_QKV;
constexpr size_t WS_ACTSH = WS_QKV + 64 * MiB;
static_assert(WS_ACT + (size_t)(M * TOPK + NEXP * 256) * EH <= WS_END, "act fits");
static_assert(WS_YBUF + (size_t)M * TOPK * DM <= WS_X1A && WS_X1A + 64 * MiB <= WS_YSH && WS_YSH + (size_t)M * DM <= WS_ACT && WS_X1B + 64 * MiB <= WS_NEED, "ybuf (unpadded rows), x1, ysh fit below act");
static_assert(WS_QKV + 6 * 64 * MiB <= WS_ACT, "qkv below act");
constexpr int CW_TMO = 0, CW_BAR = 4096, CW_CNT = 8192, CW_X1 = 12288;

constexpr int RING_BYTES = 131072;
constexpr int PHASE_LDS = 158720;
constexpr int LDSCTL_OFF = PHASE_LDS, MISC_OFF = LDSCTL_OFF + 320;
constexpr int TAB_OFF = MISC_OFF + 128;
constexpr int RLIST_OFF = RING_BYTES + 2304 * 2;
constexpr int MT2E_OFF = RING_BYTES;
constexpr int LDS_BYTES = 163840;
static_assert(TAB_OFF + 800 * 4 <= LDS_BYTES, "LDS map");

typedef unsigned short bf16_t;
typedef short bf16x8 __attribute__((ext_vector_type(8)));
typedef float f32x4 __attribute__((ext_vector_type(4)));
typedef float f32x2 __attribute__((ext_vector_type(2)));
typedef unsigned u32x4 __attribute__((ext_vector_type(4)));
typedef unsigned u32x2 __attribute__((ext_vector_type(2)));
typedef GAS unsigned gu32;
typedef int v4i_t __attribute__((ext_vector_type(4)));
typedef int v8i_t __attribute__((ext_vector_type(8)));
#define RLX_AGENT __ATOMIC_RELAXED, __HIP_MEMORY_SCOPE_AGENT

__device__ __forceinline__ unsigned cvt_pk_bf16(float lo, float hi) { unsigned r; asm volatile("v_cvt_pk_bf16_f32 %0, %1, %2" : "=v"(r) : "v"(lo), "v"(hi)); return r; }
__device__ __forceinline__ float bf_lo(unsigned w) { return __uint_as_float(w << 16); }
__device__ __forceinline__ float bf_hi(unsigned w) { return __uint_as_float(w & 0xffff0000u); }
__device__ __forceinline__ bf16_t* x1_row(unsigned char* ws, size_t m) { return (bf16_t*)(ws + (m < 32768 ? WS_X1A + m * 2048 : WS_X1B + (m - 32768) * 2048)); }
#define DPPF_(x, ctrl, rm) __int_as_float(__builtin_amdgcn_update_dpp(0, __float_as_int(x), ctrl, rm, 0xF, false))
__device__ __forceinline__ float wave_sum(float v) {
    v += DPPF_(v, 0xB1, 0xF); v += DPPF_(v, 0x4E, 0xF); v += DPPF_(v, 0x141, 0xF); v += DPPF_(v, 0x140, 0xF);
    v += DPPF_(v, 0x142, 0xA); v += DPPF_(v, 0x143, 0xC);
    return __int_as_float(__builtin_amdgcn_readlane(__float_as_int(v), 63));
}
__device__ __forceinline__ float reduce8_heads(const float (&f)[8], int lane) {
    float a[4], b[2];
#pragma unroll
    for (int i = 0; i < 4; ++i) { auto rr = __builtin_amdgcn_permlane32_swap(__float_as_uint(f[i]), __float_as_uint(f[i + 4]), false, false); a[i] = __uint_as_float(rr[0]) + __uint_as_float(rr[1]); }
#pragma unroll
    for (int i = 0; i < 2; ++i) { auto rr = __builtin_amdgcn_permlane16_swap(__float_as_uint(a[i]), __float_as_uint(a[i + 2]), false, false); b[i] = __uint_as_float(rr[0]) + __uint_as_float(rr[1]); }
    const bool b3 = (lane & 8) != 0; const float mine = b3 ? b[1] : b[0], give = b3 ? b[0] : b[1];
    float v = mine + DPPF_(give, 0x128, 0xF);
    v += DPPF_(v, 0xB1, 0xF); v += DPPF_(v, 0x4E, 0xF); v += DPPF_(v, 0x141, 0xF);
    return v;
}

__device__ const unsigned char T5B[3][132] = {
 {0,1,2,3,4,5,6,7,8,9,10,11,12,13,14,15,16,16,16,16,16,16,17,17,17,17,17,17,17,17,18,18,18,18,18,18,18,18,18,18,19,19,19,19,19,19,19,19,19,19,19,19,19,19,20,20,20,20,20,20,20,20,20,20,20,20,20,20,20,20,20,20,20,21,21,21,21,21,21,21,21,21,21,21,21,21,21,21,21,21,21,21,21,21,21,21,21,21,21,22,22,22,22,22,22,22,22,22,22,22,22,22,22,22,22,22,22,22,22,22,22,22,22,22,22,22,22,22,22,0,0,0},
 {0,4,8,12,16,16,17,17,18,18,19,19,19,19,20,20,20,20,20,21,21,21,21,21,21,22,22,22,22,22,22,22,22,22,23,23,23,23,23,23,23,23,23,23,23,23,24,24,24,24,24,24,24,24,24,24,24,24,24,24,24,24,25,25,25,25,25,25,25,25,25,25,25,25,25,25,25,25,25,25,25,25,25,26,26,26,26,26,26,26,26,26,26,26,26,26,26,26,26,26,26,26,26,26,26,26,26,26,26,26,26,26,26,27,27,27,27,27,27,27,27,27,27,27,27,27,27,27,27,0,0,0},
 {0,16,18,19,20,21,21,22,22,23,23,23,24,24,24,24,25,25,25,25,25,26,26,26,26,26,26,26,26,27,27,27,27,27,27,27,27,27,27,28,28,28,28,28,28,28,28,28,28,28,28,28,29,29,29,29,29,29,29,29,29,29,29,29,29,29,29,29,29,29,30,30,30,30,30,30,30,30,30,30,30,30,30,30,30,30,30,30,30,30,30,30,30,30,30,31,31,31,31,31,31,31,31,31,31,31,31,31,31,31,31,31,31,31,31,31,31,31,31,31,31,31,31,31,31,31,31,31,31,0,0,0}};

namespace pg8 {
constexpr int BM = 256, BK = 64, HALF = 128, HTB = HALF * BK * 2, STAGE_BYTES = 8 * HTB, NXCD = 8, WGM = 8;
__host__ __device__ __forceinline__ int lds_byte(int r, int c) { const int st = (r >> 4) * 2 + (c >> 5), rr = r & 15, cc = c & 31, ob = rr * 64 + cc * 2; return st * 1024 + (ob ^ (((ob >> 9) & 1) << 5)); }
__host__ __device__ __forceinline__ void stage_rc(int b, int& R, int& C) { const int st = b / 1024, sb = b % 1024, swz = sb ^ (((sb >> 9) & 1) << 5); R = (st >> 1) * 16 + swz / 64; C = (st & 1) * 32 + (swz % 64) / 2; }
__host__ __device__ __forceinline__ int perm32(int rho) { const int n = rho >> 4, i = rho & 15; return 8 * (i >> 2) + 4 * n + (i & 3); }

struct Unit { int pm, pn, pb, e, tile, cnt, yrow; };
struct Gemm { const bf16_t* A; const bf16_t* Bt; int K; const unsigned* list; };

struct StaticOrder {
    int nM, nN, nwg, G, c;
    __device__ void init(int Mr, int N, int G_, int c_) { nM = Mr / BM; nN = N / BM; nwg = nM * nN; G = G_; c = c_; }
    __device__ bool next(int i, Unit& u) const {
        const int L = i * G + c; if (L >= nwg) return false;
        int wgid = L; { const int q = nwg / NXCD, r = nwg % NXCD, xcd = wgid % NXCD, off = wgid / NXCD; wgid = (xcd < r ? xcd * (q + 1) : r * (q + 1) + (xcd - r) * q) + off; }
        const int nig = WGM * nN, gid = wgid / nig, fm = gid * WGM, gsz = (nM - fm) < WGM ? (nM - fm) : WGM;
        u.pm = fm + ((wgid % nig) % gsz); u.pn = (wgid % nig) / gsz; u.pb = u.pn; u.e = 0; u.tile = 0; u.cnt = 1 << 30; u.yrow = u.pm * BM; return true;
    }
};
struct GroupedOrder {
    const LAS unsigned* tp; const LAS unsigned* cn; int NT, G, c, NTB, pn0, total;
    const LAS unsigned short* mt2e;
    __device__ bool next(int i, Unit& u) const {
        const int L = i * G + c; if (L >= total) return false;
        const int mt = L / NT; u.pn = L % NT;
        const int lo = __builtin_amdgcn_readfirstlane((int)mt2e[mt]);
        u.e = lo; u.pm = mt; u.tile = mt - __builtin_amdgcn_readfirstlane((int)tp[lo]); u.pb = lo * NTB + pn0 + u.pn; u.cnt = __builtin_amdgcn_readfirstlane((int)cn[lo]); u.yrow = __builtin_amdgcn_readfirstlane((int)cn[256 + lo]) + u.tile * BM; return true;
    }
};

struct EpiQKV {
    static constexpr bool PERM = true; static constexpr int NVM = 16;
    bf16_t* O; size_t split_stride; float scale0;
    __device__ __forceinline__ void operator()(const f32x4 (&acc)[2][2][4][2], const Unit& u, int wr, int wc, int fr, int fq) const {
        const int row0 = u.pm * BM + wr * 64 + fr; int colt = u.pn * BM; const int t = colt / 512; bf16_t* base = O + (size_t)t * split_stride; colt -= t * 512;
        const float sc = (t == 0 || t == 3) ? scale0 : 1.f;
        const int col0 = colt + wc * 32 + 8 * fq;
#pragma unroll
        for (int ai = 0; ai < 2; ++ai)
#pragma unroll
            for (int m = 0; m < 4; ++m) { bf16_t* rowp = base + (size_t)(row0 + ai * HALF + m * 16) * 512 + col0;
#pragma unroll
                for (int bj = 0; bj < 2; ++bj) { const f32x4 v0 = acc[ai][bj][m][0] * sc, v1 = acc[ai][bj][m][1] * sc;
                    u32x4 w; w.x = cvt_pk_bf16(v0[0], v0[1]); w.y = cvt_pk_bf16(v0[2], v0[3]); w.z = cvt_pk_bf16(v1[0], v1[1]); w.w = cvt_pk_bf16(v1[2], v1[3]);
                    *(u32x4*)(rowp + bj * HALF) = w; } }
    }
};
struct EpiSwiglu {
    static constexpr bool PERM = true; static constexpr int NVM = 8;
    bf16_t* O;
    __device__ __forceinline__ void operator()(const f32x4 (&acc)[2][2][4][2], const Unit& u, int wr, int wc, int fr, int fq) const {
        const int row0 = u.pm * BM + wr * 64 + fr; const int col0 = u.pn * HALF + wc * 32 + 8 * fq;
#pragma unroll
        for (int ai = 0; ai < 2; ++ai)
#pragma unroll
            for (int m = 0; m < 4; ++m) { bf16_t* rowp = O + (size_t)(row0 + ai * HALF + m * 16) * EH + col0; float r[8];
#pragma unroll
                for (int n = 0; n < 2; ++n)
#pragma unroll
                    for (int i = 0; i < 4; ++i) { const float g = acc[ai][0][m][n][i], up = acc[ai][1][m][n][i]; r[n * 4 + i] = g * __builtin_amdgcn_rcpf(1.f + __expf(-g)) * up; }
                u32x4 w; w.x = cvt_pk_bf16(r[0], r[1]); w.y = cvt_pk_bf16(r[2], r[3]); w.z = cvt_pk_bf16(r[4], r[5]); w.w = cvt_pk_bf16(r[6], r[7]);
                *(u32x4*)rowp = w; }
    }
};
struct EpiSwiglu8 {
    static constexpr bool PERM = true; static constexpr int NVM = 4;
    unsigned char* O;
    __device__ __forceinline__ void operator()(const f32x4 (&acc)[2][2][4][2], const Unit& u, int wr, int wc, int fr, int fq) const {
        const size_t row0 = (size_t)u.pm * BM + wr * 64 + fr + (fq & 1) * HALF; const int col0 = u.pn * HALF + wc * 32 + 8 * (fq & 2);
#pragma unroll
        for (int m = 0; m < 4; ++m) { unsigned w[2][2];
#pragma unroll
            for (int ai = 0; ai < 2; ++ai) { float r[8];
#pragma unroll
                for (int n = 0; n < 2; ++n)
#pragma unroll
                    for (int i = 0; i < 4; ++i) { const float g = acc[ai][0][m][n][i], up = acc[ai][1][m][n][i]; r[n * 4 + i] = g * __builtin_amdgcn_rcpf(1.f + __expf(-g)) * up; }
                int w0 = __builtin_amdgcn_cvt_pk_fp8_f32(r[0], r[1], 0, false); w0 = __builtin_amdgcn_cvt_pk_fp8_f32(r[2], r[3], w0, true);
                int w1 = __builtin_amdgcn_cvt_pk_fp8_f32(r[4], r[5], 0, false); w1 = __builtin_amdgcn_cvt_pk_fp8_f32(r[6], r[7], w1, true);
                w[ai][0] = (unsigned)w0; w[ai][1] = (unsigned)w1; }
            const auto s0 = __builtin_amdgcn_permlane16_swap(w[0][0], w[1][0], false, false); const auto s1 = __builtin_amdgcn_permlane16_swap(w[0][1], w[1][1], false, false);
            u32x4 o; o.x = s0[0]; o.y = s1[0]; o.z = s0[1]; o.w = s1[1];
            *(u32x4*)(O + (row0 + m * 16) * EH + col0) = o; }
    }
};
struct EpiRes {
    static constexpr bool PERM = true; static constexpr int NVM = 0;
    const float* base; float* out; const float* gate;
    __device__ __forceinline__ void operator()(const f32x4 (&acc)[2][2][4][2], const Unit& u, int wr, int wc, int fr, int fq) const {
        const int b = u.pm >> 4; const int col0 = u.pn * BM + wc * 32 + 8 * fq; f32x4 gv[2][2];
#pragma unroll
        for (int bj = 0; bj < 2; ++bj)
#pragma unroll
            for (int n = 0; n < 2; ++n) gv[bj][n] = *(const f32x4*)(gate + (size_t)b * NMOD + col0 + bj * HALF + n * 4);
#pragma unroll
        for (int ai = 0; ai < 2; ++ai)
#pragma unroll
            for (int m = 0; m < 4; ++m) { const size_t off = (size_t)(u.pm * BM + ai * HALF + wr * 64 + m * 16 + fr) * DM + col0;
#pragma unroll
                for (int bj = 0; bj < 2; ++bj)
#pragma unroll
                    for (int n = 0; n < 2; ++n) { const f32x4 bs = *(const f32x4*)(base + off + bj * HALF + n * 4); *(f32x4*)(out + off + bj * HALF + n * 4) = bs + gv[bj][n] * acc[ai][bj][m][n]; } }
    }
};
struct EpiX1 {
    static constexpr bool PERM = true; static constexpr int NVM = 8;
    const float* base; unsigned char* ws; const float* gate;
    __device__ __forceinline__ void operator()(const f32x4 (&acc)[2][2][4][2], const Unit& u, int wr, int wc, int fr, int fq) const {
        const int b = u.pm >> 4; const int col0 = u.pn * BM + wc * 32 + 8 * fq; f32x4 gv[2][2];
#pragma unroll
        for (int bj = 0; bj < 2; ++bj)
#pragma unroll
            for (int n = 0; n < 2; ++n) gv[bj][n] = *(const f32x4*)(gate + (size_t)b * NMOD + col0 + bj * HALF + n * 4);
#pragma unroll
        for (int ai = 0; ai < 2; ++ai) { f32x4 pre[4][2][2];
#pragma unroll
            for (int m = 0; m < 4; ++m) { const size_t off = ((size_t)u.pm * BM + ai * HALF + wr * 64 + m * 16 + fr) * DM + col0;
#pragma unroll
                for (int bj = 0; bj < 2; ++bj) { pre[m][bj][0] = *(const f32x4*)(base + off + bj * HALF); pre[m][bj][1] = *(const f32x4*)(base + off + bj * HALF + 4); } }
            asm volatile("" ::: "memory");
#pragma unroll
            for (int m = 0; m < 4; ++m) { const size_t row = (size_t)u.pm * BM + ai * HALF + wr * 64 + m * 16 + fr; bf16_t* orow = x1_row(ws, row) + col0;
#pragma unroll
                for (int bj = 0; bj < 2; ++bj) { const f32x4 v0 = pre[m][bj][0] + gv[bj][0] * acc[ai][bj][m][0], v1 = pre[m][bj][1] + gv[bj][1] * acc[ai][bj][m][1];
                    u32x4 w; w.x = cvt_pk_bf16(v0[0], v0[1]); w.y = cvt_pk_bf16(v0[2], v0[3]); w.z = cvt_pk_bf16(v1[0], v1[1]); w.w = cvt_pk_bf16(v1[2], v1[3]);
                    *(u32x4*)(orow + bj * HALF) = w; } }
            asm volatile("" ::: "memory"); }
    }
};
struct EpiX1N {
    static constexpr bool PERM = true; static constexpr int NVM = 0;
    const float* base; unsigned char* ws; const float* mod; LAS unsigned char* lds; float* ex; unsigned* cnt;
    __device__ __forceinline__ void operator()(f32x4 (&acc)[2][2][4][2], const Unit& u, int wr, int wc, int fr, int fq) const {
        const int b = u.pm >> 4; const int col0 = u.pn * BM + wc * 32 + 8 * fq; const float* mb = mod + (size_t)b * NMOD;
        LAS float* red = (LAS float*)(lds + RING_BYTES); LAS float* rr = red + 4 * BM;
        float ss[2][4];
        { f32x4 gv[2][2];
#pragma unroll
          for (int bj = 0; bj < 2; ++bj)
#pragma unroll
            for (int n = 0; n < 2; ++n) gv[bj][n] = *(const f32x4*)(mb + 2 * DM + col0 + bj * HALF + n * 4);
#pragma unroll
          for (int am = 0; am < 4; ++am) { const int ai = am >> 1, m0 = (am & 1) * 2; f32x4 pre[2][2][2];
#pragma unroll
            for (int mm = 0; mm < 2; ++mm) { const size_t off = ((size_t)u.pm * BM + ai * HALF + wr * 64 + (m0 + mm) * 16 + fr) * DM + col0;
#pragma unroll
                for (int bj = 0; bj < 2; ++bj) { pre[mm][bj][0] = *(const f32x4*)(base + off + bj * HALF); pre[mm][bj][1] = *(const f32x4*)(base + off + bj * HALF + 4); } }
            asm volatile("" ::: "memory");
#pragma unroll
            for (int mm = 0; mm < 2; ++mm) { const int m = m0 + mm; const size_t row = (size_t)u.pm * BM + ai * HALF + wr * 64 + m * 16 + fr; bf16_t* orow = x1_row(ws, row) + col0; float s2 = 0.f;
#pragma unroll
                for (int bj = 0; bj < 2; ++bj) { const f32x4 v0 = pre[mm][bj][0] + gv[bj][0] * acc[ai][bj][m][0], v1 = pre[mm][bj][1] + gv[bj][1] * acc[ai][bj][m][1];
                    acc[ai][bj][m][0] = v0; acc[ai][bj][m][1] = v1;
                    s2 += ((v0[0] * v0[0] + v0[1] * v0[1]) + (v0[2] * v0[2] + v0[3] * v0[3])) + ((v1[0] * v1[0] + v1[1] * v1[1]) + (v1[2] * v1[2] + v1[3] * v1[3]));
                    u32x4 w; w.x = cvt_pk_bf16(v0[0], v0[1]); w.y = cvt_pk_bf16(v0[2], v0[3]); w.z = cvt_pk_bf16(v1[0], v1[1]); w.w = cvt_pk_bf16(v1[2], v1[3]);
                    *(u32x4*)(orow + bj * HALF) = w; }
                s2 += __shfl_xor(s2, 16); s2 += __shfl_xor(s2, 32); ss[ai][m] = s2; }
            asm volatile("" ::: "memory"); } }
        if (fq == 0) {
#pragma unroll
            for (int ai = 0; ai < 2; ++ai)
#pragma unroll
                for (int m = 0; m < 4; ++m) red[wc * BM + ai * HALF + wr * 64 + m * 16 + fr] = ss[ai][m]; }
        __syncthreads();
        const int tid = threadIdx.x; unsigned* slot = (unsigned*)ex + ((size_t)u.pm * 4) * BM;
        if (tid < BM) { const float tot = (red[tid] + red[BM + tid]) + (red[2 * BM + tid] + red[3 * BM + tid]);
            __hip_atomic_store(slot + u.pn * BM + tid, __float_as_uint(tot), __ATOMIC_RELAXED, __HIP_MEMORY_SCOPE_AGENT); }
        asm volatile("s_waitcnt vmcnt(0)" ::: "memory");
        __syncthreads();
        if (tid == 0) { (void)__hip_atomic_fetch_add(cnt + u.pm, 1u, __ATOMIC_RELAXED, __HIP_MEMORY_SCOPE_AGENT); unsigned sp = 0;
            while (__hip_atomic_load(cnt + u.pm, __ATOMIC_RELAXED, __HIP_MEMORY_SCOPE_AGENT) < 4u) { __builtin_amdgcn_s_sleep(1); if (++sp > (1u << 22)) break; } }
        __syncthreads();
        if (tid < BM) { float t4 = 0.f;
#pragma unroll
            for (int q = 0; q < 4; ++q) t4 += __uint_as_float(__hip_atomic_load(slot + q * BM + tid, __ATOMIC_RELAXED, __HIP_MEMORY_SCOPE_AGENT));
            rr[tid] = 1.f / sqrtf(t4 * (1.f / DM) + EPS); }
        __syncthreads();
        f32x4 sc[2][2], sh[2][2];
#pragma unroll
        for (int bj = 0; bj < 2; ++bj)
#pragma unroll
            for (int n = 0; n < 2; ++n) { sc[bj][n] = *(const f32x4*)(mb + 4 * DM + col0 + bj * HALF + n * 4) + 1.f; sh[bj][n] = *(const f32x4*)(mb + 3 * DM + col0 + bj * HALF + n * 4); }
        bf16_t* H2 = (bf16_t*)(ws + WS_H); unsigned char* H8 = ws + WS_H8;
        const int col8 = u.pn * BM + (fq & 1) * HALF + wc * 32 + 8 * (fq & 2);
#pragma unroll
        for (int ai = 0; ai < 2; ++ai)
#pragma unroll
            for (int m = 0; m < 4; ++m) { const int rl = ai * HALF + wr * 64 + m * 16 + fr; const size_t row = (size_t)u.pm * BM + rl; const float r = rr[rl]; unsigned w8[2][2];
#pragma unroll
                for (int bj = 0; bj < 2; ++bj) { const f32x4 h0 = acc[ai][bj][m][0] * r * sc[bj][0] + sh[bj][0], h1 = acc[ai][bj][m][1] * r * sc[bj][1] + sh[bj][1];
                    u32x4 w; w.x = cvt_pk_bf16(h0[0], h0[1]); w.y = cvt_pk_bf16(h0[2], h0[3]); w.z = cvt_pk_bf16(h1[0], h1[1]); w.w = cvt_pk_bf16(h1[2], h1[3]);
                    *(u32x4*)(H2 + row * DM + col0 + bj * HALF) = w;
                    int q0 = __builtin_amdgcn_cvt_pk_fp8_f32(h0[0], h0[1], 0, false); q0 = __builtin_amdgcn_cvt_pk_fp8_f32(h0[2], h0[3], q0, true);
                    int q1 = __builtin_amdgcn_cvt_pk_fp8_f32(h1[0], h1[1], 0, false); q1 = __builtin_amdgcn_cvt_pk_fp8_f32(h1[2], h1[3], q1, true);
                    w8[bj][0] = (unsigned)q0; w8[bj][1] = (unsigned)q1; }
                const auto s0 = __builtin_amdgcn_permlane16_swap(w8[0][0], w8[1][0], false, false); const auto s1 = __builtin_amdgcn_permlane16_swap(w8[0][1], w8[1][1], false, false);
                u32x4 o; o.x = s0[0]; o.y = s1[0]; o.z = s0[1]; o.w = s1[1];
                *(u32x4*)(H8 + row * DM + col8) = o; }
    }
};
struct EpiF32 {
    static constexpr bool PERM = false; static constexpr int NVM = 16;
    float* out; int ldc;
    __device__ __forceinline__ void operator()(const f32x4 (&acc)[2][2][4][2], const Unit& u, int wr, int wc, int fr, int fq) const {
        const int col0 = u.pn * BM + wc * 32 + 4 * fq;
#pragma unroll
        for (int ai = 0; ai < 2; ++ai)
#pragma unroll
            for (int m = 0; m < 4; ++m) { const size_t off = (size_t)(u.pm * BM + ai * HALF + wr * 64 + m * 16 + fr) * ldc + col0;
#pragma unroll
                for (int bj = 0; bj < 2; ++bj)
#pragma unroll
                    for (int n = 0; n < 2; ++n) *(f32x4*)(out + off + bj * HALF + n * 16) = acc[ai][bj][m][n]; }
    }
};
struct EpiYbuf {
    static constexpr bool PERM = true; static constexpr int NVM = 8;
    unsigned char* Y; unsigned char* dump;
    __device__ __forceinline__ void operator()(const f32x4 (&acc)[2][2][4][2], const Unit& u, int wr, int wc, int fr, int fq) const {
        const int colb = u.pn * BM + wc * 64 + (fq & 1) * 32 + 8 * (fq & 2);
#pragma unroll
        for (int ai = 0; ai < 2; ++ai)
#pragma unroll
            for (int m = 0; m < 4; ++m) { const int rl = ai * HALF + wr * 64 + m * 16 + fr; const size_t row = (size_t)u.yrow + rl; const bool live = u.tile * BM + rl < u.cnt;
                unsigned w[2][2];
#pragma unroll
                for (int bj = 0; bj < 2; ++bj) { f32x4 v0 = acc[ai][bj][m][0] * YSCALE, v1 = acc[ai][bj][m][1] * YSCALE;
#pragma unroll
                    for (int i = 0; i < 4; ++i) { v0[i] = __builtin_amdgcn_fmed3f(v0[i], -440.f, 440.f); v1[i] = __builtin_amdgcn_fmed3f(v1[i], -440.f, 440.f); }
                    int w0 = __builtin_amdgcn_cvt_pk_fp8_f32(v0[0], v0[1], 0, false); w0 = __builtin_amdgcn_cvt_pk_fp8_f32(v0[2], v0[3], w0, true);
                    int w1 = __builtin_amdgcn_cvt_pk_fp8_f32(v1[0], v1[1], 0, false); w1 = __builtin_amdgcn_cvt_pk_fp8_f32(v1[2], v1[3], w1, true);
                    w[bj][0] = (unsigned)w0; w[bj][1] = (unsigned)w1; }
                const auto s0 = __builtin_amdgcn_permlane16_swap(w[0][0], w[1][0], false, false); const auto s1 = __builtin_amdgcn_permlane16_swap(w[0][1], w[1][1], false, false);
                u32x4 o; o.x = s0[0]; o.y = s1[0]; o.z = s0[1]; o.w = s1[1];
                *(u32x4*)(live ? Y + row * DM + colb : dump + (size_t)rl * DM + colb) = o; }
    }
};

template <class Epi, class Sched, bool GATHER, bool FP8 = false, bool SHORTK = false, int VAR = 0, bool HOIST = false>
__device__ __forceinline__ void gemm_phase(LAS unsigned char* lds, const Gemm g, const Sched& S, const Epi& E) {
    int tid_ = threadIdx.x; asm volatile("" : "+v"(tid_));
    const int tid = tid_, wid = __builtin_amdgcn_readfirstlane(tid >> 6), lane = tid & 63, wr = wid >> 2, wc = wid & 3, fr = lane & 15, fq = lane >> 4;
    int K_ = g.K; if constexpr (SHORTK) asm volatile("" : "+s"(K_));
    const int K = K_, nt = K / BK;
    unsigned voffA[2], voffB[2];
#pragma unroll
    for (int i = 0; i < 2; ++i) { int R, C; stage_rc(tid * 16 + i * 8192, R, C); const int Rb = Epi::PERM ? ((R & ~31) + perm32(R & 31)) : R;
        voffA[i] = (unsigned)(R * K + C) * 2u; voffB[i] = (unsigned)(Rb * K + C) * 2u; }
    const size_t kstep = (size_t)(BK * 2);
    const size_t hstep = (size_t)HALF * K * 2;
    const size_t tstep = 2 * hstep;
    const unsigned ldsw = (unsigned)wid * 1024u;
    const int aoff = lds_byte(wr * 64 + fr, fq * 8), boff = lds_byte(wc * 32 + fr, fq * 8);
#define PG8_SA(b, h) (((b) * 2 + (h)) * HTB)
#define PG8_SB(b, h) ((4 + (b) * 2 + (h)) * HTB)
#define PG8_GLDS(src, bufoff, i) if constexpr (!(VAR & 1)) __builtin_amdgcn_global_load_lds((const unsigned*)(src), (LAS unsigned*)(lds + (bufoff) + ldsw + (i) * 8192), 16, 0, 0)
#define PG8_STAGE(bufoff, gbase, voff) do { _Pragma("unroll") for (int _i = 0; _i < 2; ++_i) PG8_GLDS((const char*)(gbase) + (voff)[_i], bufoff, _i); } while (0)
#define PG8_STA(bufoff, aptr, h, SEL) do { if constexpr (GATHER) { const unsigned _p = (SEL) ? gvn[h] : gvc[h]; _Pragma("unroll") for (int _i = 0; _i < 2; ++_i) { unsigned _c = voffB[_i]; asm volatile("" : "+v"(_c)); \
            const unsigned _o = ((_i ? (_p >> 16) : (_p & 0xffffu)) * (unsigned)(K * 2)) + (_c & (unsigned)(K * 2 - 1)); PG8_GLDS((const char*)(aptr) + _o, bufoff, _i); } } \
        else { PG8_STAGE(bufoff, (const char*)(aptr) + (h) * hstep, voffA); } } while (0)
#define PG8_LDA(dst, b, h) do { _Pragma("unroll") for (int m = 0; m < 4; ++m) _Pragma("unroll") for (int k = 0; k < 2; ++k) dst[m][k] = *(const LAS bf16x8*)(lds + PG8_SA(b, h) + aoff + m * 2048 + k * 1024); } while (0)
#define PG8_LDB(dst, b, h) do { _Pragma("unroll") for (int n = 0; n < 2; ++n) _Pragma("unroll") for (int k = 0; k < 2; ++k) dst[n][k] = *(const LAS bf16x8*)(lds + PG8_SB(b, h) + boff + n * 2048 + k * 1024); } while (0)
#define PG8_CAT8(lo, hi) ({ const v4i_t a_ = __builtin_bit_cast(v4i_t, lo), b_ = __builtin_bit_cast(v4i_t, hi); (v8i_t){a_.x, a_.y, a_.z, a_.w, b_.x, b_.y, b_.z, b_.w}; })
#define PG8_MMA(ai, bj, At, Bt) do { __builtin_amdgcn_s_setprio(1); if constexpr (VAR & 2) { asm volatile("" :: "v"(At[0][0]), "v"(At[3][1]), "v"(Bt[0][0]), "v"(Bt[1][1])); } else if constexpr (FP8) { _Pragma("unroll") for (int m = 0; m < 4; ++m) _Pragma("unroll") for (int n = 0; n < 2; ++n) \
        acc[ai][bj][m][n] = __builtin_amdgcn_mfma_scale_f32_16x16x128_f8f6f4(PG8_CAT8(Bt[n][0], Bt[n][1]), PG8_CAT8(At[m][0], At[m][1]), acc[ai][bj][m][n], 0, 0, 0, 0x7F7F7F7F, 0, 0x7F7F7F7F); } \
      else { _Pragma("unroll") for (int m = 0; m < 4; ++m) _Pragma("unroll") for (int n = 0; n < 2; ++n) _Pragma("unroll") for (int k = 0; k < 2; ++k) \
        acc[ai][bj][m][n] = __builtin_amdgcn_mfma_f32_16x16x32_bf16(Bt[n][k], At[m][k], acc[ai][bj][m][n], 0, 0, 0); } \
      if constexpr (SHORTK) { _Pragma("unroll") for (int m = 0; m < 4; ++m) _Pragma("unroll") for (int n = 0; n < 2; ++n) asm volatile("" : "+v"(acc[ai][bj][m][n])); }     \
      __builtin_amdgcn_s_setprio(0); } while (0)
#define PG8_WAIT_V(n) asm volatile("s_waitcnt vmcnt(" #n ")" ::: "memory")
#define PG8_WAIT_VF() do { if (fst) asm volatile("s_waitcnt vmcnt(%0)" :: "n"(8 + NQ) : "memory"); else asm volatile("s_waitcnt vmcnt(8)" ::: "memory"); } while (0)
#define PG8_WAIT_L(n) asm volatile("s_waitcnt lgkmcnt(" #n ")" ::: "memory")
#define PG8_BAR __builtin_amdgcn_s_barrier()
#define PG8_SCHED __builtin_amdgcn_sched_barrier(0)
#define PG8_ROWS_LOAD(u, ld) do { _Pragma("unroll") for (int _h = 0; _h < 2; ++_h) _Pragma("unroll") for (int _i = 0; _i < 2; ++_i) { int _R, _C; stage_rc(tid * 16 + _i * 8192, _R, _C); const int _idx = (u).tile * BM + _h * HALF + _R; \
            const int _ic = _idx < (u).cnt ? _idx : (u).cnt - 1; ld[_h][_i] = g.list[(size_t)(u).e * LCAP + _ic]; } } while (0)
#define PG8_ROWS_USE(u, ld, gv) do { asm volatile("" : "+v"(ld[0][0]), "+v"(ld[0][1]), "+v"(ld[1][0]), "+v"(ld[1][1])); \
        _Pragma("unroll") for (int _h = 0; _h < 2; ++_h) { unsigned _t2[2]; _Pragma("unroll") for (int _i = 0; _i < 2; ++_i) { int _R, _C; stage_rc(tid * 16 + _i * 8192, _R, _C); const int _idx = (u).tile * BM + _h * HALF + _R; \
            _t2[_i] = (_idx < (u).cnt) ? (ld[_h][_i] & 0xffffu) : 0u; } gv[_h] = _t2[0] | (_t2[1] << 16); } } while (0)
    constexpr int NQ = Epi::NVM + (GATHER ? 1 : 0);
#define PG8_ROWS_DMA(u) __builtin_amdgcn_global_load_lds((const unsigned*)(g.list + (size_t)(u).e * LCAP + (u).tile * BM + (wid & 3) * 64 + lane), (LAS unsigned*)(lds + RLIST_OFF + (wid & 3) * 256), 4, 0, 0)
#define PG8_ROWS_USE_LDS(u, gv) do { _Pragma("unroll") for (int _h = 0; _h < 2; ++_h) { unsigned _t2[2]; _Pragma("unroll") for (int _i = 0; _i < 2; ++_i) { int _R, _C; stage_rc(tid * 16 + _i * 8192, _R, _C); const int _idx = (u).tile * BM + _h * HALF + _R; \
            const unsigned _v = *(const LAS unsigned*)(lds + RLIST_OFF + (_h * HALF + _R) * 4); _t2[_i] = (_idx < (u).cnt) ? (_v & 0xffffu) : 0u; } gv[_h] = _t2[0] | (_t2[1] << 16); } } while (0)
    Unit cur, nxt; int ui = 0;
    if (!S.next(0, cur)) return;
    f32x4 acc[2][2][4][2];
#pragma unroll
    for (int a = 0; a < 2; ++a)
#pragma unroll
        for (int b = 0; b < 2; ++b)
#pragma unroll
            for (int m = 0; m < 4; ++m)
#pragma unroll
                for (int n = 0; n < 2; ++n) acc[a][b][m][n] = (f32x4){0.f, 0.f, 0.f, 0.f};
    bf16x8 At[4][2], B0[2][2], B1[2][2];
    unsigned gvc[2] = {0u, 0u}, gvn[2] = {0u, 0u};
    if constexpr (GATHER) { unsigned rld[2][2]; PG8_ROWS_LOAD(cur, rld); PG8_ROWS_USE(cur, rld, gvc); }
    const char* cA = GATHER ? (const char*)g.A : (const char*)g.A + (size_t)cur.pm * tstep; const char* cB = (const char*)g.Bt + (size_t)cur.pb * tstep;
    PG8_STAGE(PG8_SB(0, 0), cB, voffB); PG8_STAGE(PG8_SB(0, 1), cB + hstep, voffB); PG8_STA(PG8_SA(0, 0), cA, 0, false); PG8_STA(PG8_SA(0, 1), cA, 1, false);
    if (wr == 1) PG8_BAR;
    PG8_WAIT_V(2); PG8_BAR;
    PG8_STAGE(PG8_SB(1, 0), cB + kstep, voffB); PG8_STA(PG8_SA(1, 0), cA + kstep, 0, false); PG8_STAGE(PG8_SB(1, 1), cB + hstep + kstep, voffB);
    PG8_WAIT_V(6); PG8_BAR;
    for (;;) {
        const bool has_next = S.next(ui + 1, nxt);
        const char* nA = has_next ? (GATHER ? (const char*)g.A : (const char*)g.A + (size_t)nxt.pm * tstep) : cA; const char* nB = has_next ? (const char*)g.Bt + (size_t)nxt.pb * tstep : cB;
        if constexpr (GATHER) { if (!has_next) { nxt = cur; gvn[0] = gvc[0]; gvn[1] = gvc[1]; } PG8_ROWS_DMA(nxt); }
        int t = 0;
        do {
            const bool last = (t == nt - 2);
            const bool fst = HOIST && (t == 0) && (ui > 0);
            if constexpr (GATHER) { if (last && has_next) { PG8_ROWS_USE_LDS(nxt, gvn); } }
            const char* a1 = cA + (size_t)(t + 1) * kstep;
            const char* a2 = last ? nA : cA + (size_t)(t + 2) * kstep; const char* b2 = last ? nB : cB + (size_t)(t + 2) * kstep;
            const char* a3 = a2 + kstep; const char* b3 = b2 + kstep;
            PG8_LDB(B0, 0, 0); PG8_LDB(B1, 0, 1); PG8_SCHED; PG8_LDA(At, 0, 0); if (!fst) PG8_STA(PG8_SA(1, 1), a1, 1, false);
            PG8_WAIT_VF(); PG8_WAIT_L(0); PG8_BAR; PG8_MMA(0, 0, At, B0); PG8_MMA(0, 1, At, B1); PG8_BAR; PG8_SCHED;
            PG8_LDA(At, 0, 1); PG8_STAGE(PG8_SB(0, 0), b2, voffB); PG8_STAGE(PG8_SB(0, 1), b2 + hstep, voffB); PG8_STA(PG8_SA(0, 0), a2, 0, last);
            PG8_WAIT_VF(); PG8_WAIT_L(0); PG8_BAR; PG8_MMA(1, 0, At, B0); PG8_MMA(1, 1, At, B1); PG8_BAR; PG8_SCHED;
            PG8_LDB(B0, 1, 0); PG8_LDB(B1, 1, 1); PG8_SCHED; PG8_LDA(At, 1, 0); PG8_STA(PG8_SA(0, 1), a2, 1, last);
            PG8_WAIT_VF(); PG8_WAIT_L(0); PG8_BAR; PG8_MMA(0, 0, At, B0); PG8_MMA(0, 1, At, B1); PG8_BAR; PG8_SCHED;
            PG8_LDA(At, 1, 1); PG8_STAGE(PG8_SB(1, 0), b3, voffB); PG8_STAGE(PG8_SB(1, 1), b3 + hstep, voffB); PG8_STA(PG8_SA(1, 0), a3, 0, last);
            PG8_WAIT_V(8); PG8_WAIT_L(0); PG8_BAR; PG8_MMA(1, 0, At, B0); PG8_MMA(1, 1, At, B1); PG8_BAR; PG8_SCHED;
            t += 2;
        } while (t < nt);
        if constexpr (HOIST) PG8_STA(PG8_SA(1, 1), nA + kstep, 1, true);
        if (wr == 0) PG8_BAR;
        { int te_ = threadIdx.x; asm volatile("" : "+v"(te_)); int fr_ = te_ & 15, fq_ = (te_ >> 4) & 3; asm volatile("" : "+v"(fr_), "+v"(fq_));
          if constexpr (!(VAR & 4)) E(acc, cur, wr, wc, fr_, fq_); else { _Pragma("unroll") for (int a = 0; a < 2; ++a) _Pragma("unroll") for (int b = 0; b < 2; ++b) _Pragma("unroll") for (int m = 0; m < 4; ++m) _Pragma("unroll") for (int n = 0; n < 2; ++n) asm volatile("" :: "v"(acc[a][b][m][n])); } }
        if (!has_next) break;
#pragma unroll
        for (int a = 0; a < 2; ++a)
#pragma unroll
            for (int b = 0; b < 2; ++b)
#pragma unroll
                for (int m = 0; m < 4; ++m)
#pragma unroll
                    for (int n = 0; n < 2; ++n) acc[a][b][m][n] = (f32x4){0.f, 0.f, 0.f, 0.f};
        cur = nxt; cA = nA; cB = nB; ++ui;
        if constexpr (GATHER) { gvc[0] = gvn[0]; gvc[1] = gvn[1]; }
        if (wr == 1) PG8_BAR;
    }
    PG8_WAIT_V(0);
    PG8_BAR;
#undef PG8_SA
#undef PG8_SB
#undef PG8_GLDS
#undef PG8_STAGE
#undef PG8_STA
#undef PG8_LDA
#undef PG8_LDB
#undef PG8_MMA
#undef PG8_CAT8
#undef PG8_WAIT_V
#undef PG8_WAIT_VF
#undef PG8_WAIT_L
#undef PG8_BAR
#undef PG8_SCHED
#undef PG8_ROWS_LOAD
#undef PG8_ROWS_USE
#undef PG8_ROWS_DMA
#undef PG8_ROWS_USE_LDS
}
}

namespace attn_body {
using bf16 = __hip_bfloat16;
using s16x4 = __attribute__((ext_vector_type(4))) short;
using f32x16 = __attribute__((ext_vector_type(16))) float;
constexpr int D = 64, NW = 8, QBLK = 32, QB = QBLK * NW, KVBLK = 64;
__device__ __forceinline__ int crow(int r, int hi) { return (r & 3) + 8 * (r >> 2) + 4 * hi; }
#define SBAR() __builtin_amdgcn_sched_barrier(0)
__device__ __forceinline__ void cmask(f32x16& p0, f32x16& p1, int jb, int qrel, int hi) {
  const float NEG = -INFINITY; int kb = 64 * jb + 4 * hi;
  #pragma unroll
  for (int r = 0; r < 16; ++r) { int kv = kb + (r & 3) + 8 * (r >> 2); if (kv > qrel) p0[r] = NEG; if (kv + 32 > qrel) p1[r] = NEG; }
}
constexpr int NSLOT = 3, SLOTB = 8192;
constexpr int LDS_K = 0, LDS_V = NSLOT * SLOTB, LDS_WS = 2 * NSLOT * SLOTB, LDS_OST = LDS_WS + NW * 64 * 4, LDS_BYTES = LDS_OST + NW * 4096;
constexpr int LDS_KBT = LDS_BYTES;
constexpr int LDS_TREV = LDS_KBT + 16384;
constexpr int LDS_TOTAL = LDS_TREV + 3072;
constexpr float C2 = 0.125f * 1.4426950408889634f;
__device__ __forceinline__ void glds16(const void* gsrc, unsigned lds_dst) { unsigned keep;
  asm volatile("s_mov_b32 %0, m0\n\ts_mov_b32 m0, %2\n\ts_nop 0\n\tglobal_load_lds_dwordx4 %1, off\n\ts_mov_b32 m0, %0" : "=&s"(keep) : "v"(gsrc), "s"(lds_dst) : "memory"); }
__device__ __forceinline__ float max3f(float a, float b, float c) { float r; asm("v_max3_f32 %0, %1, %2, %3" : "=v"(r) : "v"(a), "v"(b), "v"(c)); return r; }
__device__ __forceinline__ float max2f(float a, float b) { float r; asm("v_max_f32_e32 %0, %1, %2" : "=v"(r) : "v"(a), "v"(b)); return r; }
__device__ __forceinline__ float fadd_s(float a, float b) { float r; asm("v_add_f32_e32 %0, %1, %2" : "=v"(r) : "v"(a), "v"(b)); return r; }
__device__ __forceinline__ float fsub_s(float a, float b) { float r; asm("v_sub_f32_e32 %0, %1, %2" : "=v"(r) : "v"(a), "v"(b)); return r; }
typedef float f32x2_t __attribute__((ext_vector_type(2))); typedef __bf16 bf16x2_t __attribute__((ext_vector_type(2)));
__device__ __forceinline__ unsigned cvtpk_s(float lo, float hi) { f32x2_t v = {lo, hi}; bf16x2_t b = __builtin_convertvector(v, bf16x2_t); return __builtin_bit_cast(unsigned, b); }
#define WAIT_BAR(N) asm volatile("s_waitcnt vmcnt(" #N ") lgkmcnt(0)\n\ts_barrier" ::: "memory")

__device__ __forceinline__ void qkt(f32x16& p0, f32x16& p1, const char* Kslot, const bf16x8* qr, int r32, int hi) {
  const char* kb = Kslot + hi * 1024 + r32 * 16;
  #pragma unroll
  for (int d0 = 0; d0 < 4; ++d0) {
    const bf16x8 b0 = *reinterpret_cast<const bf16x8*>(kb + d0 * 2048);
    const bf16x8 b1 = *reinterpret_cast<const bf16x8*>(kb + d0 * 2048 + 512);
    p0 = __builtin_amdgcn_mfma_f32_32x32x16_bf16(b0, qr[d0], p0, 0, 0, 0); p1 = __builtin_amdgcn_mfma_f32_32x32x16_bf16(b1, qr[d0], p1, 0, 0, 0); }
}
typedef __attribute__((address_space(3))) const char* lds_cptr;
typedef short v4i16_t __attribute__((ext_vector_type(4)));
__device__ __forceinline__ void kload8(bf16x8* kf, lds_cptr kp) {
  kf[0] = *(const LAS bf16x8*)(kp);        kf[1] = *(const LAS bf16x8*)(kp + 512);
  kf[2] = *(const LAS bf16x8*)(kp + 2048); kf[3] = *(const LAS bf16x8*)(kp + 2560);
  kf[4] = *(const LAS bf16x8*)(kp + 4096); kf[5] = *(const LAS bf16x8*)(kp + 4608);
  kf[6] = *(const LAS bf16x8*)(kp + 6144); kf[7] = *(const LAS bf16x8*)(kp + 6656);
}
__device__ __forceinline__ void kload2(bf16x8* kf, lds_cptr kp, int j) { kf[2 * j] = *(const LAS bf16x8*)(kp + j * 2048); kf[2 * j + 1] = *(const LAS bf16x8*)(kp + j * 2048 + 512); }
__device__ __forceinline__ s16x4 vtr(lds_cptr p) { return __builtin_bit_cast(s16x4, __builtin_amdgcn_ds_read_tr16_b64_v4i16((LAS v4i16_t*)p)); }
__device__ __forceinline__ float rowmax(const f32x16& p0, const f32x16& p1) {
  float a = max3f(p0[0], p0[1], p1[0]), b = max3f(p0[2], p0[3], p1[1]); a = max3f(a, p1[2], p1[3]);
  #pragma unroll
  for (int r = 4; r < 16; r += 4) { a = max3f(a, p0[r], p0[r + 1]); b = max3f(b, p0[r + 2], p0[r + 3]); a = max3f(a, p1[r], p1[r + 1]); b = max3f(b, p1[r + 2], p1[r + 3]); }
  const float m = max2f(a, b);
  auto rr = __builtin_amdgcn_permlane32_swap(__float_as_uint(m), __float_as_uint(m), false, false);
  return max2f(__uint_as_float(rr[0]), __uint_as_float(rr[1]));
}
__device__ __forceinline__ void pv(f32x16* o, int vb, bf16x8 pa0, bf16x8 pa1, bf16x8 pa2, bf16x8 pa3) {
  #pragma unroll
  for (int d0 = 0; d0 < 2; ++d0) { s16x4 lo[4], hi[4];
    #pragma unroll
    for (int ks = 0; ks < 4; ++ks) {
      asm volatile("ds_read_b64_tr_b16 %0,%1 offset:%c2" : "=&v"(lo[ks]) : "v"(vb), "i"(d0 * 4096 + ks * 1024) : "memory");
      asm volatile("ds_read_b64_tr_b16 %0,%1 offset:%c2" : "=&v"(hi[ks]) : "v"(vb), "i"(d0 * 4096 + ks * 1024 + 512) : "memory"); }
    asm volatile("s_waitcnt lgkmcnt(0)" ::: "memory"); SBAR();
    #define PK(k) (bf16x8){lo[k][0], lo[k][1], lo[k][2], lo[k][3], hi[k][0], hi[k][1], hi[k][2], hi[k][3]}
    o[d0] = __builtin_amdgcn_mfma_f32_32x32x16_bf16(pa0, PK(0), o[d0], 0, 0, 0);
    o[d0] = __builtin_amdgcn_mfma_f32_32x32x16_bf16(pa1, PK(1), o[d0], 0, 0, 0);
    o[d0] = __builtin_amdgcn_mfma_f32_32x32x16_bf16(pa2, PK(2), o[d0], 0, 0, 0);
    o[d0] = __builtin_amdgcn_mfma_f32_32x32x16_bf16(pa3, PK(3), o[d0], 0, 0, 0);
    #undef PK
  }
}
#define ATTN_STORE16(p, v) (*(u32x4*)(p) = (v))
template <int THRL, int MODE> __device__ __forceinline__ void attn_unit(const bf16* Qp, const bf16* __restrict__ Kp, const bf16* __restrict__ Vp, bf16* Op, long RS, long ORS, int q0, int T0, int NT, int off,
                                                                        float* lsep, long lse_stride, char* shm, const float* kbsrc, const float* relb, int dsel) {
  int tid_ = threadIdx.x; asm volatile("" : "+v"(tid_));
  const int tid = tid_, lane = tid & 63, r32 = lane & 31, hi = lane >> 5; const int wid = __builtin_amdgcn_readfirstlane(tid >> 6);
  const bf16* Qw = Qp + (long)(q0 + wid * QBLK) * RS;
  const bf16* Kh = Kp + (long)T0 * KVBLK * RS, *Vh = Vp + (long)T0 * KVBLK * RS;
  const unsigned lds0 = (unsigned)(uintptr_t)shm;
  float* wsf = (float*)(shm + LDS_WS) + wid * 64;
  const int qrel = wid * QBLK + r32;
  const LAS float* tbase;
  if (MODE == 0) { LAS float* kbt = (LAS float*)(shm + LDS_KBT); const int nk = q0 + QB;
    for (int i = 64 * T0 + tid * 4; i < nk; i += 2048) *(LAS f32x4*)(kbt + i) = *(const f32x4*)(kbsrc + i);
    tbase = kbt + 4 * hi + 64 * T0;
  } else { LAS float* tr = (LAS float*)(shm + LDS_TREV);
    for (int u = tid; u < 768; u += 512) { const int j = 383 - u; float v = -INFINITY; if (j >= 0 && j <= 128) v = relb[(int)T5B[dsel][j] * NH] * LOG2E; tr[u] = v; }
    tbase = tr + (383 - off - qrel + 4 * hi);
  }
  const bf16* ksrc = Kh + (long)lane * RS + wid * 8;
  const bf16* vsrc = Vh + (long)(16 * (wid & 3) + (lane >> 2)) * RS + (wid >> 2) * 32 + (lane & 3) * 8;
  const unsigned kdst = lds0 + LDS_K + wid * 1024, vdst = lds0 + LDS_V + wid * 1024;
  #define DMA_K(t, slot) glds16(ksrc + (long)(t) * KVBLK * RS, (unsigned)__builtin_amdgcn_readfirstlane(kdst + (slot)))
  #define DMA_V(t, slot) glds16(vsrc + (long)(t) * KVBLK * RS, (unsigned)__builtin_amdgcn_readfirstlane(vdst + (slot)))
  const int vb0 = (int)(lds0 + LDS_V) + ((lane >> 4) & 1) * 32 + (lane & 3) * 8 + (4 * hi + ((lane & 15) >> 2)) * 64;
  const char* Kbase = shm + LDS_K; bf16x8 kf[8];
  const lds_cptr shm3 = (lds_cptr)shm; const lds_cptr kp0 = shm3 + LDS_K + hi * 1024 + r32 * 16; const lds_cptr vp0 = shm3 + LDS_V + ((lane >> 4) & 1) * 32 + (lane & 3) * 8 + (4 * hi + ((lane & 15) >> 2)) * 64;
  DMA_K(0, 0); DMA_V(0, 0); DMA_K(1, SLOTB);
  bf16x8 qr[4];
  #pragma unroll
  for (int d0 = 0; d0 < 4; ++d0) qr[d0] = *reinterpret_cast<const bf16x8*>(&Qw[(long)r32 * RS + d0 * 16 + hi * 8]);
  float mhat = 0.f, l_reg = 0.f; f32x16 o[2]; o[0] = f32x16{}; o[1] = f32x16{};
  #define BLOAD(P0, P1, t) do { const LAS float* tb_ = tbase + 64 * (t); \
      if (MODE == 0) { _Pragma("unroll") for (int g_ = 0; g_ < 4; ++g_) { const f32x4 b0_ = *(const LAS f32x4*)(tb_ + 8 * g_), b1_ = *(const LAS f32x4*)(tb_ + 32 + 8 * g_); \
          _Pragma("unroll") for (int i_ = 0; i_ < 4; ++i_) { P0[4 * g_ + i_] = b0_[i_]; P1[4 * g_ + i_] = b1_[i_]; } } } \
      else { _Pragma("unroll") for (int r_ = 0; r_ < 16; ++r_) { P0[r_] = tb_[(r_ & 3) + 8 * (r_ >> 2)]; P1[r_] = tb_[32 + (r_ & 3) + 8 * (r_ >> 2)]; } } } while (0)
  #define CMASK(P0, P1, t) do { if (MODE == 0) { int jb_ = (t) - (NT - 4); if (jb_ >= 0) cmask(P0, P1, jb_, qrel, hi); } } while (0)
  bool resc = false;
  #define START(P0, P1) do { const float rm = rowmax(P0, P1); resc = false; mhat = max2f(rm, -1000.f); \
    _Pragma("unroll") for (int r = 0; r < 16; ++r) P0[r] = __builtin_amdgcn_exp2f(fsub_s(P0[r], mhat)); } while (0)
  #define RESC() do { if (resc) { asm volatile("s_waitcnt lgkmcnt(0)" ::: "memory"); \
      _Pragma("unroll") for (int d_ = 0; d_ < 2; ++d_) _Pragma("unroll") for (int r = 0; r < 16; ++r) o[d_][r] *= wsf[crow(r, hi)]; } } while (0)
  f32x16 pA0, pA1, pB0, pB1;
  int sl_prev = 0, sl_cur = 0, sl_next = SLOTB;
  #define ROT() do { sl_prev = sl_cur; sl_cur = sl_next; sl_next = (sl_next == (NSLOT - 1) * SLOTB) ? 0 : sl_next + SLOTB; } while (0)
  DMA_K(2, 2 * SLOTB);
  WAIT_BAR(3);
  BLOAD(pA0, pA1, 0);
  qkt(pA0, pA1, Kbase, qr, r32, hi); asm volatile("s_nop 15\n\ts_nop 7" : "+v"(pA0), "+v"(pA1)); CMASK(pA0, pA1, 0);
  START(pA0, pA1);
  _Pragma("unroll") for (int r = 0; r < 16; ++r) pA1[r] = __builtin_amdgcn_exp2f(fsub_s(pA1[r], mhat));
  BLOAD(pB0, pB1, 1);
  WAIT_BAR(0);
  DMA_K(3, 0); DMA_V(1, SLOTB);
  ROT();
  kload8(kf, kp0 + sl_cur);
  WAIT_BAR(2);
  s16x4 vlo[8], vhi[8]; u32x4 pw0, pw1, pw2, pw3;
  #define PKW(P, B) cvtpk_s(P[B], P[B + 1])
  #define PAF(k) __builtin_bit_cast(bf16x8, pw##k)
  #define VFR(i) (bf16x8){vlo[i][0], vlo[i][1], vlo[i][2], vlo[i][3], vhi[i][0], vhi[i][1], vhi[i][2], vhi[i][3]}
  #define PIN(x) asm volatile("" : "+v"(x))
  #define MX3(a, b, c) __builtin_fmaxf(__builtin_fmaxf((a), (b)), (c))
  #define GAPA(MF, A0, A1, A2, A3, W0, W1, PW) do { MF; sacc += A0; sacc += A1; sacc += A2; sacc += A3; PIN(sacc); W0; W1; PIN(PW); SBAR(); } while (0)
  #define EX(v) __builtin_amdgcn_exp2f(v)
  #define GAPB(MF, X, B) do { MF; X[B] = EX(X[B] - mhat); X[B + 1] = EX(X[B + 1] - mhat); X[B + 2] = EX(X[B + 2] - mhat); X[B + 3] = EX(X[B + 3] - mhat); PIN(X); SBAR(); } while (0)
  #define VRD(i) do { vlo[i] = vtr(vp_ + (((i) >> 2) * 4096 + ((i) & 3) * 1024)); vhi[i] = vtr(vp_ + (((i) >> 2) * 4096 + ((i) & 3) * 1024 + 512)); } while (0)
  #define KRD(G, j) do { if (G) { kload2(kf, kp0 + sl_next, j); SBAR(); } } while (0)
  #define STEP(C0, C1, P0, P1, t, GK, GV, GL) do { SBAR(); \
    const lds_cptr vp_ = vp0 + sl_prev; \
    VRD(0); SBAR(); float sacc = (P0[0] + P0[1]); \
    GAPA(C0 = __builtin_amdgcn_mfma_f32_32x32x16_bf16(kf[0], qr[0], C0, 0, 0, 0), P0[2], P0[3], P0[4], P0[5],     pw0[0] = PKW(P0, 0), pw0[1] = PKW(P0, 2), pw0); \
    VRD(4); SBAR(); GAPA(C1 = __builtin_amdgcn_mfma_f32_32x32x16_bf16(kf[1], qr[0], C1, 0, 0, 0), P0[6], P0[7], P0[8], P0[9],     pw0[2] = PKW(P0, 4), pw0[3] = PKW(P0, 6), pw0); \
    VRD(1); SBAR(); GAPA(C0 = __builtin_amdgcn_mfma_f32_32x32x16_bf16(kf[2], qr[1], C0, 0, 0, 0),   P0[10], P0[11], P0[12], P0[13], pw1[0] = PKW(P0, 8), pw1[1] = PKW(P0, 10), pw1); \
    VRD(5); SBAR(); GAPA(C1 = __builtin_amdgcn_mfma_f32_32x32x16_bf16(kf[3], qr[1], C1, 0, 0, 0),   P0[14], P0[15], P1[0], P1[1],   pw1[2] = PKW(P0, 12), pw1[3] = PKW(P0, 14), pw1); \
    VRD(2); SBAR(); GAPA(C0 = __builtin_amdgcn_mfma_f32_32x32x16_bf16(kf[4], qr[2], C0, 0, 0, 0),   P1[2], P1[3], P1[4], P1[5],     pw2[0] = PKW(P1, 0), pw2[1] = PKW(P1, 2), pw2); \
    VRD(6); SBAR(); GAPA(C1 = __builtin_amdgcn_mfma_f32_32x32x16_bf16(kf[5], qr[2], C1, 0, 0, 0),   P1[6], P1[7], P1[8], P1[9],     pw2[2] = PKW(P1, 4), pw2[3] = PKW(P1, 6), pw2); \
    VRD(3); SBAR(); GAPA(C0 = __builtin_amdgcn_mfma_f32_32x32x16_bf16(kf[6], qr[3], C0, 0, 0, 0),   P1[10], P1[11], P1[12], P1[13], pw3[0] = PKW(P1, 8), pw3[1] = PKW(P1, 10), pw3); \
    VRD(7); SBAR(); GAPA(C1 = __builtin_amdgcn_mfma_f32_32x32x16_bf16(kf[7], qr[3], C1, 0, 0, 0),   P1[14], P1[15], 0.f, 0.f,       pw3[2] = PKW(P1, 12), pw3[3] = PKW(P1, 14), pw3); \
    l_reg += sacc; \
    if (GK) { DMA_K((t) + 3, sl_cur); } if (GV) { DMA_V((t) + 1, sl_next); } \
    CMASK(C0, C1, t); \
    { float a = MX3(C0[0], C0[1], C1[0]), b = MX3(C0[2], C0[3], C1[1]); a = MX3(a, C1[2], C1[3]); \
      _Pragma("unroll") for (int r = 4; r < 16; r += 4) { a = MX3(a, C0[r], C0[r + 1]); b = MX3(b, C0[r + 2], C0[r + 3]); a = MX3(a, C1[r], C1[r + 1]); b = MX3(b, C1[r + 2], C1[r + 3]); } \
      float rm = __builtin_fmaxf(a, b); { auto rr = __builtin_amdgcn_permlane32_swap(__float_as_uint(rm), __float_as_uint(rm), false, false); rm = __builtin_fmaxf(__uint_as_float(rr[0]), __uint_as_float(rr[1])); } \
      rm -= mhat; resc = false; \
      if (__builtin_expect(__any(rm > (float)THRL), 0)) { const float dl = __builtin_fmaxf(rm, 0.f); mhat += dl; \
        const float f = __builtin_amdgcn_exp2f(-dl); l_reg *= f; if (hi == 0) wsf[r32] = f; resc = true; } } \
    SBAR(); \
    if ((t) + 1 < NT) { BLOAD(P0, P1, (t) + 1); SBAR(); }        \
    GAPB(o[0] = __builtin_amdgcn_mfma_f32_32x32x16_bf16(PAF(0), VFR(0), o[0], 0, 0, 0), C0, 0); \
    GAPB(o[1] = __builtin_amdgcn_mfma_f32_32x32x16_bf16(PAF(0), VFR(4), o[1], 0, 0, 0), C0, 4); \
    KRD(GL, 0); GAPB(o[0] = __builtin_amdgcn_mfma_f32_32x32x16_bf16(PAF(1), VFR(1), o[0], 0, 0, 0), C0, 8); \
    KRD(GL, 1); GAPB(o[1] = __builtin_amdgcn_mfma_f32_32x32x16_bf16(PAF(1), VFR(5), o[1], 0, 0, 0), C0, 12); \
    KRD(GL, 2); GAPB(o[0] = __builtin_amdgcn_mfma_f32_32x32x16_bf16(PAF(2), VFR(2), o[0], 0, 0, 0), C1, 0); \
    KRD(GL, 3); GAPB(o[1] = __builtin_amdgcn_mfma_f32_32x32x16_bf16(PAF(2), VFR(6), o[1], 0, 0, 0), C1, 4); \
    GAPB(o[0] = __builtin_amdgcn_mfma_f32_32x32x16_bf16(PAF(3), VFR(3), o[0], 0, 0, 0), C1, 8); \
    GAPB(o[1] = __builtin_amdgcn_mfma_f32_32x32x16_bf16(PAF(3), VFR(7), o[1], 0, 0, 0), C1, 12); \
    } while (0)
  int t = 1;
  for (; t + 5 < NT; t += 2) {
    STEP(pB0, pB1, pA0, pA1, t, true, true, true);     WAIT_BAR(2); RESC(); ROT();
    STEP(pA0, pA1, pB0, pB1, t + 1, true, true, true); WAIT_BAR(2); RESC(); ROT();
  }
  #define ENDW(tt) do { if ((tt) + 3 < NT) { WAIT_BAR(2); } else if ((tt) + 2 < NT) { WAIT_BAR(1); } else { WAIT_BAR(0); } } while (0)
  for (; t + 1 < NT; t += 2) {
    STEP(pB0, pB1, pA0, pA1, t, (t + 3 < NT), (t + 1 < NT), (t + 1 < NT));     ENDW(t);     RESC(); ROT();
    STEP(pA0, pA1, pB0, pB1, t + 1, (t + 4 < NT), (t + 2 < NT), (t + 2 < NT)); ENDW(t + 1); RESC(); ROT();
  }
  STEP(pB0, pB1, pA0, pA1, NT - 1, false, false, false); RESC();
  { float sacc = pB0[0] + pB0[1]; _Pragma("unroll") for (int r = 2; r < 16; ++r) sacc += pB0[r]; _Pragma("unroll") for (int r = 0; r < 16; ++r) sacc += pB1[r]; l_reg += sacc;
    pw0 = (u32x4){PKW(pB0, 0), PKW(pB0, 2), PKW(pB0, 4), PKW(pB0, 6)}; pw1 = (u32x4){PKW(pB0, 8), PKW(pB0, 10), PKW(pB0, 12), PKW(pB0, 14)}; pw2 = (u32x4){PKW(pB1, 0), PKW(pB1, 2), PKW(pB1, 4), PKW(pB1, 6)}; pw3 = (u32x4){PKW(pB1, 8), PKW(pB1, 10), PKW(pB1, 12), PKW(pB1, 14)};
    SBAR(); pv(o, vb0 + sl_cur, PAF(0), PAF(1), PAF(2), PAF(3)); }
  #undef PKW
  #undef PAF
  #undef VFR
  #undef PIN
  #undef MX3
  #undef GAPA
  #undef GAPB
  #undef EX
  #undef VRD
  #undef KRD
  #undef STEP
  #undef ENDW
  { auto rr = __builtin_amdgcn_permlane32_swap(__float_as_uint(l_reg), __float_as_uint(l_reg), false, false); l_reg = __uint_as_float(rr[0]) + __uint_as_float(rr[1]); }
  if (lsep != nullptr && hi == 0) lsep[(long)(q0 + qrel) * lse_stride] = mhat + __log2f(l_reg);
  if (hi == 0) wsf[32 + r32] = l_reg; asm volatile("s_waitcnt lgkmcnt(0)" ::: "memory");
  float rli[16];
  #pragma unroll
  for (int r = 0; r < 16; ++r) rli[r] = __builtin_amdgcn_rcpf(wsf[32 + crow(r, hi)]);
  bf16* Ow = Op + (long)(q0 + wid * QBLK) * ORS;
  { bf16* stg = (bf16*)(shm + LDS_OST) + wid * 2048;
    #pragma unroll
    for (int r = 0; r < 16; ++r) { const int orow = crow(r, hi);
      #pragma unroll
      for (int d0 = 0; d0 < 2; ++d0) stg[orow * 64 + d0 * 32 + r32] = __float2bfloat16(o[d0][r] * rli[r]); }
    asm volatile("s_waitcnt lgkmcnt(0)" ::: "memory");
    #pragma unroll
    for (int i = 0; i < 4; ++i) { const int row = i * 8 + (lane >> 3), ch = lane & 7; const u32x4 v = *(const u32x4*)(stg + row * 64 + ch * 8); ATTN_STORE16(Ow + (long)row * ORS + ch * 8, v); } }
  asm volatile("s_waitcnt lgkmcnt(0)\n\ts_barrier" ::: "memory");
  #undef DMA_K
  #undef DMA_V
  #undef CMASK
  #undef BLOAD
  #undef START
  #undef RESC
  #undef ROT
}

constexpr int DL_K = 0, DL_KB = 49152, DL_V = 98304, DL_VPAD = 147456, DL_ZEND = 153600, DL_WS = 153600, DL_TREV = 155648, DL_TOTAL = DL_TREV + 3072;
static_assert(DL_WS + NW * 256 <= DL_TREV, "dilated LDS map");
struct DilSrc { const bf16* K; const bf16* V; long RS; int q0; int first; };
__device__ __forceinline__ void dil_issue_k(const DilSrc& u, unsigned lds0, int kbuf, int lane, int wid) {
  const long kr0 = (long)u.q0 - 128; const bf16* ksrc = u.K + (kr0 + lane) * u.RS + wid * 8; const unsigned kdst = lds0 + kbuf + wid * 1024;
  #pragma unroll
  for (int i = 0; i < 6; ++i) if (i >= 2 || !u.first) glds16(ksrc + (long)i * KVBLK * u.RS, (unsigned)__builtin_amdgcn_readfirstlane(kdst + i * 8192));
}
__device__ __forceinline__ void dil_issue_v(const DilSrc& u, unsigned lds0, int lane, int wid) {
  const long kr0 = (long)u.q0 - 128; const bf16* vsrc = u.V + (kr0 + 16 * (wid & 3) + (lane >> 2)) * u.RS + (wid >> 2) * 32 + (lane & 3) * 8; const unsigned vdst = lds0 + DL_V + wid * 1024;
  #pragma unroll
  for (int i = 0; i < 6; ++i) if (i >= 2 || !u.first) glds16(vsrc + (long)i * KVBLK * u.RS, (unsigned)__builtin_amdgcn_readfirstlane(vdst + i * 8192));
}
template <int THRL> __device__ __forceinline__ void dil_unit(const bf16* Qp, const DilSrc cur, int kb, bool issued, const DilSrc nxt, bool has_next, bf16* Op,
                                                             float* lsep, long lse_stride, char* shm, const float* relb, int dsel, bool build_tab) {
  int tid_ = threadIdx.x; asm volatile("" : "+v"(tid_));
  const int tid = tid_, lane = tid & 63, r32 = lane & 31, hi = lane >> 5; const int wid = __builtin_amdgcn_readfirstlane(tid >> 6);
  const unsigned lds0 = (unsigned)(uintptr_t)shm;
  const long RS = cur.RS; const int q0 = cur.q0; const bool first = cur.first != 0;
  float* wsf = (float*)(shm + DL_WS) + wid * 64;
  LAS float* tr = (LAS float*)(shm + DL_TREV);
  if (build_tab) { for (int u = tid; u < 768; u += 512) { const int j = 383 - u; float v = -INFINITY; if (j >= 0 && j <= 128) v = relb[(int)T5B[dsel][j] * NH] * LOG2E; tr[u] = v; } }
  const LAS float* tbase = tr + (255 - r32 + 4 * hi);
  if (!issued) { dil_issue_k(cur, lds0, kb, lane, wid); dil_issue_v(cur, lds0, lane, wid); }
  const bf16* Qw = Qp + (long)(q0 + wid * QBLK) * RS;
  bf16x8 qr[4];
  #pragma unroll
  for (int d0 = 0; d0 < 4; ++d0) qr[d0] = *reinterpret_cast<const bf16x8*>(&Qw[(long)r32 * RS + d0 * 16 + hi * 8]);
  asm volatile("s_waitcnt vmcnt(0) lgkmcnt(0)\n\ts_barrier" ::: "memory");
  if (has_next) dil_issue_k(nxt, lds0, kb ^ DL_KB, lane, wid);
  const int g = wid;
  const lds_cptr shm3 = (lds_cptr)shm;
  const lds_cptr kl = shm3 + kb + hi * 1024 + r32 * 16;
  const lds_cptr vl = shm3 + DL_V + ((lane >> 4) & 1) * 32 + (lane & 3) * 8 + (4 * hi + ((lane & 15) >> 2)) * 64;
  #define KBO(blk) ((((blk)) >> 1) * 8192 + (((blk)) & 1) * 512)
  #define VBO(blk) ((((blk)) >> 1) * 8192 + (((blk)) & 1) * 2048)
  #define DKLOAD2(s_, j_) do { const int b0_ = g + 2 * (s_); kf[2 * (j_)] = *(const LAS bf16x8*)(kl + KBO(b0_) + (j_) * 2048); kf[2 * (j_) + 1] = *(const LAS bf16x8*)(kl + KBO(b0_ + 1) + (j_) * 2048); } while (0)
  float mhat = 0.f, l_reg = 0.f; f32x16 o[2]; o[0] = f32x16{}; o[1] = f32x16{};
  bf16x8 kf[8];
  #define BLOAD(P0, P1, t) do { const LAS float* tb_ = tbase + 64 * (t); \
      _Pragma("unroll") for (int r_ = 0; r_ < 16; ++r_) { P0[r_] = tb_[(r_ & 3) + 8 * (r_ >> 2)]; P1[r_] = tb_[32 + (r_ & 3) + 8 * (r_ >> 2)]; } } while (0)
  #define PMASK(P0, P1, t) do { if (first && (32 * g + 64 * (t)) < 128) { const int kb_ = 32 * g + 64 * (t) + 4 * hi - 128; \
      _Pragma("unroll") for (int r_ = 0; r_ < 16; ++r_) { const int kp_ = kb_ + (r_ & 3) + 8 * (r_ >> 2); if (kp_ < 0) P0[r_] = -INFINITY; if (kp_ + 32 < 0) P1[r_] = -INFINITY; } } } while (0)
  bool resc = false;
  #define RESC() do { if (resc) { asm volatile("s_waitcnt lgkmcnt(0)" ::: "memory"); \
      _Pragma("unroll") for (int d_ = 0; d_ < 2; ++d_) _Pragma("unroll") for (int r = 0; r < 16; ++r) o[d_][r] *= wsf[crow(r, hi)]; } } while (0)
  f32x16 pA0, pA1, pB0, pB1;
  BLOAD(pA0, pA1, 0);
  DKLOAD2(0, 0); DKLOAD2(0, 1); DKLOAD2(0, 2); DKLOAD2(0, 3);
  #pragma unroll
  for (int d0 = 0; d0 < 4; ++d0) { pA0 = __builtin_amdgcn_mfma_f32_32x32x16_bf16(kf[2 * d0], qr[d0], pA0, 0, 0, 0); pA1 = __builtin_amdgcn_mfma_f32_32x32x16_bf16(kf[2 * d0 + 1], qr[d0], pA1, 0, 0, 0); }
  asm volatile("s_nop 15\n\ts_nop 7" : "+v"(pA0), "+v"(pA1)); PMASK(pA0, pA1, 0);
  asm volatile("s_nop 3" : "+v"(pA0), "+v"(pA1));
  { const float rm = rowmax(pA0, pA1); mhat = max2f(rm, -1000.f);
    _Pragma("unroll") for (int r = 0; r < 16; ++r) pA0[r] = __builtin_amdgcn_exp2f(fsub_s(pA0[r], mhat));
    _Pragma("unroll") for (int r = 0; r < 16; ++r) pA1[r] = __builtin_amdgcn_exp2f(fsub_s(pA1[r], mhat)); }
  BLOAD(pB0, pB1, 1);
  DKLOAD2(1, 0); DKLOAD2(1, 1); DKLOAD2(1, 2); DKLOAD2(1, 3);
  s16x4 vlo[8], vhi[8]; u32x4 pw0, pw1, pw2, pw3;
  #define PKW(P, B) cvtpk_s(P[B], P[B + 1])
  #define PAF(k) __builtin_bit_cast(bf16x8, pw##k)
  #define VFR(i) (bf16x8){vlo[i][0], vlo[i][1], vlo[i][2], vlo[i][3], vhi[i][0], vhi[i][1], vhi[i][2], vhi[i][3]}
  #define PIN(x) asm volatile("" : "+v"(x))
  #define MX3(a, b, c) __builtin_fmaxf(__builtin_fmaxf((a), (b)), (c))
  #define GAPA(MF, A0, A1, A2, A3, W0, W1, PW) do { MF; sacc += A0; sacc += A1; sacc += A2; sacc += A3; PIN(sacc); W0; W1; PIN(PW); SBAR(); } while (0)
  #define EX(v) __builtin_amdgcn_exp2f(v)
  #define GAPB(MF, X, B) do { MF; X[B] = EX(X[B] - mhat); X[B + 1] = EX(X[B + 1] - mhat); X[B + 2] = EX(X[B + 2] - mhat); X[B + 3] = EX(X[B + 3] - mhat); PIN(X); SBAR(); } while (0)
  #define VRD(i) do { const lds_cptr va_ = vl + VBO(g + 2 * tv_ + (((i) & 3) >> 1)) + ((i) >> 2) * 4096 + ((i) & 1) * 1024; vlo[i] = vtr(va_); vhi[i] = vtr(va_ + 512); } while (0)
  #define KRD(G, j) do { if (G) { DKLOAD2(tk_, j); SBAR(); } } while (0)
  #define STEP(C0, C1, P0, P1, t, GL) do { SBAR(); const int tv_ = (t) - 1, tk_ = (t) + 1; \
    VRD(0); SBAR(); float sacc = (P0[0] + P0[1]); \
    GAPA(C0 = __builtin_amdgcn_mfma_f32_32x32x16_bf16(kf[0], qr[0], C0, 0, 0, 0), P0[2], P0[3], P0[4], P0[5],     pw0[0] = PKW(P0, 0), pw0[1] = PKW(P0, 2), pw0); \
    VRD(4); SBAR(); GAPA(C1 = __builtin_amdgcn_mfma_f32_32x32x16_bf16(kf[1], qr[0], C1, 0, 0, 0), P0[6], P0[7], P0[8], P0[9],     pw0[2] = PKW(P0, 4), pw0[3] = PKW(P0, 6), pw0); \
    VRD(1); SBAR(); GAPA(C0 = __builtin_amdgcn_mfma_f32_32x32x16_bf16(kf[2], qr[1], C0, 0, 0, 0),   P0[10], P0[11], P0[12], P0[13], pw1[0] = PKW(P0, 8), pw1[1] = PKW(P0, 10), pw1); \
    VRD(5); SBAR(); GAPA(C1 = __builtin_amdgcn_mfma_f32_32x32x16_bf16(kf[3], qr[1], C1, 0, 0, 0),   P0[14], P0[15], P1[0], P1[1],   pw1[2] = PKW(P0, 12), pw1[3] = PKW(P0, 14), pw1); \
    VRD(2); SBAR(); GAPA(C0 = __builtin_amdgcn_mfma_f32_32x32x16_bf16(kf[4], qr[2], C0, 0, 0, 0),   P1[2], P1[3], P1[4], P1[5],     pw2[0] = PKW(P1, 0), pw2[1] = PKW(P1, 2), pw2); \
    VRD(6); SBAR(); GAPA(C1 = __builtin_amdgcn_mfma_f32_32x32x16_bf16(kf[5], qr[2], C1, 0, 0, 0),   P1[6], P1[7], P1[8], P1[9],     pw2[2] = PKW(P1, 4), pw2[3] = PKW(P1, 6), pw2); \
    VRD(3); SBAR(); GAPA(C0 = __builtin_amdgcn_mfma_f32_32x32x16_bf16(kf[6], qr[3], C0, 0, 0, 0),   P1[10], P1[11], P1[12], P1[13], pw3[0] = PKW(P1, 8), pw3[1] = PKW(P1, 10), pw3); \
    VRD(7); SBAR(); GAPA(C1 = __builtin_amdgcn_mfma_f32_32x32x16_bf16(kf[7], qr[3], C1, 0, 0, 0),   P1[14], P1[15], 0.f, 0.f,       pw3[2] = PKW(P1, 12), pw3[3] = PKW(P1, 14), pw3); \
    l_reg += sacc; \
    PMASK(C0, C1, t); \
    { float a = MX3(C0[0], C0[1], C1[0]), b = MX3(C0[2], C0[3], C1[1]); a = MX3(a, C1[2], C1[3]); \
      _Pragma("unroll") for (int r = 4; r < 16; r += 4) { a = MX3(a, C0[r], C0[r + 1]); b = MX3(b, C0[r + 2], C0[r + 3]); a = MX3(a, C1[r], C1[r + 1]); b = MX3(b, C1[r + 2], C1[r + 3]); } \
      float rm = __builtin_fmaxf(a, b); { auto rr = __builtin_amdgcn_permlane32_swap(__float_as_uint(rm), __float_as_uint(rm), false, false); rm = __builtin_fmaxf(__uint_as_float(rr[0]), __uint_as_float(rr[1])); } \
      rm -= mhat; resc = false; \
      if (__builtin_expect(__any(rm > (float)THRL), 0)) { const float dl = __builtin_fmaxf(rm, 0.f); mhat += dl; \
        const float f = __builtin_amdgcn_exp2f(-dl); l_reg *= f; if (hi == 0) wsf[r32] = f; resc = true; } } \
    SBAR(); \
    if ((t) + 1 < 3) { BLOAD(P0, P1, (t) + 1); SBAR(); } \
    GAPB(o[0] = __builtin_amdgcn_mfma_f32_32x32x16_bf16(PAF(0), VFR(0), o[0], 0, 0, 0), C0, 0); \
    GAPB(o[1] = __builtin_amdgcn_mfma_f32_32x32x16_bf16(PAF(0), VFR(4), o[1], 0, 0, 0), C0, 4); \
    KRD(GL, 0); GAPB(o[0] = __builtin_amdgcn_mfma_f32_32x32x16_bf16(PAF(1), VFR(1), o[0], 0, 0, 0), C0, 8); \
    KRD(GL, 1); GAPB(o[1] = __builtin_amdgcn_mfma_f32_32x32x16_bf16(PAF(1), VFR(5), o[1], 0, 0, 0), C0, 12); \
    KRD(GL, 2); GAPB(o[0] = __builtin_amdgcn_mfma_f32_32x32x16_bf16(PAF(2), VFR(2), o[0], 0, 0, 0), C1, 0); \
    KRD(GL, 3); GAPB(o[1] = __builtin_amdgcn_mfma_f32_32x32x16_bf16(PAF(2), VFR(6), o[1], 0, 0, 0), C1, 4); \
    GAPB(o[0] = __builtin_amdgcn_mfma_f32_32x32x16_bf16(PAF(3), VFR(3), o[0], 0, 0, 0), C1, 8); \
    GAPB(o[1] = __builtin_amdgcn_mfma_f32_32x32x16_bf16(PAF(3), VFR(7), o[1], 0, 0, 0), C1, 12); \
    } while (0)
  STEP(pB0, pB1, pA0, pA1, 1, true);  RESC();
  STEP(pA0, pA1, pB0, pB1, 2, false); RESC();
  { float sacc = pA0[0] + pA0[1]; _Pragma("unroll") for (int r = 2; r < 16; ++r) sacc += pA0[r]; _Pragma("unroll") for (int r = 0; r < 16; ++r) sacc += pA1[r]; l_reg += sacc;
    pw0 = (u32x4){PKW(pA0, 0), PKW(pA0, 2), PKW(pA0, 4), PKW(pA0, 6)}; pw1 = (u32x4){PKW(pA0, 8), PKW(pA0, 10), PKW(pA0, 12), PKW(pA0, 14)}; pw2 = (u32x4){PKW(pA1, 0), PKW(pA1, 2), PKW(pA1, 4), PKW(pA1, 6)}; pw3 = (u32x4){PKW(pA1, 8), PKW(pA1, 10), PKW(pA1, 12), PKW(pA1, 14)};
    SBAR(); const int tv_ = 2;
    VRD(0); VRD(1); VRD(2); VRD(3); VRD(4); VRD(5); VRD(6); VRD(7);
    o[0] = __builtin_amdgcn_mfma_f32_32x32x16_bf16(PAF(0), VFR(0), o[0], 0, 0, 0); o[1] = __builtin_amdgcn_mfma_f32_32x32x16_bf16(PAF(0), VFR(4), o[1], 0, 0, 0);
    o[0] = __builtin_amdgcn_mfma_f32_32x32x16_bf16(PAF(1), VFR(1), o[0], 0, 0, 0); o[1] = __builtin_amdgcn_mfma_f32_32x32x16_bf16(PAF(1), VFR(5), o[1], 0, 0, 0);
    o[0] = __builtin_amdgcn_mfma_f32_32x32x16_bf16(PAF(2), VFR(2), o[0], 0, 0, 0); o[1] = __builtin_amdgcn_mfma_f32_32x32x16_bf16(PAF(2), VFR(6), o[1], 0, 0, 0);
    o[0] = __builtin_amdgcn_mfma_f32_32x32x16_bf16(PAF(3), VFR(3), o[0], 0, 0, 0); o[1] = __builtin_amdgcn_mfma_f32_32x32x16_bf16(PAF(3), VFR(7), o[1], 0, 0, 0); }
  #undef PKW
  #undef PAF
  #undef VFR
  #undef PIN
  #undef MX3
  #undef GAPA
  #undef GAPB
  #undef EX
  #undef VRD
  #undef KRD
  #undef STEP
  const int qrel = wid * QBLK + r32;
  { auto rr = __builtin_amdgcn_permlane32_swap(__float_as_uint(l_reg), __float_as_uint(l_reg), false, false); l_reg = __uint_as_float(rr[0]) + __uint_as_float(rr[1]); }
  if (hi == 0) lsep[(long)(q0 + qrel) * lse_stride] = mhat + __log2f(l_reg);
  if (hi == 0) wsf[32 + r32] = l_reg; asm volatile("s_waitcnt lgkmcnt(0)" ::: "memory");
  float rli[16];
  #pragma unroll
  for (int r = 0; r < 16; ++r) rli[r] = __builtin_amdgcn_rcpf(wsf[32 + crow(r, hi)]);
  asm volatile("s_waitcnt lgkmcnt(0)\n\ts_barrier" ::: "memory");
  if (has_next) dil_issue_v(nxt, lds0, lane, wid);
  bf16* Ow = Op + (long)(q0 + wid * QBLK) * RS;
  { bf16* stg = (bf16*)(shm + kb) + wid * 2048;
    #pragma unroll
    for (int r = 0; r < 16; ++r) { const int orow = crow(r, hi);
      #pragma unroll
      for (int d0 = 0; d0 < 2; ++d0) stg[orow * 64 + d0 * 32 + r32] = __float2bfloat16(o[d0][r] * rli[r]); }
    asm volatile("s_waitcnt lgkmcnt(0)" ::: "memory");
    #pragma unroll
    for (int i = 0; i < 4; ++i) { const int row = i * 8 + (lane >> 3), ch = lane & 7; const u32x4 v = *(const u32x4*)(stg + row * 64 + ch * 8); ATTN_STORE16(Ow + (long)row * RS + ch * 8, v); } }
  if (!has_next) asm volatile("s_waitcnt lgkmcnt(0)\n\ts_barrier" ::: "memory");
  #undef KBO
  #undef VBO
  #undef DKLOAD2
  #undef BLOAD
  #undef PMASK
  #undef RESC
}
#undef SBAR
#undef WAIT_BAR
}
static_assert(attn_body::LDS_TOTAL <= RING_BYTES && attn_body::DL_TOTAL <= PHASE_LDS, "attention LDS");

#define XB_TMO      128
#define XB_XCNT(j)  (256  + 64 * (j))
#define XB_XSUB(j)  (1280 + 64 * (j))
#define XB_XGEN(j)  (2304 + 64 * (j))
#define XB_TOP      3328
#define XB_TOPGEN   3392
#define XCD_BAR_WORDS 3456
#define XB_SPIN_CAP (1u << 18)
__device__ __forceinline__ unsigned xb_ld(unsigned* p)              { return __hip_atomic_load(p, __ATOMIC_RELAXED, __HIP_MEMORY_SCOPE_AGENT); }
__device__ __forceinline__ unsigned xb_add(unsigned* p, unsigned v) { return __hip_atomic_fetch_add(p, v, __ATOMIC_RELAXED, __HIP_MEMORY_SCOPE_AGENT); }
__device__ __forceinline__ unsigned xb_xcc_id() { return (unsigned)__builtin_amdgcn_s_getreg((3 << 11) | 20) & 0xFu; }
#define XB_SPIN(cond, bar) do { unsigned _sp = 0; while (cond) { __builtin_amdgcn_s_sleep(1); \
    if ((++_sp & 255u) == 0u) { if (xb_ld(&(bar)[XB_TMO])) break; if (_sp > XB_SPIN_CAP) { atomicAdd(&(bar)[XB_TMO], 1u); break; } } } } while (0)
struct XcdBarrier { unsigned* bar; unsigned x; volatile LAS unsigned* st; };
__device__ __forceinline__ XcdBarrier xcd_barrier_post(unsigned* bar, volatile LAS unsigned* st) {
    XcdBarrier b; b.bar = bar; b.x = xb_xcc_id(); b.st = st;
    if (threadIdx.x == 0) (void)xb_add(&bar[XB_XCNT(b.x)], 1u);
    return b;
}
__device__ __forceinline__ void xcd_barrier_complete(unsigned* bar, unsigned x, unsigned& nloc, unsigned& nx) {
    const unsigned G = gridDim.x * gridDim.y * gridDim.z;
    unsigned sum, cnt, mine, sp = 0u;
    for (;;) {
        sum = 0u; cnt = 0u; mine = 0u;
#pragma unroll
        for (unsigned j = 0; j < 16; ++j) { const unsigned c = xb_ld(&bar[XB_XCNT(j)]); sum += c; cnt += (c > 0u) ? 1u : 0u; mine = (j == x) ? c : mine; }
        if (sum == G) break;
        __builtin_amdgcn_s_sleep(1);
        if ((++sp & 255u) == 0u) { if (xb_ld(&bar[XB_TMO])) break; if (sp > XB_SPIN_CAP) { atomicAdd(&bar[XB_TMO], 1u); break; } }
    }
    nloc = mine > 0u ? mine : 1u; nx = cnt > 0u ? cnt : 1u;
}
__device__ __forceinline__ void xcd_barrier(const XcdBarrier& b) {
    asm volatile("s_waitcnt vmcnt(0)" ::: "memory");
    __syncthreads();
    if (threadIdx.x == 0) {
        unsigned* bar = b.bar;
        __builtin_amdgcn_s_waitcnt(0);
        unsigned nloc = b.st[0], nx = b.st[1];
        if (nloc == 0u) { xcd_barrier_complete(bar, b.x, nloc, nx); b.st[0] = nloc; b.st[1] = nx; }
        const unsigned old = xb_add(&bar[XB_XSUB(b.x)], 1u);
        const unsigned gen = old / nloc;
        if (old + 1u == (gen + 1u) * nloc) {
            __builtin_amdgcn_fence(__ATOMIC_RELEASE, "agent");
            asm volatile("s_waitcnt vmcnt(0)" ::: "memory");
            const unsigned og = xb_add(&bar[XB_TOP], 1u);
            const unsigned tg = og / nx;
            if (og + 1u == (tg + 1u) * nx) xb_add(&bar[XB_TOPGEN], 1u);
            else XB_SPIN(xb_ld(&bar[XB_TOPGEN]) == tg, bar);
            __builtin_amdgcn_fence(__ATOMIC_ACQUIRE, "agent");
            xb_add(&bar[XB_XGEN(b.x)], 1u);
            asm volatile("s_waitcnt vmcnt(0)" ::: "memory");
        } else {
            XB_SPIN(xb_ld(&bar[XB_XGEN(b.x)]) == gen, bar);
            __builtin_amdgcn_fence(__ATOMIC_ACQUIRE, "agent");
            asm volatile("s_waitcnt vmcnt(0)" ::: "memory");
        }
    }
    __syncthreads();
}

struct Frame {
    LAS unsigned char* lds;
    volatile LAS unsigned* MISC;
    gu32* ctl;
    int tid, lane, wave;
    int vcu, G;
    unsigned char* ws;
    float* out;
};
#define LDS_WAIT() asm volatile("s_waitcnt lgkmcnt(0)" ::: "memory")

__device__ __forceinline__ void p0_mod(Frame& F, const float* c, const float* w_ada, const float* b_ada, float* mod) {
    LAS float* sc = (LAS float*)F.lds;
    LAS float* part = (LAS float*)(F.lds + 65536);
    __syncthreads();
    for (int cg = blockIdx.x; cg < NMOD / 64; cg += F.G) {
        for (int i = F.tid; i < BATCH * DM; i += NWAVES * 64) { const float v = c[i]; sc[i] = v / (1.f + __expf(-v)); }
        __syncthreads();
        const int n = cg * 64 + F.lane; float acc[BATCH];
#pragma unroll
        for (int b = 0; b < BATCH; ++b) acc[b] = 0.f;
        const int kb = F.wave * 128;
        for (int k0 = kb; k0 < kb + 128; k0 += 32) { float wv[32];
#pragma unroll
            for (int i = 0; i < 32; ++i) wv[i] = w_ada[(size_t)(k0 + i) * NMOD + n];
#pragma unroll
            for (int i = 0; i < 32; ++i)
#pragma unroll
                for (int b = 0; b < BATCH; ++b) acc[b] += sc[b * DM + k0 + i] * wv[i]; }
#pragma unroll
        for (int b = 0; b < BATCH; ++b) part[(F.wave * BATCH + b) * 64 + F.lane] = acc[b];
        __syncthreads();
        for (int o = F.tid; o < BATCH * 64; o += NWAVES * 64) { const int b = o >> 6, l = o & 63; float s = b_ada[cg * 64 + l];
#pragma unroll
            for (int w = 0; w < NWAVES; ++w) s += part[(w * BATCH + b) * 64 + l];
            mod[(size_t)b * NMOD + cg * 64 + l] = s; }
        __syncthreads();
    }
}
__device__ __forceinline__ int gu_row(int c, int up) { return (c >> 7) * 256 + up * 128 + (c & 127); }
__device__ __forceinline__ int dn_row(int c) { const int cc = c & 255; return (c & ~255) + ((cc >> 5) & 1) * 128 + (cc >> 6) * 32 + (cc & 31); }
struct P0Ptrs { const float *w_in, *w_out, *w_router, *w_eg, *w_eu, *w_ed, *w_sg, *w_su, *w_sd; };
struct TrItem { const float* src; unsigned char* dst; int ldw, Kd, f8; };
__device__ __forceinline__ TrItem tr_make(const float* W, int ldw, int k0, int c0, void* WT, int drow0, int Kd, int f8 = 0) { TrItem t; t.src = W + (size_t)k0 * ldw + c0; t.dst = (unsigned char*)WT + ((size_t)drow0 * Kd + k0) * (f8 ? 1 : 2); t.ldw = ldw; t.Kd = Kd; t.f8 = f8; return t; }
__device__ __forceinline__ TrItem p0_decode(const P0Ptrs& P, unsigned char* ws, int it) {
    bf16_t* WIN = (bf16_t*)(ws + WS_WIN); bf16_t* WOUT = (bf16_t*)(ws + WS_WOUT); bf16_t* WR = (bf16_t*)(ws + WS_WR);
    bf16_t* WSHGU = (bf16_t*)(ws + WS_WSHGU); bf16_t* WSHD = (bf16_t*)(ws + WS_WSHD); unsigned char* WD = ws + WS_WD; unsigned char* WGU = ws + WS_WGU;
    constexpr int I_EXP = NEXP * 384, I_IN = 768, I_OUT = 512, I_S = 128;
    int r = it;
    if (r < I_EXP) { const int e = r / 384, q = r % 384;
        if (q < 256) { const int up = q >> 7, qq = q & 127, kb = qq >> 3, nb = qq & 7;
            return tr_make((up ? P.w_eu : P.w_eg) + (size_t)e * DM * EH, EH, 64 * kb, 32 * nb, WGU + (size_t)e * 512 * DM, gu_row(32 * nb, up), DM, 1); }
        const int qq = q - 256, kb = qq >> 5, nb = qq & 31;
        return tr_make(P.w_ed + (size_t)e * EH * DM, DM, 64 * kb, 32 * nb, WD + (size_t)e * DM * EH, dn_row(32 * nb), EH, 1); }
    r -= I_EXP;
    if (r < I_IN) { const int kb = r / 48, nb = r % 48; return tr_make(P.w_in, INC, 64 * kb, 32 * nb, WIN, 32 * nb, DM); } r -= I_IN;
    if (r < I_IN) { const int kb = r / 48, nb = r % 48; return tr_make(P.w_in, INC, 64 * kb, 1544 + 32 * nb, WIN, 1536 + 32 * nb, DM); } r -= I_IN;
    if (r < I_OUT) { const int kb = r >> 5, nb = r & 31; return tr_make(P.w_out, DM, 64 * kb, 32 * nb, WOUT, 32 * nb, DM); } r -= I_OUT;
    if (r < I_S) { const int kb = r >> 3, nb = r & 7; return tr_make(P.w_router, NEXP, 64 * kb, 32 * nb, WR, 32 * nb, DM); } r -= I_S;
    if (r < I_S) { const int kb = r >> 3, nb = r & 7; return tr_make(P.w_sg, EH, 64 * kb, 32 * nb, WSHGU, gu_row(32 * nb, 0), DM); } r -= I_S;
    if (r < I_S) { const int kb = r >> 3, nb = r & 7; return tr_make(P.w_su, EH, 64 * kb, 32 * nb, WSHGU, gu_row(32 * nb, 1), DM); } r -= I_S;
    { const int kb = r >> 5, nb = r & 31; return tr_make(P.w_sd, DM, 64 * kb, 32 * nb, WSHD, dn_row(32 * nb), EH); }
}
__device__ __forceinline__ void tr_load(const TrItem& t, int lane, f32x4 (&v)[8]) {
    const float* p = t.src + (size_t)(lane >> 3) * t.ldw + (lane & 7) * 4;
#pragma unroll
    for (int i = 0; i < 8; ++i) v[i] = *(const GAS f32x4*)(p + (size_t)(8 * i) * t.ldw);
}
__device__ __forceinline__ void tr_store(const TrItem& t, int lane, const f32x4 (&v)[8], LAS float* scr) {
    LAS float* w = scr + (lane >> 3) * 33 + (lane & 7) * 4;
#pragma unroll
    for (int i = 0; i < 8; ++i) { w[(8 * i) * 33 + 0] = v[i].x; w[(8 * i) * 33 + 1] = v[i].y; w[(8 * i) * 33 + 2] = v[i].z; w[(8 * i) * 33 + 3] = v[i].w; }
    LDS_WAIT(); asm volatile("" ::: "memory");
    const int c = lane & 7;
#pragma unroll
    for (int j = 0; j < 4; ++j) { const int n = (lane >> 3) + 8 * j; const LAS float* s = scr + (8 * c) * 33 + n;
        if (t.f8) { int w0 = __builtin_amdgcn_cvt_pk_fp8_f32(s[0 * 33], s[1 * 33], 0, false); w0 = __builtin_amdgcn_cvt_pk_fp8_f32(s[2 * 33], s[3 * 33], w0, true);
            int w1 = __builtin_amdgcn_cvt_pk_fp8_f32(s[4 * 33], s[5 * 33], 0, false); w1 = __builtin_amdgcn_cvt_pk_fp8_f32(s[6 * 33], s[7 * 33], w1, true);
            u32x2 o; o.x = (unsigned)w0; o.y = (unsigned)w1; *(GAS u32x2*)(t.dst + (size_t)n * t.Kd + 8 * c) = o; }
        else { u32x4 o; o.x = cvt_pk_bf16(s[0 * 33], s[1 * 33]); o.y = cvt_pk_bf16(s[2 * 33], s[3 * 33]); o.z = cvt_pk_bf16(s[4 * 33], s[5 * 33]); o.w = cvt_pk_bf16(s[6 * 33], s[7 * 33]);
            *(GAS u32x4*)(t.dst + ((size_t)n * t.Kd + 8 * c) * 2) = o; } }
    LDS_WAIT(); asm volatile("" ::: "memory");
}
__device__ __forceinline__ void p0_weights(Frame& F, const P0Ptrs& P, int it_lo, int it_hi) {
    LAS float* scr = (LAS float*)(F.lds + F.wave * 16384);
    const int gw = F.vcu * NWAVES + F.wave, NGW = F.G * NWAVES;
    int it = it_lo + gw; if (it >= it_hi) return;
    TrItem cur = p0_decode(P, F.ws, it); f32x4 v[8]; tr_load(cur, F.lane, v);
    for (;;) {
        const int nit = it + NGW; const bool more = nit < it_hi;
        f32x4 nv[8];
        const TrItem nx = p0_decode(P, F.ws, more ? nit : it); tr_load(nx, F.lane, nv);
        tr_store(cur, F.lane, v, scr);
        if (!more) break;
        cur = nx; it = nit;
#pragma unroll
        for (int i = 0; i < 8; ++i) v[i] = nv[i];
    }
}
constexpr int P0_EXPERT_ITEMS = NEXP * 384, P0_ALL_ITEMS = NEXP * 384 + 2 * 768 + 512 + 4 * 128;
struct CvItem { const float* src; unsigned char* dst; int ldw, Kd, rowbase, down, n0; };
__device__ __forceinline__ CvItem cv_decode(const P0Ptrs& P, unsigned char* ws, int sit) {
    const int e = sit / 24, q = sit % 24; CvItem c;
    if (q < 16) { const int up = q >> 3, kb = q & 7;
        c.src = (up ? P.w_eu : P.w_eg) + (size_t)e * DM * EH + (size_t)(128 * kb) * EH; c.ldw = EH; c.dst = ws + WS_WGU + (size_t)e * 512 * DM + 128 * kb; c.Kd = DM; c.rowbase = up * 128; c.down = 0; c.n0 = 0; }
    else { const int qq = q - 16, kb = qq >> 2, nb = qq & 3;
        c.src = P.w_ed + (size_t)e * EH * DM + (size_t)(128 * kb) * DM + 256 * nb; c.ldw = DM; c.dst = ws + WS_WD + (size_t)e * DM * EH + 128 * kb; c.Kd = EH; c.rowbase = 0; c.down = 1; c.n0 = 256 * nb; }
    return c;
}
__device__ __forceinline__ void cv_issue(Frame& F, const CvItem& c, int sub, int buf) {
    const float* g = c.src + (size_t)(32 * sub + 4 * F.wave) * c.ldw + F.lane * 4;
#pragma unroll
    for (int i = 0; i < 4; ++i) __builtin_amdgcn_global_load_lds((const unsigned*)(g + (size_t)i * c.ldw), (LAS unsigned*)(F.lds + buf * 32768 + (4 * F.wave + i) * 1024), 16, 0, 0);
}
__device__ __forceinline__ void conv_experts(Frame& F, const P0Ptrs& P) {
    constexpr int NSI = NEXP * 24;
    const int G = F.G; const int si0 = F.vcu; if (si0 >= NSI) return;
    const int nmine = (NSI - si0 + G - 1) / G;
    const int NT = nmine * 4;
    int tid_ = threadIdx.x; asm volatile("" : "+v"(tid_)); const int tid = tid_;
    LAS unsigned char* Bb = F.lds + 3 * 32768;
#define CV_SUB(t_) do { const int tt_ = (t_) < NT ? (t_) : NT - 1; const CvItem c_ = cv_decode(P, F.ws, si0 + (tt_ >> 2) * G); cv_issue(F, c_, tt_ & 3, (t_) % 3); } while (0)
    CV_SUB(0); CV_SUB(1);
    CvItem cur = cv_decode(P, F.ws, si0);
    for (int t = 0; t < NT; ++t) { const int sub = t & 3;
        asm volatile("s_waitcnt vmcnt(4)" ::: "memory");
        __builtin_amdgcn_s_barrier(); asm volatile("" ::: "memory");
        CV_SUB(t + 2);
        { const int n = tid & 255, kq = tid >> 8; const LAS float* a = (const LAS float*)(F.lds + (t % 3) * 32768) + (16 * kq) * 256 + n; unsigned w[4];
#pragma unroll
          for (int j = 0; j < 4; ++j) { const float f0 = a[(4 * j) * 256], f1 = a[(4 * j + 1) * 256], f2 = a[(4 * j + 2) * 256], f3 = a[(4 * j + 3) * 256];
              int q0 = __builtin_amdgcn_cvt_pk_fp8_f32(f0, f1, 0, false); q0 = __builtin_amdgcn_cvt_pk_fp8_f32(f2, f3, q0, true); w[j] = (unsigned)q0; }
          *(LAS u32x4*)(Bb + n * 144 + 32 * sub + 16 * kq) = (u32x4){w[0], w[1], w[2], w[3]}; }
        if (sub == 3) {
            asm volatile("s_waitcnt lgkmcnt(0)" ::: "memory"); __builtin_amdgcn_s_barrier(); asm volatile("" ::: "memory");
#pragma unroll
            for (int j = 0; j < 4; ++j) { const int nl = (tid >> 3) + 64 * j, ch = tid & 7; const u32x4 v = *(const LAS u32x4*)(Bb + nl * 144 + 16 * ch);
                const int drow = cur.down ? dn_row(cur.n0 + nl) : (nl >> 7) * 256 + cur.rowbase + (nl & 127);
                *(GAS u32x4*)(cur.dst + (size_t)drow * cur.Kd + 16 * ch) = v; }
            asm volatile("s_waitcnt lgkmcnt(0)" ::: "memory");
            if (t + 1 < NT) cur = cv_decode(P, F.ws, si0 + ((t + 1) >> 2) * G);
        }
    }
#undef CV_SUB
    asm volatile("s_waitcnt vmcnt(0)" ::: "memory");
    __builtin_amdgcn_s_barrier();
}
template <bool FL> __device__ __forceinline__ void norm_rows(Frame& F, const float* src  , bf16_t* dst, const float* mod, int shift_off, int scale_off, const float* w_in, const float* b_forget, float* lf, unsigned char* dst8) {
    LAS float* wf = (LAS float*)F.lds;
    if (FL) { for (int i = F.tid; i < DM * NH; i += NWAVES * 64) wf[(i & 7) * DM + (i >> 3)] = w_in[(size_t)(i >> 3) * INC + 1536 + (i & 7)]; __syncthreads(); }
    const int gw = F.vcu * NWAVES + F.wave, NGW = F.G * NWAVES;
    constexpr int CH = 32;
#define NR_ROW(i_) (rowb + 128 * (i_))
#define NR_LD(dst_, row_, j_) do { if (FL) dst_ = ((const GAS f32x4*)(src + (size_t)(row_) * DM) + F.lane)[64 * (j_)]; \
        else { const u32x2 t_ = ((const GAS u32x2*)x1_row(F.ws, (size_t)(row_)) + F.lane)[64 * (j_)]; dst_ = (f32x4){bf_lo(t_.x), bf_hi(t_.x), bf_lo(t_.y), bf_hi(t_.y)}; } } while (0)
    for (int ch = gw; ch < M / CH; ch += NGW) {
        const int b = ch >> 7, rowb = b * SEQ + (ch & 127);
        f32x4 sc[4], sh[4];
#pragma unroll
        for (int j = 0; j < 4; ++j) { sc[j] = *(const f32x4*)(mod + (size_t)b * NMOD + scale_off + 256 * j + 4 * F.lane) + 1.f; sh[j] = *(const f32x4*)(mod + (size_t)b * NMOD + shift_off + 256 * j + 4 * F.lane); }
        f32x4 nv[2][4];
#pragma unroll
        for (int q = 0; q < 2; ++q)
#pragma unroll
            for (int j = 0; j < 4; ++j) NR_LD(nv[q][j], NR_ROW(q), j);
        for (int mm = 0; mm < CH; mm += 2) {
            f32x4 vv[2][4];
#pragma unroll
            for (int q = 0; q < 2; ++q)
#pragma unroll
                for (int j = 0; j < 4; ++j) vv[q][j] = nv[q][j];
            if (mm + 2 < CH) {
#pragma unroll
                for (int q = 0; q < 2; ++q)
#pragma unroll
                    for (int j = 0; j < 4; ++j) NR_LD(nv[q][j], NR_ROW(mm + 2 + q), j); }
#pragma unroll
            for (int q = 0; q < 2; ++q) { const int m = NR_ROW(mm + q); f32x4 (&v)[4] = vv[q];
            float s2 = 0.f;
#pragma unroll
            for (int j = 0; j < 4; ++j) s2 += (v[j].x * v[j].x + v[j].y * v[j].y) + (v[j].z * v[j].z + v[j].w * v[j].w);
            const float r = 1.f / sqrtf(wave_sum(s2) * (1.f / DM) + EPS);
#pragma unroll
            for (int j = 0; j < 4; ++j) v[j] = v[j] * r * sc[j] + sh[j];
            GAS u32x2* o8 = (GAS u32x2*)(dst + (size_t)m * DM) + F.lane;
#pragma unroll
            for (int j = 0; j < 4; ++j) { u32x2 w; w.x = cvt_pk_bf16(v[j].x, v[j].y); w.y = cvt_pk_bf16(v[j].z, v[j].w); o8[64 * j] = w; }
            if (!FL) { GAS unsigned* o4 = (GAS unsigned*)(dst8 + (size_t)m * DM) + F.lane;
#pragma unroll
                for (int j = 0; j < 4; ++j) { int w = __builtin_amdgcn_cvt_pk_fp8_f32(v[j].x, v[j].y, 0, false); w = __builtin_amdgcn_cvt_pk_fp8_f32(v[j].z, v[j].w, w, true); o4[64 * j] = (unsigned)w; } }
            if (FL) { float fl[NH];
#pragma unroll
                for (int h = 0; h < NH; ++h) fl[h] = 0.f;
#pragma unroll
                for (int j = 0; j < 4; ++j)
#pragma unroll
                    for (int h = 0; h < NH; ++h) { const f32x4 w4 = *(const LAS f32x4*)(wf + h * DM + 256 * j + 4 * F.lane); fl[h] += (v[j].x * w4.x + v[j].y * w4.y) + (v[j].z * w4.z + v[j].w * w4.w); }
                const float mine = reduce8_heads(fl, F.lane); const int hh = F.lane >> 3;
                if ((F.lane & 7) == 0) { const float z = mine + b_forget[hh]; const float ls = fminf(z, 0.f) - log1pf(__expf(-fabsf(z))); lf[((size_t)b * NH + hh) * SEQ + (m & (SEQ - 1))] = ls; } }
            }
        }
    }
}
#undef NR_ROW
#undef NR_LD
__device__ __forceinline__ void scan_rows(Frame& F, const float* lf, float* kb, int* t0tab) {
    LAS float* wt = (LAS float*)F.lds; LAS float* kl = wt + 16;
    for (int s = blockIdx.x; s < BATCH * NH; s += F.G) {
        const float* src = lf + (size_t)s * SEQ + F.tid * 8; float v[8];
        { const f32x4 a = *(const f32x4*)src, b2 = *(const f32x4*)(src + 4); v[0] = a.x; v[1] = a.y; v[2] = a.z; v[3] = a.w; v[4] = b2.x; v[5] = b2.y; v[6] = b2.z; v[7] = b2.w; }
#pragma unroll
        for (int i = 1; i < 8; ++i) v[i] += v[i - 1];
        float incl = v[7];
#pragma unroll
        for (int o = 1; o < 64; o <<= 1) { const float t = __shfl_up(incl, o); if (F.lane >= o) incl += t; }
        if (F.lane == 63) wt[F.wave] = incl;
        __syncthreads();
        float base = incl - v[7];
        for (int w = 0; w < F.wave; ++w) base += wt[w];
        float* dst = kb + (size_t)s * SEQ + F.tid * 8;
        f32x4 a, b2; a.x = -(v[0] + base) * LOG2E; a.y = -(v[1] + base) * LOG2E; a.z = -(v[2] + base) * LOG2E; a.w = -(v[3] + base) * LOG2E;
        b2.x = -(v[4] + base) * LOG2E; b2.y = -(v[5] + base) * LOG2E; b2.z = -(v[6] + base) * LOG2E; b2.w = -(v[7] + base) * LOG2E;
        *(f32x4*)dst = a; *(f32x4*)(dst + 4) = b2;
        *(LAS f32x4*)(kl + F.tid * 8) = a; *(LAS f32x4*)(kl + F.tid * 8 + 4) = b2;
        __syncthreads();
        if (F.tid < 16) { const int q0 = 256 * F.tid; const float target = kl[q0] - FOX_SKIP_LOG2; int lo = 0, hi = q0;
            while (lo < hi) { const int mid = (lo + hi) >> 1; if (kl[mid] <= target) lo = mid + 1; else hi = mid; }
            t0tab[s * 16 + F.tid] = (lo >> 6) & ~1; }
        __syncthreads();
    }
}
__device__ __forceinline__ void unpack8(const u32x4 w, float* f) { f[0] = bf_lo(w.x); f[1] = bf_hi(w.x); f[2] = bf_lo(w.y); f[3] = bf_hi(w.y); f[4] = bf_lo(w.z); f[5] = bf_hi(w.z); f[6] = bf_lo(w.w); f[7] = bf_hi(w.w); }
__device__ __forceinline__ void merge_rows(Frame& F, const float* g_fox, const float* g_dil) {
    const bf16_t* OF = (const bf16_t*)(F.ws + WS_OF); const bf16_t* O1 = (const bf16_t*)(F.ws + WS_O1); const bf16_t* O2 = (const bf16_t*)(F.ws + WS_O2); const bf16_t* O3 = (const bf16_t*)(F.ws + WS_O3);
    const float* LSE = (const float*)(F.ws + WS_LSE); bf16_t* YM = (bf16_t*)(F.ws + WS_YM);
    const int gw = F.vcu * NWAVES + F.wave, NGW = F.G * NWAVES;
    float gf[8], gd[8];
    { const f32x4 a = *(const f32x4*)(g_fox + 8 * F.lane), b = *(const f32x4*)(g_fox + 8 * F.lane + 4), c = *(const f32x4*)(g_dil + 8 * F.lane), d = *(const f32x4*)(g_dil + 8 * F.lane + 4);
      gf[0] = a.x; gf[1] = a.y; gf[2] = a.z; gf[3] = a.w; gf[4] = b.x; gf[5] = b.y; gf[6] = b.z; gf[7] = b.w; gd[0] = c.x; gd[1] = c.y; gd[2] = c.z; gd[3] = c.w; gd[4] = d.x; gd[5] = d.y; gd[6] = d.z; gd[7] = d.w; }
    struct Row { u32x4 wf, w1, w2, w3; float l1, l2, l3; };
    const int hd = F.lane >> 3;
#define MR_LOAD(R, m_) do { const size_t eo_ = (size_t)(m_) * HW + 8 * F.lane; R.wf = *(const GAS u32x4*)(OF + eo_); R.w1 = *(const GAS u32x4*)(O1 + eo_); R.w2 = *(const GAS u32x4*)(O2 + eo_); R.w3 = *(const GAS u32x4*)(O3 + eo_); \
        R.l1 = LSE[(size_t)(m_) * NH + hd]; R.l2 = LSE[(size_t)M * NH + (size_t)(m_) * NH + hd]; R.l3 = LSE[(size_t)2 * M * NH + (size_t)(m_) * NH + hd]; } while (0)
    for (int ch = gw; ch < M / 32; ch += NGW) {
        const size_t rowb = (size_t)(ch >> 7) * SEQ + (ch & 127);
        Row nr[2]; MR_LOAD(nr[0], rowb); MR_LOAD(nr[1], rowb + 128);
        for (int mm = 0; mm < 32; mm += 2) {
            Row cr[2]; cr[0] = nr[0]; cr[1] = nr[1];
            if (mm + 2 < 32) { MR_LOAD(nr[0], rowb + 128 * (mm + 2)); MR_LOAD(nr[1], rowb + 128 * (mm + 3)); }
#pragma unroll
            for (int q = 0; q < 2; ++q) { const size_t m = rowb + 128 * (mm + q); const Row& R = cr[q];
            const float mx = fmaxf(R.l1, fmaxf(R.l2, R.l3)); float e1 = __builtin_amdgcn_exp2f(R.l1 - mx), e2 = __builtin_amdgcn_exp2f(R.l2 - mx), e3 = __builtin_amdgcn_exp2f(R.l3 - mx);
            const float inv = 1.f / (e1 + e2 + e3); e1 *= inv; e2 *= inv; e3 *= inv;
            float yf[8], a1[8], a2[8], a3[8], yd[8]; unpack8(R.wf, yf); unpack8(R.w1, a1); unpack8(R.w2, a2); unpack8(R.w3, a3);
            float sf = 0.f, sd = 0.f;
#pragma unroll
            for (int i = 0; i < 8; ++i) { yd[i] = e1 * a1[i] + e2 * a2[i] + e3 * a3[i]; sf += yf[i] * yf[i]; sd += yd[i] * yd[i]; }
            const float rf = 1.f / sqrtf(wave_sum(sf) * (1.f / HW) + EPS), rd = 1.f / sqrtf(wave_sum(sd) * (1.f / HW) + EPS);
            u32x4 of, od;
            of.x = cvt_pk_bf16(yf[0] * rf * gf[0], yf[1] * rf * gf[1]); of.y = cvt_pk_bf16(yf[2] * rf * gf[2], yf[3] * rf * gf[3]); of.z = cvt_pk_bf16(yf[4] * rf * gf[4], yf[5] * rf * gf[5]); of.w = cvt_pk_bf16(yf[6] * rf * gf[6], yf[7] * rf * gf[7]);
            od.x = cvt_pk_bf16(yd[0] * rd * gd[0], yd[1] * rd * gd[1]); od.y = cvt_pk_bf16(yd[2] * rd * gd[2], yd[3] * rd * gd[3]); od.z = cvt_pk_bf16(yd[4] * rd * gd[4], yd[5] * rd * gd[5]); od.w = cvt_pk_bf16(yd[6] * rd * gd[6], yd[7] * rd * gd[7]);
            *(GAS u32x4*)(YM + m * DM + 8 * F.lane) = of; *(GAS u32x4*)(YM + m * DM + HW + 8 * F.lane) = od; }
        }
    }
#undef MR_LOAD
}
__device__ __forceinline__ void route_rows(Frame& F, int pm, const float* logits, const float* rbias, unsigned* list, float* wts, unsigned* pose) {
    LAS unsigned* lcount = (LAS unsigned*)F.lds;
    LAS unsigned* lbase = lcount + 256;
    LAS unsigned* lsel = lbase + 256;
    LAS unsigned* lwt = lsel + 2048;
    if (F.tid < 256) lcount[F.tid] = 0u;
    __syncthreads();
    const f32x4 rb = *(const f32x4*)(rbias + 4 * F.lane);
#define DPPF(x, ctrl) __int_as_float(__builtin_amdgcn_update_dpp(0, __float_as_int(x), ctrl, 0xF, 0xF, false))
#define DPPUMAX(v, ctrl, rm) v = max(v, (unsigned)__builtin_amdgcn_update_dpp(0, (int)v, ctrl, rm, 0xF, false))
    f32x4 lgn = *(const GAS f32x4*)(logits + ((size_t)pm * 256 + F.wave * 32) * NEXP + 4 * F.lane);
    for (int i = 0; i < 32; ++i) { const int rl = F.wave * 32 + i; const size_t row = (size_t)pm * 256 + rl;
        const f32x4 lg = lgn;
        if (i + 1 < 32) lgn = *(const GAS f32x4*)(logits + (row + 1) * NEXP + 4 * F.lane);
        float s[4], sel[4];
#pragma unroll
        for (int q = 0; q < 4; ++q) { s[q] = 1.f / (1.f + __expf(-lg[q])); sel[q] = s[q] + rb[q]; }
        float m1 = -INFINITY, m2 = -INFINITY;
#pragma unroll
        for (int q = 0; q < 4; ++q) { if (sel[q] > m1) { m2 = m1; m1 = sel[q]; } else if (sel[q] > m2) m2 = sel[q]; }
        { float b1 = DPPF(m1, 0xB1), b2 = DPPF(m2, 0xB1); float n1 = fmaxf(m1, b1), n2 = fmaxf(fminf(m1, b1), fmaxf(m2, b2)); m1 = n1; m2 = n2;
          b1 = DPPF(m1, 0x4E); b2 = DPPF(m2, 0x4E); n1 = fmaxf(m1, b1); n2 = fmaxf(fminf(m1, b1), fmaxf(m2, b2)); m1 = n1; m2 = n2;
          b1 = DPPF(m1, 0x141); b2 = DPPF(m2, 0x141); n1 = fmaxf(m1, b1); n2 = fmaxf(fminf(m1, b1), fmaxf(m2, b2)); m1 = n1; m2 = n2; }
        const float gs = m1 + m2; const int g = F.lane >> 3; int rank = 0;
#pragma unroll
        for (int gg = 0; gg < 8; ++gg) { const float og = __int_as_float(__builtin_amdgcn_readlane(__float_as_int(gs), gg * 8)); rank += (og > gs || (og == gs && gg < g)) ? 1 : 0; }
        const bool gsel = rank < 4;
        unsigned key[4];
#pragma unroll
        for (int q = 0; q < 4; ++q) { const unsigned bq = __float_as_uint(sel[q]); key[q] = gsel ? (bq ^ ((bq >> 31) ? 0xffffffffu : 0x80000000u)) : 0u; }
        int myE = 0; float myS = 0.f, ssum = 0.f;
#pragma unroll 1
        for (int k = 0; k < TOPK; ++k) {
            unsigned v = max(max(key[0], key[1]), max(key[2], key[3]));
            DPPUMAX(v, 0xB1, 0xF); DPPUMAX(v, 0x4E, 0xF); DPPUMAX(v, 0x141, 0xF); DPPUMAX(v, 0x140, 0xF); DPPUMAX(v, 0x142, 0xA); DPPUMAX(v, 0x143, 0xC);
            const unsigned best = (unsigned)__builtin_amdgcn_readlane((int)v, 63);
            const int myq = (key[0] == best) ? 0 : (key[1] == best) ? 1 : (key[2] == best) ? 2 : (key[3] == best) ? 3 : 4;
            const unsigned long long bal = __ballot(myq < 4);
            const int L = __builtin_amdgcn_readfirstlane((int)__ffsll((long long)bal) - 1);
            const int q = __builtin_amdgcn_readlane(myq, L);
            const float mys = (q == 0) ? s[0] : (q == 1) ? s[1] : (q == 2) ? s[2] : s[3];
            const float sk = __int_as_float(__builtin_amdgcn_readlane(__float_as_int(mys), L));
            if (F.lane == L) {
#pragma unroll
                for (int qq = 0; qq < 4; ++qq) if (qq == q) key[qq] = 0u; }
            if (F.lane == k) { myE = 4 * L + q; myS = sk; }
            ssum += sk;
        }
        if (F.lane < TOPK) { const unsigned lp = atomicAdd((unsigned*)(lcount + myE), 1u); lsel[rl * 8 + F.lane] = (unsigned)myE | (lp << 8); lwt[rl * 8 + F.lane] = __float_as_uint(myS / ssum * 2.5f); }
    }
#undef DPPF
#undef DPPUMAX
    __syncthreads();
    if (F.tid < 256) { const unsigned n = lcount[F.tid]; lbase[F.tid] = n ? __hip_atomic_fetch_add((unsigned*)(F.ctl + CW_CNT + F.tid), n, RLX_AGENT) : 0u; }
    __syncthreads();
    for (int a = F.tid; a < 2048; a += NWAVES * 64) { const unsigned se = lsel[a]; const unsigned e = se & 255u, lp = se >> 8; const unsigned pos = lbase[e] + lp; const unsigned tok = (unsigned)(pm * 256 + (a >> 3));
        wts[(size_t)tok * TOPK + (a & 7)] = __uint_as_float(lwt[a]); pose[(size_t)tok * TOPK + (a & 7)] = (e << 16) | (pos & 0xffffu);
        if (pos < (unsigned)LCAP) list[(size_t)e * LCAP + pos] = tok | ((unsigned)(a & 7) << 16); }
    __syncthreads();
}
__device__ __forceinline__ void build_tables(Frame& F) {
    LAS unsigned* tp = (LAS unsigned*)(F.lds + TAB_OFF); LAS unsigned* cn = tp + 260; LAS unsigned* cp = cn + 256; LAS unsigned* wt = cp + 256;
    __syncthreads();
    unsigned cnt = 0u, tiles = 0u, incl = 0u, cincl = 0u;
    if (F.tid < 256) { cnt = __hip_atomic_load((unsigned*)(F.ctl + CW_CNT + F.tid), RLX_AGENT); if (cnt > (unsigned)LCAP) cnt = LCAP; tiles = (cnt + 255u) >> 8; incl = tiles; cincl = cnt;
#pragma unroll
        for (int o = 1; o < 64; o <<= 1) { const unsigned t = __shfl_up(incl, o), t2 = __shfl_up(cincl, o); if (F.lane >= o) { incl += t; cincl += t2; } }
        if (F.lane == 63) { wt[F.wave] = incl; wt[8 + F.wave] = cincl; } }
    __syncthreads();
    if (F.tid < 256) { unsigned base = 0u, cbase = 0u; for (int w = 0; w < F.wave; ++w) { base += wt[w]; cbase += wt[8 + w]; } tp[F.tid + 1] = base + incl; cn[F.tid] = cnt; cp[F.tid] = cbase + cincl - cnt; if (F.tid == 0) tp[0] = 0u;
        LAS unsigned short* mt2e = (LAS unsigned short*)(F.lds + MT2E_OFF); const unsigned t0 = base + incl - tiles; for (unsigned t = 0; t < tiles; ++t) mt2e[t0 + t] = (unsigned short)F.tid; }
    __syncthreads();
}
__device__ __forceinline__ void combine_rows(Frame& F, const float* gate2, const float* g_final, float* dst) {
    const unsigned char* Y = (const unsigned char*)(F.ws + WS_YBUF); const float* WT = (const float*)(F.ws + WS_WTS); const unsigned* PE = (const unsigned*)(F.ws + WS_POSE);
    const LAS unsigned* cp = (const LAS unsigned*)(F.lds + TAB_OFF) + 260 + 256;
    const int gw = F.vcu * NWAVES + F.wave, NGW = F.G * NWAVES; const int c0 = 16 * F.lane;
    const unsigned char* YS = (const unsigned char*)(F.ws + WS_YSH);
    struct CRow { u32x4 yv[8]; u32x4 ys, xb[2]; f32x4 w0, w1; };
#define CR_LOAD(R, m_) do { const size_t mq_ = (size_t)(m_); const unsigned pe_ = PE[mq_ * TOPK + (F.lane & 7)]; const unsigned myrow_ = cp[pe_ >> 16] + (pe_ & 0xffffu); \
        _Pragma("unroll") for (int k = 0; k < 8; ++k) { const size_t yr_ = (size_t)(unsigned)__builtin_amdgcn_readlane((int)myrow_, k); R.yv[k] = *(const GAS u32x4*)(Y + yr_ * DM + c0); } \
        R.ys = *(const GAS u32x4*)(YS + mq_ * DM + c0); const GAS u32x4* or_ = (const GAS u32x4*)(x1_row(F.ws, mq_) + c0); R.xb[0] = or_[0]; R.xb[1] = or_[1]; R.w0 = *(const GAS f32x4*)(WT + mq_ * TOPK); R.w1 = *(const GAS f32x4*)(WT + mq_ * TOPK + 4); } while (0)
    f32x4 gf[4];
#pragma unroll
    for (int j = 0; j < 4; ++j) gf[j] = *(const f32x4*)(g_final + c0 + 4 * j);
    for (int ch = gw; ch < M / 32; ch += NGW) {
        const int b = ch >> 7; const size_t rowb = (size_t)b * SEQ + (ch & 127);
        f32x4 g2[4];
#pragma unroll
        for (int j = 0; j < 4; ++j) g2[j] = *(const f32x4*)(gate2 + (size_t)b * NMOD + c0 + 4 * j) * (1.f / YSCALE);
        CRow nr; CR_LOAD(nr, rowb);
        for (int mm = 0; mm < 32; ++mm) { const size_t m = rowb + 128 * mm;
            CRow R = nr;
            if (mm + 1 < 32) CR_LOAD(nr, m + 128);
            const float wk[8] = {R.w0.x, R.w0.y, R.w0.z, R.w0.w, R.w1.x, R.w1.y, R.w1.z, R.w1.w};
            f32x4 acc[4];
#pragma unroll
            for (int j = 0; j < 4; ++j) { const int wv = (int)R.ys[j]; const f32x2 lo = __builtin_amdgcn_cvt_pk_f32_fp8(wv, false), hi = __builtin_amdgcn_cvt_pk_f32_fp8(wv, true); f32x4 a = (f32x4){lo.x, lo.y, hi.x, hi.y};
#pragma unroll
                for (int k = 0; k < 8; ++k) { const int wk_ = (int)R.yv[k][j]; const f32x2 l2 = __builtin_amdgcn_cvt_pk_f32_fp8(wk_, false), h2 = __builtin_amdgcn_cvt_pk_f32_fp8(wk_, true);
                    a.x += wk[k] * l2.x; a.y += wk[k] * l2.y; a.z += wk[k] * h2.x; a.w += wk[k] * h2.y; }
                acc[j] = a; __builtin_amdgcn_sched_barrier(0); }
            float s2 = 0.f; f32x4 v[4];
#pragma unroll
            for (int j = 0; j < 4; ++j) { const unsigned xa = R.xb[j >> 1][(j & 1) * 2], xc = R.xb[j >> 1][(j & 1) * 2 + 1]; const f32x4 xj = (f32x4){bf_lo(xa), bf_hi(xa), bf_lo(xc), bf_hi(xc)}; v[j] = xj + g2[j] * acc[j]; s2 += (v[j].x * v[j].x + v[j].y * v[j].y) + (v[j].z * v[j].z + v[j].w * v[j].w); }
            const float r = 1.f / sqrtf(wave_sum(s2) * (1.f / DM) + EPS);
            GAS f32x4* orow = (GAS f32x4*)(dst + m * DM + c0);
#pragma unroll
            for (int j = 0; j < 4; ++j) orow[j] = v[j] * r * gf[j];
        }
    }
#undef CR_LOAD
}

struct Args { const float* in[19]; float* out; unsigned char* ws; int ph_lo, ph_hi, li, pad; };
__global__ void __launch_bounds__(NWAVES * 64, 2) fwd_kernel(Args args) {
    extern __shared__ __attribute__((aligned(16))) unsigned char lds[];
    Frame F;
    F.lds = (LAS unsigned char*)lds;
    F.MISC = (volatile LAS unsigned*)(F.lds + MISC_OFF);
    F.tid = threadIdx.x; F.lane = F.tid & 63; F.wave = __builtin_amdgcn_readfirstlane(F.tid >> 6);
    F.G = gridDim.x; { const int bx = blockIdx.x; F.vcu = (F.G % 8 == 0) ? (bx % 8) * (F.G / 8) + bx / 8 : bx; }
    F.ws = args.ws; F.out = args.out; F.ctl = (gu32*)(args.ws + WS_CTL);
    unsigned char* ws = args.ws;
    typedef const __attribute__((address_space(4))) Args* KArgP;
#define KA(i) ({ KArgP p_ = (KArgP)__builtin_amdgcn_kernarg_segment_ptr(); asm volatile("" : "+s"(p_)); p_->in[i]; })
#define MOD ((float*)(ws + WS_MOD))
#define LF ((float*)(ws + WS_LF))
#define KB ((float*)(ws + WS_KB))
#define LSE ((float*)(ws + WS_LSE))
#define HB ((bf16_t*)(ws + WS_H))
#define QKV ((bf16_t*)(ws + WS_QKV))
#define LIST ((unsigned*)(ws + WS_LIST))
    for (int u = F.tid; u < (LDS_BYTES - LDSCTL_OFF) / 4; u += NWAVES * 64) ((LAS unsigned*)(F.lds + LDSCTL_OFF))[u] = 0u;
    __syncthreads();
    XcdBarrier bar; bar.bar = (unsigned*)(F.ctl + CW_BAR); bar.x = 0; bar.st = nullptr;
    if (N_LAUNCHES == 1) bar = xcd_barrier_post((unsigned*)(F.ctl + CW_BAR), F.MISC + 8);
#define GRID_BAR() do { if (N_LAUNCHES == 1) xcd_barrier(bar); } while (0)
#define REFRESH() do { int t_ = threadIdx.x; asm volatile("" : "+v"(t_)); F.tid = t_; F.lane = t_ & 63; } while (0)
    const int lo = args.ph_lo, hi = args.ph_hi;
#ifndef ONLY_PHASE
#define ONLY_PHASE -1
#endif
#define IN(k) ((ONLY_PHASE < 0 || ONLY_PHASE == (k)) && lo <= (k) && (k) < hi)
#define BOTH(k) (IN(k) && IN((k) + 1))

    if (IN(0)) {
        REFRESH();
        _Pragma("unroll") for (int rep_ = 0; rep_ < DUPN(0); ++rep_) {
        p0_mod(F, KA(1), KA(7), KA(8), MOD);
        P0Ptrs P{KA(2), KA(6), KA(9), KA(11), KA(12), KA(13), KA(14), KA(15), KA(16)};
        p0_weights(F, P, P0_EXPERT_ITEMS, P0_ALL_ITEMS); }
        if (BOTH(0)) GRID_BAR();
    }
    if (IN(1)) {
        REFRESH();
        _Pragma("unroll") for (int rep_ = 0; rep_ < DUPN(1); ++rep_) norm_rows<true>(F, KA(0), HB, MOD, 0, DM, KA(2), KA(3), LF, nullptr);
        if (BOTH(1)) GRID_BAR();
    }
    if (IN(2)) {
        REFRESH();
        _Pragma("unroll") for (int rep_ = 0; rep_ < DUPN(2); ++rep_) {
        scan_rows(F, LF, KB, (int*)(ws + WS_T0));
        pg8::Gemm g{HB, (const bf16_t*)(ws + WS_WIN), DM, nullptr}; pg8::StaticOrder S; S.init(M, 3072, F.G, (int)blockIdx.x);
        pg8::EpiQKV E{QKV, (size_t)M * HW, attn_body::C2};
        pg8::gemm_phase<pg8::EpiQKV, pg8::StaticOrder, false>(F.lds, g, S, E); }
        if (BOTH(2)) GRID_BAR();
    }
    if (IN(3)) {
        REFRESH();
        using attn_body::bf16; const float* rel_bias = KA(17);
        const bf16* Qf = (const bf16*)QKV; const bf16* Kf = Qf + (size_t)M * HW; const bf16* Vf = Kf + (size_t)M * HW;
        const bf16* Qd = Vf + (size_t)M * HW; const bf16* Kd = Qd + (size_t)M * HW; const bf16* Vd = Kd + (size_t)M * HW;
        bf16* OF = (bf16*)(ws + WS_OF);
        bool conv_done = false;
        const P0Ptrs PW{KA(2), KA(6), KA(9), KA(11), KA(12), KA(13), KA(14), KA(15), KA(16)};
        for (int cu = F.vcu; cu < 16 * BATCH; cu += F.G) {
            const int b = cu >> 4, j = cu & 15;
            int hc = 2 * (F.vcu & 3); asm volatile("" : "+s"(hc));
            for (int part = 0; part < 2; ++part) {
            if (part == 1 && !conv_done) { __syncthreads(); conv_experts(F, PW); __syncthreads(); conv_done = true; }
            const int h_lo = part ? hc : 0, h_hi = part ? NH : hc;
            for (int h = h_lo; h < h_hi; ++h) { const int q = (j + 4 * (h >> 1)) & 15; const int qb = (h & 1) ? 15 - q : q; const int bh = b * NH + h;
                const size_t hb = (size_t)b * SEQ * HW + h * HD; const int T0 = ((const int*)(ws + WS_T0))[bh * 16 + qb];
                if (DUPN(3) == 2) attn_body::attn_unit<8, 0>(Qf + hb, Kf + hb, Vf + hb, (bf16*)(ws + WS_SS0), (long)HW, 0L, qb * 256, T0, 4 * qb + 4 - T0, 0, nullptr, 0, (char*)lds, KB + (size_t)bh * SEQ, nullptr, 0);
                attn_body::attn_unit<8, 0>(Qf + hb, Kf + hb, Vf + hb, OF + hb, (long)HW, (long)HW, qb * 256, T0, 4 * qb + 4 - T0, 0, nullptr, 0, (char*)lds, KB + (size_t)bh * SEQ, nullptr, 0); }
            }
        }
        if (!conv_done) { __syncthreads(); conv_experts(F, PW); __syncthreads(); }
        for (int job = F.vcu; job < 2 * BATCH * NH; job += F.G) {
            const int bh = job >> 1, sub = job & 1, b = bh >> 3, h = bh & 7;
            const size_t hb = (size_t)b * SEQ * HW + h * HD;
            const int nd = sub ? 25 : 23; int tabkey = -1;
            { __syncthreads(); for (int i = F.tid; i < attn_body::DL_ZEND / 16; i += NWAVES * 64) *(LAS f32x4*)(F.lds + i * 16) = (f32x4){0.f, 0.f, 0.f, 0.f}; __syncthreads(); }
#define DIL_PARAMS(i_, dsel_, d_, r_, qb_) do { if ((i_) < 16) { if (sub == 0) { dsel_ = 0; d_ = 1; r_ = 0; qb_ = (i_); } else { dsel_ = 1; d_ = 4; r_ = (i_) >> 2; qb_ = (i_) & 3; } } \
                else { dsel_ = 2; d_ = 16; r_ = ((i_) - 16) + (sub ? 7 : 0); qb_ = 0; } } while (0)
            for (int i = 0; i < nd; ++i) {
                int dsel, d, r, qb; DIL_PARAMS(i, dsel, d, r, qb);
                int dseln = 0, dn = 1, rn = 0, qbn = 0; const bool has_next = (i + 1 < nd); if (has_next) DIL_PARAMS(i + 1, dseln, dn, rn, qbn);
                bf16* OB = (bf16*)(ws + (dsel == 0 ? WS_O1 : dsel == 1 ? WS_O2 : WS_O3));
                const size_t sb = hb + (size_t)r * HW, sbn = hb + (size_t)rn * HW;
                float* lsep = LSE + (size_t)dsel * M * NH + ((size_t)b * SEQ + r) * NH + h;
                const bool bt = (tabkey != dsel); tabkey = dsel;
                const attn_body::DilSrc cu{Kd + sb, Vd + sb, (long)d * HW, qb * 256, qb == 0}, nx{Kd + sbn, Vd + sbn, (long)dn * HW, qbn * 256, qbn == 0};
                _Pragma("unroll") for (int rep_ = 0; rep_ < DUPN(3); ++rep_)
                attn_body::dil_unit<8>(Qd + sb, cu, (i & 1) ? attn_body::DL_KB : attn_body::DL_K, i > 0 && DUPN(3) == 1, nx, has_next && DUPN(3) == 1, OB + sb, lsep, (long)d * NH, (char*)lds, rel_bias + h, dsel, bt); }
#undef DIL_PARAMS
        }
        if (BOTH(3)) GRID_BAR();
    }
    if (IN(4)) {
        REFRESH();
        _Pragma("unroll") for (int rep_ = 0; rep_ < DUPN(4); ++rep_) merge_rows(F, KA(4), KA(5));
        if (BOTH(4)) GRID_BAR();
    }
    if (IN(5)) {
        REFRESH();
        _Pragma("unroll") for (int rep_ = 0; rep_ < DUPN(5); ++rep_) {
        pg8::Gemm g{(const bf16_t*)(ws + WS_YM), (const bf16_t*)(ws + WS_WOUT), DM, nullptr}; pg8::StaticOrder S; S.init(M, DM, F.G, (int)blockIdx.x);
        pg8::EpiX1N E{KA(0), ws, MOD, F.lds, (float*)(ws + WS_EX), (unsigned*)(F.ctl + CW_X1)};
        pg8::gemm_phase<pg8::EpiX1N, pg8::StaticOrder, false>(F.lds, g, S, E); }
        if (BOTH(5)) GRID_BAR();
    }
    if (IN(6)) {
        REFRESH();
        (void)0;
    }
    if (IN(7)) {
        REFRESH();
        float* LOGITS = (float*)(ws + WS_LOGITS); const float* rbias_ = KA(10);
        { pg8::Gemm g{HB, (const bf16_t*)(ws + WS_WR), DM, nullptr}; pg8::StaticOrder S; S.init(M, NEXP, F.G, (int)blockIdx.x);
          pg8::EpiF32 E{LOGITS, NEXP};
          pg8::gemm_phase<pg8::EpiF32, pg8::StaticOrder, false>(F.lds, g, S, E);
          asm volatile("s_waitcnt vmcnt(0)" ::: "memory"); __syncthreads();
          pg8::Unit u; for (int i = 0; S.next(i, u); ++i) route_rows(F, u.pm, LOGITS, rbias_, LIST, (float*)(ws + WS_WTS), (unsigned*)(ws + WS_POSE)); }
        _Pragma("unroll") for (int rep_ = 0; rep_ < DUPN(7); ++rep_)
        { pg8::Gemm g{HB, (const bf16_t*)(ws + WS_WSHGU), DM, nullptr}; pg8::StaticOrder S; S.init(M, 512, F.G, (int)blockIdx.x);
          pg8::EpiSwiglu E{(bf16_t*)(ws + WS_ACTSH)};
          pg8::gemm_phase<pg8::EpiSwiglu, pg8::StaticOrder, false>(F.lds, g, S, E); }
        if (BOTH(7)) GRID_BAR();
    }
    if (IN(8)) {
        REFRESH();
        { pg8::Gemm g{(const bf16_t*)(ws + WS_ACTSH), (const bf16_t*)(ws + WS_WSHD), EH, nullptr}; pg8::StaticOrder S; S.init(M, DM, F.G, (int)blockIdx.x);
          pg8::EpiYbuf E{ws + WS_YSH, ws + WS_DUMP};
          pg8::gemm_phase<pg8::EpiYbuf, pg8::StaticOrder, false, false, true, 0, HOIST_SD>(F.lds, g, S, E); }
        build_tables(F);
#if PROBE_G1
        { pg8::Gemm g{(const bf16_t*)(ws + WS_H8), (const bf16_t*)(ws + WS_WGU), DM / 2, LIST};
          pg8::GroupedOrder S{(const LAS unsigned*)(F.lds + TAB_OFF), (const LAS unsigned*)(F.lds + TAB_OFF) + 260, 2, F.G, F.vcu, 2, 0, 0, (const LAS unsigned short*)(F.lds + MT2E_OFF)}; S.total = __builtin_amdgcn_readfirstlane((int)S.tp[256]) * 2;
          pg8::EpiSwiglu8 E{ws + WS_ACT};
          pg8::gemm_phase<pg8::EpiSwiglu8, pg8::GroupedOrder, true, true, true, PROBE_G1>(F.lds, g, S, E); }
#endif
        _Pragma("unroll") for (int rep_ = 0; rep_ < DUPN(8); ++rep_)
        { pg8::Gemm g{(const bf16_t*)(ws + WS_H8), (const bf16_t*)(ws + WS_WGU), DM / 2, LIST};
          pg8::GroupedOrder S{(const LAS unsigned*)(F.lds + TAB_OFF), (const LAS unsigned*)(F.lds + TAB_OFF) + 260, 2, F.G, F.vcu, 2, 0, 0, (const LAS unsigned short*)(F.lds + MT2E_OFF)}; S.total = __builtin_amdgcn_readfirstlane((int)S.tp[256]) * 2;
          pg8::EpiSwiglu8 E{ws + WS_ACT};
          pg8::gemm_phase<pg8::EpiSwiglu8, pg8::GroupedOrder, true, true, true, 0, HOIST_G1>(F.lds, g, S, E); }
        if (BOTH(8)) GRID_BAR();
    }
    if (IN(9)) {
        REFRESH();
        build_tables(F);
#if PROBE_G2
        { pg8::Gemm g{(const bf16_t*)(ws + WS_ACT), (const bf16_t*)(ws + WS_WD), EH / 2, LIST};
          pg8::GroupedOrder S{(const LAS unsigned*)(F.lds + TAB_OFF), (const LAS unsigned*)(F.lds + TAB_OFF) + 260, 4, F.G, F.vcu, 4, 0, 0, (const LAS unsigned short*)(F.lds + MT2E_OFF)}; S.total = __builtin_amdgcn_readfirstlane((int)S.tp[256]) * 4;
          pg8::EpiYbuf E{(unsigned char*)(ws + WS_YBUF), ws + WS_DUMP};
          pg8::gemm_phase<pg8::EpiYbuf, pg8::GroupedOrder, false, true, true, PROBE_G2>(F.lds, g, S, E); }
#endif
        _Pragma("unroll") for (int rep_ = 0; rep_ < DUPN(9); ++rep_)
        { pg8::Gemm g{(const bf16_t*)(ws + WS_ACT), (const bf16_t*)(ws + WS_WD), EH / 2, LIST};
          pg8::GroupedOrder S{(const LAS unsigned*)(F.lds + TAB_OFF), (const LAS unsigned*)(F.lds + TAB_OFF) + 260, 4, F.G, F.vcu, 4, 0, 0, (const LAS unsigned short*)(F.lds + MT2E_OFF)}; S.total = __builtin_amdgcn_readfirstlane((int)S.tp[256]) * 4;
          pg8::EpiYbuf E{(unsigned char*)(ws + WS_YBUF), ws + WS_DUMP};
          pg8::gemm_phase<pg8::EpiYbuf, pg8::GroupedOrder, false, true, true, 0, HOIST_G2>(F.lds, g, S, E); }
        if (BOTH(9)) GRID_BAR();
    }
    if (IN(10)) {
        REFRESH();
        build_tables(F);
        if (DUPN(10) == 2) combine_rows(F, MOD + 5 * DM, KA(18), (float*)(ws + WS_ACT));
        combine_rows(F, MOD + 5 * DM, KA(18), F.out);
    }
#undef KA
#undef MOD
#undef LF
#undef KB
#undef LSE
#undef HB
#undef QKV
#undef LIST
#undef REFRESH
#undef IN
#undef BOTH
#undef GRID_BAR
}

extern "C" void kernel_launch(void* const* d_in, const int* in_sizes, int n_in, void* d_out, int out_size, void* d_ws, size_t ws_size, hipStream_t stream) {
    static int grid = 0;
    if (grid == 0) {
        if (n_in != 19 || in_sizes[0] != M * DM || out_size != M * DM || ws_size < WS_NEED) {
            fprintf(stderr, "kernel_launch: unexpected shapes: n_in %d in0 %d out %d ws %zu (need %zu); nothing launched\n", n_in, n_in > 0 ? in_sizes[0] : -1, out_size, ws_size, (size_t)WS_NEED); grid = -1; return; }
        int dev = 0, cus = 0, per_cu = 0;
        if (hipGetDevice(&dev) != hipSuccess || hipDeviceGetAttribute(&cus, hipDeviceAttributeMultiprocessorCount, dev) != hipSuccess) { fprintf(stderr, "kernel_launch: device query failed\n"); grid = -1; return; }
        if (hipFuncSetAttribute((const void*)fwd_kernel, hipFuncAttributeMaxDynamicSharedMemorySize, LDS_BYTES) != hipSuccess) { fprintf(stderr, "kernel_launch: hipFuncSetAttribute failed\n"); grid = -1; return; }
        if (hipOccupancyMaxActiveBlocksPerMultiprocessor(&per_cu, (const void*)fwd_kernel, NWAVES * 64, LDS_BYTES) != hipSuccess || per_cu < 1)
            fprintf(stderr, "kernel_launch: note: occupancy query reports %d workgroups per CU\n", per_cu);
        (void)hipGetLastError();
        grid = cus;
    }
    if (grid < 0) return;
    if (hipMemsetAsync((char*)d_ws + WS_CTL, 0, CTL_ZERO_BYTES, stream) != hipSuccess) { fprintf(stderr, "kernel_launch: memset failed\n"); return; }
    Args a{};
    for (int i = 0; i < 19; ++i) a.in[i] = (const float*)d_in[i];
    a.out = (float*)d_out; a.ws = (unsigned char*)d_ws; a.pad = 0;
    for (int li = 0; li < N_LAUNCHES; ++li) {
        a.ph_lo = (N_LAUNCHES == 1) ? 0 : li; a.ph_hi = (N_LAUNCHES == 1) ? NPHASE : li + 1; a.li = li;
        hipLaunchKernelGGL(fwd_kernel, dim3(grid), dim3(NWAVES * 64), LDS_BYTES, stream, a);
        const hipError_t le = hipPeekAtLastError();
        if (le != hipSuccess) { fprintf(stderr, "kernel_launch: launch %d failed: %s\n", li, hipGetErrorName(le)); break; }
    }
}
```

```cpp
#include <hip/hip_runtime.h>
#include <hip/hip_bf16.h>
#include <cstdio>
#include <cstdint>

#ifndef DUP_MASK
#define DUP_MASK 0
#endif
#ifndef CONV_PROBE
#define CONV_PROBE 0
#endif
#ifndef HOIST_SD
#define HOIST_SD false
#endif
#ifndef HOIST_G1
#define HOIST_G1 false
#endif
#ifndef HOIST_G2
#define HOIST_G2 true
#endif
#ifndef PROBE_G1
#define PROBE_G1 0
#endif
#ifndef PROBE_G2
#define PROBE_G2 0
#endif
#define DUPN(k) (((DUP_MASK >> (k)) & 1) ? 2 : 1)
#ifndef MK_N_LAUNCHES
#define MK_N_LAUNCHES 1
#endif

#define GAS __attribute__((address_space(1)))
#define LAS __attribute__((address_space(3)))

constexpr int BATCH = 16, SEQ = 4096, DM = 1024, M = BATCH * SEQ;
constexpr int NH = 8, HD = 64, HW = NH * HD;
constexpr int INC = 3080;
constexpr int NEXP = 256, TOPK = 8, EH = 256;
constexpr int NMOD = 6 * DM;
constexpr int LCAP = 65536;
constexpr float LOG2E = 1.4426950408889634f;
constexpr float EPS = 1e-6f;
constexpr float FOX_SKIP_LOG2 = 80.f;
constexpr float YSCALE = 16.f;
constexpr int NWAVES = 8;
constexpr int NPHASE = 11;
constexpr int N_LAUNCHES = MK_N_LAUNCHES;

constexpr size_t MiB = 1u << 20;
constexpr size_t WS_CTL = 0, CTL_ZERO_BYTES = 1 * MiB;
constexpr size_t WS_DUMP = 512 * 1024;
constexpr size_t WS_MOD = 1 * MiB;
constexpr size_t WS_LF = 2 * MiB;
constexpr size_t WS_KB = 4 * MiB;
constexpr size_t WS_LSE = 6 * MiB;
constexpr size_t WS_WIN = 12 * MiB;
constexpr size_t WS_WOUT = 18 * MiB;
constexpr size_t WS_WR = 20 * MiB;
constexpr size_t WS_WSHGU = WS_WR + MiB / 2;
constexpr size_t WS_WSHD = WS_WSHGU + MiB;
constexpr size_t WS_WTS = 22 * MiB;
constexpr size_t WS_SS0 = WS_MOD + MiB / 2;
constexpr size_t WS_T0 = WS_MOD + MiB / 2 + 65536;
constexpr size_t WS_WD = 24 * MiB;
constexpr size_t WS_WGU = 88 * MiB;
constexpr size_t WS_LIST = 216 * MiB;
constexpr size_t WS_O3 = WS_LIST;
constexpr size_t WS_H = 280 * MiB;
constexpr size_t WS_H8 = 408 * MiB;
constexpr size_t WS_QKV = 472 * MiB;
constexpr size_t WS_ACT = 856 * MiB;
constexpr size_t WS_YSH = 792 * MiB;
constexpr size_t WS_X1A = 728 * MiB;
constexpr size_t WS_X1B = 1000 * MiB;
constexpr size_t WS_END = 1000 * MiB, WS_NEED = 1064 * MiB;
constexpr size_t WS_YBUF = WS_LIST;
constexpr size_t WS_EX = WS_LSE + 4 * MiB;
constexpr size_t WS_POSE = WS_LSE;
constexpr size_t WS_OF = WS_QKV;
constexpr size_t WS_O1 = WS_H, WS_O2 = WS_H + 64 * MiB;
constexpr size_t WS_YM = WS_QKV + 64 * MiB;
constexpr size_t WS_LOGITS = WS_QKV;
constexpr size_t WS_ACTSH = WS_QKV + 64 * MiB;
static_assert(WS_ACT + (size_t)(M * TOPK + NEXP * 256) * EH <= WS_END, "act fits");
static_assert(WS_YBUF + (size_t)M * TOPK * DM <= WS_X1A && WS_X1A + 64 * MiB <= WS_YSH && WS_YSH + (size_t)M * DM <= WS_ACT && WS_X1B + 64 * MiB <= WS_NEED, "ybuf (unpadded rows), x1, ysh fit below act");
static_assert(WS_QKV + 6 * 64 * MiB <= WS_ACT, "qkv below act");
constexpr int CW_TMO = 0, CW_BAR = 4096, CW_CNT = 8192, CW_X1 = 12288;

constexpr int RING_BYTES = 131072;
constexpr int PHASE_LDS = 158720;
constexpr int LDSCTL_OFF = PHASE_LDS, MISC_OFF = LDSCTL_OFF + 320;
constexpr int TAB_OFF = MISC_OFF + 128;
constexpr int RLIST_OFF = RING_BYTES + 2304 * 2;
constexpr int MT2E_OFF = RING_BYTES;
constexpr int LDS_BYTES = 163840;
static_assert(TAB_OFF + 800 * 4 <= LDS_BYTES, "LDS map");

typedef unsigned short bf16_t;
typedef short bf16x8 __attribute__((ext_vector_type(8)));
typedef float f32x4 __attribute__((ext_vector_type(4)));
typedef float f32x2 __attribute__((ext_vector_type(2)));
typedef unsigned u32x4 __attribute__((ext_vector_type(4)));
typedef unsigned u32x2 __attribute__((ext_vector_type(2)));
typedef GAS unsigned gu32;
typedef int v4i_t __attribute__((ext_vector_type(4)));
typedef int v8i_t __attribute__((ext_vector_type(8)));
#define RLX_AGENT __ATOMIC_RELAXED, __HIP_MEMORY_SCOPE_AGENT

__device__ __forceinline__ unsigned cvt_pk_bf16(float lo, float hi) { unsigned r; asm volatile("v_cvt_pk_bf16_f32 %0, %1, %2" : "=v"(r) : "v"(lo), "v"(hi)); return r; }
__device__ __forceinline__ float bf_lo(unsigned w) { return __uint_as_float(w << 16); }
__device__ __forceinline__ float bf_hi(unsigned w) { return __uint_as_float(w & 0xffff0000u); }
__device__ __forceinline__ bf16_t* x1_row(unsigned char* ws, size_t m) { return (bf16_t*)(ws + (m < 32768 ? WS_X1A + m * 2048 : WS_X1B + (m - 32768) * 2048)); }
#define DPPF_(x, ctrl, rm) __int_as_float(__builtin_amdgcn_update_dpp(0, __float_as_int(x), ctrl, rm, 0xF, false))
__device__ __forceinline__ float wave_sum(float v) {
    v += DPPF_(v, 0xB1, 0xF); v += DPPF_(v, 0x4E, 0xF); v += DPPF_(v, 0x141, 0xF); v += DPPF_(v, 0x140, 0xF);
    v += DPPF_(v, 0x142, 0xA); v += DPPF_(v, 0x143, 0xC);
    return __int_as_float(__builtin_amdgcn_readlane(__float_as_int(v), 63));
}
__device__ __forceinline__ float reduce8_heads(const float (&f)[8], int lane) {
    float a[4], b[2];
#pragma unroll
    for (int i = 0; i < 4; ++i) { auto rr = __builtin_amdgcn_permlane32_swap(__float_as_uint(f[i]), __float_as_uint(f[i + 4]), false, false); a[i] = __uint_as_float(rr[0]) + __uint_as_float(rr[1]); }
#pragma unroll
    for (int i = 0; i < 2; ++i) { auto rr = __builtin_amdgcn_permlane16_swap(__float_as_uint(a[i]), __float_as_uint(a[i + 2]), false, false); b[i] = __uint_as_float(rr[0]) + __uint_as_float(rr[1]); }
    const bool b3 = (lane & 8) != 0; const float mine = b3 ? b[1] : b[0], give = b3 ? b[0] : b[1];
    float v = mine + DPPF_(give, 0x128, 0xF);
    v += DPPF_(v, 0xB1, 0xF); v += DPPF_(v, 0x4E, 0xF); v += DPPF_(v, 0x141, 0xF);
    return v;
}

__device__ const unsigned char T5B[3][132] = {
 {0,1,2,3,4,5,6,7,8,9,10,11,12,13,14,15,16,16,16,16,16,16,17,17,17,17,17,17,17,17,18,18,18,18,18,18,18,18,18,18,19,19,19,19,19,19,19,19,19,19,19,19,19,19,20,20,20,20,20,20,20,20,20,20,20,20,20,20,20,20,20,20,20,21,21,21,21,21,21,21,21,21,21,21,21,21,21,21,21,21,21,21,21,21,21,21,21,21,21,22,22,22,22,22,22,22,22,22,22,22,22,22,22,22,22,22,22,22,22,22,22,22,22,22,22,22,22,22,22,0,0,0},
 {0,4,8,12,16,16,17,17,18,18,19,19,19,19,20,20,20,20,20,21,21,21,21,21,21,22,22,22,22,22,22,22,22,22,23,23,23,23,23,23,23,23,23,23,23,23,24,24,24,24,24,24,24,24,24,24,24,24,24,24,24,24,25,25,25,25,25,25,25,25,25,25,25,25,25,25,25,25,25,25,25,25,25,26,26,26,26,26,26,26,26,26,26,26,26,26,26,26,26,26,26,26,26,26,26,26,26,26,26,26,26,26,26,27,27,27,27,27,27,27,27,27,27,27,27,27,27,27,27,0,0,0},
 {0,16,18,19,20,21,21,22,22,23,23,23,24,24,24,24,25,25,25,25,25,26,26,26,26,26,26,26,26,27,27,27,27,27,27,27,27,27,27,28,28,28,28,28,28,28,28,28,28,28,28,28,29,29,29,29,29,29,29,29,29,29,29,29,29,29,29,29,29,29,30,30,30,30,30,30,30,30,30,30,30,30,30,30,30,30,30,30,30,30,30,30,30,30,30,31,31,31,31,31,31,31,31,31,31,31,31,31,31,31,31,31,31,31,31,31,31,31,31,31,31,31,31,31,31,31,31,31,31,0,0,0}};

namespace pg8 {
constexpr int BM = 256, BK = 64, HALF = 128, HTB = HALF * BK * 2, STAGE_BYTES = 8 * HTB, NXCD = 8, WGM = 8;
__host__ __device__ __forceinline__ int lds_byte(int r, int c) { const int st = (r >> 4) * 2 + (c >> 5), rr = r & 15, cc = c & 31, ob = rr * 64 + cc * 2; return st * 1024 + (ob ^ (((ob >> 9) & 1) << 5)); }
__host__ __device__ __forceinline__ void stage_rc(int b, int& R, int& C) { const int st = b / 1024, sb = b % 1024, swz = sb ^ (((sb >> 9) & 1) << 5); R = (st >> 1) * 16 + swz / 64; C = (st & 1) * 32 + (swz % 64) / 2; }
__host__ __device__ __forceinline__ int perm32(int rho) { const int n = rho >> 4, i = rho & 15; return 8 * (i >> 2) + 4 * n + (i & 3); }

struct Unit { int pm, pn, pb, e, tile, cnt, yrow; };
struct Gemm { const bf16_t* A; const bf16_t* Bt; int K; const unsigned* list; };

struct StaticOrder {
    int nM, nN, nwg, G, c;
    __device__ void init(int Mr, int N, int G_, int c_) { nM = Mr / BM; nN = N / BM; nwg = nM * nN; G = G_; c = c_; }
    __device__ bool next(int i, Unit& u) const {
        const int L = i * G + c; if (L >= nwg) return false;
        int wgid = L; { const int q = nwg / NXCD, r = nwg % NXCD, xcd = wgid % NXCD, off = wgid / NXCD; wgid = (xcd < r ? xcd * (q + 1) : r * (q + 1) + (xcd - r) * q) + off; }
        const int nig = WGM * nN, gid = wgid / nig, fm = gid * WGM, gsz = (nM - fm) < WGM ? (nM - fm) : WGM;
        u.pm = fm + ((wgid % nig) % gsz); u.pn = (wgid % nig) / gsz; u.pb = u.pn; u.e = 0; u.tile = 0; u.cnt = 1 << 30; u.yrow = u.pm * BM; return true;
    }
};
struct GroupedOrder {
    const LAS unsigned* tp; const LAS unsigned* cn; int NT, G, c, NTB, pn0, total;
    const LAS unsigned short* mt2e;
    __device__ bool next(int i, Unit& u) const {
        const int L = i * G + c; if (L >= total) return false;
        const int mt = L / NT; u.pn = L % NT;
        const int lo = __builtin_amdgcn_readfirstlane((int)mt2e[mt]);
        u.e = lo; u.pm = mt; u.tile = mt - __builtin_amdgcn_readfirstlane((int)tp[lo]); u.pb = lo * NTB + pn0 + u.pn; u.cnt = __builtin_amdgcn_readfirstlane((int)cn[lo]); u.yrow = __builtin_amdgcn_readfirstlane((int)cn[256 + lo]) + u.tile * BM; return true;
    }
};

struct EpiQKV {
    static constexpr bool PERM = true; static constexpr int NVM = 16;
    bf16_t* O; size_t split_stride; float scale0;
    __device__ __forceinline__ void operator()(const f32x4 (&acc)[2][2][4][2], const Unit& u, int wr, int wc, int fr, int fq) const {
        const int row0 = u.pm * BM + wr * 64 + fr; int colt = u.pn * BM; const int t = colt / 512; bf16_t* base = O + (size_t)t * split_stride; colt -= t * 512;
        const float sc = (t == 0 || t == 3) ? scale0 : 1.f;
        const int col0 = colt + wc * 32 + 8 * fq;
#pragma unroll
        for (int ai = 0; ai < 2; ++ai)
#pragma unroll
            for (int m = 0; m < 4; ++m) { bf16_t* rowp = base + (size_t)(row0 + ai * HALF + m * 16) * 512 + col0;
#pragma unroll
                for (int bj = 0; bj < 2; ++bj) { const f32x4 v0 = acc[ai][bj][m][0] * sc, v1 = acc[ai][bj][m][1] * sc;
                    u32x4 w; w.x = cvt_pk_bf16(v0[0], v0[1]); w.y = cvt_pk_bf16(v0[2], v0[3]); w.z = cvt_pk_bf16(v1[0], v1[1]); w.w = cvt_pk_bf16(v1[2], v1[3]);
                    *(u32x4*)(rowp + bj * HALF) = w; } }
    }
};
struct EpiSwiglu {
    static constexpr bool PERM = true; static constexpr int NVM = 8;
    bf16_t* O;
    __device__ __forceinline__ void operator()(const f32x4 (&acc)[2][2][4][2], const Unit& u, int wr, int wc, int fr, int fq) const {
        const int row0 = u.pm * BM + wr * 64 + fr; const int col0 = u.pn * HALF + wc * 32 + 8 * fq;
#pragma unroll
        for (int ai = 0; ai < 2; ++ai)
#pragma unroll
            for (int m = 0; m < 4; ++m) { bf16_t* rowp = O + (size_t)(row0 + ai * HALF + m * 16) * EH + col0; float r[8];
#pragma unroll
                for (int n = 0; n < 2; ++n)
#pragma unroll
                    for (int i = 0; i < 4; ++i) { const float g = acc[ai][0][m][n][i], up = acc[ai][1][m][n][i]; r[n * 4 + i] = g * __builtin_amdgcn_rcpf(1.f + __expf(-g)) * up; }
                u32x4 w; w.x = cvt_pk_bf16(r[0], r[1]); w.y = cvt_pk_bf16(r[2], r[3]); w.z = cvt_pk_bf16(r[4], r[5]); w.w = cvt_pk_bf16(r[6], r[7]);
                *(u32x4*)rowp = w; }
    }
};
struct EpiSwiglu8 {
    static constexpr bool PERM = true; static constexpr int NVM = 4;
    unsigned char* O;
    __device__ __forceinline__ void operator()(const f32x4 (&acc)[2][2][4][2], const Unit& u, int wr, int wc, int fr, int fq) const {
        const size_t row0 = (size_t)u.pm * BM + wr * 64 + fr + (fq & 1) * HALF; const int col0 = u.pn * HALF + wc * 32 + 8 * (fq & 2);
#pragma unroll
        for (int m = 0; m < 4; ++m) { unsigned w[2][2];
#pragma unroll
            for (int ai = 0; ai < 2; ++ai) { float r[8];
#pragma unroll
                for (int n = 0; n < 2; ++n)
#pragma unroll
                    for (int i = 0; i < 4; ++i) { const float g = acc[ai][0][m][n][i], up = acc[ai][1][m][n][i]; r[n * 4 + i] = g * __builtin_amdgcn_rcpf(1.f + __expf(-g)) * up; }
                int w0 = __builtin_amdgcn_cvt_pk_fp8_f32(r[0], r[1], 0, false); w0 = __builtin_amdgcn_cvt_pk_fp8_f32(r[2], r[3], w0, true);
                int w1 = __builtin_amdgcn_cvt_pk_fp8_f32(r[4], r[5], 0, false); w1 = __builtin_amdgcn_cvt_pk_fp8_f32(r[6], r[7], w1, true);
                w[ai][0] = (unsigned)w0; w[ai][1] = (unsigned)w1; }
            const auto s0 = __builtin_amdgcn_permlane16_swap(w[0][0], w[1][0], false, false); const auto s1 = __builtin_amdgcn_permlane16_swap(w[0][1], w[1][1], false, false);
            u32x4 o; o.x = s0[0]; o.y = s1[0]; o.z = s0[1]; o.w = s1[1];
            *(u32x4*)(O + (row0 + m * 16) * EH + col0) = o; }
    }
};
struct EpiRes {
    static constexpr bool PERM = true; static constexpr int NVM = 0;
    const float* base; float* out; const float* gate;
    __device__ __forceinline__ void operator()(const f32x4 (&acc)[2][2][4][2], const Unit& u, int wr, int wc, int fr, int fq) const {
        const int b = u.pm >> 4; const int col0 = u.pn * BM + wc * 32 + 8 * fq; f32x4 gv[2][2];
#pragma unroll
        for (int bj = 0; bj < 2; ++bj)
#pragma unroll
            for (int n = 0; n < 2; ++n) gv[bj][n] = *(const f32x4*)(gate + (size_t)b * NMOD + col0 + bj * HALF + n * 4);
#pragma unroll
        for (int ai = 0; ai < 2; ++ai)
#pragma unroll
            for (int m = 0; m < 4; ++m) { const size_t off = (size_t)(u.pm * BM + ai * HALF + wr * 64 + m * 16 + fr) * DM + col0;
#pragma unroll
                for (int bj = 0; bj < 2; ++bj)
#pragma unroll
                    for (int n = 0; n < 2; ++n) { const f32x4 bs = *(const f32x4*)(base + off + bj * HALF + n * 4); *(f32x4*)(out + off + bj * HALF + n * 4) = bs + gv[bj][n] * acc[ai][bj][m][n]; } }
    }
};
struct EpiX1 {
    static constexpr bool PERM = true; static constexpr int NVM = 8;
    const float* base; unsigned char* ws; const float* gate;
    __device__ __forceinline__ void operator()(const f32x4 (&acc)[2][2][4][2], const Unit& u, int wr, int wc, int fr, int fq) const {
        const int b = u.pm >> 4; const int col0 = u.pn * BM + wc * 32 + 8 * fq; f32x4 gv[2][2];
#pragma unroll
        for (int bj = 0; bj < 2; ++bj)
#pragma unroll
            for (int n = 0; n < 2; ++n) gv[bj][n] = *(const f32x4*)(gate + (size_t)b * NMOD + col0 + bj * HALF + n * 4);
#pragma unroll
        for (int ai = 0; ai < 2; ++ai) { f32x4 pre[4][2][2];
#pragma unroll
            for (int m = 0; m < 4; ++m) { const size_t off = ((size_t)u.pm * BM + ai * HALF + wr * 64 + m * 16 + fr) * DM + col0;
#pragma unroll
                for (int bj = 0; bj < 2; ++bj) { pre[m][bj][0] = *(const f32x4*)(base + off + bj * HALF); pre[m][bj][1] = *(const f32x4*)(base + off + bj * HALF + 4); } }
            asm volatile("" ::: "memory");
#pragma unroll
            for (int m = 0; m < 4; ++m) { const size_t row = (size_t)u.pm * BM + ai * HALF + wr * 64 + m * 16 + fr; bf16_t* orow = x1_row(ws, row) + col0;
#pragma unroll
                for (int bj = 0; bj < 2; ++bj) { const f32x4 v0 = pre[m][bj][0] + gv[bj][0] * acc[ai][bj][m][0], v1 = pre[m][bj][1] + gv[bj][1] * acc[ai][bj][m][1];
                    u32x4 w; w.x = cvt_pk_bf16(v0[0], v0[1]); w.y = cvt_pk_bf16(v0[2], v0[3]); w.z = cvt_pk_bf16(v1[0], v1[1]); w.w = cvt_pk_bf16(v1[2], v1[3]);
                    *(u32x4*)(orow + bj * HALF) = w; } }
            asm volatile("" ::: "memory"); }
    }
};
struct EpiX1N {
    static constexpr bool PERM = true; static constexpr int NVM = 0;
    const float* base; unsigned char* ws; const float* mod; LAS unsigned char* lds; float* ex; unsigned* cnt;
    __device__ __forceinline__ void operator()(f32x4 (&acc)[2][2][4][2], const Unit& u, int wr, int wc, int fr, int fq) const {
        const int b = u.pm >> 4; const int col0 = u.pn * BM + wc * 32 + 8 * fq; const float* mb = mod + (size_t)b * NMOD;
        LAS float* red = (LAS float*)(lds + RING_BYTES); LAS float* rr = red + 4 * BM;
        float ss[2][4];
        { f32x4 gv[2][2];
#pragma unroll
          for (int bj = 0; bj < 2; ++bj)
#pragma unroll
            for (int n = 0; n < 2; ++n) gv[bj][n] = *(const f32x4*)(mb + 2 * DM + col0 + bj * HALF + n * 4);
#pragma unroll
          for (int am = 0; am < 4; ++am) { const int ai = am >> 1, m0 = (am & 1) * 2; f32x4 pre[2][2][2];
#pragma unroll
            for (int mm = 0; mm < 2; ++mm) { const size_t off = ((size_t)u.pm * BM + ai * HALF + wr * 64 + (m0 + mm) * 16 + fr) * DM + col0;
#pragma unroll
                for (int bj = 0; bj < 2; ++bj) { pre[mm][bj][0] = *(const f32x4*)(base + off + bj * HALF); pre[mm][bj][1] = *(const f32x4*)(base + off + bj * HALF + 4); } }
            asm volatile("" ::: "memory");
#pragma unroll
            for (int mm = 0; mm < 2; ++mm) { const int m = m0 + mm; const size_t row = (size_t)u.pm * BM + ai * HALF + wr * 64 + m * 16 + fr; bf16_t* orow = x1_row(ws, row) + col0; float s2 = 0.f;
#pragma unroll
                for (int bj = 0; bj < 2; ++bj) { const f32x4 v0 = pre[mm][bj][0] + gv[bj][0] * acc[ai][bj][m][0], v1 = pre[mm][bj][1] + gv[bj][1] * acc[ai][bj][m][1];
                    acc[ai][bj][m][0] = v0; acc[ai][bj][m][1] = v1;
                    s2 += ((v0[0] * v0[0] + v0[1] * v0[1]) + (v0[2] * v0[2] + v0[3] * v0[3])) + ((v1[0] * v1[0] + v1[1] * v1[1]) + (v1[2] * v1[2] + v1[3] * v1[3]));
                    u32x4 w; w.x = cvt_pk_bf16(v0[0], v0[1]); w.y = cvt_pk_bf16(v0[2], v0[3]); w.z = cvt_pk_bf16(v1[0], v1[1]); w.w = cvt_pk_bf16(v1[2], v1[3]);
                    *(u32x4*)(orow + bj * HALF) = w; }
                s2 += __shfl_xor(s2, 16); s2 += __shfl_xor(s2, 32); ss[ai][m] = s2; }
            asm volatile("" ::: "memory"); } }
        if (fq == 0) {
#pragma unroll
            for (int ai = 0; ai < 2; ++ai)
#pragma unroll
                for (int m = 0; m < 4; ++m) red[wc * BM + ai * HALF + wr * 64 + m * 16 + fr] = ss[ai][m]; }
        __syncthreads();
        const int tid = threadIdx.x; unsigned* slot = (unsigned*)ex + ((size_t)u.pm * 4) * BM;
        if (tid < BM) { const float tot = (red[tid] + red[BM + tid]) + (red[2 * BM + tid] + red[3 * BM + tid]);
            __hip_atomic_store(slot + u.pn * BM + tid, __float_as_uint(tot), __ATOMIC_RELAXED, __HIP_MEMORY_SCOPE_AGENT); }
        asm volatile("s_waitcnt vmcnt(0)" ::: "memory");
        __syncthreads();
        if (tid == 0) { (void)__hip_atomic_fetch_add(cnt + u.pm, 1u, __ATOMIC_RELAXED, __HIP_MEMORY_SCOPE_AGENT); unsigned sp = 0;
            while (__hip_atomic_load(cnt + u.pm, __ATOMIC_RELAXED, __HIP_MEMORY_SCOPE_AGENT) < 4u) { __builtin_amdgcn_s_sleep(1); if (++sp > (1u << 22)) break; } }
        __syncthreads();
        if (tid < BM) { float t4 = 0.f;
#pragma unroll
            for (int q = 0; q < 4; ++q) t4 += __uint_as_float(__hip_atomic_load(slot + q * BM + tid, __ATOMIC_RELAXED, __HIP_MEMORY_SCOPE_AGENT));
            rr[tid] = 1.f / sqrtf(t4 * (1.f / DM) + EPS); }
        __syncthreads();
        f32x4 sc[2][2], sh[2][2];
#pragma unroll
        for (int bj = 0; bj < 2; ++bj)
#pragma unroll
            for (int n = 0; n < 2; ++n) { sc[bj][n] = *(const f32x4*)(mb + 4 * DM + col0 + bj * HALF + n * 4) + 1.f; sh[bj][n] = *(const f32x4*)(mb + 3 * DM + col0 + bj * HALF + n * 4); }
        bf16_t* H2 = (bf16_t*)(ws + WS_H); unsigned char* H8 = ws + WS_H8;
        const int col8 = u.pn * BM + (fq & 1) * HALF + wc * 32 + 8 * (fq & 2);
#pragma unroll
        for (int ai = 0; ai < 2; ++ai)
#pragma unroll
            for (int m = 0; m < 4; ++m) { const int rl = ai * HALF + wr * 64 + m * 16 + fr; const size_t row = (size_t)u.pm * BM + rl; const float r = rr[rl]; unsigned w8[2][2];
#pragma unroll
                for (int bj = 0; bj < 2; ++bj) { const f32x4 h0 = acc[ai][bj][m][0] * r * sc[bj][0] + sh[bj][0], h1 = acc[ai][bj][m][1] * r * sc[bj][1] + sh[bj][1];
                    u32x4 w; w.x = cvt_pk_bf16(h0[0], h0[1]); w.y = cvt_pk_bf16(h0[2], h0[3]); w.z = cvt_pk_bf16(h1[0], h1[1]); w.w = cvt_pk_bf16(h1[2], h1[3]);
                    *(u32x4*)(H2 + row * DM + col0 + bj * HALF) = w;
                    int q0 = __builtin_amdgcn_cvt_pk_fp8_f32(h0[0], h0[1], 0, false); q0 = __builtin_amdgcn_cvt_pk_fp8_f32(h0[2], h0[3], q0, true);
                    int q1 = __builtin_amdgcn_cvt_pk_fp8_f32(h1[0], h1[1], 0, false); q1 = __builtin_amdgcn_cvt_pk_fp8_f32(h1[2], h1[3], q1, true);
                    w8[bj][0] = (unsigned)q0; w8[bj][1] = (unsigned)q1; }
                const auto s0 = __builtin_amdgcn_permlane16_swap(w8[0][0], w8[1][0], false, false); const auto s1 = __builtin_amdgcn_permlane16_swap(w8[0][1], w8[1][1], false, false);
                u32x4 o; o.x = s0[0]; o.y = s1[0]; o.z = s0[1]; o.w = s1[1];
                *(u32x4*)(H8 + row * DM + col8) = o; }
    }
};
struct EpiF32 {
    static constexpr bool PERM = false; static constexpr int NVM = 16;
    float* out; int ldc;
    __device__ __forceinline__ void operator()(const f32x4 (&acc)[2][2][4][2], const Unit& u, int wr, int wc, int fr, int fq) const {
        const int col0 = u.pn * BM + wc * 32 + 4 * fq;
#pragma unroll
        for (int ai = 0; ai < 2; ++ai)
#pragma unroll
            for (int m = 0; m < 4; ++m) { const size_t off = (size_t)(u.pm * BM + ai * HALF + wr * 64 + m * 16 + fr) * ldc + col0;
#pragma unroll
                for (int bj = 0; bj < 2; ++bj)
#pragma unroll
                    for (int n = 0; n < 2; ++n) *(f32x4*)(out + off + bj * HALF + n * 16) = acc[ai][bj][m][n]; }
    }
};
struct EpiYbuf {
    static constexpr bool PERM = true; static constexpr int NVM = 8;
    unsigned char* Y; unsigned char* dump;
    __device__ __forceinline__ void operator()(const f32x4 (&acc)[2][2][4][2], const Unit& u, int wr, int wc, int fr, int fq) const {
        const int colb = u.pn * BM + wc * 64 + (fq & 1) * 32 + 8 * (fq & 2);
#pragma unroll
        for (int ai = 0; ai < 2; ++ai)
#pragma unroll
            for (int m = 0; m < 4; ++m) { const int rl = ai * HALF + wr * 64 + m * 16 + fr; const size_t row = (size_t)u.yrow + rl; const bool live = u.tile * BM + rl < u.cnt;
                unsigned w[2][2];
#pragma unroll
                for (int bj = 0; bj < 2; ++bj) { f32x4 v0 = acc[ai][bj][m][0] * YSCALE, v1 = acc[ai][bj][m][1] * YSCALE;
#pragma unroll
                    for (int i = 0; i < 4; ++i) { v0[i] = __builtin_amdgcn_fmed3f(v0[i], -440.f, 440.f); v1[i] = __builtin_amdgcn_fmed3f(v1[i], -440.f, 440.f); }
                    int w0 = __builtin_amdgcn_cvt_pk_fp8_f32(v0[0], v0[1], 0, false); w0 = __builtin_amdgcn_cvt_pk_fp8_f32(v0[2], v0[3], w0, true);
                    int w1 = __builtin_amdgcn_cvt_pk_fp8_f32(v1[0], v1[1], 0, false); w1 = __builtin_amdgcn_cvt_pk_fp8_f32(v1[2], v1[3], w1, true);
                    w[bj][0] = (unsigned)w0; w[bj][1] = (unsigned)w1; }
                const auto s0 = __builtin_amdgcn_permlane16_swap(w[0][0], w[1][0], false, false); const auto s1 = __builtin_amdgcn_permlane16_swap(w[0][1], w[1][1], false, false);
                u32x4 o; o.x = s0[0]; o.y = s1[0]; o.z = s0[1]; o.w = s1[1];
                *(u32x4*)(live ? Y + row * DM + colb : dump + (size_t)rl * DM + colb) = o; }
    }
};

template <class Epi, class Sched, bool GATHER, bool FP8 = false, bool SHORTK = false, int VAR = 0, bool HOIST = false>
__device__ __forceinline__ void gemm_phase(LAS unsigned char* lds, const Gemm g, const Sched& S, const Epi& E) {
    int tid_ = threadIdx.x; asm volatile("" : "+v"(tid_));
    const int tid = tid_, wid = __builtin_amdgcn_readfirstlane(tid >> 6), lane = tid & 63, wr = wid >> 2, wc = wid & 3, fr = lane & 15, fq = lane >> 4;
    int K_ = g.K; if constexpr (SHORTK) asm volatile("" : "+s"(K_));
    const int K = K_, nt = K / BK;
    unsigned voffA[2], voffB[2];
#pragma unroll
    for (int i = 0; i < 2; ++i) { int R, C; stage_rc(tid * 16 + i * 8192, R, C); const int Rb = Epi::PERM ? ((R & ~31) + perm32(R & 31)) : R;
        voffA[i] = (unsigned)(R * K + C) * 2u; voffB[i] = (unsigned)(Rb * K + C) * 2u; }
    const size_t kstep = (size_t)(BK * 2);
    const size_t hstep = (size_t)HALF * K * 2;
    const size_t tstep = 2 * hstep;
    const unsigned ldsw = (unsigned)wid * 1024u;
    const int aoff = lds_byte(wr * 64 + fr, fq * 8), boff = lds_byte(wc * 32 + fr, fq * 8);
#define PG8_SA(b, h) (((b) * 2 + (h)) * HTB)
#define PG8_SB(b, h) ((4 + (b) * 2 + (h)) * HTB)
#define PG8_GLDS(src, bufoff, i) if constexpr (!(VAR & 1)) __builtin_amdgcn_global_load_lds((const unsigned*)(src), (LAS unsigned*)(lds + (bufoff) + ldsw + (i) * 8192), 16, 0, 0)
#define PG8_STAGE(bufoff, gbase, voff) do { _Pragma("unroll") for (int _i = 0; _i < 2; ++_i) PG8_GLDS((const char*)(gbase) + (voff)[_i], bufoff, _i); } while (0)
#define PG8_STA(bufoff, aptr, h, SEL) do { if constexpr (GATHER) { const unsigned _p = (SEL) ? gvn[h] : gvc[h]; _Pragma("unroll") for (int _i = 0; _i < 2; ++_i) { unsigned _c = voffB[_i]; asm volatile("" : "+v"(_c)); \
            const unsigned _o = ((_i ? (_p >> 16) : (_p & 0xffffu)) * (unsigned)(K * 2)) + (_c & (unsigned)(K * 2 - 1)); PG8_GLDS((const char*)(aptr) + _o, bufoff, _i); } } \
        else { PG8_STAGE(bufoff, (const char*)(aptr) + (h) * hstep, voffA); } } while (0)
#define PG8_LDA(dst, b, h) do { _Pragma("unroll") for (int m = 0; m < 4; ++m) _Pragma("unroll") for (int k = 0; k < 2; ++k) dst[m][k] = *(const LAS bf16x8*)(lds + PG8_SA(b, h) + aoff + m * 2048 + k * 1024); } while (0)
#define PG8_LDB(dst, b, h) do { _Pragma("unroll") for (int n = 0; n < 2; ++n) _Pragma("unroll") for (int k = 0; k < 2; ++k) dst[n][k] = *(const LAS bf16x8*)(lds + PG8_SB(b, h) + boff + n * 2048 + k * 1024); } while (0)
#define PG8_CAT8(lo, hi) ({ const v4i_t a_ = __builtin_bit_cast(v4i_t, lo), b_ = __builtin_bit_cast(v4i_t, hi); (v8i_t){a_.x, a_.y, a_.z, a_.w, b_.x, b_.y, b_.z, b_.w}; })
#define PG8_MMA(ai, bj, At, Bt) do { __builtin_amdgcn_s_setprio(1); if constexpr (VAR & 2) { asm volatile("" :: "v"(At[0][0]), "v"(At[3][1]), "v"(Bt[0][0]), "v"(Bt[1][1])); } else if constexpr (FP8) { _Pragma("unroll") for (int m = 0; m < 4; ++m) _Pragma("unroll") for (int n = 0; n < 2; ++n) \
        acc[ai][bj][m][n] = __builtin_amdgcn_mfma_scale_f32_16x16x128_f8f6f4(PG8_CAT8(Bt[n][0], Bt[n][1]), PG8_CAT8(At[m][0], At[m][1]), acc[ai][bj][m][n], 0, 0, 0, 0x7F7F7F7F, 0, 0x7F7F7F7F); } \
      else { _Pragma("unroll") for (int m = 0; m < 4; ++m) _Pragma("unroll") for (int n = 0; n < 2; ++n) _Pragma("unroll") for (int k = 0; k < 2; ++k) \
        acc[ai][bj][m][n] = __builtin_amdgcn_mfma_f32_16x16x32_bf16(Bt[n][k], At[m][k], acc[ai][bj][m][n], 0, 0, 0); } \
      if constexpr (SHORTK) { _Pragma("unroll") for (int m = 0; m < 4; ++m) _Pragma("unroll") for (int n = 0; n < 2; ++n) asm volatile("" : "+v"(acc[ai][bj][m][n])); }     \
      __builtin_amdgcn_s_setprio(0); } while (0)
#define PG8_WAIT_V(n) asm volatile("s_waitcnt vmcnt(" #n ")" ::: "memory")
#define PG8_WAIT_VF() do { if (fst) asm volatile("s_waitcnt vmcnt(%0)" :: "n"(8 + NQ) : "memory"); else asm volatile("s_waitcnt vmcnt(8)" ::: "memory"); } while (0)
#define PG8_WAIT_L(n) asm volatile("s_waitcnt lgkmcnt(" #n ")" ::: "memory")
#define PG8_BAR __builtin_amdgcn_s_barrier()
#define PG8_SCHED __builtin_amdgcn_sched_barrier(0)
#define PG8_ROWS_LOAD(u, ld) do { _Pragma("unroll") for (int _h = 0; _h < 2; ++_h) _Pragma("unroll") for (int _i = 0; _i < 2; ++_i) { int _R, _C; stage_rc(tid * 16 + _i * 8192, _R, _C); const int _idx = (u).tile * BM + _h * HALF + _R; \
            const int _ic = _idx < (u).cnt ? _idx : (u).cnt - 1; ld[_h][_i] = g.list[(size_t)(u).e * LCAP + _ic]; } } while (0)
#define PG8_ROWS_USE(u, ld, gv) do { asm volatile("" : "+v"(ld[0][0]), "+v"(ld[0][1]), "+v"(ld[1][0]), "+v"(ld[1][1])); \
        _Pragma("unroll") for (int _h = 0; _h < 2; ++_h) { unsigned _t2[2]; _Pragma("unroll") for (int _i = 0; _i < 2; ++_i) { int _R, _C; stage_rc(tid * 16 + _i * 8192, _R, _C); const int _idx = (u).tile * BM + _h * HALF + _R; \
            _t2[_i] = (_idx < (u).cnt) ? (ld[_h][_i] & 0xffffu) : 0u; } gv[_h] = _t2[0] | (_t2[1] << 16); } } while (0)
    constexpr int NQ = Epi::NVM + (GATHER ? 1 : 0);
#define PG8_ROWS_DMA(u) __builtin_amdgcn_global_load_lds((const unsigned*)(g.list + (size_t)(u).e * LCAP + (u).tile * BM + (wid & 3) * 64 + lane), (LAS unsigned*)(lds + RLIST_OFF + (wid & 3) * 256), 4, 0, 0)
#define PG8_ROWS_USE_LDS(u, gv) do { _Pragma("unroll") for (int _h = 0; _h < 2; ++_h) { unsigned _t2[2]; _Pragma("unroll") for (int _i = 0; _i < 2; ++_i) { int _R, _C; stage_rc(tid * 16 + _i * 8192, _R, _C); const int _idx = (u).tile * BM + _h * HALF + _R; \
            const unsigned _v = *(const LAS unsigned*)(lds + RLIST_OFF + (_h * HALF + _R) * 4); _t2[_i] = (_idx < (u).cnt) ? (_v & 0xffffu) : 0u; } gv[_h] = _t2[0] | (_t2[1] << 16); } } while (0)
    Unit cur, nxt; int ui = 0;
    if (!S.next(0, cur)) return;
    f32x4 acc[2][2][4][2];
#pragma unroll
    for (int a = 0; a < 2; ++a)
#pragma unroll
        for (int b = 0; b < 2; ++b)
#pragma unroll
            for (int m = 0; m < 4; ++m)
#pragma unroll
                for (int n = 0; n < 2; ++n) acc[a][b][m][n] = (f32x4){0.f, 0.f, 0.f, 0.f};
    bf16x8 At[4][2], B0[2][2], B1[2][2];
    unsigned gvc[2] = {0u, 0u}, gvn[2] = {0u, 0u};
    if constexpr (GATHER) { unsigned rld[2][2]; PG8_ROWS_LOAD(cur, rld); PG8_ROWS_USE(cur, rld, gvc); }
    const char* cA = GATHER ? (const char*)g.A : (const char*)g.A + (size_t)cur.pm * tstep; const char* cB = (const char*)g.Bt + (size_t)cur.pb * tstep;
    PG8_STAGE(PG8_SB(0, 0), cB, voffB); PG8_STAGE(PG8_SB(0, 1), cB + hstep, voffB); PG8_STA(PG8_SA(0, 0), cA, 0, false); PG8_STA(PG8_SA(0, 1), cA, 1, false);
    if (wr == 1) PG8_BAR;
    PG8_WAIT_V(2); PG8_BAR;
    PG8_STAGE(PG8_SB(1, 0), cB + kstep, voffB); PG8_STA(PG8_SA(1, 0), cA + kstep, 0, false); PG8_STAGE(PG8_SB(1, 1), cB + hstep + kstep, voffB);
    PG8_WAIT_V(6); PG8_BAR;
    for (;;) {
        const bool has_next = S.next(ui + 1, nxt);
        const char* nA = has_next ? (GATHER ? (const char*)g.A : (const char*)g.A + (size_t)nxt.pm * tstep) : cA; const char* nB = has_next ? (const char*)g.Bt + (size_t)nxt.pb * tstep : cB;
        if constexpr (GATHER) { if (!has_next) { nxt = cur; gvn[0] = gvc[0]; gvn[1] = gvc[1]; } PG8_ROWS_DMA(nxt); }
        int t = 0;
        do {
            const bool last = (t == nt - 2);
            const bool fst = HOIST && (t == 0) && (ui > 0);
            if constexpr (GATHER) { if (last && has_next) { PG8_ROWS_USE_LDS(nxt, gvn); } }
            const char* a1 = cA + (size_t)(t + 1) * kstep;
            const char* a2 = last ? nA : cA + (size_t)(t + 2) * kstep; const char* b2 = last ? nB : cB + (size_t)(t + 2) * kstep;
            const char* a3 = a2 + kstep; const char* b3 = b2 + kstep;
            PG8_LDB(B0, 0, 0); PG8_LDB(B1, 0, 1); PG8_SCHED; PG8_LDA(At, 0, 0); if (!fst) PG8_STA(PG8_SA(1, 1), a1, 1, false);
            PG8_WAIT_VF(); PG8_WAIT_L(0); PG8_BAR; PG8_MMA(0, 0, At, B0); PG8_MMA(0, 1, At, B1); PG8_BAR; PG8_SCHED;
            PG8_LDA(At, 0, 1); PG8_STAGE(PG8_SB(0, 0), b2, voffB); PG8_STAGE(PG8_SB(0, 1), b2 + hstep, voffB); PG8_STA(PG8_SA(0, 0), a2, 0, last);
            PG8_WAIT_VF(); PG8_WAIT_L(0); PG8_BAR; PG8_MMA(1, 0, At, B0); PG8_MMA(1, 1, At, B1); PG8_BAR; PG8_SCHED;
            PG8_LDB(B0, 1, 0); PG8_LDB(B1, 1, 1); PG8_SCHED; PG8_LDA(At, 1, 0); PG8_STA(PG8_SA(0, 1), a2, 1, last);
            PG8_WAIT_VF(); PG8_WAIT_L(0); PG8_BAR; PG8_MMA(0, 0, At, B0); PG8_MMA(0, 1, At, B1); PG8_BAR; PG8_SCHED;
            PG8_LDA(At, 1, 1); PG8_STAGE(PG8_SB(1, 0), b3, voffB); PG8_STAGE(PG8_SB(1, 1), b3 + hstep, voffB); PG8_STA(PG8_SA(1, 0), a3, 0, last);
            PG8_WAIT_V(8); PG8_WAIT_L(0); PG8_BAR; PG8_MMA(1, 0, At, B0); PG8_MMA(1, 1, At, B1); PG8_BAR; PG8_SCHED;
            t += 2;
        } while (t < nt);
        if constexpr (HOIST) PG8_STA(PG8_SA(1, 1), nA + kstep, 1, true);
        if (wr == 0) PG8_BAR;
        { int te_ = threadIdx.x; asm volatile("" : "+v"(te_)); int fr_ = te_ & 15, fq_ = (te_ >> 4) & 3; asm volatile("" : "+v"(fr_), "+v"(fq_));
          if constexpr (!(VAR & 4)) E(acc, cur, wr, wc, fr_, fq_); else { _Pragma("unroll") for (int a = 0; a < 2; ++a) _Pragma("unroll") for (int b = 0; b < 2; ++b) _Pragma("unroll") for (int m = 0; m < 4; ++m) _Pragma("unroll") for (int n = 0; n < 2; ++n) asm volatile("" :: "v"(acc[a][b][m][n])); } }
        if (!has_next) break;
#pragma unroll
        for (int a = 0; a < 2; ++a)
#pragma unroll
            for (int b = 0; b < 2; ++b)
#pragma unroll
                for (int m = 0; m < 4; ++m)
#pragma unroll
                    for (int n = 0; n < 2; ++n) acc[a][b][m][n] = (f32x4){0.f, 0.f, 0.f, 0.f};
        cur = nxt; cA = nA; cB = nB; ++ui;
        if constexpr (GATHER) { gvc[0] = gvn[0]; gvc[1] = gvn[1]; }
        if (wr == 1) PG8_BAR;
    }
    PG8_WAIT_V(0);
    PG8_BAR;
#undef PG8_SA
#undef PG8_SB
#undef PG8_GLDS
#undef PG8_STAGE
#undef PG8_STA
#undef PG8_LDA
#undef PG8_LDB
#undef PG8_MMA
#undef PG8_CAT8
#undef PG8_WAIT_V
#undef PG8_WAIT_VF
#undef PG8_WAIT_L
#undef PG8_BAR
#undef PG8_SCHED
#undef PG8_ROWS_LOAD
#undef PG8_ROWS_USE
#undef PG8_ROWS_DMA
#undef PG8_ROWS_USE_LDS
}
}

namespace attn_body {
using bf16 = __hip_bfloat16;
using s16x4 = __attribute__((ext_vector_type(4))) short;
using f32x16 = __attribute__((ext_vector_type(16))) float;
constexpr int D = 64, NW = 8, QBLK = 32, QB = QBLK * NW, KVBLK = 64;
__device__ __forceinline__ int crow(int r, int hi) { return (r & 3) + 8 * (r >> 2) + 4 * hi; }
#define SBAR() __builtin_amdgcn_sched_barrier(0)
__device__ __forceinline__ void cmask(f32x16& p0, f32x16& p1, int jb, int qrel, int hi) {
  const float NEG = -INFINITY; int kb = 64 * jb + 4 * hi;
  #pragma unroll
  for (int r = 0; r < 16; ++r) { int kv = kb + (r & 3) + 8 * (r >> 2); if (kv > qrel) p0[r] = NEG; if (kv + 32 > qrel) p1[r] = NEG; }
}
constexpr int NSLOT = 3, SLOTB = 8192;
constexpr int LDS_K = 0, LDS_V = NSLOT * SLOTB, LDS_WS = 2 * NSLOT * SLOTB, LDS_OST = LDS_WS + NW * 64 * 4, LDS_BYTES = LDS_OST + NW * 4096;
constexpr int LDS_KBT = LDS_BYTES;
constexpr int LDS_TREV = LDS_KBT + 16384;
constexpr int LDS_TOTAL = LDS_TREV + 3072;
constexpr float C2 = 0.125f * 1.4426950408889634f;
__device__ __forceinline__ void glds16(const void* gsrc, unsigned lds_dst) { unsigned keep;
  asm volatile("s_mov_b32 %0, m0\n\ts_mov_b32 m0, %2\n\ts_nop 0\n\tglobal_load_lds_dwordx4 %1, off\n\ts_mov_b32 m0, %0" : "=&s"(keep) : "v"(gsrc), "s"(lds_dst) : "memory"); }
__device__ __forceinline__ float max3f(float a, float b, float c) { float r; asm("v_max3_f32 %0, %1, %2, %3" : "=v"(r) : "v"(a), "v"(b), "v"(c)); return r; }
__device__ __forceinline__ float max2f(float a, float b) { float r; asm("v_max_f32_e32 %0, %1, %2" : "=v"(r) : "v"(a), "v"(b)); return r; }
__device__ __forceinline__ float fadd_s(float a, float b) { float r; asm("v_add_f32_e32 %0, %1, %2" : "=v"(r) : "v"(a), "v"(b)); return r; }
__device__ __forceinline__ float fsub_s(float a, float b) { float r; asm("v_sub_f32_e32 %0, %1, %2" : "=v"(r) : "v"(a), "v"(b)); return r; }
typedef float f32x2_t __attribute__((ext_vector_type(2))); typedef __bf16 bf16x2_t __attribute__((ext_vector_type(2)));
__device__ __forceinline__ unsigned cvtpk_s(float lo, float hi) { f32x2_t v = {lo, hi}; bf16x2_t b = __builtin_convertvector(v, bf16x2_t); return __builtin_bit_cast(unsigned, b); }
#define WAIT_BAR(N) asm volatile("s_waitcnt vmcnt(" #N ") lgkmcnt(0)\n\ts_barrier" ::: "memory")

__device__ __forceinline__ void qkt(f32x16& p0, f32x16& p1, const char* Kslot, const bf16x8* qr, int r32, int hi) {
  const char* kb = Kslot + hi * 1024 + r32 * 16;
  #pragma unroll
  for (int d0 = 0; d0 < 4; ++d0) {
    const bf16x8 b0 = *reinterpret_cast<const bf16x8*>(kb + d0 * 2048);
    const bf16x8 b1 = *reinterpret_cast<const bf16x8*>(kb + d0 * 2048 + 512);
    p0 = __builtin_amdgcn_mfma_f32_32x32x16_bf16(b0, qr[d0], p0, 0, 0, 0); p1 = __builtin_amdgcn_mfma_f32_32x32x16_bf16(b1, qr[d0], p1, 0, 0, 0); }
}
typedef __attribute__((address_space(3))) const char* lds_cptr;
typedef short v4i16_t __attribute__((ext_vector_type(4)));
__device__ __forceinline__ void kload8(bf16x8* kf, lds_cptr kp) {
  kf[0] = *(const LAS bf16x8*)(kp);        kf[1] = *(const LAS bf16x8*)(kp + 512);
  kf[2] = *(const LAS bf16x8*)(kp + 2048); kf[3] = *(const LAS bf16x8*)(kp + 2560);
  kf[4] = *(const LAS bf16x8*)(kp + 4096); kf[5] = *(const LAS bf16x8*)(kp + 4608);
  kf[6] = *(const LAS bf16x8*)(kp + 6144); kf[7] = *(const LAS bf16x8*)(kp + 6656);
}
__device__ __forceinline__ void kload2(bf16x8* kf, lds_cptr kp, int j) { kf[2 * j] = *(const LAS bf16x8*)(kp + j * 2048); kf[2 * j + 1] = *(const LAS bf16x8*)(kp + j * 2048 + 512); }
__device__ __forceinline__ s16x4 vtr(lds_cptr p) { return __builtin_bit_cast(s16x4, __builtin_amdgcn_ds_read_tr16_b64_v4i16((LAS v4i16_t*)p)); }
__device__ __forceinline__ float rowmax(const f32x16& p0, const f32x16& p1) {
  float a = max3f(p0[0], p0[1], p1[0]), b = max3f(p0[2], p0[3], p1[1]); a = max3f(a, p1[2], p1[3]);
  #pragma unroll
  for (int r = 4; r < 16; r += 4) { a = max3f(a, p0[r], p0[r + 1]); b = max3f(b, p0[r + 2], p0[r + 3]); a = max3f(a, p1[r], p1[r + 1]); b = max3f(b, p1[r + 2], p1[r + 3]); }
  const float m = max2f(a, b);
  auto rr = __builtin_amdgcn_permlane32_swap(__float_as_uint(m), __float_as_uint(m), false, false);
  return max2f(__uint_as_float(rr[0]), __uint_as_float(rr[1]));
}
__device__ __forceinline__ void pv(f32x16* o, int vb, bf16x8 pa0, bf16x8 pa1, bf16x8 pa2, bf16x8 pa3) {
  #pragma unroll
  for (int d0 = 0; d0 < 2; ++d0) { s16x4 lo[4], hi[4];
    #pragma unroll
    for (int ks = 0; ks < 4; ++ks) {
      asm volatile("ds_read_b64_tr_b16 %0,%1 offset:%c2" : "=&v"(lo[ks]) : "v"(vb), "i"(d0 * 4096 + ks * 1024) : "memory");
      asm volatile("ds_read_b64_tr_b16 %0,%1 offset:%c2" : "=&v"(hi[ks]) : "v"(vb), "i"(d0 * 4096 + ks * 1024 + 512) : "memory"); }
    asm volatile("s_waitcnt lgkmcnt(0)" ::: "memory"); SBAR();
    #define PK(k) (bf16x8){lo[k][0], lo[k][1], lo[k][2], lo[k][3], hi[k][0], hi[k][1], hi[k][2], hi[k][3]}
    o[d0] = __builtin_amdgcn_mfma_f32_32x32x16_bf16(pa0, PK(0), o[d0], 0, 0, 0);
    o[d0] = __builtin_amdgcn_mfma_f32_32x32x16_bf16(pa1, PK(1), o[d0], 0, 0, 0);
    o[d0] = __builtin_amdgcn_mfma_f32_32x32x16_bf16(pa2, PK(2), o[d0], 0, 0, 0);
    o[d0] = __builtin_amdgcn_mfma_f32_32x32x16_bf16(pa3, PK(3), o[d0], 0, 0, 0);
    #undef PK
  }
}
#define ATTN_STORE16(p, v) (*(u32x4*)(p) = (v))
template <int THRL, int MODE> __device__ __forceinline__ void attn_unit(const bf16* Qp, const bf16* __restrict__ Kp, const bf16* __restrict__ Vp, bf16* Op, long RS, long ORS, int q0, int T0, int NT, int off,
                                                                        float* lsep, long lse_stride, char* shm, const float* kbsrc, const float* relb, int dsel) {
  int tid_ = threadIdx.x; asm volatile("" : "+v"(tid_));
  const int tid = tid_, lane = tid & 63, r32 = lane & 31, hi = lane >> 5; const int wid = __builtin_amdgcn_readfirstlane(tid >> 6);
  const bf16* Qw = Qp + (long)(q0 + wid * QBLK) * RS;
  const bf16* Kh = Kp + (long)T0 * KVBLK * RS, *Vh = Vp + (long)T0 * KVBLK * RS;
  const unsigned lds0 = (unsigned)(uintptr_t)shm;
  float* wsf = (float*)(shm + LDS_WS) + wid * 64;
  const int qrel = wid * QBLK + r32;
  const LAS float* tbase;
  if (MODE == 0) { LAS float* kbt = (LAS float*)(shm + LDS_KBT); const int nk = q0 + QB;
    for (int i = 64 * T0 + tid * 4; i < nk; i += 2048) *(LAS f32x4*)(kbt + i) = *(const f32x4*)(kbsrc + i);
    tbase = kbt + 4 * hi + 64 * T0;
  } else { LAS float* tr = (LAS float*)(shm + LDS_TREV);
    for (int u = tid; u < 768; u += 512) { const int j = 383 - u; float v = -INFINITY; if (j >= 0 && j <= 128) v = relb[(int)T5B[dsel][j] * NH] * LOG2E; tr[u] = v; }
    tbase = tr + (383 - off - qrel + 4 * hi);
  }
  const bf16* ksrc = Kh + (long)lane * RS + wid * 8;
  const bf16* vsrc = Vh + (long)(16 * (wid & 3) + (lane >> 2)) * RS + (wid >> 2) * 32 + (lane & 3) * 8;
  const unsigned kdst = lds0 + LDS_K + wid * 1024, vdst = lds0 + LDS_V + wid * 1024;
  #define DMA_K(t, slot) glds16(ksrc + (long)(t) * KVBLK * RS, (unsigned)__builtin_amdgcn_readfirstlane(kdst + (slot)))
  #define DMA_V(t, slot) glds16(vsrc + (long)(t) * KVBLK * RS, (unsigned)__builtin_amdgcn_readfirstlane(vdst + (slot)))
  const int vb0 = (int)(lds0 + LDS_V) + ((lane >> 4) & 1) * 32 + (lane & 3) * 8 + (4 * hi + ((lane & 15) >> 2)) * 64;
  const char* Kbase = shm + LDS_K; bf16x8 kf[8];
  const lds_cptr shm3 = (lds_cptr)shm; const lds_cptr kp0 = shm3 + LDS_K + hi * 1024 + r32 * 16; const lds_cptr vp0 = shm3 + LDS_V + ((lane >> 4) & 1) * 32 + (lane & 3) * 8 + (4 * hi + ((lane & 15) >> 2)) * 64;
  DMA_K(0, 0); DMA_V(0, 0); DMA_K(1, SLOTB);
  bf16x8 qr[4];
  #pragma unroll
  for (int d0 = 0; d0 < 4; ++d0) qr[d0] = *reinterpret_cast<const bf16x8*>(&Qw[(long)r32 * RS + d0 * 16 + hi * 8]);
  float mhat = 0.f, l_reg = 0.f; f32x16 o[2]; o[0] = f32x16{}; o[1] = f32x16{};
  #define BLOAD(P0, P1, t) do { const LAS float* tb_ = tbase + 64 * (t); \
      if (MODE == 0) { _Pragma("unroll") for (int g_ = 0; g_ < 4; ++g_) { const f32x4 b0_ = *(const LAS f32x4*)(tb_ + 8 * g_), b1_ = *(const LAS f32x4*)(tb_ + 32 + 8 * g_); \
          _Pragma("unroll") for (int i_ = 0; i_ < 4; ++i_) { P0[4 * g_ + i_] = b0_[i_]; P1[4 * g_ + i_] = b1_[i_]; } } } \
      else { _Pragma("unroll") for (int r_ = 0; r_ < 16; ++r_) { P0[r_] = tb_[(r_ & 3) + 8 * (r_ >> 2)]; P1[r_] = tb_[32 + (r_ & 3) + 8 * (r_ >> 2)]; } } } while (0)
  #define CMASK(P0, P1, t) do { if (MODE == 0) { int jb_ = (t) - (NT - 4); if (jb_ >= 0) cmask(P0, P1, jb_, qrel, hi); } } while (0)
  bool resc = false;
  #define START(P0, P1) do { const float rm = rowmax(P0, P1); resc = false; mhat = max2f(rm, -1000.f); \
    _Pragma("unroll") for (int r = 0; r < 16; ++r) P0[r] = __builtin_amdgcn_exp2f(fsub_s(P0[r], mhat)); } while (0)
  #define RESC() do { if (resc) { asm volatile("s_waitcnt lgkmcnt(0)" ::: "memory"); \
      _Pragma("unroll") for (int d_ = 0; d_ < 2; ++d_) _Pragma("unroll") for (int r = 0; r < 16; ++r) o[d_][r] *= wsf[crow(r, hi)]; } } while (0)
  f32x16 pA0, pA1, pB0, pB1;
  int sl_prev = 0, sl_cur = 0, sl_next = SLOTB;
  #define ROT() do { sl_prev = sl_cur; sl_cur = sl_next; sl_next = (sl_next == (NSLOT - 1) * SLOTB) ? 0 : sl_next + SLOTB; } while (0)
  DMA_K(2, 2 * SLOTB);
  WAIT_BAR(3);
  BLOAD(pA0, pA1, 0);
  qkt(pA0, pA1, Kbase, qr, r32, hi); asm volatile("s_nop 15\n\ts_nop 7" : "+v"(pA0), "+v"(pA1)); CMASK(pA0, pA1, 0);
  START(pA0, pA1);
  _Pragma("unroll") for (int r = 0; r < 16; ++r) pA1[r] = __builtin_amdgcn_exp2f(fsub_s(pA1[r], mhat));
  BLOAD(pB0, pB1, 1);
  WAIT_BAR(0);
  DMA_K(3, 0); DMA_V(1, SLOTB);
  ROT();
  kload8(kf, kp0 + sl_cur);
  WAIT_BAR(2);
  s16x4 vlo[8], vhi[8]; u32x4 pw0, pw1, pw2, pw3;
  #define PKW(P, B) cvtpk_s(P[B], P[B + 1])
  #define PAF(k) __builtin_bit_cast(bf16x8, pw##k)
  #define VFR(i) (bf16x8){vlo[i][0], vlo[i][1], vlo[i][2], vlo[i][3], vhi[i][0], vhi[i][1], vhi[i][2], vhi[i][3]}
  #define PIN(x) asm volatile("" : "+v"(x))
  #define MX3(a, b, c) __builtin_fmaxf(__builtin_fmaxf((a), (b)), (c))
  #define GAPA(MF, A0, A1, A2, A3, W0, W1, PW) do { MF; sacc += A0; sacc += A1; sacc += A2; sacc += A3; PIN(sacc); W0; W1; PIN(PW); SBAR(); } while (0)
  #define EX(v) __builtin_amdgcn_exp2f(v)
  #define GAPB(MF, X, B) do { MF; X[B] = EX(X[B] - mhat); X[B + 1] = EX(X[B + 1] - mhat); X[B + 2] = EX(X[B + 2] - mhat); X[B + 3] = EX(X[B + 3] - mhat); PIN(X); SBAR(); } while (0)
  #define VRD(i) do { vlo[i] = vtr(vp_ + (((i) >> 2) * 4096 + ((i) & 3) * 1024)); vhi[i] = vtr(vp_ + (((i) >> 2) * 4096 + ((i) & 3) * 1024 + 512)); } while (0)
  #define KRD(G, j) do { if (G) { kload2(kf, kp0 + sl_next, j); SBAR(); } } while (0)
  #define STEP(C0, C1, P0, P1, t, GK, GV, GL) do { SBAR(); \
    const lds_cptr vp_ = vp0 + sl_prev; \
    VRD(0); SBAR(); float sacc = (P0[0] + P0[1]); \
    GAPA(C0 = __builtin_amdgcn_mfma_f32_32x32x16_bf16(kf[0], qr[0], C0, 0, 0, 0), P0[2], P0[3], P0[4], P0[5],     pw0[0] = PKW(P0, 0), pw0[1] = PKW(P0, 2), pw0); \
    VRD(4); SBAR(); GAPA(C1 = __builtin_amdgcn_mfma_f32_32x32x16_bf16(kf[1], qr[0], C1, 0, 0, 0), P0[6], P0[7], P0[8], P0[9],     pw0[2] = PKW(P0, 4), pw0[3] = PKW(P0, 6), pw0); \
    VRD(1); SBAR(); GAPA(C0 = __builtin_amdgcn_mfma_f32_32x32x16_bf16(kf[2], qr[1], C0, 0, 0, 0),   P0[10], P0[11], P0[12], P0[13], pw1[0] = PKW(P0, 8), pw1[1] = PKW(P0, 10), pw1); \
    VRD(5); SBAR(); GAPA(C1 = __builtin_amdgcn_mfma_f32_32x32x16_bf16(kf[3], qr[1], C1, 0, 0, 0),   P0[14], P0[15], P1[0], P1[1],   pw1[2] = PKW(P0, 12), pw1[3] = PKW(P0, 14), pw1); \
    VRD(2); SBAR(); GAPA(C0 = __builtin_amdgcn_mfma_f32_32x32x16_bf16(kf[4], qr[2], C0, 0, 0, 0),   P1[2], P1[3], P1[4], P1[5],     pw2[0] = PKW(P1, 0), pw2[1] = PKW(P1, 2), pw2); \
    VRD(6); SBAR(); GAPA(C1 = __builtin_amdgcn_mfma_f32_32x32x16_bf16(kf[5], qr[2], C1, 0, 0, 0),   P1[6], P1[7], P1[8], P1[9],     pw2[2] = PKW(P1, 4), pw2[3] = PKW(P1, 6), pw2); \
    VRD(3); SBAR(); GAPA(C0 = __builtin_amdgcn_mfma_f32_32x32x16_bf16(kf[6], qr[3], C0, 0, 0, 0),   P1[10], P1[11], P1[12], P1[13], pw3[0] = PKW(P1, 8), pw3[1] = PKW(P1, 10), pw3); \
    VRD(7); SBAR(); GAPA(C1 = __builtin_amdgcn_mfma_f32_32x32x16_bf16(kf[7], qr[3], C1, 0, 0, 0),   P1[14], P1[15], 0.f, 0.f,       pw3[2] = PKW(P1, 12), pw3[3] = PKW(P1, 14), pw3); \
    l_reg += sacc; \
    if (GK) { DMA_K((t) + 3, sl_cur); } if (GV) { DMA_V((t) + 1, sl_next); } \
    CMASK(C0, C1, t); \
    { float a = MX3(C0[0], C0[1], C1[0]), b = MX3(C0[2], C0[3], C1[1]); a = MX3(a, C1[2], C1[3]); \
      _Pragma("unroll") for (int r = 4; r < 16; r += 4) { a = MX3(a, C0[r], C0[r + 1]); b = MX3(b, C0[r + 2], C0[r + 3]); a = MX3(a, C1[r], C1[r + 1]); b = MX3(b, C1[r + 2], C1[r + 3]); } \
      float rm = __builtin_fmaxf(a, b); { auto rr = __builtin_amdgcn_permlane32_swap(__float_as_uint(rm), __float_as_uint(rm), false, false); rm = __builtin_fmaxf(__uint_as_float(rr[0]), __uint_as_float(rr[1])); } \
      rm -= mhat; resc = false; \
      if (__builtin_expect(__any(rm > (float)THRL), 0)) { const float dl = __builtin_fmaxf(rm, 0.f); mhat += dl; \
        const float f = __builtin_amdgcn_exp2f(-dl); l_reg *= f; if (hi == 0) wsf[r32] = f; resc = true; } } \
    SBAR(); \
    if ((t) + 1 < NT) { BLOAD(P0, P1, (t) + 1); SBAR(); }        \
    GAPB(o[0] = __builtin_amdgcn_mfma_f32_32x32x16_bf16(PAF(0), VFR(0), o[0], 0, 0, 0), C0, 0); \
    GAPB(o[1] = __builtin_amdgcn_mfma_f32_32x32x16_bf16(PAF(0), VFR(4), o[1], 0, 0, 0), C0, 4); \
    KRD(GL, 0); GAPB(o[0] = __builtin_amdgcn_mfma_f32_32x32x16_bf16(PAF(1), VFR(1), o[0], 0, 0, 0), C0, 8); \
    KRD(GL, 1); GAPB(o[1] = __builtin_amdgcn_mfma_f32_32x32x16_bf16(PAF(1), VFR(5), o[1], 0, 0, 0), C0, 12); \
    KRD(GL, 2); GAPB(o[0] = __builtin_amdgcn_mfma_f32_32x32x16_bf16(PAF(2), VFR(2), o[0], 0, 0, 0), C1, 0); \
    KRD(GL, 3); GAPB(o[1] = __builtin_amdgcn_mfma_f32_32x32x16_bf16(PAF(2), VFR(6), o[1], 0, 0, 0), C1, 4); \
    GAPB(o[0] = __builtin_amdgcn_mfma_f32_32x32x16_bf16(PAF(3), VFR(3), o[0], 0, 0, 0), C1, 8); \
    GAPB(o[1] = __builtin_amdgcn_mfma_f32_32x32x16_bf16(PAF(3), VFR(7), o[1], 0, 0, 0), C1, 12); \
    } while (0)
  int t = 1;
  for (; t + 5 < NT; t += 2) {
    STEP(pB0, pB1, pA0, pA1, t, true, true, true);     WAIT_BAR(2); RESC(); ROT();
    STEP(pA0, pA1, pB0, pB1, t + 1, true, true, true); WAIT_BAR(2); RESC(); ROT();
  }
  #define ENDW(tt) do { if ((tt) + 3 < NT) { WAIT_BAR(2); } else if ((tt) + 2 < NT) { WAIT_BAR(1); } else { WAIT_BAR(0); } } while (0)
  for (; t + 1 < NT; t += 2) {
    STEP(pB0, pB1, pA0, pA1, t, (t + 3 < NT), (t + 1 < NT), (t + 1 < NT));     ENDW(t);     RESC(); ROT();
    STEP(pA0, pA1, pB0, pB1, t + 1, (t + 4 < NT), (t + 2 < NT), (t + 2 < NT)); ENDW(t + 1); RESC(); ROT();
  }
  STEP(pB0, pB1, pA0, pA1, NT - 1, false, false, false); RESC();
  { float sacc = pB0[0] + pB0[1]; _Pragma("unroll") for (int r = 2; r < 16; ++r) sacc += pB0[r]; _Pragma("unroll") for (int r = 0; r < 16; ++r) sacc += pB1[r]; l_reg += sacc;
    pw0 = (u32x4){PKW(pB0, 0), PKW(pB0, 2), PKW(pB0, 4), PKW(pB0, 6)}; pw1 = (u32x4){PKW(pB0, 8), PKW(pB0, 10), PKW(pB0, 12), PKW(pB0, 14)}; pw2 = (u32x4){PKW(pB1, 0), PKW(pB1, 2), PKW(pB1, 4), PKW(pB1, 6)}; pw3 = (u32x4){PKW(pB1, 8), PKW(pB1, 10), PKW(pB1, 12), PKW(pB1, 14)};
    SBAR(); pv(o, vb0 + sl_cur, PAF(0), PAF(1), PAF(2), PAF(3)); }
  #undef PKW
  #undef PAF
  #undef VFR
  #undef PIN
  #undef MX3
  #undef GAPA
  #undef GAPB
  #undef EX
  #undef VRD
  #undef KRD
  #undef STEP
  #undef ENDW
  { auto rr = __builtin_amdgcn_permlane32_swap(__float_as_uint(l_reg), __float_as_uint(l_reg), false, false); l_reg = __uint_as_float(rr[0]) + __uint_as_float(rr[1]); }
  if (lsep != nullptr && hi == 0) lsep[(long)(q0 + qrel) * lse_stride] = mhat + __log2f(l_reg);
  if (hi == 0) wsf[32 + r32] = l_reg; asm volatile("s_waitcnt lgkmcnt(0)" ::: "memory");
  float rli[16];
  #pragma unroll
  for (int r = 0; r < 16; ++r) rli[r] = __builtin_amdgcn_rcpf(wsf[32 + crow(r, hi)]);
  bf16* Ow = Op + (long)(q0 + wid * QBLK) * ORS;
  { bf16* stg = (bf16*)(shm + LDS_OST) + wid * 2048;
    #pragma unroll
    for (int r = 0; r < 16; ++r) { const int orow = crow(r, hi);
      #pragma unroll
      for (int d0 = 0; d0 < 2; ++d0) stg[orow * 64 + d0 * 32 + r32] = __float2bfloat16(o[d0][r] * rli[r]); }
    asm volatile("s_waitcnt lgkmcnt(0)" ::: "memory");
    #pragma unroll
    for (int i = 0; i < 4; ++i) { const int row = i * 8 + (lane >> 3), ch = lane & 7; const u32x4 v = *(const u32x4*)(stg + row * 64 + ch * 8); ATTN_STORE16(Ow + (long)row * ORS + ch * 8, v); } }
  asm volatile("s_waitcnt lgkmcnt(0)\n\ts_barrier" ::: "memory");
  #undef DMA_K
  #undef DMA_V
  #undef CMASK
  #undef BLOAD
  #undef START
  #undef RESC
  #undef ROT
}

constexpr int DL_K = 0, DL_KB = 49152, DL_V = 98304, DL_VPAD = 147456, DL_ZEND = 153600, DL_WS = 153600, DL_TREV = 155648, DL_TOTAL = DL_TREV + 3072;
static_assert(DL_WS + NW * 256 <= DL_TREV, "dilated LDS map");
struct DilSrc { const bf16* K; const bf16* V; long RS; int q0; int first; };
__device__ __forceinline__ void dil_issue_k(const DilSrc& u, unsigned lds0, int kbuf, int lane, int wid) {
  const long kr0 = (long)u.q0 - 128; const bf16* ksrc = u.K + (kr0 + lane) * u.RS + wid * 8; const unsigned kdst = lds0 + kbuf + wid * 1024;
  #pragma unroll
  for (int i = 0; i < 6; ++i) if (i >= 2 || !u.first) glds16(ksrc + (long)i * KVBLK * u.RS, (unsigned)__builtin_amdgcn_readfirstlane(kdst + i * 8192));
}
__device__ __forceinline__ void dil_issue_v(const DilSrc& u, unsigned lds0, int lane, int wid) {
  const long kr0 = (long)u.q0 - 128; const bf16* vsrc = u.V + (kr0 + 16 * (wid & 3) + (lane >> 2)) * u.RS + (wid >> 2) * 32 + (lane & 3) * 8; const unsigned vdst = lds0 + DL_V + wid * 1024;
  #pragma unroll
  for (int i = 0; i < 6; ++i) if (i >= 2 || !u.first) glds16(vsrc + (long)i * KVBLK * u.RS, (unsigned)__builtin_amdgcn_readfirstlane(vdst + i * 8192));
}
template <int THRL> __device__ __forceinline__ void dil_unit(const bf16* Qp, const DilSrc cur, int kb, bool issued, const DilSrc nxt, bool has_next, bf16* Op,
                                                             float* lsep, long lse_stride, char* shm, const float* relb, int dsel, bool build_tab) {
  int tid_ = threadIdx.x; asm volatile("" : "+v"(tid_));
  const int tid = tid_, lane = tid & 63, r32 = lane & 31, hi = lane >> 5; const int wid = __builtin_amdgcn_readfirstlane(tid >> 6);
  const unsigned lds0 = (unsigned)(uintptr_t)shm;
  const long RS = cur.RS; const int q0 = cur.q0; const bool first = cur.first != 0;
  float* wsf = (float*)(shm + DL_WS) + wid * 64;
  LAS float* tr = (LAS float*)(shm + DL_TREV);
  if (build_tab) { for (int u = tid; u < 768; u += 512) { const int j = 383 - u; float v = -INFINITY; if (j >= 0 && j <= 128) v = relb[(int)T5B[dsel][j] * NH] * LOG2E; tr[u] = v; } }
  const LAS float* tbase = tr + (255 - r32 + 4 * hi);
  if (!issued) { dil_issue_k(cur, lds0, kb, lane, wid); dil_issue_v(cur, lds0, lane, wid); }
  const bf16* Qw = Qp + (long)(q0 + wid * QBLK) * RS;
  bf16x8 qr[4];
  #pragma unroll
  for (int d0 = 0; d0 < 4; ++d0) qr[d0] = *reinterpret_cast<const bf16x8*>(&Qw[(long)r32 * RS + d0 * 16 + hi * 8]);
  asm volatile("s_waitcnt vmcnt(0) lgkmcnt(0)\n\ts_barrier" ::: "memory");
  if (has_next) dil_issue_k(nxt, lds0, kb ^ DL_KB, lane, wid);
  const int g = wid;
  const lds_cptr shm3 = (lds_cptr)shm;
  const lds_cptr kl = shm3 + kb + hi * 1024 + r32 * 16;
  const lds_cptr vl = shm3 + DL_V + ((lane >> 4) & 1) * 32 + (lane & 3) * 8 + (4 * hi + ((lane & 15) >> 2)) * 64;
  #define KBO(blk) ((((blk)) >> 1) * 8192 + (((blk)) & 1) * 512)
  #define VBO(blk) ((((blk)) >> 1) * 8192 + (((blk)) & 1) * 2048)
  #define DKLOAD2(s_, j_) do { const int b0_ = g + 2 * (s_); kf[2 * (j_)] = *(const LAS bf16x8*)(kl + KBO(b0_) + (j_) * 2048); kf[2 * (j_) + 1] = *(const LAS bf16x8*)(kl + KBO(b0_ + 1) + (j_) * 2048); } while (0)
  float mhat = 0.f, l_reg = 0.f; f32x16 o[2]; o[0] = f32x16{}; o[1] = f32x16{};
  bf16x8 kf[8];
  #define BLOAD(P0, P1, t) do { const LAS float* tb_ = tbase + 64 * (t); \
      _Pragma("unroll") for (int r_ = 0; r_ < 16; ++r_) { P0[r_] = tb_[(r_ & 3) + 8 * (r_ >> 2)]; P1[r_] = tb_[32 + (r_ & 3) + 8 * (r_ >> 2)]; } } while (0)
  #define PMASK(P0, P1, t) do { if (first && (32 * g + 64 * (t)) < 128) { const int kb_ = 32 * g + 64 * (t) + 4 * hi - 128; \
      _Pragma("unroll") for (int r_ = 0; r_ < 16; ++r_) { const int kp_ = kb_ + (r_ & 3) + 8 * (r_ >> 2); if (kp_ < 0) P0[r_] = -INFINITY; if (kp_ + 32 < 0) P1[r_] = -INFINITY; } } } while (0)
  bool resc = false;
  #define RESC() do { if (resc) { asm volatile("s_waitcnt lgkmcnt(0)" ::: "memory"); \
      _Pragma("unroll") for (int d_ = 0; d_ < 2; ++d_) _Pragma("unroll") for (int r = 0; r < 16; ++r) o[d_][r] *= wsf[crow(r, hi)]; } } while (0)
  f32x16 pA0, pA1, pB0, pB1;
  BLOAD(pA0, pA1, 0);
  DKLOAD2(0, 0); DKLOAD2(0, 1); DKLOAD2(0, 2); DKLOAD2(0, 3);
  #pragma unroll
  for (int d0 = 0; d0 < 4; ++d0) { pA0 = __builtin_amdgcn_mfma_f32_32x32x16_bf16(kf[2 * d0], qr[d0], pA0, 0, 0, 0); pA1 = __builtin_amdgcn_mfma_f32_32x32x16_bf16(kf[2 * d0 + 1], qr[d0], pA1, 0, 0, 0); }
  asm volatile("s_nop 15\n\ts_nop 7" : "+v"(pA0), "+v"(pA1)); PMASK(pA0, pA1, 0);
  asm volatile("s_nop 3" : "+v"(pA0), "+v"(pA1));
  { const float rm = rowmax(pA0, pA1); mhat = max2f(rm, -1000.f);
    _Pragma("unroll") for (int r = 0; r < 16; ++r) pA0[r] = __builtin_amdgcn_exp2f(fsub_s(pA0[r], mhat));
    _Pragma("unroll") for (int r = 0; r < 16; ++r) pA1[r] = __builtin_amdgcn_exp2f(fsub_s(pA1[r], mhat)); }
  BLOAD(pB0, pB1, 1);
  DKLOAD2(1, 0); DKLOAD2(1, 1); DKLOAD2(1, 2); DKLOAD2(1, 3);
  s16x4 vlo[8], vhi[8]; u32x4 pw0, pw1, pw2, pw3;
  #define PKW(P, B) cvtpk_s(P[B], P[B + 1])
  #define PAF(k) __builtin_bit_cast(bf16x8, pw##k)
  #define VFR(i) (bf16x8){vlo[i][0], vlo[i][1], vlo[i][2], vlo[i][3], vhi[i][0], vhi[i][1], vhi[i][2], vhi[i][3]}
  #define PIN(x) asm volatile("" : "+v"(x))
  #define MX3(a, b, c) __builtin_fmaxf(__builtin_fmaxf((a), (b)), (c))
  #define GAPA(MF, A0, A1, A2, A3, W0, W1, PW) do { MF; sacc += A0; sacc += A1; sacc += A2; sacc += A3; PIN(sacc); W0; W1; PIN(PW); SBAR(); } while (0)
  #define EX(v) __builtin_amdgcn_exp2f(v)
  #define GAPB(MF, X, B) do { MF; X[B] = EX(X[B] - mhat); X[B + 1] = EX(X[B + 1] - mhat); X[B + 2] = EX(X[B + 2] - mhat); X[B + 3] = EX(X[B + 3] - mhat); PIN(X); SBAR(); } while (0)
  #define VRD(i) do { const lds_cptr va_ = vl + VBO(g + 2 * tv_ + (((i) & 3) >> 1)) + ((i) >> 2) * 4096 + ((i) & 1) * 1024; vlo[i] = vtr(va_); vhi[i] = vtr(va_ + 512); } while (0)
  #define KRD(G, j) do { if (G) { DKLOAD2(tk_, j); SBAR(); } } while (0)
  #define STEP(C0, C1, P0, P1, t, GL) do { SBAR(); const int tv_ = (t) - 1, tk_ = (t) + 1; \
    VRD(0); SBAR(); float sacc = (P0[0] + P0[1]); \
    GAPA(C0 = __builtin_amdgcn_mfma_f32_32x32x16_bf16(kf[0], qr[0], C0, 0, 0, 0), P0[2], P0[3], P0[4], P0[5],     pw0[0] = PKW(P0, 0), pw0[1] = PKW(P0, 2), pw0); \
    VRD(4); SBAR(); GAPA(C1 = __builtin_amdgcn_mfma_f32_32x32x16_bf16(kf[1], qr[0], C1, 0, 0, 0), P0[6], P0[7], P0[8], P0[9],     pw0[2] = PKW(P0, 4), pw0[3] = PKW(P0, 6), pw0); \
    VRD(1); SBAR(); GAPA(C0 = __builtin_amdgcn_mfma_f32_32x32x16_bf16(kf[2], qr[1], C0, 0, 0, 0),   P0[10], P0[11], P0[12], P0[13], pw1[0] = PKW(P0, 8), pw1[1] = PKW(P0, 10), pw1); \
    VRD(5); SBAR(); GAPA(C1 = __builtin_amdgcn_mfma_f32_32x32x16_bf16(kf[3], qr[1], C1, 0, 0, 0),   P0[14], P0[15], P1[0], P1[1],   pw1[2] = PKW(P0, 12), pw1[3] = PKW(P0, 14), pw1); \
    VRD(2); SBAR(); GAPA(C0 = __builtin_amdgcn_mfma_f32_32x32x16_bf16(kf[4], qr[2], C0, 0, 0, 0),   P1[2], P1[3], P1[4], P1[5],     pw2[0] = PKW(P1, 0), pw2[1] = PKW(P1, 2), pw2); \
    VRD(6); SBAR(); GAPA(C1 = __builtin_amdgcn_mfma_f32_32x32x16_bf16(kf[5], qr[2], C1, 0, 0, 0),   P1[6], P1[7], P1[8], P1[9],     pw2[2] = PKW(P1, 4), pw2[3] = PKW(P1, 6), pw2); \
    VRD(3); SBAR(); GAPA(C0 = __builtin_amdgcn_mfma_f32_32x32x16_bf16(kf[6], qr[3], C0, 0, 0, 0),   P1[10], P1[11], P1[12], P1[13], pw3[0] = PKW(P1, 8), pw3[1] = PKW(P1, 10), pw3); \
    VRD(7); SBAR(); GAPA(C1 = __builtin_amdgcn_mfma_f32_32x32x16_bf16(kf[7], qr[3], C1, 0, 0, 0),   P1[14], P1[15], 0.f, 0.f,       pw3[2] = PKW(P1, 12), pw3[3] = PKW(P1, 14), pw3); \
    l_reg += sacc; \
    PMASK(C0, C1, t); \
    { float a = MX3(C0[0], C0[1], C1[0]), b = MX3(C0[2], C0[3], C1[1]); a = MX3(a, C1[2], C1[3]); \
      _Pragma("unroll") for (int r = 4; r < 16; r += 4) { a = MX3(a, C0[r], C0[r + 1]); b = MX3(b, C0[r + 2], C0[r + 3]); a = MX3(a, C1[r], C1[r + 1]); b = MX3(b, C1[r + 2], C1[r + 3]); } \
      float rm = __builtin_fmaxf(a, b); { auto rr = __builtin_amdgcn_permlane32_swap(__float_as_uint(rm), __float_as_uint(rm), false, false); rm = __builtin_fmaxf(__uint_as_float(rr[0]), __uint_as_float(rr[1])); } \
      rm -= mhat; resc = false; \
      if (__builtin_expect(__any(rm > (float)THRL), 0)) { const float dl = __builtin_fmaxf(rm, 0.f); mhat += dl; \
        const float f = __builtin_amdgcn_exp2f(-dl); l_reg *= f; if (hi == 0) wsf[r32] = f; resc = true; } } \
    SBAR(); \
    if ((t) + 1 < 3) { BLOAD(P0, P1, (t) + 1); SBAR(); } \
    GAPB(o[0] = __builtin_amdgcn_mfma_f32_32x32x16_bf16(PAF(0), VFR(0), o[0], 0, 0, 0), C0, 0); \
    GAPB(o[1] = __builtin_amdgcn_mfma_f32_32x32x16_bf16(PAF(0), VFR(4), o[1], 0, 0, 0), C0, 4); \
    KRD(GL, 0); GAPB(o[0] = __builtin_amdgcn_mfma_f32_32x32x16_bf16(PAF(1), VFR(1), o[0], 0, 0, 0), C0, 8); \
    KRD(GL, 1); GAPB(o[1] = __builtin_amdgcn_mfma_f32_32x32x16_bf16(PAF(1), VFR(5), o[1], 0, 0, 0), C0, 12); \
    KRD(GL, 2); GAPB(o[0] = __builtin_amdgcn_mfma_f32_32x32x16_bf16(PAF(2), VFR(2), o[0], 0, 0, 0), C1, 0); \
    KRD(GL, 3); GAPB(o[1] = __builtin_amdgcn_mfma_f32_32x32x16_bf16(PAF(2), VFR(6), o[1], 0, 0, 0), C1, 4); \
    GAPB(o[0] = __builtin_amdgcn_mfma_f32_32x32x16_bf16(PAF(3), VFR(3), o[0], 0, 0, 0), C1, 8); \
    GAPB(o[1] = __builtin_amdgcn_mfma_f32_32x32x16_bf16(PAF(3), VFR(7), o[1], 0, 0, 0), C1, 12); \
    } while (0)
  STEP(pB0, pB1, pA0, pA1, 1, true);  RESC();
  STEP(pA0, pA1, pB0, pB1, 2, false); RESC();
  { float sacc = pA0[0] + pA0[1]; _Pragma("unroll") for (int r = 2; r < 16; ++r) sacc += pA0[r]; _Pragma("unroll") for (int r = 0; r < 16; ++r) sacc += pA1[r]; l_reg += sacc;
    pw0 = (u32x4){PKW(pA0, 0), PKW(pA0, 2), PKW(pA0, 4), PKW(pA0, 6)}; pw1 = (u32x4){PKW(pA0, 8), PKW(pA0, 10), PKW(pA0, 12), PKW(pA0, 14)}; pw2 = (u32x4){PKW(pA1, 0), PKW(pA1, 2), PKW(pA1, 4), PKW(pA1, 6)}; pw3 = (u32x4){PKW(pA1, 8), PKW(pA1, 10), PKW(pA1, 12), PKW(pA1, 14)};
    SBAR(); const int tv_ = 2;
    VRD(0); VRD(1); VRD(2); VRD(3); VRD(4); VRD(5); VRD(6); VRD(7);
    o[0] = __builtin_amdgcn_mfma_f32_32x32x16_bf16(PAF(0), VFR(0), o[0], 0, 0, 0); o[1] = __builtin_amdgcn_mfma_f32_32x32x16_bf16(PAF(0), VFR(4), o[1], 0, 0, 0);
    o[0] = __builtin_amdgcn_mfma_f32_32x32x16_bf16(PAF(1), VFR(1), o[0], 0, 0, 0); o[1] = __builtin_amdgcn_mfma_f32_32x32x16_bf16(PAF(1), VFR(5), o[1], 0, 0, 0);
    o[0] = __builtin_amdgcn_mfma_f32_32x32x16_bf16(PAF(2), VFR(2), o[0], 0, 0, 0); o[1] = __builtin_amdgcn_mfma_f32_32x32x16_bf16(PAF(2), VFR(6), o[1], 0, 0, 0);
    o[0] = __builtin_amdgcn_mfma_f32_32x32x16_bf16(PAF(3), VFR(3), o[0], 0, 0, 0); o[1] = __builtin_amdgcn_mfma_f32_32x32x16_bf16(PAF(3), VFR(7), o[1], 0, 0, 0); }
  #undef PKW
  #undef PAF
  #undef VFR
  #undef PIN
  #undef MX3
  #undef GAPA
  #undef GAPB
  #undef EX
  #undef VRD
  #undef KRD
  #undef STEP
  const int qrel = wid * QBLK + r32;
  { auto rr = __builtin_amdgcn_permlane32_swap(__float_as_uint(l_reg), __float_as_uint(l_reg), false, false); l_reg = __uint_as_float(rr[0]) + __uint_as_float(rr[1]); }
  if (hi == 0) lsep[(long)(q0 + qrel) * lse_stride] = mhat + __log2f(l_reg);
  if (hi == 0) wsf[32 + r32] = l_reg; asm volatile("s_waitcnt lgkmcnt(0)" ::: "memory");
  float rli[16];
  #pragma unroll
  for (int r = 0; r < 16; ++r) rli[r] = __builtin_amdgcn_rcpf(wsf[32 + crow(r, hi)]);
  asm volatile("s_waitcnt lgkmcnt(0)\n\ts_barrier" ::: "memory");
  if (has_next) dil_issue_v(nxt, lds0, lane, wid);
  bf16* Ow = Op + (long)(q0 + wid * QBLK) * RS;
  { bf16* stg = (bf16*)(shm + kb) + wid * 2048;
    #pragma unroll
    for (int r = 0; r < 16; ++r) { const int orow = crow(r, hi);
      #pragma unroll
      for (int d0 = 0; d0 < 2; ++d0) stg[orow * 64 + d0 * 32 + r32] = __float2bfloat16(o[d0][r] * rli[r]); }
    asm volatile("s_waitcnt lgkmcnt(0)" ::: "memory");
    #pragma unroll
    for (int i = 0; i < 4; ++i) { const int row = i * 8 + (lane >> 3), ch = lane & 7; const u32x4 v = *(const u32x4*)(stg + row * 64 + ch * 8); ATTN_STORE16(Ow + (long)row * RS + ch * 8, v); } }
  if (!has_next) asm volatile("s_waitcnt lgkmcnt(0)\n\ts_barrier" ::: "memory");
  #undef KBO
  #undef VBO
  #undef DKLOAD2
  #undef BLOAD
  #undef PMASK
  #undef RESC
}
#undef SBAR
#undef WAIT_BAR
}
static_assert(attn_body::LDS_TOTAL <= RING_BYTES && attn_body::DL_TOTAL <= PHASE_LDS, "attention LDS");

#define XB_TMO      128
#define XB_XCNT(j)  (256  + 64 * (j))
#define XB_XSUB(j)  (1280 + 64 * (j))
#define XB_XGEN(j)  (2304 + 64 * (j))
#define XB_TOP      3328
#define XB_TOPGEN   3392
#define XCD_BAR_WORDS 3456
#define XB_SPIN_CAP (1u << 18)
__device__ __forceinline__ unsigned xb_ld(unsigned* p)              { return __hip_atomic_load(p, __ATOMIC_RELAXED, __HIP_MEMORY_SCOPE_AGENT); }
__device__ __forceinline__ unsigned xb_add(unsigned* p, unsigned v) { return __hip_atomic_fetch_add(p, v, __ATOMIC_RELAXED, __HIP_MEMORY_SCOPE_AGENT); }
__device__ __forceinline__ unsigned xb_xcc_id() { return (unsigned)__builtin_amdgcn_s_getreg((3 << 11) | 20) & 0xFu; }
#define XB_SPIN(cond, bar) do { unsigned _sp = 0; while (cond) { __builtin_amdgcn_s_sleep(1); \
    if ((++_sp & 255u) == 0u) { if (xb_ld(&(bar)[XB_TMO])) break; if (_sp > XB_SPIN_CAP) { atomicAdd(&(bar)[XB_TMO], 1u); break; } } } } while (0)
struct XcdBarrier { unsigned* bar; unsigned x; volatile LAS unsigned* st; };
__device__ __forceinline__ XcdBarrier xcd_barrier_post(unsigned* bar, volatile LAS unsigned* st) {
    XcdBarrier b; b.bar = bar; b.x = xb_xcc_id(); b.st = st;
    if (threadIdx.x == 0) (void)xb_add(&bar[XB_XCNT(b.x)], 1u);
    return b;
}
__device__ __forceinline__ void xcd_barrier_complete(unsigned* bar, unsigned x, unsigned& nloc, unsigned& nx) {
    const unsigned G = gridDim.x * gridDim.y * gridDim.z;
    unsigned sum, cnt, mine, sp = 0u;
    for (;;) {
        sum = 0u; cnt = 0u; mine = 0u;
#pragma unroll
        for (unsigned j = 0; j < 16; ++j) { const unsigned c = xb_ld(&bar[XB_XCNT(j)]); sum += c; cnt += (c > 0u) ? 1u : 0u; mine = (j == x) ? c : mine; }
        if (sum == G) break;
        __builtin_amdgcn_s_sleep(1);
        if ((++sp & 255u) == 0u) { if (xb_ld(&bar[XB_TMO])) break; if (sp > XB_SPIN_CAP) { atomicAdd(&bar[XB_TMO], 1u); break; } }
    }
    nloc = mine > 0u ? mine : 1u; nx = cnt > 0u ? cnt : 1u;
}
__device__ __forceinline__ void xcd_barrier(const XcdBarrier& b) {
    asm volatile("s_waitcnt vmcnt(0)" ::: "memory");
    __syncthreads();
    if (threadIdx.x == 0) {
        unsigned* bar = b.bar;
        __builtin_amdgcn_s_waitcnt(0);
        unsigned nloc = b.st[0], nx = b.st[1];
        if (nloc == 0u) { xcd_barrier_complete(bar, b.x, nloc, nx); b.st[0] = nloc; b.st[1] = nx; }
        const unsigned old = xb_add(&bar[XB_XSUB(b.x)], 1u);
        const unsigned gen = old / nloc;
        if (old + 1u == (gen + 1u) * nloc) {
            __builtin_amdgcn_fence(__ATOMIC_RELEASE, "agent");
            asm volatile("s_waitcnt vmcnt(0)" ::: "memory");
            const unsigned og = xb_add(&bar[XB_TOP], 1u);
            const unsigned tg = og / nx;
            if (og + 1u == (tg + 1u) * nx) xb_add(&bar[XB_TOPGEN], 1u);
            else XB_SPIN(xb_ld(&bar[XB_TOPGEN]) == tg, bar);
            __builtin_amdgcn_fence(__ATOMIC_ACQUIRE, "agent");
            xb_add(&bar[XB_XGEN(b.x)], 1u);
            asm volatile("s_waitcnt vmcnt(0)" ::: "memory");
        } else {
            XB_SPIN(xb_ld(&bar[XB_XGEN(b.x)]) == gen, bar);
            __builtin_amdgcn_fence(__ATOMIC_ACQUIRE, "agent");
            asm volatile("s_waitcnt vmcnt(0)" ::: "memory");
        }
    }
    __syncthreads();
}

struct Frame {
    LAS unsigned char* lds;
    volatile LAS unsigned* MISC;
    gu32* ctl;
    int tid, lane, wave;
    int vcu, G;
    unsigned char* ws;
    float* out;
};
#define LDS_WAIT() asm volatile("s_waitcnt lgkmcnt(0)" ::: "memory")

__device__ __forceinline__ void p0_mod(Frame& F, const float* c, const float* w_ada, const float* b_ada, float* mod) {
    LAS float* sc = (LAS float*)F.lds;
    LAS float* part = (LAS float*)(F.lds + 65536);
    __syncthreads();
    for (int cg = blockIdx.x; cg < NMOD / 64; cg += F.G) {
        for (int i = F.tid; i < BATCH * DM; i += NWAVES * 64) { const float v = c[i]; sc[i] = v / (1.f + __expf(-v)); }
        __syncthreads();
        const int n = cg * 64 + F.lane; float acc[BATCH];
#pragma unroll
        for (int b = 0; b < BATCH; ++b) acc[b] = 0.f;
        const int kb = F.wave * 128;
        for (int k0 = kb; k0 < kb + 128; k0 += 32) { float wv[32];
#pragma unroll
            for (int i = 0; i < 32; ++i) wv[i] = w_ada[(size_t)(k0 + i) * NMOD + n];
#pragma unroll
            for (int i = 0; i < 32; ++i)
#pragma unroll
                for (int b = 0; b < BATCH; ++b) acc[b] += sc[b * DM + k0 + i] * wv[i]; }
#pragma unroll
        for (int b = 0; b < BATCH; ++b) part[(F.wave * BATCH + b) * 64 + F.lane] = acc[b];
        __syncthreads();
        for (int o = F.tid; o < BATCH * 64; o += NWAVES * 64) { const int b = o >> 6, l = o & 63; float s = b_ada[cg * 64 + l];
#pragma unroll
            for (int w = 0; w < NWAVES; ++w) s += part[(w * BATCH + b) * 64 + l];
            mod[(size_t)b * NMOD + cg * 64 + l] = s; }
        __syncthreads();
    }
}
__device__ __forceinline__ int gu_row(int c, int up) { return (c >> 7) * 256 + up * 128 + (c & 127); }
__device__ __forceinline__ int dn_row(int c) { const int cc = c & 255; return (c & ~255) + ((cc >> 5) & 1) * 128 + (cc >> 6) * 32 + (cc & 31); }
struct P0Ptrs { const float *w_in, *w_out, *w_router, *w_eg, *w_eu, *w_ed, *w_sg, *w_su, *w_sd; };
struct TrItem { const float* src; unsigned char* dst; int ldw, Kd, f8; };
__device__ __forceinline__ TrItem tr_make(const float* W, int ldw, int k0, int c0, void* WT, int drow0, int Kd, int f8 = 0) { TrItem t; t.src = W + (size_t)k0 * ldw + c0; t.dst = (unsigned char*)WT + ((size_t)drow0 * Kd + k0) * (f8 ? 1 : 2); t.ldw = ldw; t.Kd = Kd; t.f8 = f8; return t; }
__device__ __forceinline__ TrItem p0_decode(const P0Ptrs& P, unsigned char* ws, int it) {
    bf16_t* WIN = (bf16_t*)(ws + WS_WIN); bf16_t* WOUT = (bf16_t*)(ws + WS_WOUT); bf16_t* WR = (bf16_t*)(ws + WS_WR);
    bf16_t* WSHGU = (bf16_t*)(ws + WS_WSHGU); bf16_t* WSHD = (bf16_t*)(ws + WS_WSHD); unsigned char* WD = ws + WS_WD; unsigned char* WGU = ws + WS_WGU;
    constexpr int I_EXP = NEXP * 384, I_IN = 768, I_OUT = 512, I_S = 128;
    int r = it;
    if (r < I_EXP) { const int e = r / 384, q = r % 384;
        if (q < 256) { const int up = q >> 7, qq = q & 127, kb = qq >> 3, nb = qq & 7;
            return tr_make((up ? P.w_eu : P.w_eg) + (size_t)e * DM * EH, EH, 64 * kb, 32 * nb, WGU + (size_t)e * 512 * DM, gu_row(32 * nb, up), DM, 1); }
        const int qq = q - 256, kb = qq >> 5, nb = qq & 31;
        return tr_make(P.w_ed + (size_t)e * EH * DM, DM, 64 * kb, 32 * nb, WD + (size_t)e * DM * EH, dn_row(32 * nb), EH, 1); }
    r -= I_EXP;
    if (r < I_IN) { const int kb = r / 48, nb = r % 48; return tr_make(P.w_in, INC, 64 * kb, 32 * nb, WIN, 32 * nb, DM); } r -= I_IN;
    if (r < I_IN) { const int kb = r / 48, nb = r % 48; return tr_make(P.w_in, INC, 64 * kb, 1544 + 32 * nb, WIN, 1536 + 32 * nb, DM); } r -= I_IN;
    if (r < I_OUT) { const int kb = r >> 5, nb = r & 31; return tr_make(P.w_out, DM, 64 * kb, 32 * nb, WOUT, 32 * nb, DM); } r -= I_OUT;
    if (r < I_S) { const int kb = r >> 3, nb = r & 7; return tr_make(P.w_router, NEXP, 64 * kb, 32 * nb, WR, 32 * nb, DM); } r -= I_S;
    if (r < I_S) { const int kb = r >> 3, nb = r & 7; return tr_make(P.w_sg, EH, 64 * kb, 32 * nb, WSHGU, gu_row(32 * nb, 0), DM); } r -= I_S;
    if (r < I_S) { const int kb = r >> 3, nb = r & 7; return tr_make(P.w_su, EH, 64 * kb, 32 * nb, WSHGU, gu_row(32 * nb, 1), DM); } r -= I_S;
    { const int kb = r >> 5, nb = r & 31; return tr_make(P.w_sd, DM, 64 * kb, 32 * nb, WSHD, dn_row(32 * nb), EH); }
}
__device__ __forceinline__ void tr_load(const TrItem& t, int lane, f32x4 (&v)[8]) {
    const float* p = t.src + (size_t)(lane >> 3) * t.ldw + (lane & 7) * 4;
#pragma unroll
    for (int i = 0; i < 8; ++i) v[i] = *(const GAS f32x4*)(p + (size_t)(8 * i) * t.ldw);
}
__device__ __forceinline__ void tr_store(const TrItem& t, int lane, const f32x4 (&v)[8], LAS float* scr) {
    LAS float* w = scr + (lane >> 3) * 33 + (lane & 7) * 4;
#pragma unroll
    for (int i = 0; i < 8; ++i) { w[(8 * i) * 33 + 0] = v[i].x; w[(8 * i) * 33 + 1] = v[i].y; w[(8 * i) * 33 + 2] = v[i].z; w[(8 * i) * 33 + 3] = v[i].w; }
    LDS_WAIT(); asm volatile("" ::: "memory");
    const int c = lane & 7;
#pragma unroll
    for (int j = 0; j < 4; ++j) { const int n = (lane >> 3) + 8 * j; const LAS float* s = scr + (8 * c) * 33 + n;
        if (t.f8) { int w0 = __builtin_amdgcn_cvt_pk_fp8_f32(s[0 * 33], s[1 * 33], 0, false); w0 = __builtin_amdgcn_cvt_pk_fp8_f32(s[2 * 33], s[3 * 33], w0, true);
            int w1 = __builtin_amdgcn_cvt_pk_fp8_f32(s[4 * 33], s[5 * 33], 0, false); w1 = __builtin_amdgcn_cvt_pk_fp8_f32(s[6 * 33], s[7 * 33], w1, true);
            u32x2 o; o.x = (unsigned)w0; o.y = (unsigned)w1; *(GAS u32x2*)(t.dst + (size_t)n * t.Kd + 8 * c) = o; }
        else { u32x4 o; o.x = cvt_pk_bf16(s[0 * 33], s[1 * 33]); o.y = cvt_pk_bf16(s[2 * 33], s[3 * 33]); o.z = cvt_pk_bf16(s[4 * 33], s[5 * 33]); o.w = cvt_pk_bf16(s[6 * 33], s[7 * 33]);
            *(GAS u32x4*)(t.dst + ((size_t)n * t.Kd + 8 * c) * 2) = o; } }
    LDS_WAIT(); asm volatile("" ::: "memory");
}
__device__ __forceinline__ void p0_weights(Frame& F, const P0Ptrs& P, int it_lo, int it_hi) {
    LAS float* scr = (LAS float*)(F.lds + F.wave * 16384);
    const int gw = F.vcu * NWAVES + F.wave, NGW = F.G * NWAVES;
    int it = it_lo + gw; if (it >= it_hi) return;
    TrItem cur = p0_decode(P, F.ws, it); f32x4 v[8]; tr_load(cur, F.lane, v);
    for (;;) {
        const int nit = it + NGW; const bool more = nit < it_hi;
        f32x4 nv[8];
        const TrItem nx = p0_decode(P, F.ws, more ? nit : it); tr_load(nx, F.lane, nv);
        tr_store(cur, F.lane, v, scr);
        if (!more) break;
        cur = nx; it = nit;
#pragma unroll
        for (int i = 0; i < 8; ++i) v[i] = nv[i];
    }
}
constexpr int P0_EXPERT_ITEMS = NEXP * 384, P0_ALL_ITEMS = NEXP * 384 + 2 * 768 + 512 + 4 * 128;
struct CvItem { const float* src; unsigned char* dst; int ldw, Kd, rowbase, down, n0; };
__device__ __forceinline__ CvItem cv_decode(const P0Ptrs& P, unsigned char* ws, int sit) {
    const int e = sit / 24, q = sit % 24; CvItem c;
    if (q < 16) { const int up = q >> 3, kb = q & 7;
        c.src = (up ? P.w_eu : P.w_eg) + (size_t)e * DM * EH + (size_t)(128 * kb) * EH; c.ldw = EH; c.dst = ws + WS_WGU + (size_t)e * 512 * DM + 128 * kb; c.Kd = DM; c.rowbase = up * 128; c.down = 0; c.n0 = 0; }
    else { const int qq = q - 16, kb = qq >> 2, nb = qq & 3;
        c.src = P.w_ed + (size_t)e * EH * DM + (size_t)(128 * kb) * DM + 256 * nb; c.ldw = DM; c.dst = ws + WS_WD + (size_t)e * DM * EH + 128 * kb; c.Kd = EH; c.rowbase = 0; c.down = 1; c.n0 = 256 * nb; }
    return c;
}
__device__ __forceinline__ void cv_issue(Frame& F, const CvItem& c, int sub, int buf) {
    const float* g = c.src + (size_t)(32 * sub + 4 * F.wave) * c.ldw + F.lane * 4;
#pragma unroll
    for (int i = 0; i < 4; ++i) __builtin_amdgcn_global_load_lds((const unsigned*)(g + (size_t)i * c.ldw), (LAS unsigned*)(F.lds + buf * 32768 + (4 * F.wave + i) * 1024), 16, 0, 0);
}
__device__ __forceinline__ void conv_experts(Frame& F, const P0Ptrs& P) {
    constexpr int NSI = NEXP * 24;
    const int G = F.G; const int si0 = F.vcu; if (si0 >= NSI) return;
    const int nmine = (NSI - si0 + G - 1) / G;
    const int NT = nmine * 4;
    int tid_ = threadIdx.x; asm volatile("" : "+v"(tid_)); const int tid = tid_;
    LAS unsigned char* Bb = F.lds + 3 * 32768;
#define CV_SUB(t_) do { const int tt_ = (t_) < NT ? (t_) : NT - 1; const CvItem c_ = cv_decode(P, F.ws, si0 + (tt_ >> 2) * G); cv_issue(F, c_, tt_ & 3, (t_) % 3); } while (0)
    CV_SUB(0); CV_SUB(1);
    CvItem cur = cv_decode(P, F.ws, si0);
    for (int t = 0; t < NT; ++t) { const int sub = t & 3;
        asm volatile("s_waitcnt vmcnt(4)" ::: "memory");
        __builtin_amdgcn_s_barrier(); asm volatile("" ::: "memory");
        CV_SUB(t + 2);
        { const int n = tid & 255, kq = tid >> 8; const LAS float* a = (const LAS float*)(F.lds + (t % 3) * 32768) + (16 * kq) * 256 + n; unsigned w[4];
#pragma unroll
          for (int j = 0; j < 4; ++j) { const float f0 = a[(4 * j) * 256], f1 = a[(4 * j + 1) * 256], f2 = a[(4 * j + 2) * 256], f3 = a[(4 * j + 3) * 256];
              int q0 = __builtin_amdgcn_cvt_pk_fp8_f32(f0, f1, 0, false); q0 = __builtin_amdgcn_cvt_pk_fp8_f32(f2, f3, q0, true); w[j] = (unsigned)q0; }
          *(LAS u32x4*)(Bb + n * 144 + 32 * sub + 16 * kq) = (u32x4){w[0], w[1], w[2], w[3]}; }
        if (sub == 3) {
            asm volatile("s_waitcnt lgkmcnt(0)" ::: "memory"); __builtin_amdgcn_s_barrier(); asm volatile("" ::: "memory");
#pragma unroll
            for (int j = 0; j < 4; ++j) { const int nl = (tid >> 3) + 64 * j, ch = tid & 7; const u32x4 v = *(const LAS u32x4*)(Bb + nl * 144 + 16 * ch);
                const int drow = cur.down ? dn_row(cur.n0 + nl) : (nl >> 7) * 256 + cur.rowbase + (nl & 127);
                *(GAS u32x4*)(cur.dst + (size_t)drow * cur.Kd + 16 * ch) = v; }
            asm volatile("s_waitcnt lgkmcnt(0)" ::: "memory");
            if (t + 1 < NT) cur = cv_decode(P, F.ws, si0 + ((t + 1) >> 2) * G);
        }
    }
#undef CV_SUB
    asm volatile("s_waitcnt vmcnt(0)" ::: "memory");
    __builtin_amdgcn_s_barrier();
}
template <bool FL> __device__ __forceinline__ void norm_rows(Frame& F, const float* src  , bf16_t* dst, const float* mod, int shift_off, int scale_off, const float* w_in, const float* b_forget, float* lf, unsigned char* dst8) {
    LAS float* wf = (LAS float*)F.lds;
    if (FL) { for (int i = F.tid; i < DM * NH; i += NWAVES * 64) wf[(i & 7) * DM + (i >> 3)] = w_in[(size_t)(i >> 3) * INC + 1536 + (i & 7)]; __syncthreads(); }
    const int gw = F.vcu * NWAVES + F.wave, NGW = F.G * NWAVES;
    constexpr int CH = 32;
#define NR_ROW(i_) (rowb + 128 * (i_))
#define NR_LD(dst_, row_, j_) do { if (FL) dst_ = ((const GAS f32x4*)(src + (size_t)(row_) * DM) + F.lane)[64 * (j_)]; \
        else { const u32x2 t_ = ((const GAS u32x2*)x1_row(F.ws, (size_t)(row_)) + F.lane)[64 * (j_)]; dst_ = (f32x4){bf_lo(t_.x), bf_hi(t_.x), bf_lo(t_.y), bf_hi(t_.y)}; } } while (0)
    for (int ch = gw; ch < M / CH; ch += NGW) {
        const int b = ch >> 7, rowb = b * SEQ + (ch & 127);
        f32x4 sc[4], sh[4];
#pragma unroll
        for (int j = 0; j < 4; ++j) { sc[j] = *(const f32x4*)(mod + (size_t)b * NMOD + scale_off + 256 * j + 4 * F.lane) + 1.f; sh[j] = *(const f32x4*)(mod + (size_t)b * NMOD + shift_off + 256 * j + 4 * F.lane); }
        f32x4 nv[2][4];
#pragma unroll
        for (int q = 0; q < 2; ++q)
#pragma unroll
            for (int j = 0; j < 4; ++j) NR_LD(nv[q][j], NR_ROW(q), j);
        for (int mm = 0; mm < CH; mm += 2) {
            f32x4 vv[2][4];
#pragma unroll
            for (int q = 0; q < 2; ++q)
#pragma unroll
                for (int j = 0; j < 4; ++j) vv[q][j] = nv[q][j];
            if (mm + 2 < CH) {
#pragma unroll
                for (int q = 0; q < 2; ++q)
#pragma unroll
                    for (int j = 0; j < 4; ++j) NR_LD(nv[q][j], NR_ROW(mm + 2 + q), j); }
#pragma unroll
            for (int q = 0; q < 2; ++q) { const int m = NR_ROW(mm + q); f32x4 (&v)[4] = vv[q];
            float s2 = 0.f;
#pragma unroll
            for (int j = 0; j < 4; ++j) s2 += (v[j].x * v[j].x + v[j].y * v[j].y) + (v[j].z * v[j].z + v[j].w * v[j].w);
            const float r = 1.f / sqrtf(wave_sum(s2) * (1.f / DM) + EPS);
#pragma unroll
            for (int j = 0; j < 4; ++j) v[j] = v[j] * r * sc[j] + sh[j];
            GAS u32x2* o8 = (GAS u32x2*)(dst + (size_t)m * DM) + F.lane;
#pragma unroll
            for (int j = 0; j < 4; ++j) { u32x2 w; w.x = cvt_pk_bf16(v[j].x, v[j].y); w.y = cvt_pk_bf16(v[j].z, v[j].w); o8[64 * j] = w; }
            if (!FL) { GAS unsigned* o4 = (GAS unsigned*)(dst8 + (size_t)m * DM) + F.lane;
#pragma unroll
                for (int j = 0; j < 4; ++j) { int w = __builtin_amdgcn_cvt_pk_fp8_f32(v[j].x, v[j].y, 0, false); w = __builtin_amdgcn_cvt_pk_fp8_f32(v[j].z, v[j].w, w, true); o4[64 * j] = (unsigned)w; } }
            if (FL) { float fl[NH];
#pragma unroll
                for (int h = 0; h < NH; ++h) fl[h] = 0.f;
#pragma unroll
                for (int j = 0; j < 4; ++j)
#pragma unroll
                    for (int h = 0; h < NH; ++h) { const f32x4 w4 = *(const LAS f32x4*)(wf + h * DM + 256 * j + 4 * F.lane); fl[h] += (v[j].x * w4.x + v[j].y * w4.y) + (v[j].z * w4.z + v[j].w * w4.w); }
                const float mine = reduce8_heads(fl, F.lane); const int hh = F.lane >> 3;
                if ((F.lane & 7) == 0) { const float z = mine + b_forget[hh]; const float ls = fminf(z, 0.f) - log1pf(__expf(-fabsf(z))); lf[((size_t)b * NH + hh) * SEQ + (m & (SEQ - 1))] = ls; } }
            }
        }
    }
}
#undef NR_ROW
#undef NR_LD
__device__ __forceinline__ void scan_rows(Frame& F, const float* lf, float* kb, int* t0tab) {
    LAS float* wt = (LAS float*)F.lds; LAS float* kl = wt + 16;
    for (int s = blockIdx.x; s < BATCH * NH; s += F.G) {
        const float* src = lf + (size_t)s * SEQ + F.tid * 8; float v[8];
        { const f32x4 a = *(const f32x4*)src, b2 = *(const f32x4*)(src + 4); v[0] = a.x; v[1] = a.y; v[2] = a.z; v[3] = a.w; v[4] = b2.x; v[5] = b2.y; v[6] = b2.z; v[7] = b2.w; }
#pragma unroll
        for (int i = 1; i < 8; ++i) v[i] += v[i - 1];
        float incl = v[7];
#pragma unroll
        for (int o = 1; o < 64; o <<= 1) { const float t = __shfl_up(incl, o); if (F.lane >= o) incl += t; }
        if (F.lane == 63) wt[F.wave] = incl;
        __syncthreads();
        float base = incl - v[7];
        for (int w = 0; w < F.wave; ++w) base += wt[w];
        float* dst = kb + (size_t)s * SEQ + F.tid * 8;
        f32x4 a, b2; a.x = -(v[0] + base) * LOG2E; a.y = -(v[1] + base) * LOG2E; a.z = -(v[2] + base) * LOG2E; a.w = -(v[3] + base) * LOG2E;
        b2.x = -(v[4] + base) * LOG2E; b2.y = -(v[5] + base) * LOG2E; b2.z = -(v[6] + base) * LOG2E; b2.w = -(v[7] + base) * LOG2E;
        *(f32x4*)dst = a; *(f32x4*)(dst + 4) = b2;
        *(LAS f32x4*)(kl + F.tid * 8) = a; *(LAS f32x4*)(kl + F.tid * 8 + 4) = b2;
        __syncthreads();
        if (F.tid < 16) { const int q0 = 256 * F.tid; const float target = kl[q0] - FOX_SKIP_LOG2; int lo = 0, hi = q0;
            while (lo < hi) { const int mid = (lo + hi) >> 1; if (kl[mid] <= target) lo = mid + 1; else hi = mid; }
            t0tab[s * 16 + F.tid] = (lo >> 6) & ~1; }
        __syncthreads();
    }
}
__device__ __forceinline__ void unpack8(const u32x4 w, float* f) { f[0] = bf_lo(w.x); f[1] = bf_hi(w.x); f[2] = bf_lo(w.y); f[3] = bf_hi(w.y); f[4] = bf_lo(w.z); f[5] = bf_hi(w.z); f[6] = bf_lo(w.w); f[7] = bf_hi(w.w); }
__device__ __forceinline__ void merge_rows(Frame& F, const float* g_fox, const float* g_dil) {
    const bf16_t* OF = (const bf16_t*)(F.ws + WS_OF); const bf16_t* O1 = (const bf16_t*)(F.ws + WS_O1); const bf16_t* O2 = (const bf16_t*)(F.ws + WS_O2); const bf16_t* O3 = (const bf16_t*)(F.ws + WS_O3);
    const float* LSE = (const float*)(F.ws + WS_LSE); bf16_t* YM = (bf16_t*)(F.ws + WS_YM);
    const int gw = F.vcu * NWAVES + F.wave, NGW = F.G * NWAVES;
    float gf[8], gd[8];
    { const f32x4 a = *(const f32x4*)(g_fox + 8 * F.lane), b = *(const f32x4*)(g_fox + 8 * F.lane + 4), c = *(const f32x4*)(g_dil + 8 * F.lane), d = *(const f32x4*)(g_dil + 8 * F.lane + 4);
      gf[0] = a.x; gf[1] = a.y; gf[2] = a.z; gf[3] = a.w; gf[4] = b.x; gf[5] = b.y; gf[6] = b.z; gf[7] = b.w; gd[0] = c.x; gd[1] = c.y; gd[2] = c.z; gd[3] = c.w; gd[4] = d.x; gd[5] = d.y; gd[6] = d.z; gd[7] = d.w; }
    struct Row { u32x4 wf, w1, w2, w3; float l1, l2, l3; };
    const int hd = F.lane >> 3;
#define MR_LOAD(R, m_) do { const size_t eo_ = (size_t)(m_) * HW + 8 * F.lane; R.wf = *(const GAS u32x4*)(OF + eo_); R.w1 = *(const GAS u32x4*)(O1 + eo_); R.w2 = *(const GAS u32x4*)(O2 + eo_); R.w3 = *(const GAS u32x4*)(O3 + eo_); \
        R.l1 = LSE[(size_t)(m_) * NH + hd]; R.l2 = LSE[(size_t)M * NH + (size_t)(m_) * NH + hd]; R.l3 = LSE[(size_t)2 * M * NH + (size_t)(m_) * NH + hd]; } while (0)
    for (int ch = gw; ch < M / 32; ch += NGW) {
        const size_t rowb = (size_t)(ch >> 7) * SEQ + (ch & 127);
        Row nr[2]; MR_LOAD(nr[0], rowb); MR_LOAD(nr[1], rowb + 128);
        for (int mm = 0; mm < 32; mm += 2) {
            Row cr[2]; cr[0] = nr[0]; cr[1] = nr[1];
            if (mm + 2 < 32) { MR_LOAD(nr[0], rowb + 128 * (mm + 2)); MR_LOAD(nr[1], rowb + 128 * (mm + 3)); }
#pragma unroll
            for (int q = 0; q < 2; ++q) { const size_t m = rowb + 128 * (mm + q); const Row& R = cr[q];
            const float mx = fmaxf(R.l1, fmaxf(R.l2, R.l3)); float e1 = __builtin_amdgcn_exp2f(R.l1 - mx), e2 = __builtin_amdgcn_exp2f(R.l2 - mx), e3 = __builtin_amdgcn_exp2f(R.l3 - mx);
            const float inv = 1.f / (e1 + e2 + e3); e1 *= inv; e2 *= inv; e3 *= inv;
            float yf[8], a1[8], a2[8], a3[8], yd[8]; unpack8(R.wf, yf); unpack8(R.w1, a1); unpack8(R.w2, a2); unpack8(R.w3, a3);
            float sf = 0.f, sd = 0.f;
#pragma unroll
            for (int i = 0; i < 8; ++i) { yd[i] = e1 * a1[i] + e2 * a2[i] + e3 * a3[i]; sf += yf[i] * yf[i]; sd += yd[i] * yd[i]; }
            const float rf = 1.f / sqrtf(wave_sum(sf) * (1.f / HW) + EPS), rd = 1.f / sqrtf(wave_sum(sd) * (1.f / HW) + EPS);
            u32x4 of, od;
            of.x = cvt_pk_bf16(yf[0] * rf * gf[0], yf[1] * rf * gf[1]); of.y = cvt_pk_bf16(yf[2] * rf * gf[2], yf[3] * rf * gf[3]); of.z = cvt_pk_bf16(yf[4] * rf * gf[4], yf[5] * rf * gf[5]); of.w = cvt_pk_bf16(yf[6] * rf * gf[6], yf[7] * rf * gf[7]);
            od.x = cvt_pk_bf16(yd[0] * rd * gd[0], yd[1] * rd * gd[1]); od.y = cvt_pk_bf16(yd[2] * rd * gd[2], yd[3] * rd * gd[3]); od.z = cvt_pk_bf16(yd[4] * rd * gd[4], yd[5] * rd * gd[5]); od.w = cvt_pk_bf16(yd[6] * rd * gd[6], yd[7] * rd * gd[7]);
            *(GAS u32x4*)(YM + m * DM + 8 * F.lane) = of; *(GAS u32x4*)(YM + m * DM + HW + 8 * F.lane) = od; }
        }
    }
#undef MR_LOAD
}
__device__ __forceinline__ void route_rows(Frame& F, int pm, const float* logits, const float* rbias, unsigned* list, float* wts, unsigned* pose) {
    LAS unsigned* lcount = (LAS unsigned*)F.lds;
    LAS unsigned* lbase = lcount + 256;
    LAS unsigned* lsel = lbase + 256;
    LAS unsigned* lwt = lsel + 2048;
    if (F.tid < 256) lcount[F.tid] = 0u;
    __syncthreads();
    const f32x4 rb = *(const f32x4*)(rbias + 4 * F.lane);
#define DPPF(x, ctrl) __int_as_float(__builtin_amdgcn_update_dpp(0, __float_as_int(x), ctrl, 0xF, 0xF, false))
#define DPPUMAX(v, ctrl, rm) v = max(v, (unsigned)__builtin_amdgcn_update_dpp(0, (int)v, ctrl, rm, 0xF, false))
    f32x4 lgn = *(const GAS f32x4*)(logits + ((size_t)pm * 256 + F.wave * 32) * NEXP + 4 * F.lane);
    for (int i = 0; i < 32; ++i) { const int rl = F.wave * 32 + i; const size_t row = (size_t)pm * 256 + rl;
        const f32x4 lg = lgn;
        if (i + 1 < 32) lgn = *(const GAS f32x4*)(logits + (row + 1) * NEXP + 4 * F.lane);
        float s[4], sel[4];
#pragma unroll
        for (int q = 0; q < 4; ++q) { s[q] = 1.f / (1.f + __expf(-lg[q])); sel[q] = s[q] + rb[q]; }
        float m1 = -INFINITY, m2 = -INFINITY;
#pragma unroll
        for (int q = 0; q < 4; ++q) { if (sel[q] > m1) { m2 = m1; m1 = sel[q]; } else if (sel[q] > m2) m2 = sel[q]; }
        { float b1 = DPPF(m1, 0xB1), b2 = DPPF(m2, 0xB1); float n1 = fmaxf(m1, b1), n2 = fmaxf(fminf(m1, b1), fmaxf(m2, b2)); m1 = n1; m2 = n2;
          b1 = DPPF(m1, 0x4E); b2 = DPPF(m2, 0x4E); n1 = fmaxf(m1, b1); n2 = fmaxf(fminf(m1, b1), fmaxf(m2, b2)); m1 = n1; m2 = n2;
          b1 = DPPF(m1, 0x141); b2 = DPPF(m2, 0x141); n1 = fmaxf(m1, b1); n2 = fmaxf(fminf(m1, b1), fmaxf(m2, b2)); m1 = n1; m2 = n2; }
        const float gs = m1 + m2; const int g = F.lane >> 3; int rank = 0;
#pragma unroll
        for (int gg = 0; gg < 8; ++gg) { const float og = __int_as_float(__builtin_amdgcn_readlane(__float_as_int(gs), gg * 8)); rank += (og > gs || (og == gs && gg < g)) ? 1 : 0; }
        const bool gsel = rank < 4;
        unsigned key[4];
#pragma unroll
        for (int q = 0; q < 4; ++q) { const unsigned bq = __float_as_uint(sel[q]); key[q] = gsel ? (bq ^ ((bq >> 31) ? 0xffffffffu : 0x80000000u)) : 0u; }
        int myE = 0; float myS = 0.f, ssum = 0.f;
#pragma unroll 1
        for (int k = 0; k < TOPK; ++k) {
            unsigned v = max(max(key[0], key[1]), max(key[2], key[3]));
            DPPUMAX(v, 0xB1, 0xF); DPPUMAX(v, 0x4E, 0xF); DPPUMAX(v, 0x141, 0xF); DPPUMAX(v, 0x140, 0xF); DPPUMAX(v, 0x142, 0xA); DPPUMAX(v, 0x143, 0xC);
            const unsigned best = (unsigned)__builtin_amdgcn_readlane((int)v, 63);
            const int myq = (key[0] == best) ? 0 : (key[1] == best) ? 1 : (key[2] == best) ? 2 : (key[3] == best) ? 3 : 4;
            const unsigned long long bal = __ballot(myq < 4);
            const int L = __builtin_amdgcn_readfirstlane((int)__ffsll((long long)bal) - 1);
            const int q = __builtin_amdgcn_readlane(myq, L);
            const float mys = (q == 0) ? s[0] : (q == 1) ? s[1] : (q == 2) ? s[2] : s[3];
            const float sk = __int_as_float(__builtin_amdgcn_readlane(__float_as_int(mys), L));
            if (F.lane == L) {
#pragma unroll
                for (int qq = 0; qq < 4; ++qq) if (qq == q) key[qq] = 0u; }
            if (F.lane == k) { myE = 4 * L + q; myS = sk; }
            ssum += sk;
        }
        if (F.lane < TOPK) { const unsigned lp = atomicAdd((unsigned*)(lcount + myE), 1u); lsel[rl * 8 + F.lane] = (unsigned)myE | (lp << 8); lwt[rl * 8 + F.lane] = __float_as_uint(myS / ssum * 2.5f); }
    }
#undef DPPF
#undef DPPUMAX
    __syncthreads();
    if (F.tid < 256) { const unsigned n = lcount[F.tid]; lbase[F.tid] = n ? __hip_atomic_fetch_add((unsigned*)(F.ctl + CW_CNT + F.tid), n, RLX_AGENT) : 0u; }
    __syncthreads();
    for (int a = F.tid; a < 2048; a += NWAVES * 64) { const unsigned se = lsel[a]; const unsigned e = se & 255u, lp = se >> 8; const unsigned pos = lbase[e] + lp; const unsigned tok = (unsigned)(pm * 256 + (a >> 3));
        wts[(size_t)tok * TOPK + (a & 7)] = __uint_as_float(lwt[a]); pose[(size_t)tok * TOPK + (a & 7)] = (e << 16) | (pos & 0xffffu);
        if (pos < (unsigned)LCAP) list[(size_t)e * LCAP + pos] = tok | ((unsigned)(a & 7) << 16); }
    __syncthreads();
}
__device__ __forceinline__ void build_tables(Frame& F) {
    LAS unsigned* tp = (LAS unsigned*)(F.lds + TAB_OFF); LAS unsigned* cn = tp + 260; LAS unsigned* cp = cn + 256; LAS unsigned* wt = cp + 256;
    __syncthreads();
    unsigned cnt = 0u, tiles = 0u, incl = 0u, cincl = 0u;
    if (F.tid < 256) { cnt = __hip_atomic_load((unsigned*)(F.ctl + CW_CNT + F.tid), RLX_AGENT); if (cnt > (unsigned)LCAP) cnt = LCAP; tiles = (cnt + 255u) >> 8; incl = tiles; cincl = cnt;
#pragma unroll
        for (int o = 1; o < 64; o <<= 1) { const unsigned t = __shfl_up(incl, o), t2 = __shfl_up(cincl, o); if (F.lane >= o) { incl += t; cincl += t2; } }
        if (F.lane == 63) { wt[F.wave] = incl; wt[8 + F.wave] = cincl; } }
    __syncthreads();
    if (F.tid < 256) { unsigned base = 0u, cbase = 0u; for (int w = 0; w < F.wave; ++w) { base += wt[w]; cbase += wt[8 + w]; } tp[F.tid + 1] = base + incl; cn[F.tid] = cnt; cp[F.tid] = cbase + cincl - cnt; if (F.tid == 0) tp[0] = 0u;
        LAS unsigned short* mt2e = (LAS unsigned short*)(F.lds + MT2E_OFF); const unsigned t0 = base + incl - tiles; for (unsigned t = 0; t < tiles; ++t) mt2e[t0 + t] = (unsigned short)F.tid; }
    __syncthreads();
}
__device__ __forceinline__ void combine_rows(Frame& F, const float* gate2, const float* g_final, float* dst) {
    const unsigned char* Y = (const unsigned char*)(F.ws + WS_YBUF); const float* WT = (const float*)(F.ws + WS_WTS); const unsigned* PE = (const unsigned*)(F.ws + WS_POSE);
    const LAS unsigned* cp = (const LAS unsigned*)(F.lds + TAB_OFF) + 260 + 256;
    const int gw = F.vcu * NWAVES + F.wave, NGW = F.G * NWAVES; const int c0 = 16 * F.lane;
    const unsigned char* YS = (const unsigned char*)(F.ws + WS_YSH);
    struct CRow { u32x4 yv[8]; u32x4 ys, xb[2]; f32x4 w0, w1; };
#define CR_LOAD(R, m_) do { const size_t mq_ = (size_t)(m_); const unsigned pe_ = PE[mq_ * TOPK + (F.lane & 7)]; const unsigned myrow_ = cp[pe_ >> 16] + (pe_ & 0xffffu); \
        _Pragma("unroll") for (int k = 0; k < 8; ++k) { const size_t yr_ = (size_t)(unsigned)__builtin_amdgcn_readlane((int)myrow_, k); R.yv[k] = *(const GAS u32x4*)(Y + yr_ * DM + c0); } \
        R.ys = *(const GAS u32x4*)(YS + mq_ * DM + c0); const GAS u32x4* or_ = (const GAS u32x4*)(x1_row(F.ws, mq_) + c0); R.xb[0] = or_[0]; R.xb[1] = or_[1]; R.w0 = *(const GAS f32x4*)(WT + mq_ * TOPK); R.w1 = *(const GAS f32x4*)(WT + mq_ * TOPK + 4); } while (0)
    f32x4 gf[4];
#pragma unroll
    for (int j = 0; j < 4; ++j) gf[j] = *(const f32x4*)(g_final + c0 + 4 * j);
    for (int ch = gw; ch < M / 32; ch += NGW) {
        const int b = ch >> 7; const size_t rowb = (size_t)b * SEQ + (ch & 127);
        f32x4 g2[4];
#pragma unroll
        for (int j = 0; j < 4; ++j) g2[j] = *(const f32x4*)(gate2 + (size_t)b * NMOD + c0 + 4 * j) * (1.f / YSCALE);
        CRow nr; CR_LOAD(nr, rowb);
        for (int mm = 0; mm < 32; ++mm) { const size_t m = rowb + 128 * mm;
            CRow R = nr;
            if (mm + 1 < 32) CR_LOAD(nr, m + 128);
            const float wk[8] = {R.w0.x, R.w0.y, R.w0.z, R.w0.w, R.w1.x, R.w1.y, R.w1.z, R.w1.w};
            f32x4 acc[4];
#pragma unroll
            for (int j = 0; j < 4; ++j) { const int wv = (int)R.ys[j]; const f32x2 lo = __builtin_amdgcn_cvt_pk_f32_fp8(wv, false), hi = __builtin_amdgcn_cvt_pk_f32_fp8(wv, true); f32x4 a = (f32x4){lo.x, lo.y, hi.x, hi.y};
#pragma unroll
                for (int k = 0; k < 8; ++k) { const int wk_ = (int)R.yv[k][j]; const f32x2 l2 = __builtin_amdgcn_cvt_pk_f32_fp8(wk_, false), h2 = __builtin_amdgcn_cvt_pk_f32_fp8(wk_, true);
                    a.x += wk[k] * l2.x; a.y += wk[k] * l2.y; a.z += wk[k] * h2.x; a.w += wk[k] * h2.y; }
                acc[j] = a; __builtin_amdgcn_sched_barrier(0); }
            float s2 = 0.f; f32x4 v[4];
#pragma unroll
            for (int j = 0; j < 4; ++j) { const unsigned xa = R.xb[j >> 1][(j & 1) * 2], xc = R.xb[j >> 1][(j & 1) * 2 + 1]; const f32x4 xj = (f32x4){bf_lo(xa), bf_hi(xa), bf_lo(xc), bf_hi(xc)}; v[j] = xj + g2[j] * acc[j]; s2 += (v[j].x * v[j].x + v[j].y * v[j].y) + (v[j].z * v[j].z + v[j].w * v[j].w); }
            const float r = 1.f / sqrtf(wave_sum(s2) * (1.f / DM) + EPS);
            GAS f32x4* orow = (GAS f32x4*)(dst + m * DM + c0);
#pragma unroll
            for (int j = 0; j < 4; ++j) orow[j] = v[j] * r * gf[j];
        }
    }
#undef CR_LOAD
}

struct Args { const float* in[19]; float* out; unsigned char* ws; int ph_lo, ph_hi, li, pad; };
__global__ void __launch_bounds__(NWAVES * 64, 2) fwd_kernel(Args args) {
    extern __shared__ __attribute__((aligned(16))) unsigned char lds[];
    Frame F;
    F.lds = (LAS unsigned char*)lds;
    F.MISC = (volatile LAS unsigned*)(F.lds + MISC_OFF);
    F.tid = threadIdx.x; F.lane = F.tid & 63; F.wave = __builtin_amdgcn_readfirstlane(F.tid >> 6);
    F.G = gridDim.x; { const int bx = blockIdx.x; F.vcu = (F.G % 8 == 0) ? (bx % 8) * (F.G / 8) + bx / 8 : bx; }
    F.ws = args.ws; F.out = args.out; F.ctl = (gu32*)(args.ws + WS_CTL);
    unsigned char* ws = args.ws;
    typedef const __attribute__((address_space(4))) Args* KArgP;
#define KA(i) ({ KArgP p_ = (KArgP)__builtin_amdgcn_kernarg_segment_ptr(); asm volatile("" : "+s"(p_)); p_->in[i]; })
#define MOD ((float*)(ws + WS_MOD))
#define LF ((float*)(ws + WS_LF))
#define KB ((float*)(ws + WS_KB))
#define LSE ((float*)(ws + WS_LSE))
#define HB ((bf16_t*)(ws + WS_H))
#define QKV ((bf16_t*)(ws + WS_QKV))
#define LIST ((unsigned*)(ws + WS_LIST))
    for (int u = F.tid; u < (LDS_BYTES - LDSCTL_OFF) / 4; u += NWAVES * 64) ((LAS unsigned*)(F.lds + LDSCTL_OFF))[u] = 0u;
    __syncthreads();
    XcdBarrier bar; bar.bar = (unsigned*)(F.ctl + CW_BAR); bar.x = 0; bar.st = nullptr;
    if (N_LAUNCHES == 1) bar = xcd_barrier_post((unsigned*)(F.ctl + CW_BAR), F.MISC + 8);
#define GRID_BAR() do { if (N_LAUNCHES == 1) xcd_barrier(bar); } while (0)
#define REFRESH() do { int t_ = threadIdx.x; asm volatile("" : "+v"(t_)); F.tid = t_; F.lane = t_ & 63; } while (0)
    const int lo = args.ph_lo, hi = args.ph_hi;
#ifndef ONLY_PHASE
#define ONLY_PHASE -1
#endif
#define IN(k) ((ONLY_PHASE < 0 || ONLY_PHASE == (k)) && lo <= (k) && (k) < hi)
#define BOTH(k) (IN(k) && IN((k) + 1))

    if (IN(0)) {
        REFRESH();
        _Pragma("unroll") for (int rep_ = 0; rep_ < DUPN(0); ++rep_) {
        p0_mod(F, KA(1), KA(7), KA(8), MOD);
        P0Ptrs P{KA(2), KA(6), KA(9), KA(11), KA(12), KA(13), KA(14), KA(15), KA(16)};
        p0_weights(F, P, P0_EXPERT_ITEMS, P0_ALL_ITEMS); }
        if (BOTH(0)) GRID_BAR();
    }
    if (IN(1)) {
        REFRESH();
        _Pragma("unroll") for (int rep_ = 0; rep_ < DUPN(1); ++rep_) norm_rows<true>(F, KA(0), HB, MOD, 0, DM, KA(2), KA(3), LF, nullptr);
        if (BOTH(1)) GRID_BAR();
    }
    if (IN(2)) {
        REFRESH();
        _Pragma("unroll") for (int rep_ = 0; rep_ < DUPN(2); ++rep_) {
        scan_rows(F, LF, KB, (int*)(ws + WS_T0));
        pg8::Gemm g{HB, (const bf16_t*)(ws + WS_WIN), DM, nullptr}; pg8::StaticOrder S; S.init(M, 3072, F.G, (int)blockIdx.x);
        pg8::EpiQKV E{QKV, (size_t)M * HW, attn_body::C2};
        pg8::gemm_phase<pg8::EpiQKV, pg8::StaticOrder, false>(F.lds, g, S, E); }
        if (BOTH(2)) GRID_BAR();
    }
    if (IN(3)) {
        REFRESH();
        using attn_body::bf16; const float* rel_bias = KA(17);
        const bf16* Qf = (const bf16*)QKV; const bf16* Kf = Qf + (size_t)M * HW; const bf16* Vf = Kf + (size_t)M * HW;
        const bf16* Qd = Vf + (size_t)M * HW; const bf16* Kd = Qd + (size_t)M * HW; const bf16* Vd = Kd + (size_t)M * HW;
        bf16* OF = (bf16*)(ws + WS_OF);
        bool conv_done = false;
        const P0Ptrs PW{KA(2), KA(6), KA(9), KA(11), KA(12), KA(13), KA(14), KA(15), KA(16)};
        for (int cu = F.vcu; cu < 16 * BATCH; cu += F.G) {
            const int b = cu >> 4, j = cu & 15;
            int hc = 2 * (F.vcu % 5); asm volatile("" : "+s"(hc));
            for (int part = 0; part < 2; ++part) {
            if (part == 1 && !conv_done) { __syncthreads(); conv_experts(F, PW); __syncthreads(); conv_done = true; }
            const int h_lo = part ? hc : 0, h_hi = part ? NH : hc;
            for (int h = h_lo; h < h_hi; ++h) { const int q = (j + 4 * (h >> 1)) & 15; const int qb = (h & 1) ? 15 - q : q; const int bh = b * NH + h;
                const size_t hb = (size_t)b * SEQ * HW + h * HD; const int T0 = ((const int*)(ws + WS_T0))[bh * 16 + qb];
                if (DUPN(3) == 2) attn_body::attn_unit<8, 0>(Qf + hb, Kf + hb, Vf + hb, (bf16*)(ws + WS_SS0), (long)HW, 0L, qb * 256, T0, 4 * qb + 4 - T0, 0, nullptr, 0, (char*)lds, KB + (size_t)bh * SEQ, nullptr, 0);
                attn_body::attn_unit<8, 0>(Qf + hb, Kf + hb, Vf + hb, OF + hb, (long)HW, (long)HW, qb * 256, T0, 4 * qb + 4 - T0, 0, nullptr, 0, (char*)lds, KB + (size_t)bh * SEQ, nullptr, 0); }
            }
        }
        if (!conv_done) { __syncthreads(); conv_experts(F, PW); __syncthreads(); }
        for (int job = F.vcu; job < 2 * BATCH * NH; job += F.G) {
            const int bh = job >> 1, sub = job & 1, b = bh >> 3, h = bh & 7;
            const size_t hb = (size_t)b * SEQ * HW + h * HD;
            const int nd = sub ? 25 : 23; int tabkey = -1;
            { __syncthreads(); for (int i = F.tid; i < attn_body::DL_ZEND / 16; i += NWAVES * 64) *(LAS f32x4*)(F.lds + i * 16) = (f32x4){0.f, 0.f, 0.f, 0.f}; __syncthreads(); }
#define DIL_PARAMS(i_, dsel_, d_, r_, qb_) do { if ((i_) < 16) { if (sub == 0) { dsel_ = 0; d_ = 1; r_ = 0; qb_ = (i_); } else { dsel_ = 1; d_ = 4; r_ = (i_) >> 2; qb_ = (i_) & 3; } } \
                else { dsel_ = 2; d_ = 16; r_ = ((i_) - 16) + (sub ? 7 : 0); qb_ = 0; } } while (0)
            for (int i = 0; i < nd; ++i) {
                int dsel, d, r, qb; DIL_PARAMS(i, dsel, d, r, qb);
                int dseln = 0, dn = 1, rn = 0, qbn = 0; const bool has_next = (i + 1 < nd); if (has_next) DIL_PARAMS(i + 1, dseln, dn, rn, qbn);
                bf16* OB = (bf16*)(ws + (dsel == 0 ? WS_O1 : dsel == 1 ? WS_O2 : WS_O3));
                const size_t sb = hb + (size_t)r * HW, sbn = hb + (size_t)rn * HW;
                float* lsep = LSE + (size_t)dsel * M * NH + ((size_t)b * SEQ + r) * NH + h;
                const bool bt = (tabkey != dsel); tabkey = dsel;
                const attn_body::DilSrc cu{Kd + sb, Vd + sb, (long)d * HW, qb * 256, qb == 0}, nx{Kd + sbn, Vd + sbn, (long)dn * HW, qbn * 256, qbn == 0};
                _Pragma("unroll") for (int rep_ = 0; rep_ < DUPN(3); ++rep_)
                attn_body::dil_unit<8>(Qd + sb, cu, (i & 1) ? attn_body::DL_KB : attn_body::DL_K, i > 0 && DUPN(3) == 1, nx, has_next && DUPN(3) == 1, OB + sb, lsep, (long)d * NH, (char*)lds, rel_bias + h, dsel, bt); }
#undef DIL_PARAMS
        }
        if (BOTH(3)) GRID_BAR();
    }
    if (IN(4)) {
        REFRESH();
        _Pragma("unroll") for (int rep_ = 0; rep_ < DUPN(4); ++rep_) merge_rows(F, KA(4), KA(5));
        if (BOTH(4)) GRID_BAR();
    }
    if (IN(5)) {
        REFRESH();
        _Pragma("unroll") for (int rep_ = 0; rep_ < DUPN(5); ++rep_) {
        pg8::Gemm g{(const bf16_t*)(ws + WS_YM), (const bf16_t*)(ws + WS_WOUT), DM, nullptr}; pg8::StaticOrder S; S.init(M, DM, F.G, (int)blockIdx.x);
        pg8::EpiX1N E{KA(0), ws, MOD, F.lds, (float*)(ws + WS_EX), (unsigned*)(F.ctl + CW_X1)};
        pg8::gemm_phase<pg8::EpiX1N, pg8::StaticOrder, false>(F.lds, g, S, E); }
        if (BOTH(5)) GRID_BAR();
    }
    if (IN(6)) {
        REFRESH();
        (void)0;
    }
    if (IN(7)) {
        REFRESH();
        float* LOGITS = (float*)(ws + WS_LOGITS); const float* rbias_ = KA(10);
        { pg8::Gemm g{HB, (const bf16_t*)(ws + WS_WR), DM, nullptr}; pg8::StaticOrder S; S.init(M, NEXP, F.G, (int)blockIdx.x);
          pg8::EpiF32 E{LOGITS, NEXP};
          pg8::gemm_phase<pg8::EpiF32, pg8::StaticOrder, false>(F.lds, g, S, E);
          asm volatile("s_waitcnt vmcnt(0)" ::: "memory"); __syncthreads();
          pg8::Unit u; for (int i = 0; S.next(i, u); ++i) route_rows(F, u.pm, LOGITS, rbias_, LIST, (float*)(ws + WS_WTS), (unsigned*)(ws + WS_POSE)); }
        _Pragma("unroll") for (int rep_ = 0; rep_ < DUPN(7); ++rep_)
        { pg8::Gemm g{HB, (const bf16_t*)(ws + WS_WSHGU), DM, nullptr}; pg8::StaticOrder S; S.init(M, 512, F.G, (int)blockIdx.x);
          pg8::EpiSwiglu E{(bf16_t*)(ws + WS_ACTSH)};
          pg8::gemm_phase<pg8::EpiSwiglu, pg8::StaticOrder, false>(F.lds, g, S, E); }
        if (BOTH(7)) GRID_BAR();
    }
    if (IN(8)) {
        REFRESH();
        { pg8::Gemm g{(const bf16_t*)(ws + WS_ACTSH), (const bf16_t*)(ws + WS_WSHD), EH, nullptr}; pg8::StaticOrder S; S.init(M, DM, F.G, (int)blockIdx.x);
          pg8::EpiYbuf E{ws + WS_YSH, ws + WS_DUMP};
          pg8::gemm_phase<pg8::EpiYbuf, pg8::StaticOrder, false, false, true, 0, HOIST_SD>(F.lds, g, S, E); }
        build_tables(F);
#if PROBE_G1
        { pg8::Gemm g{(const bf16_t*)(ws + WS_H8), (const bf16_t*)(ws + WS_WGU), DM / 2, LIST};
          pg8::GroupedOrder S{(const LAS unsigned*)(F.lds + TAB_OFF), (const LAS unsigned*)(F.lds + TAB_OFF) + 260, 2, F.G, F.vcu, 2, 0, 0, (const LAS unsigned short*)(F.lds + MT2E_OFF)}; S.total = __builtin_amdgcn_readfirstlane((int)S.tp[256]) * 2;
          pg8::EpiSwiglu8 E{ws + WS_ACT};
          pg8::gemm_phase<pg8::EpiSwiglu8, pg8::GroupedOrder, true, true, true, PROBE_G1>(F.lds, g, S, E); }
#endif
        _Pragma("unroll") for (int rep_ = 0; rep_ < DUPN(8); ++rep_)
        { pg8::Gemm g{(const bf16_t*)(ws + WS_H8), (const bf16_t*)(ws + WS_WGU), DM / 2, LIST};
          pg8::GroupedOrder S{(const LAS unsigned*)(F.lds + TAB_OFF), (const LAS unsigned*)(F.lds + TAB_OFF) + 260, 2, F.G, F.vcu, 2, 0, 0, (const LAS unsigned short*)(F.lds + MT2E_OFF)}; S.total = __builtin_amdgcn_readfirstlane((int)S.tp[256]) * 2;
          pg8::EpiSwiglu8 E{ws + WS_ACT};
          pg8::gemm_phase<pg8::EpiSwiglu8, pg8::GroupedOrder, true, true, true, 0, HOIST_G1>(F.lds, g, S, E); }
        if (BOTH(8)) GRID_BAR();
    }
    if (IN(9)) {
        REFRESH();
        build_tables(F);
#if PROBE_G2
        { pg8::Gemm g{(const bf16_t*)(ws + WS_ACT), (const bf16_t*)(ws + WS_WD), EH / 2, LIST};
          pg8::GroupedOrder S{(const LAS unsigned*)(F.lds + TAB_OFF), (const LAS unsigned*)(F.lds + TAB_OFF) + 260, 4, F.G, F.vcu, 4, 0, 0, (const LAS unsigned short*)(F.lds + MT2E_OFF)}; S.total = __builtin_amdgcn_readfirstlane((int)S.tp[256]) * 4;
          pg8::EpiYbuf E{(unsigned char*)(ws + WS_YBUF), ws + WS_DUMP};
          pg8::gemm_phase<pg8::EpiYbuf, pg8::GroupedOrder, false, true, true, PROBE_G2>(F.lds, g, S, E); }
#endif
        _Pragma("unroll") for (int rep_ = 0; rep_ < DUPN(9); ++rep_)
        { pg8::Gemm g{(const bf16_t*)(ws + WS_ACT), (const bf16_t*)(ws + WS_WD), EH / 2, LIST};
          pg8::GroupedOrder S{(const LAS unsigned*)(F.lds + TAB_OFF), (const LAS unsigned*)(F.lds + TAB_OFF) + 260, 4, F.G, F.vcu, 4, 0, 0, (const LAS unsigned short*)(F.lds + MT2E_OFF)}; S.total = __builtin_amdgcn_readfirstlane((int)S.tp[256]) * 4;
          pg8::EpiYbuf E{(unsigned char*)(ws + WS_YBUF), ws + WS_DUMP};
          pg8::gemm_phase<pg8::EpiYbuf, pg8::GroupedOrder, false, true, true, 0, HOIST_G2>(F.lds, g, S, E); }
        if (BOTH(9)) GRID_BAR();
    }
    if (IN(10)) {
        REFRESH();
        build_tables(F);
        if (DUPN(10) == 2) combine_rows(F, MOD + 5 * DM, KA(18), (float*)(ws + WS_ACT));
        combine_rows(F, MOD + 5 * DM, KA(18), F.out);
    }
#undef KA
#undef MOD
#undef LF
#undef KB
#undef LSE
#undef HB
#undef QKV
#undef LIST
#undef REFRESH
#undef IN
#undef BOTH
#undef GRID_BAR
}

extern "C" void kernel_launch(void* const* d_in, const int* in_sizes, int n_in, void* d_out, int out_size, void* d_ws, size_t ws_size, hipStream_t stream) {
    static int grid = 0;
    if (grid == 0) {
        if (n_in != 19 || in_sizes[0] != M * DM || out_size != M * DM || ws_size < WS_NEED) {
            fprintf(stderr, "kernel_launch: unexpected shapes: n_in %d in0 %d out %d ws %zu (need %zu); nothing launched\n", n_in, n_in > 0 ? in_sizes[0] : -1, out_size, ws_size, (size_t)WS_NEED); grid = -1; return; }
        int dev = 0, cus = 0, per_cu = 0;
        if (hipGetDevice(&dev) != hipSuccess || hipDeviceGetAttribute(&cus, hipDeviceAttributeMultiprocessorCount, dev) != hipSuccess) { fprintf(stderr, "kernel_launch: device query failed\n"); grid = -1; return; }
        if (hipFuncSetAttribute((const void*)fwd_kernel, hipFuncAttributeMaxDynamicSharedMemorySize, LDS_BYTES) != hipSuccess) { fprintf(stderr, "kernel_launch: hipFuncSetAttribute failed\n"); grid = -1; return; }
        if (hipOccupancyMaxActiveBlocksPerMultiprocessor(&per_cu, (const void*)fwd_kernel, NWAVES * 64, LDS_BYTES) != hipSuccess || per_cu < 1)
            fprintf(stderr, "kernel_launch: note: occupancy query reports %d workgroups per CU\n", per_cu);
        (void)hipGetLastError();
        grid = cus;
    }
    if (grid < 0) return;
    if (hipMemsetAsync((char*)d_ws + WS_CTL, 0, CTL_ZERO_BYTES, stream) != hipSuccess) { fprintf(stderr, "kernel_launch: memset failed\n"); return; }
    Args a{};
    for (int i = 0; i < 19; ++i) a.in[i] = (const float*)d_in[i];
    a.out = (float*)d_out; a.ws = (unsigned char*)d_ws; a.pad = 0;
    for (int li = 0; li < N_LAUNCHES; ++li) {
        a.ph_lo = (N_LAUNCHES == 1) ? 0 : li; a.ph_hi = (N_LAUNCHES == 1) ? NPHASE : li + 1; a.li = li;
        hipLaunchKernelGGL(fwd_kernel, dim3(grid), dim3(NWAVES * 64), LDS_BYTES, stream, a);
        const hipError_t le = hipPeekAtLastError();
        if (le != hipSuccess) { fprintf(stderr, "kernel_launch: launch %d failed: %s\n", li, hipGetErrorName(le)); break; }
    }
}
```

```cpp
#include <hip/hip_runtime.h>
#include <hip/hip_bf16.h>
#include <cstdio>
#include <cstdint>

#ifndef DUP_MASK
#define DUP_MASK 0
#endif
#ifndef CONV_PROBE
#define CONV_PROBE 0
#endif
#ifndef HOIST_SD
#define HOIST_SD false
#endif
#ifndef HOIST_G1
#define HOIST_G1 false
#endif
#ifndef HOIST_G2
#define HOIST_G2 true
#endif
#ifndef PROBE_G1
#define PROBE_G1 0
#endif
#ifndef PROBE_G2
#define PROBE_G2 0
#endif
#define DUPN(k) (((DUP_MASK >> (k)) & 1) ? 2 : 1)
#ifndef MK_N_LAUNCHES
#define MK_N_LAUNCHES 1
#endif

#define GAS __attribute__((address_space(1)))
#define LAS __attribute__((address_space(3)))

constexpr int BATCH = 16, SEQ = 4096, DM = 1024, M = BATCH * SEQ;
constexpr int NH = 8, HD = 64, HW = NH * HD;
constexpr int INC = 3080;
constexpr int NEXP = 256, TOPK = 8, EH = 256;
constexpr int NMOD = 6 * DM;
constexpr int LCAP = 65536;
constexpr float LOG2E = 1.4426950408889634f;
constexpr float EPS = 1e-6f;
constexpr float FOX_SKIP_LOG2 = 80.f;
constexpr float YSCALE = 16.f;
constexpr int NWAVES = 8;
constexpr int NPHASE = 11;
constexpr int N_LAUNCHES = MK_N_LAUNCHES;

constexpr size_t MiB = 1u << 20;
constexpr size_t WS_CTL = 0, CTL_ZERO_BYTES = 1 * MiB;
constexpr size_t WS_DUMP = 512 * 1024;
constexpr size_t WS_MOD = 1 * MiB;
constexpr size_t WS_LF = 2 * MiB;
constexpr size_t WS_KB = 4 * MiB;
constexpr size_t WS_LSE = 6 * MiB;
constexpr size_t WS_WIN = 12 * MiB;
constexpr size_t WS_WOUT = 18 * MiB;
constexpr size_t WS_WR = 20 * MiB;
constexpr size_t WS_WSHGU = WS_WR + MiB / 2;
constexpr size_t WS_WSHD = WS_WSHGU + MiB;
constexpr size_t WS_WTS = 22 * MiB;
constexpr size_t WS_SS0 = WS_MOD + MiB / 2;
constexpr size_t WS_T0 = WS_MOD + MiB / 2 + 65536;
constexpr size_t WS_WD = 24 * MiB;
constexpr size_t WS_WGU = 88 * MiB;
constexpr size_t WS_LIST = 216 * MiB;
constexpr size_t WS_O3 = WS_LIST;
constexpr size_t WS_H = 280 * MiB;
constexpr size_t WS_H8 = 408 * MiB;
constexpr size_t WS_QKV = 472 * MiB;
constexpr size_t WS_ACT = 856 * MiB;
constexpr size_t WS_YSH = 792 * MiB;
constexpr size_t WS_X1A = 728 * MiB;
constexpr size_t WS_X1B = 1000 * MiB;
constexpr size_t WS_END = 1000 * MiB, WS_NEED = 1064 * MiB;
constexpr size_t WS_YBUF = WS_LIST;
constexpr size_t WS_EX = WS_LSE + 4 * MiB;
constexpr size_t WS_POSE = WS_LSE;
constexpr size_t WS_OF = WS_QKV;
constexpr size_t WS_O1 = WS_H, WS_O2 = WS_H + 64 * MiB;
constexpr size_t WS_YM = WS_QKV + 64 * MiB;
constexpr size_t WS_LOGITS = WS_QKV;
constexpr size_t WS_ACTSH = WS_QKV + 64 * MiB;
static_assert(WS_ACT + (size_t)(M * TOPK + NEXP * 256) * EH <= WS_END, "act fits");
static_assert(WS_YBUF + (size_t)M * TOPK * DM <= WS_X1A && WS_X1A + 64 * MiB <= WS_YSH && WS_YSH + (size_t)M * DM <= WS_ACT && WS_X1B + 64 * MiB <= WS_NEED, "ybuf (unpadded rows), x1, ysh fit below act");
static_assert(WS_QKV + 6 * 64 * MiB <= WS_ACT, "qkv below act");
constexpr int CW_TMO = 0, CW_BAR = 4096, CW_CNT = 8192, CW_X1 = 12288;

constexpr int RING_BYTES = 131072;
constexpr int PHASE_LDS = 158720;
constexpr int LDSCTL_OFF = PHASE_LDS, MISC_OFF = LDSCTL_OFF + 320;
constexpr int TAB_OFF = MISC_OFF + 128;
constexpr int RLIST_OFF = RING_BYTES + 2304 * 2;
constexpr int MT2E_OFF = RING_BYTES;
constexpr int LDS_BYTES = 163840;
static_assert(TAB_OFF + 800 * 4 <= LDS_BYTES, "LDS map");

typedef unsigned short bf16_t;
typedef short bf16x8 __attribute__((ext_vector_type(8)));
typedef float f32x4 __attribute__((ext_vector_type(4)));
typedef float f32x2 __attribute__((ext_vector_type(2)));
typedef unsigned u32x4 __attribute__((ext_vector_type(4)));
typedef unsigned u32x2 __attribute__((ext_vector_type(2)));
typedef GAS unsigned gu32;
typedef int v4i_t __attribute__((ext_vector_type(4)));
typedef int v8i_t __attribute__((ext_vector_type(8)));
#define RLX_AGENT __ATOMIC_RELAXED, __HIP_MEMORY_SCOPE_AGENT

__device__ __forceinline__ unsigned cvt_pk_bf16(float lo, float hi) { unsigned r; asm volatile("v_cvt_pk_bf16_f32 %0, %1, %2" : "=v"(r) : "v"(lo), "v"(hi)); return r; }
__device__ __forceinline__ float bf_lo(unsigned w) { return __uint_as_float(w << 16); }
__device__ __forceinline__ float bf_hi(unsigned w) { return __uint_as_float(w & 0xffff0000u); }
__device__ __forceinline__ bf16_t* x1_row(unsigned char* ws, size_t m) { return (bf16_t*)(ws + (m < 32768 ? WS_X1A + m * 2048 : WS_X1B + (m - 32768) * 2048)); }
#define DPPF_(x, ctrl, rm) __int_as_float(__builtin_amdgcn_update_dpp(0, __float_as_int(x), ctrl, rm, 0xF, false))
__device__ __forceinline__ float wave_sum(float v) {
    v += DPPF_(v, 0xB1, 0xF); v += DPPF_(v, 0x4E, 0xF); v += DPPF_(v, 0x141, 0xF); v += DPPF_(v, 0x140, 0xF);
    v += DPPF_(v, 0x142, 0xA); v += DPPF_(v, 0x143, 0xC);
    return __int_as_float(__builtin_amdgcn_readlane(__float_as_int(v), 63));
}
__device__ __forceinline__ float reduce8_heads(const float (&f)[8], int lane) {
    float a[4], b[2];
#pragma unroll
    for (int i = 0; i < 4; ++i) { auto rr = __builtin_amdgcn_permlane32_swap(__float_as_uint(f[i]), __float_as_uint(f[i + 4]), false, false); a[i] = __uint_as_float(rr[0]) + __uint_as_float(rr[1]); }
#pragma unroll
    for (int i = 0; i < 2; ++i) { auto rr = __builtin_amdgcn_permlane16_swap(__float_as_uint(a[i]), __float_as_uint(a[i + 2]), false, false); b[i] = __uint_as_float(rr[0]) + __uint_as_float(rr[1]); }
    const bool b3 = (lane & 8) != 0; const float mine = b3 ? b[1] : b[0], give = b3 ? b[0] : b[1];
    float v = mine + DPPF_(give, 0x128, 0xF);
    v += DPPF_(v, 0xB1, 0xF); v += DPPF_(v, 0x4E, 0xF); v += DPPF_(v, 0x141, 0xF);
    return v;
}

__device__ const unsigned char T5B[3][132] = {
 {0,1,2,3,4,5,6,7,8,9,10,11,12,13,14,15,16,16,16,16,16,16,17,17,17,17,17,17,17,17,18,18,18,18,18,18,18,18,18,18,19,19,19,19,19,19,19,19,19,19,19,19,19,19,20,20,20,20,20,20,20,20,20,20,20,20,20,20,20,20,20,20,20,21,21,21,21,21,21,21,21,21,21,21,21,21,21,21,21,21,21,21,21,21,21,21,21,21,21,22,22,22,22,22,22,22,22,22,22,22,22,22,22,22,22,22,22,22,22,22,22,22,22,22,22,22,22,22,22,0,0,0},
 {0,4,8,12,16,16,17,17,18,18,19,19,19,19,20,20,20,20,20,21,21,21,21,21,21,22,22,22,22,22,22,22,22,22,23,23,23,23,23,23,23,23,23,23,23,23,24,24,24,24,24,24,24,24,24,24,24,24,24,24,24,24,25,25,25,25,25,25,25,25,25,25,25,25,25,25,25,25,25,25,25,25,25,26,26,26,26,26,26,26,26,26,26,26,26,26,26,26,26,26,26,26,26,26,26,26,26,26,26,26,26,26,26,27,27,27,27,27,27,27,27,27,27,27,27,27,27,27,27,0,0,0},
 {0,16,18,19,20,21,21,22,22,23,23,23,24,24,24,24,25,25,25,25,25,26,26,26,26,26,26,26,26,27,27,27,27,27,27,27,27,27,27,28,28,28,28,28,28,28,28,28,28,28,28,28,29,29,29,29,29,29,29,29,29,29,29,29,29,29,29,29,29,29,30,30,30,30,30,30,30,30,30,30,30,30,30,30,30,30,30,30,30,30,30,30,30,30,30,31,31,31,31,31,31,31,31,31,31,31,31,31,31,31,31,31,31,31,31,31,31,31,31,31,31,31,31,31,31,31,31,31,31,0,0,0}};

namespace pg8 {
constexpr int BM = 256, BK = 64, HALF = 128, HTB = HALF * BK * 2, STAGE_BYTES = 8 * HTB, NXCD = 8, WGM = 8;
__host__ __device__ __forceinline__ int lds_byte(int r, int c) { const int st = (r >> 4) * 2 + (c >> 5), rr = r & 15, cc = c & 31, ob = rr * 64 + cc * 2; return st * 1024 + (ob ^ (((ob >> 9) & 1) << 5)); }
__host__ __device__ __forceinline__ void stage_rc(int b, int& R, int& C) { const int st = b / 1024, sb = b % 1024, swz = sb ^ (((sb >> 9) & 1) << 5); R = (st >> 1) * 16 + swz / 64; C = (st & 1) * 32 + (swz % 64) / 2; }
__host__ __device__ __forceinline__ int perm32(int rho) { const int n = rho >> 4, i = rho & 15; return 8 * (i >> 2) + 4 * n + (i & 3); }

struct Unit { int pm, pn, pb, e, tile, cnt, yrow; };
struct Gemm { const bf16_t* A; const bf16_t* Bt; int K; const unsigned* list; };

struct StaticOrder {
    int nM, nN, nwg, G, c;
    __device__ void init(int Mr, int N, int G_, int c_) { nM = Mr / BM; nN = N / BM; nwg = nM * nN; G = G_; c = c_; }
    __device__ bool next(int i, Unit& u) const {
        const int L = i * G + c; if (L >= nwg) return false;
        int wgid = L; { const int q = nwg / NXCD, r = nwg % NXCD, xcd = wgid % NXCD, off = wgid / NXCD; wgid = (xcd < r ? xcd * (q + 1) : r * (q + 1) + (xcd - r) * q) + off; }
        const int nig = WGM * nN, gid = wgid / nig, fm = gid * WGM, gsz = (nM - fm) < WGM ? (nM - fm) : WGM;
        u.pm = fm + ((wgid % nig) % gsz); u.pn = (wgid % nig) / gsz; u.pb = u.pn; u.e = 0; u.tile = 0; u.cnt = 1 << 30; u.yrow = u.pm * BM; return true;
    }
};
struct GroupedOrder {
    const LAS unsigned* tp; const LAS unsigned* cn; int NT, G, c, NTB, pn0, total;
    const LAS unsigned short* mt2e;
    __device__ bool next(int i, Unit& u) const {
        const int L = i * G + c; if (L >= total) return false;
        const int mt = L / NT; u.pn = L % NT;
        const int lo = __builtin_amdgcn_readfirstlane((int)mt2e[mt]);
        u.e = lo; u.pm = mt; u.tile = mt - __builtin_amdgcn_readfirstlane((int)tp[lo]); u.pb = lo * NTB + pn0 + u.pn; u.cnt = __builtin_amdgcn_readfirstlane((int)cn[lo]); u.yrow = __builtin_amdgcn_readfirstlane((int)cn[256 + lo]) + u.tile * BM; return true;
    }
};

struct EpiQKV {
    static constexpr bool PERM = true; static constexpr int NVM = 16;
    bf16_t* O; size_t split_stride; float scale0;
    __device__ __forceinline__ void operator()(const f32x4 (&acc)[2][2][4][2], const Unit& u, int wr, int wc, int fr, int fq) const {
        const int row0 = u.pm * BM + wr * 64 + fr; int colt = u.pn * BM; const int t = colt / 512; bf16_t* base = O + (size_t)t * split_stride; colt -= t * 512;
        const float sc = (t == 0 || t == 3) ? scale0 : 1.f;
        const int col0 = colt + wc * 32 + 8 * fq;
#pragma unroll
        for (int ai = 0; ai < 2; ++ai)
#pragma unroll
            for (int m = 0; m < 4; ++m) { bf16_t* rowp = base + (size_t)(row0 + ai * HALF + m * 16) * 512 + col0;
#pragma unroll
                for (int bj = 0; bj < 2; ++bj) { const f32x4 v0 = acc[ai][bj][m][0] * sc, v1 = acc[ai][bj][m][1] * sc;
                    u32x4 w; w.x = cvt_pk_bf16(v0[0], v0[1]); w.y = cvt_pk_bf16(v0[2], v0[3]); w.z = cvt_pk_bf16(v1[0], v1[1]); w.w = cvt_pk_bf16(v1[2], v1[3]);
                    *(u32x4*)(rowp + bj * HALF) = w; } }
    }
};
struct EpiSwiglu {
    static constexpr bool PERM = true; static constexpr int NVM = 8;
    bf16_t* O;
    __device__ __forceinline__ void operator()(const f32x4 (&acc)[2][2][4][2], const Unit& u, int wr, int wc, int fr, int fq) const {
        const int row0 = u.pm * BM + wr * 64 + fr; const int col0 = u.pn * HALF + wc * 32 + 8 * fq;
#pragma unroll
        for (int ai = 0; ai < 2; ++ai)
#pragma unroll
            for (int m = 0; m < 4; ++m) { bf16_t* rowp = O + (size_t)(row0 + ai * HALF + m * 16) * EH + col0; float r[8];
#pragma unroll
                for (int n = 0; n < 2; ++n)
#pragma unroll
                    for (int i = 0; i < 4; ++i) { const float g = acc[ai][0][m][n][i], up = acc[ai][1][m][n][i]; r[n * 4 + i] = g * __builtin_amdgcn_rcpf(1.f + __expf(-g)) * up; }
                u32x4 w; w.x = cvt_pk_bf16(r[0], r[1]); w.y = cvt_pk_bf16(r[2], r[3]); w.z = cvt_pk_bf16(r[4], r[5]); w.w = cvt_pk_bf16(r[6], r[7]);
                *(u32x4*)rowp = w; }
    }
};
struct EpiSwiglu8 {
    static constexpr bool PERM = true; static constexpr int NVM = 4;
    unsigned char* O;
    __device__ __forceinline__ void operator()(const f32x4 (&acc)[2][2][4][2], const Unit& u, int wr, int wc, int fr, int fq) const {
        const size_t row0 = (size_t)u.pm * BM + wr * 64 + fr + (fq & 1) * HALF; const int col0 = u.pn * HALF + wc * 32 + 8 * (fq & 2);
#pragma unroll
        for (int m = 0; m < 4; ++m) { unsigned w[2][2];
#pragma unroll
            for (int ai = 0; ai < 2; ++ai) { float r[8];
#pragma unroll
                for (int n = 0; n < 2; ++n)
#pragma unroll
                    for (int i = 0; i < 4; ++i) { const float g = acc[ai][0][m][n][i], up = acc[ai][1][m][n][i]; r[n * 4 + i] = g * __builtin_amdgcn_rcpf(1.f + __expf(-g)) * up; }
                int w0 = __builtin_amdgcn_cvt_pk_fp8_f32(r[0], r[1], 0, false); w0 = __builtin_amdgcn_cvt_pk_fp8_f32(r[2], r[3], w0, true);
                int w1 = __builtin_amdgcn_cvt_pk_fp8_f32(r[4], r[5], 0, false); w1 = __builtin_amdgcn_cvt_pk_fp8_f32(r[6], r[7], w1, true);
                w[ai][0] = (unsigned)w0; w[ai][1] = (unsigned)w1; }
            const auto s0 = __builtin_amdgcn_permlane16_swap(w[0][0], w[1][0], false, false); const auto s1 = __builtin_amdgcn_permlane16_swap(w[0][1], w[1][1], false, false);
            u32x4 o; o.x = s0[0]; o.y = s1[0]; o.z = s0[1]; o.w = s1[1];
            *(u32x4*)(O + (row0 + m * 16) * EH + col0) = o; }
    }
};
struct EpiRes {
    static constexpr bool PERM = true; static constexpr int NVM = 0;
    const float* base; float* out; const float* gate;
    __device__ __forceinline__ void operator()(const f32x4 (&acc)[2][2][4][2], const Unit& u, int wr, int wc, int fr, int fq) const {
        const int b = u.pm >> 4; const int col0 = u.pn * BM + wc * 32 + 8 * fq; f32x4 gv[2][2];
#pragma unroll
        for (int bj = 0; bj < 2; ++bj)
#pragma unroll
            for (int n = 0; n < 2; ++n) gv[bj][n] = *(const f32x4*)(gate + (size_t)b * NMOD + col0 + bj * HALF + n * 4);
#pragma unroll
        for (int ai = 0; ai < 2; ++ai)
#pragma unroll
            for (int m = 0; m < 4; ++m) { const size_t off = (size_t)(u.pm * BM + ai * HALF + wr * 64 + m * 16 + fr) * DM + col0;
#pragma unroll
                for (int bj = 0; bj < 2; ++bj)
#pragma unroll
                    for (int n = 0; n < 2; ++n) { const f32x4 bs = *(const f32x4*)(base + off + bj * HALF + n * 4); *(f32x4*)(out + off + bj * HALF + n * 4) = bs + gv[bj][n] * acc[ai][bj][m][n]; } }
    }
};
struct EpiX1 {
    static constexpr bool PERM = true; static constexpr int NVM = 8;
    const float* base; unsigned char* ws; const float* gate;
    __device__ __forceinline__ void operator()(const f32x4 (&acc)[2][2][4][2], const Unit& u, int wr, int wc, int fr, int fq) const {
        const int b = u.pm >> 4; const int col0 = u.pn * BM + wc * 32 + 8 * fq; f32x4 gv[2][2];
#pragma unroll
        for (int bj = 0; bj < 2; ++bj)
#pragma unroll
            for (int n = 0; n < 2; ++n) gv[bj][n] = *(const f32x4*)(gate + (size_t)b * NMOD + col0 + bj * HALF + n * 4);
#pragma unroll
        for (int ai = 0; ai < 2; ++ai) { f32x4 pre[4][2][2];
#pragma unroll
            for (int m = 0; m < 4; ++m) { const size_t off = ((size_t)u.pm * BM + ai * HALF + wr * 64 + m * 16 + fr) * DM + col0;
#pragma unroll
                for (int bj = 0; bj < 2; ++bj) { pre[m][bj][0] = *(const f32x4*)(base + off + bj * HALF); pre[m][bj][1] = *(const f32x4*)(base + off + bj * HALF + 4); } }
            asm volatile("" ::: "memory");
#pragma unroll
            for (int m = 0; m < 4; ++m) { const size_t row = (size_t)u.pm * BM + ai * HALF + wr * 64 + m * 16 + fr; bf16_t* orow = x1_row(ws, row) + col0;
#pragma unroll
                for (int bj = 0; bj < 2; ++bj) { const f32x4 v0 = pre[m][bj][0] + gv[bj][0] * acc[ai][bj][m][0], v1 = pre[m][bj][1] + gv[bj][1] * acc[ai][bj][m][1];
                    u32x4 w; w.x = cvt_pk_bf16(v0[0], v0[1]); w.y = cvt_pk_bf16(v0[2], v0[3]); w.z = cvt_pk_bf16(v1[0], v1[1]); w.w = cvt_pk_bf16(v1[2], v1[3]);
                    *(u32x4*)(orow + bj * HALF) = w; } }
            asm volatile("" ::: "memory"); }
    }
};
struct EpiX1N {
    static constexpr bool PERM = true; static constexpr int NVM = 0;
    const float* base; unsigned char* ws; const float* mod; LAS unsigned char* lds; float* ex; unsigned* cnt;
    __device__ __forceinline__ void operator()(f32x4 (&acc)[2][2][4][2], const Unit& u, int wr, int wc, int fr, int fq) const {
        const int b = u.pm >> 4; const int col0 = u.pn * BM + wc * 32 + 8 * fq; const float* mb = mod + (size_t)b * NMOD;
        LAS float* red = (LAS float*)(lds + RING_BYTES); LAS float* rr = red + 4 * BM;
        float ss[2][4];
        { f32x4 gv[2][2];
#pragma unroll
          for (int bj = 0; bj < 2; ++bj)
#pragma unroll
            for (int n = 0; n < 2; ++n) gv[bj][n] = *(const f32x4*)(mb + 2 * DM + col0 + bj * HALF + n * 4);
#pragma unroll
          for (int am = 0; am < 4; ++am) { const int ai = am >> 1, m0 = (am & 1) * 2; f32x4 pre[2][2][2];
#pragma unroll
            for (int mm = 0; mm < 2; ++mm) { const size_t off = ((size_t)u.pm * BM + ai * HALF + wr * 64 + (m0 + mm) * 16 + fr) * DM + col0;
#pragma unroll
                for (int bj = 0; bj < 2; ++bj) { pre[mm][bj][0] = *(const f32x4*)(base + off + bj * HALF); pre[mm][bj][1] = *(const f32x4*)(base + off + bj * HALF + 4); } }
            asm volatile("" ::: "memory");
#pragma unroll
            for (int mm = 0; mm < 2; ++mm) { const int m = m0 + mm; const size_t row = (size_t)u.pm * BM + ai * HALF + wr * 64 + m * 16 + fr; bf16_t* orow = x1_row(ws, row) + col0; float s2 = 0.f;
#pragma unroll
                for (int bj = 0; bj < 2; ++bj) { const f32x4 v0 = pre[mm][bj][0] + gv[bj][0] * acc[ai][bj][m][0], v1 = pre[mm][bj][1] + gv[bj][1] * acc[ai][bj][m][1];
                    acc[ai][bj][m][0] = v0; acc[ai][bj][m][1] = v1;
                    s2 += ((v0[0] * v0[0] + v0[1] * v0[1]) + (v0[2] * v0[2] + v0[3] * v0[3])) + ((v1[0] * v1[0] + v1[1] * v1[1]) + (v1[2] * v1[2] + v1[3] * v1[3]));
                    u32x4 w; w.x = cvt_pk_bf16(v0[0], v0[1]); w.y = cvt_pk_bf16(v0[2], v0[3]); w.z = cvt_pk_bf16(v1[0], v1[1]); w.w = cvt_pk_bf16(v1[2], v1[3]);
                    *(u32x4*)(orow + bj * HALF) = w; }
                s2 += __shfl_xor(s2, 16); s2 += __shfl_xor(s2, 32); ss[ai][m] = s2; }
            asm volatile("" ::: "memory"); } }
        if (fq == 0) {
#pragma unroll
            for (int ai = 0; ai < 2; ++ai)
#pragma unroll
                for (int m = 0; m < 4; ++m) red[wc * BM + ai * HALF + wr * 64 + m * 16 + fr] = ss[ai][m]; }
        __syncthreads();
        const int tid = threadIdx.x; unsigned* slot = (unsigned*)ex + ((size_t)u.pm * 4) * BM;
        if (tid < BM) { const float tot = (red[tid] + red[BM + tid]) + (red[2 * BM + tid] + red[3 * BM + tid]);
            __hip_atomic_store(slot + u.pn * BM + tid, __float_as_uint(tot), __ATOMIC_RELAXED, __HIP_MEMORY_SCOPE_AGENT); }
        asm volatile("s_waitcnt vmcnt(0)" ::: "memory");
        __syncthreads();
        if (tid == 0) { (void)__hip_atomic_fetch_add(cnt + u.pm, 1u, __ATOMIC_RELAXED, __HIP_MEMORY_SCOPE_AGENT); unsigned sp = 0;
            while (__hip_atomic_load(cnt + u.pm, __ATOMIC_RELAXED, __HIP_MEMORY_SCOPE_AGENT) < 4u) { __builtin_amdgcn_s_sleep(1); if (++sp > (1u << 22)) break; } }
        __syncthreads();
        if (tid < BM) { float t4 = 0.f;
#pragma unroll
            for (int q = 0; q < 4; ++q) t4 += __uint_as_float(__hip_atomic_load(slot + q * BM + tid, __ATOMIC_RELAXED, __HIP_MEMORY_SCOPE_AGENT));
            rr[tid] = 1.f / sqrtf(t4 * (1.f / DM) + EPS); }
        __syncthreads();
        f32x4 sc[2][2], sh[2][2];
#pragma unroll
        for (int bj = 0; bj < 2; ++bj)
#pragma unroll
            for (int n = 0; n < 2; ++n) { sc[bj][n] = *(const f32x4*)(mb + 4 * DM + col0 + bj * HALF + n * 4) + 1.f; sh[bj][n] = *(const f32x4*)(mb + 3 * DM + col0 + bj * HALF + n * 4); }
        bf16_t* H2 = (bf16_t*)(ws + WS_H); unsigned char* H8 = ws + WS_H8;
        const int col8 = u.pn * BM + (fq & 1) * HALF + wc * 32 + 8 * (fq & 2);
#pragma unroll
        for (int ai = 0; ai < 2; ++ai)
#pragma unroll
            for (int m = 0; m < 4; ++m) { const int rl = ai * HALF + wr * 64 + m * 16 + fr; const size_t row = (size_t)u.pm * BM + rl; const float r = rr[rl]; unsigned w8[2][2];
#pragma unroll
                for (int bj = 0; bj < 2; ++bj) { const f32x4 h0 = acc[ai][bj][m][0] * r * sc[bj][0] + sh[bj][0], h1 = acc[ai][bj][m][1] * r * sc[bj][1] + sh[bj][1];
                    u32x4 w; w.x = cvt_pk_bf16(h0[0], h0[1]); w.y = cvt_pk_bf16(h0[2], h0[3]); w.z = cvt_pk_bf16(h1[0], h1[1]); w.w = cvt_pk_bf16(h1[2], h1[3]);
                    *(u32x4*)(H2 + row * DM + col0 + bj * HALF) = w;
                    int q0 = __builtin_amdgcn_cvt_pk_fp8_f32(h0[0], h0[1], 0, false); q0 = __builtin_amdgcn_cvt_pk_fp8_f32(h0[2], h0[3], q0, true);
                    int q1 = __builtin_amdgcn_cvt_pk_fp8_f32(h1[0], h1[1], 0, false); q1 = __builtin_amdgcn_cvt_pk_fp8_f32(h1[2], h1[3], q1, true);
                    w8[bj][0] = (unsigned)q0; w8[bj][1] = (unsigned)q1; }
                const auto s0 = __builtin_amdgcn_permlane16_swap(w8[0][0], w8[1][0], false, false); const auto s1 = __builtin_amdgcn_permlane16_swap(w8[0][1], w8[1][1], false, false);
                u32x4 o; o.x = s0[0]; o.y = s1[0]; o.z = s0[1]; o.w = s1[1];
                *(u32x4*)(H8 + row * DM + col8) = o; }
    }
};
struct EpiF32 {
    static constexpr bool PERM = false; static constexpr int NVM = 16;
    float* out; int ldc;
    __device__ __forceinline__ void operator()(const f32x4 (&acc)[2][2][4][2], const Unit& u, int wr, int wc, int fr, int fq) const {
        const int col0 = u.pn * BM + wc * 32 + 4 * fq;
#pragma unroll
        for (int ai = 0; ai < 2; ++ai)
#pragma unroll
            for (int m = 0; m < 4; ++m) { const size_t off = (size_t)(u.pm * BM + ai * HALF + wr * 64 + m * 16 + fr) * ldc + col0;
#pragma unroll
                for (int bj = 0; bj < 2; ++bj)
#pragma unroll
                    for (int n = 0; n < 2; ++n) *(f32x4*)(out + off + bj * HALF + n * 16) = acc[ai][bj][m][n]; }
    }
};
struct EpiYbuf {
    static constexpr bool PERM = true; static constexpr int NVM = 8;
    unsigned char* Y; unsigned char* dump;
    __device__ __forceinline__ void operator()(const f32x4 (&acc)[2][2][4][2], const Unit& u, int wr, int wc, int fr, int fq) const {
        const int colb = u.pn * BM + wc * 64 + (fq & 1) * 32 + 8 * (fq & 2);
#pragma unroll
        for (int ai = 0; ai < 2; ++ai)
#pragma unroll
            for (int m = 0; m < 4; ++m) { const int rl = ai * HALF + wr * 64 + m * 16 + fr; const size_t row = (size_t)u.yrow + rl; const bool live = u.tile * BM + rl < u.cnt;
                unsigned w[2][2];
#pragma unroll
                for (int bj = 0; bj < 2; ++bj) { f32x4 v0 = acc[ai][bj][m][0] * YSCALE, v1 = acc[ai][bj][m][1] * YSCALE;
#pragma unroll
                    for (int i = 0; i < 4; ++i) { v0[i] = __builtin_amdgcn_fmed3f(v0[i], -440.f, 440.f); v1[i] = __builtin_amdgcn_fmed3f(v1[i], -440.f, 440.f); }
                    int w0 = __builtin_amdgcn_cvt_pk_fp8_f32(v0[0], v0[1], 0, false); w0 = __builtin_amdgcn_cvt_pk_fp8_f32(v0[2], v0[3], w0, true);
                    int w1 = __builtin_amdgcn_cvt_pk_fp8_f32(v1[0], v1[1], 0, false); w1 = __builtin_amdgcn_cvt_pk_fp8_f32(v1[2], v1[3], w1, true);
                    w[bj][0] = (unsigned)w0; w[bj][1] = (unsigned)w1; }
                const auto s0 = __builtin_amdgcn_permlane16_swap(w[0][0], w[1][0], false, false); const auto s1 = __builtin_amdgcn_permlane16_swap(w[0][1], w[1][1], false, false);
                u32x4 o; o.x = s0[0]; o.y = s1[0]; o.z = s0[1]; o.w = s1[1];
                *(u32x4*)(live ? Y + row * DM + colb : dump + (size_t)rl * DM + colb) = o; }
    }
};

template <class Epi, class Sched, bool GATHER, bool FP8 = false, bool SHORTK = false, int VAR = 0, bool HOIST = false>
__device__ __forceinline__ void gemm_phase(LAS unsigned char* lds, const Gemm g, const Sched& S, const Epi& E) {
    int tid_ = threadIdx.x; asm volatile("" : "+v"(tid_));
    const int tid = tid_, wid = __builtin_amdgcn_readfirstlane(tid >> 6), lane = tid & 63, wr = wid >> 2, wc = wid & 3, fr = lane & 15, fq = lane >> 4;
    int K_ = g.K; if constexpr (SHORTK) asm volatile("" : "+s"(K_));
    const int K = K_, nt = K / BK;
    unsigned voffA[2], voffB[2];
#pragma unroll
    for (int i = 0; i < 2; ++i) { int R, C; stage_rc(tid * 16 + i * 8192, R, C); const int Rb = Epi::PERM ? ((R & ~31) + perm32(R & 31)) : R;
        voffA[i] = (unsigned)(R * K + C) * 2u; voffB[i] = (unsigned)(Rb * K + C) * 2u; }
    const size_t kstep = (size_t)(BK * 2);
    const size_t hstep = (size_t)HALF * K * 2;
    const size_t tstep = 2 * hstep;
    const unsigned ldsw = (unsigned)wid * 1024u;
    const int aoff = lds_byte(wr * 64 + fr, fq * 8), boff = lds_byte(wc * 32 + fr, fq * 8);
#define PG8_SA(b, h) (((b) * 2 + (h)) * HTB)
#define PG8_SB(b, h) ((4 + (b) * 2 + (h)) * HTB)
#define PG8_GLDS(src, bufoff, i) if constexpr (!(VAR & 1)) __builtin_amdgcn_global_load_lds((const unsigned*)(src), (LAS unsigned*)(lds + (bufoff) + ldsw + (i) * 8192), 16, 0, 0)
#define PG8_STAGE(bufoff, gbase, voff) do { _Pragma("unroll") for (int _i = 0; _i < 2; ++_i) PG8_GLDS((const char*)(gbase) + (voff)[_i], bufoff, _i); } while (0)
#define PG8_STA(bufoff, aptr, h, SEL) do { if constexpr (GATHER) { const unsigned _p = (SEL) ? gvn[h] : gvc[h]; _Pragma("unroll") for (int _i = 0; _i < 2; ++_i) { unsigned _c = voffB[_i]; asm volatile("" : "+v"(_c)); \
            const unsigned _o = ((_i ? (_p >> 16) : (_p & 0xffffu)) * (unsigned)(K * 2)) + (_c & (unsigned)(K * 2 - 1)); PG8_GLDS((const char*)(aptr) + _o, bufoff, _i); } } \
        else { PG8_STAGE(bufoff, (const char*)(aptr) + (h) * hstep, voffA); } } while (0)
#define PG8_LDA(dst, b, h) do { _Pragma("unroll") for (int m = 0; m < 4; ++m) _Pragma("unroll") for (int k = 0; k < 2; ++k) dst[m][k] = *(const LAS bf16x8*)(lds + PG8_SA(b, h) + aoff + m * 2048 + k * 1024); } while (0)
#define PG8_LDB(dst, b, h) do { _Pragma("unroll") for (int n = 0; n < 2; ++n) _Pragma("unroll") for (int k = 0; k < 2; ++k) dst[n][k] = *(const LAS bf16x8*)(lds + PG8_SB(b, h) + boff + n * 2048 + k * 1024); } while (0)
#define PG8_CAT8(lo, hi) ({ const v4i_t a_ = __builtin_bit_cast(v4i_t, lo), b_ = __builtin_bit_cast(v4i_t, hi); (v8i_t){a_.x, a_.y, a_.z, a_.w, b_.x, b_.y, b_.z, b_.w}; })
#define PG8_MMA(ai, bj, At, Bt) do { __builtin_amdgcn_s_setprio(1); if constexpr (VAR & 2) { asm volatile("" :: "v"(At[0][0]), "v"(At[3][1]), "v"(Bt[0][0]), "v"(Bt[1][1])); } else if constexpr (FP8) { _Pragma("unroll") for (int m = 0; m < 4; ++m) _Pragma("unroll") for (int n = 0; n < 2; ++n) \
        acc[ai][bj][m][n] = __builtin_amdgcn_mfma_scale_f32_16x16x128_f8f6f4(PG8_CAT8(Bt[n][0], Bt[n][1]), PG8_CAT8(At[m][0], At[m][1]), acc[ai][bj][m][n], 0, 0, 0, 0x7F7F7F7F, 0, 0x7F7F7F7F); } \
      else { _Pragma("unroll") for (int m = 0; m < 4; ++m) _Pragma("unroll") for (int n = 0; n < 2; ++n) _Pragma("unroll") for (int k = 0; k < 2; ++k) \
        acc[ai][bj][m][n] = __builtin_amdgcn_mfma_f32_16x16x32_bf16(Bt[n][k], At[m][k], acc[ai][bj][m][n], 0, 0, 0); } \
      if constexpr (SHORTK) { _Pragma("unroll") for (int m = 0; m < 4; ++m) _Pragma("unroll") for (int n = 0; n < 2; ++n) asm volatile("" : "+v"(acc[ai][bj][m][n])); }     \
      __builtin_amdgcn_s_setprio(0); } while (0)
#define PG8_WAIT_V(n) asm volatile("s_waitcnt vmcnt(" #n ")" ::: "memory")
#define PG8_WAIT_VF() do { if (fst) asm volatile("s_waitcnt vmcnt(%0)" :: "n"(8 + NQ) : "memory"); else asm volatile("s_waitcnt vmcnt(8)" ::: "memory"); } while (0)
#define PG8_WAIT_L(n) asm volatile("s_waitcnt lgkmcnt(" #n ")" ::: "memory")
#define PG8_BAR __builtin_amdgcn_s_barrier()
#define PG8_SCHED __builtin_amdgcn_sched_barrier(0)
#define PG8_ROWS_LOAD(u, ld) do { _Pragma("unroll") for (int _h = 0; _h < 2; ++_h) _Pragma("unroll") for (int _i = 0; _i < 2; ++_i) { int _R, _C; stage_rc(tid * 16 + _i * 8192, _R, _C); const int _idx = (u).tile * BM + _h * HALF + _R; \
            const int _ic = _idx < (u).cnt ? _idx : (u).cnt - 1; ld[_h][_i] = g.list[(size_t)(u).e * LCAP + _ic]; } } while (0)
#define PG8_ROWS_USE(u, ld, gv) do { asm volatile("" : "+v"(ld[0][0]), "+v"(ld[0][1]), "+v"(ld[1][0]), "+v"(ld[1][1])); \
        _Pragma("unroll") for (int _h = 0; _h < 2; ++_h) { unsigned _t2[2]; _Pragma("unroll") for (int _i = 0; _i < 2; ++_i) { int _R, _C; stage_rc(tid * 16 + _i * 8192, _R, _C); const int _idx = (u).tile * BM + _h * HALF + _R; \
            _t2[_i] = (_idx < (u).cnt) ? (ld[_h][_i] & 0xffffu) : 0u; } gv[_h] = _t2[0] | (_t2[1] << 16); } } while (0)
    constexpr int NQ = Epi::NVM + (GATHER ? 1 : 0);
#define PG8_ROWS_DMA(u) __builtin_amdgcn_global_load_lds((const unsigned*)(g.list + (size_t)(u).e * LCAP + (u).tile * BM + (wid & 3) * 64 + lane), (LAS unsigned*)(lds + RLIST_OFF + (wid & 3) * 256), 4, 0, 0)
#define PG8_ROWS_USE_LDS(u, gv) do { _Pragma("unroll") for (int _h = 0; _h < 2; ++_h) { unsigned _t2[2]; _Pragma("unroll") for (int _i = 0; _i < 2; ++_i) { int _R, _C; stage_rc(tid * 16 + _i * 8192, _R, _C); const int _idx = (u).tile * BM + _h * HALF + _R; \
            const unsigned _v = *(const LAS unsigned*)(lds + RLIST_OFF + (_h * HALF + _R) * 4); _t2[_i] = (_idx < (u).cnt) ? (_v & 0xffffu) : 0u; } gv[_h] = _t2[0] | (_t2[1] << 16); } } while (0)
    Unit cur, nxt; int ui = 0;
    if (!S.next(0, cur)) return;
    f32x4 acc[2][2][4][2];
#pragma unroll
    for (int a = 0; a < 2; ++a)
#pragma unroll
        for (int b = 0; b < 2; ++b)
#pragma unroll
            for (int m = 0; m < 4; ++m)
#pragma unroll
                for (int n = 0; n < 2; ++n) acc[a][b][m][n] = (f32x4){0.f, 0.f, 0.f, 0.f};
    bf16x8 At[4][2], B0[2][2], B1[2][2];
    unsigned gvc[2] = {0u, 0u}, gvn[2] = {0u, 0u};
    if constexpr (GATHER) { unsigned rld[2][2]; PG8_ROWS_LOAD(cur, rld); PG8_ROWS_USE(cur, rld, gvc); }
    const char* cA = GATHER ? (const char*)g.A : (const char*)g.A + (size_t)cur.pm * tstep; const char* cB = (const char*)g.Bt + (size_t)cur.pb * tstep;
    PG8_STAGE(PG8_SB(0, 0), cB, voffB); PG8_STAGE(PG8_SB(0, 1), cB + hstep, voffB); PG8_STA(PG8_SA(0, 0), cA, 0, false); PG8_STA(PG8_SA(0, 1), cA, 1, false);
    if (wr == 1) PG8_BAR;
    PG8_WAIT_V(2); PG8_BAR;
    PG8_STAGE(PG8_SB(1, 0), cB + kstep, voffB); PG8_STA(PG8_SA(1, 0), cA + kstep, 0, false); PG8_STAGE(PG8_SB(1, 1), cB + hstep + kstep, voffB);
    PG8_WAIT_V(6); PG8_BAR;
    for (;;) {
        const bool has_next = S.next(ui + 1, nxt);
        const char* nA = has_next ? (GATHER ? (const char*)g.A : (const char*)g.A + (size_t)nxt.pm * tstep) : cA; const char* nB = has_next ? (const char*)g.Bt + (size_t)nxt.pb * tstep : cB;
        if constexpr (GATHER) { if (!has_next) { nxt = cur; gvn[0] = gvc[0]; gvn[1] = gvc[1]; } PG8_ROWS_DMA(nxt); }
        int t = 0;
        do {
            const bool last = (t == nt - 2);
            const bool fst = HOIST && (t == 0) && (ui > 0);
            if constexpr (GATHER) { if (last && has_next) { PG8_ROWS_USE_LDS(nxt, gvn); } }
            const char* a1 = cA + (size_t)(t + 1) * kstep;
            const char* a2 = last ? nA : cA + (size_t)(t + 2) * kstep; const char* b2 = last ? nB : cB + (size_t)(t + 2) * kstep;
            const char* a3 = a2 + kstep; const char* b3 = b2 + kstep;
            PG8_LDB(B0, 0, 0); PG8_LDB(B1, 0, 1); PG8_SCHED; PG8_LDA(At, 0, 0); if (!fst) PG8_STA(PG8_SA(1, 1), a1, 1, false);
            PG8_WAIT_VF(); PG8_WAIT_L(0); PG8_BAR; PG8_MMA(0, 0, At, B0); PG8_MMA(0, 1, At, B1); PG8_BAR; PG8_SCHED;
            PG8_LDA(At, 0, 1); PG8_STAGE(PG8_SB(0, 0), b2, voffB); PG8_STAGE(PG8_SB(0, 1), b2 + hstep, voffB); PG8_STA(PG8_SA(0, 0), a2, 0, last);
            PG8_WAIT_VF(); PG8_WAIT_L(0); PG8_BAR; PG8_MMA(1, 0, At, B0); PG8_MMA(1, 1, At, B1); PG8_BAR; PG8_SCHED;
            PG8_LDB(B0, 1, 0); PG8_LDB(B1, 1, 1); PG8_SCHED; PG8_LDA(At, 1, 0); PG8_STA(PG8_SA(0, 1), a2, 1, last);
            PG8_WAIT_VF(); PG8_WAIT_L(0); PG8_BAR; PG8_MMA(0, 0, At, B0); PG8_MMA(0, 1, At, B1); PG8_BAR; PG8_SCHED;
            PG8_LDA(At, 1, 1); PG8_STAGE(PG8_SB(1, 0), b3, voffB); PG8_STAGE(PG8_SB(1, 1), b3 + hstep, voffB); PG8_STA(PG8_SA(1, 0), a3, 0, last);
            PG8_WAIT_V(8); PG8_WAIT_L(0); PG8_BAR; PG8_MMA(1, 0, At, B0); PG8_MMA(1, 1, At, B1); PG8_BAR; PG8_SCHED;
            t += 2;
        } while (t < nt);
        if constexpr (HOIST) PG8_STA(PG8_SA(1, 1), nA + kstep, 1, true);
        if (wr == 0) PG8_BAR;
        { int te_ = threadIdx.x; asm volatile("" : "+v"(te_)); int fr_ = te_ & 15, fq_ = (te_ >> 4) & 3; asm volatile("" : "+v"(fr_), "+v"(fq_));
          if constexpr (!(VAR & 4)) E(acc, cur, wr, wc, fr_, fq_); else { _Pragma("unroll") for (int a = 0; a < 2; ++a) _Pragma("unroll") for (int b = 0; b < 2; ++b) _Pragma("unroll") for (int m = 0; m < 4; ++m) _Pragma("unroll") for (int n = 0; n < 2; ++n) asm volatile("" :: "v"(acc[a][b][m][n])); } }
        if (!has_next) break;
#pragma unroll
        for (int a = 0; a < 2; ++a)
#pragma unroll
            for (int b = 0; b < 2; ++b)
#pragma unroll
                for (int m = 0; m < 4; ++m)
#pragma unroll
                    for (int n = 0; n < 2; ++n) acc[a][b][m][n] = (f32x4){0.f, 0.f, 0.f, 0.f};
        cur = nxt; cA = nA; cB = nB; ++ui;
        if constexpr (GATHER) { gvc[0] = gvn[0]; gvc[1] = gvn[1]; }
        if (wr == 1) PG8_BAR;
    }
    PG8_WAIT_V(0);
    PG8_BAR;
#undef PG8_SA
#undef PG8_SB
#undef PG8_GLDS
#undef PG8_STAGE
#undef PG8_STA
#undef PG8_LDA
#undef PG8_LDB
#undef PG8_MMA
#undef PG8_CAT8
#undef PG8_WAIT_V
#undef PG8_WAIT_VF
#undef PG8_WAIT_L
#undef PG8_BAR
#undef PG8_SCHED
#undef PG8_ROWS_LOAD
#undef PG8_ROWS_USE
#undef PG8_ROWS_DMA
#undef PG8_ROWS_USE_LDS
}
}

namespace attn_body {
using bf16 = __hip_bfloat16;
using s16x4 = __attribute__((ext_vector_type(4))) short;
using f32x16 = __attribute__((ext_vector_type(16))) float;
constexpr int D = 64, NW = 8, QBLK = 32, QB = QBLK * NW, KVBLK = 64;
__device__ __forceinline__ int crow(int r, int hi) { return (r & 3) + 8 * (r >> 2) + 4 * hi; }
#define SBAR() __builtin_amdgcn_sched_barrier(0)
__device__ __forceinline__ void cmask(f32x16& p0, f32x16& p1, int jb, int qrel, int hi) {
  const float NEG = -INFINITY; int kb = 64 * jb + 4 * hi;
  #pragma unroll
  for (int r = 0; r < 16; ++r) { int kv = kb + (r & 3) + 8 * (r >> 2); if (kv > qrel) p0[r] = NEG; if (kv + 32 > qrel) p1[r] = NEG; }
}
constexpr int NSLOT = 3, SLOTB = 8192;
constexpr int LDS_K = 0, LDS_V = NSLOT * SLOTB, LDS_WS = 2 * NSLOT * SLOTB, LDS_OST = LDS_WS + NW * 64 * 4, LDS_BYTES = LDS_OST + NW * 4096;
constexpr int LDS_KBT = LDS_BYTES;
constexpr int LDS_TREV = LDS_KBT + 16384;
constexpr int LDS_TOTAL = LDS_TREV + 3072;
constexpr float C2 = 0.125f * 1.4426950408889634f;
__device__ __forceinline__ void glds16(const void* gsrc, unsigned lds_dst) { unsigned keep;
  asm volatile("s_mov_b32 %0, m0\n\ts_mov_b32 m0, %2\n\ts_nop 0\n\tglobal_load_lds_dwordx4 %1, off\n\ts_mov_b32 m0, %0" : "=&s"(keep) : "v"(gsrc), "s"(lds_dst) : "memory"); }
__device__ __forceinline__ float max3f(float a, float b, float c) { float r; asm("v_max3_f32 %0, %1, %2, %3" : "=v"(r) : "v"(a), "v"(b), "v"(c)); return r; }
__device__ __forceinline__ float max2f(float a, float b) { float r; asm("v_max_f32_e32 %0, %1, %2" : "=v"(r) : "v"(a), "v"(b)); return r; }
__device__ __forceinline__ float fadd_s(float a, float b) { float r; asm("v_add_f32_e32 %0, %1, %2" : "=v"(r) : "v"(a), "v"(b)); return r; }
__device__ __forceinline__ float fsub_s(float a, float b) { float r; asm("v_sub_f32_e32 %0, %1, %2" : "=v"(r) : "v"(a), "v"(b)); return r; }
typedef float f32x2_t __attribute__((ext_vector_type(2))); typedef __bf16 bf16x2_t __attribute__((ext_vector_type(2)));
__device__ __forceinline__ unsigned cvtpk_s(float lo, float hi) { f32x2_t v = {lo, hi}; bf16x2_t b = __builtin_convertvector(v, bf16x2_t); return __builtin_bit_cast(unsigned, b); }
#define WAIT_BAR(N) asm volatile("s_waitcnt vmcnt(" #N ") lgkmcnt(0)\n\ts_barrier" ::: "memory")

__device__ __forceinline__ void qkt(f32x16& p0, f32x16& p1, const char* Kslot, const bf16x8* qr, int r32, int hi) {
  const char* kb = Kslot + hi * 1024 + r32 * 16;
  #pragma unroll
  for (int d0 = 0; d0 < 4; ++d0) {
    const bf16x8 b0 = *reinterpret_cast<const bf16x8*>(kb + d0 * 2048);
    const bf16x8 b1 = *reinterpret_cast<const bf16x8*>(kb + d0 * 2048 + 512);
    p0 = __builtin_amdgcn_mfma_f32_32x32x16_bf16(b0, qr[d0], p0, 0, 0, 0); p1 = __builtin_amdgcn_mfma_f32_32x32x16_bf16(b1, qr[d0], p1, 0, 0, 0); }
}
typedef __attribute__((address_space(3))) const char* lds_cptr;
typedef short v4i16_t __attribute__((ext_vector_type(4)));
__device__ __forceinline__ void kload8(bf16x8* kf, lds_cptr kp) {
  kf[0] = *(const LAS bf16x8*)(kp);        kf[1] = *(const LAS bf16x8*)(kp + 512);
  kf[2] = *(const LAS bf16x8*)(kp + 2048); kf[3] = *(const LAS bf16x8*)(kp + 2560);
  kf[4] = *(const LAS bf16x8*)(kp + 4096); kf[5] = *(const LAS bf16x8*)(kp + 4608);
  kf[6] = *(const LAS bf16x8*)(kp + 6144); kf[7] = *(const LAS bf16x8*)(kp + 6656);
}
__device__ __forceinline__ void kload2(bf16x8* kf, lds_cptr kp, int j) { kf[2 * j] = *(const LAS bf16x8*)(kp + j * 2048); kf[2 * j + 1] = *(const LAS bf16x8*)(kp + j * 2048 + 512); }
__device__ __forceinline__ s16x4 vtr(lds_cptr p) { return __builtin_bit_cast(s16x4, __builtin_amdgcn_ds_read_tr16_b64_v4i16((LAS v4i16_t*)p)); }
__device__ __forceinline__ float rowmax(const f32x16& p0, const f32x16& p1) {
  float a = max3f(p0[0], p0[1], p1[0]), b = max3f(p0[2], p0[3], p1[1]); a = max3f(a, p1[2], p1[3]);
  #pragma unroll
  for (int r = 4; r < 16; r += 4) { a = max3f(a, p0[r], p0[r + 1]); b = max3f(b, p0[r + 2], p0[r + 3]); a = max3f(a, p1[r], p1[r + 1]); b = max3f(b, p1[r + 2], p1[r + 3]); }
  const float m = max2f(a, b);
  auto rr = __builtin_amdgcn_permlane32_swap(__float_as_uint(m), __float_as_uint(m), false, false);
  return max2f(__uint_as_float(rr[0]), __uint_as_float(rr[1]));
}
__device__ __forceinline__ void pv(f32x16* o, int vb, bf16x8 pa0, bf16x8 pa1, bf16x8 pa2, bf16x8 pa3) {
  #pragma unroll
  for (int d0 = 0; d0 < 2; ++d0) { s16x4 lo[4], hi[4];
    #pragma unroll
    for (int ks = 0; ks < 4; ++ks) {
      asm volatile("ds_read_b64_tr_b16 %0,%1 offset:%c2" : "=&v"(lo[ks]) : "v"(vb), "i"(d0 * 4096 + ks * 1024) : "memory");
      asm volatile("ds_read_b64_tr_b16 %0,%1 offset:%c2" : "=&v"(hi[ks]) : "v"(vb), "i"(d0 * 4096 + ks * 1024 + 512) : "memory"); }
    asm volatile("s_waitcnt lgkmcnt(0)" ::: "memory"); SBAR();
    #define PK(k) (bf16x8){lo[k][0], lo[k][1], lo[k][2], lo[k][3], hi[k][0], hi[k][1], hi[k][2], hi[k][3]}
    o[d0] = __builtin_amdgcn_mfma_f32_32x32x16_bf16(pa0, PK(0), o[d0], 0, 0, 0);
    o[d0] = __builtin_amdgcn_mfma_f32_32x32x16_bf16(pa1, PK(1), o[d0], 0, 0, 0);
    o[d0] = __builtin_amdgcn_mfma_f32_32x32x16_bf16(pa2, PK(2), o[d0], 0, 0, 0);
    o[d0] = __builtin_amdgcn_mfma_f32_32x32x16_bf16(pa3, PK(3), o[d0], 0, 0, 0);
    #undef PK
  }
}
#define ATTN_STORE16(p, v) (*(u32x4*)(p) = (v))
template <int THRL, int MODE> __device__ __forceinline__ void attn_unit(const bf16* Qp, const bf16* __restrict__ Kp, const bf16* __restrict__ Vp, bf16* Op, long RS, long ORS, int q0, int T0, int NT, int off,
                                                                        float* lsep, long lse_stride, char* shm, const float* kbsrc, const float* relb, int dsel) {
  int tid_ = threadIdx.x; asm volatile("" : "+v"(tid_));
  const int tid = tid_, lane = tid & 63, r32 = lane & 31, hi = lane >> 5; const int wid = __builtin_amdgcn_readfirstlane(tid >> 6);
  const bf16* Qw = Qp + (long)(q0 + wid * QBLK) * RS;
  const bf16* Kh = Kp + (long)T0 * KVBLK * RS, *Vh = Vp + (long)T0 * KVBLK * RS;
  const unsigned lds0 = (unsigned)(uintptr_t)shm;
  float* wsf = (float*)(shm + LDS_WS) + wid * 64;
  const int qrel = wid * QBLK + r32;
  const LAS float* tbase;
  if (MODE == 0) { LAS float* kbt = (LAS float*)(shm + LDS_KBT); const int nk = q0 + QB;
    for (int i = 64 * T0 + tid * 4; i < nk; i += 2048) *(LAS f32x4*)(kbt + i) = *(const f32x4*)(kbsrc + i);
    tbase = kbt + 4 * hi + 64 * T0;
  } else { LAS float* tr = (LAS float*)(shm + LDS_TREV);
    for (int u = tid; u < 768; u += 512) { const int j = 383 - u; float v = -INFINITY; if (j >= 0 && j <= 128) v = relb[(int)T5B[dsel][j] * NH] * LOG2E; tr[u] = v; }
    tbase = tr + (383 - off - qrel + 4 * hi);
  }
  const bf16* ksrc = Kh + (long)lane * RS + wid * 8;
  const bf16* vsrc = Vh + (long)(16 * (wid & 3) + (lane >> 2)) * RS + (wid >> 2) * 32 + (lane & 3) * 8;
  const unsigned kdst = lds0 + LDS_K + wid * 1024, vdst = lds0 + LDS_V + wid * 1024;
  #define DMA_K(t, slot) glds16(ksrc + (long)(t) * KVBLK * RS, (unsigned)__builtin_amdgcn_readfirstlane(kdst + (slot)))
  #define DMA_V(t, slot) glds16(vsrc + (long)(t) * KVBLK * RS, (unsigned)__builtin_amdgcn_readfirstlane(vdst + (slot)))
  const int vb0 = (int)(lds0 + LDS_V) + ((lane >> 4) & 1) * 32 + (lane & 3) * 8 + (4 * hi + ((lane & 15) >> 2)) * 64;
  const char* Kbase = shm + LDS_K; bf16x8 kf[8];
  const lds_cptr shm3 = (lds_cptr)shm; const lds_cptr kp0 = shm3 + LDS_K + hi * 1024 + r32 * 16; const lds_cptr vp0 = shm3 + LDS_V + ((lane >> 4) & 1) * 32 + (lane & 3) * 8 + (4 * hi + ((lane & 15) >> 2)) * 64;
  DMA_K(0, 0); DMA_V(0, 0); DMA_K(1, SLOTB);
  bf16x8 qr[4];
  #pragma unroll
  for (int d0 = 0; d0 < 4; ++d0) qr[d0] = *reinterpret_cast<const bf16x8*>(&Qw[(long)r32 * RS + d0 * 16 + hi * 8]);
  float mhat = 0.f, l_reg = 0.f; f32x16 o[2]; o[0] = f32x16{}; o[1] = f32x16{};
  #define BLOAD(P0, P1, t) do { const LAS float* tb_ = tbase + 64 * (t); \
      if (MODE == 0) { _Pragma("unroll") for (int g_ = 0; g_ < 4; ++g_) { const f32x4 b0_ = *(const LAS f32x4*)(tb_ + 8 * g_), b1_ = *(const LAS f32x4*)(tb_ + 32 + 8 * g_); \
          _Pragma("unroll") for (int i_ = 0; i_ < 4; ++i_) { P0[4 * g_ + i_] = b0_[i_]; P1[4 * g_ + i_] = b1_[i_]; } } } \
      else { _Pragma("unroll") for (int r_ = 0; r_ < 16; ++r_) { P0[r_] = tb_[(r_ & 3) + 8 * (r_ >> 2)]; P1[r_] = tb_[32 + (r_ & 3) + 8 * (r_ >> 2)]; } } } while (0)
  #define CMASK(P0, P1, t) do { if (MODE == 0) { int jb_ = (t) - (NT - 4); if (jb_ >= 0) cmask(P0, P1, jb_, qrel, hi); } } while (0)
  bool resc = false;
  #define START(P0, P1) do { const float rm = rowmax(P0, P1); resc = false; mhat = max2f(rm, -1000.f); \
    _Pragma("unroll") for (int r = 0; r < 16; ++r) P0[r] = __builtin_amdgcn_exp2f(fsub_s(P0[r], mhat)); } while (0)
  #define RESC() do { if (resc) { asm volatile("s_waitcnt lgkmcnt(0)" ::: "memory"); \
      _Pragma("unroll") for (int d_ = 0; d_ < 2; ++d_) _Pragma("unroll") for (int r = 0; r < 16; ++r) o[d_][r] *= wsf[crow(r, hi)]; } } while (0)
  f32x16 pA0, pA1, pB0, pB1;
  int sl_prev = 0, sl_cur = 0, sl_next = SLOTB;
  #define ROT() do { sl_prev = sl_cur; sl_cur = sl_next; sl_next = (sl_next == (NSLOT - 1) * SLOTB) ? 0 : sl_next + SLOTB; } while (0)
  DMA_K(2, 2 * SLOTB);
  WAIT_BAR(3);
  BLOAD(pA0, pA1, 0);
  qkt(pA0, pA1, Kbase, qr, r32, hi); asm volatile("s_nop 15\n\ts_nop 7" : "+v"(pA0), "+v"(pA1)); CMASK(pA0, pA1, 0);
  START(pA0, pA1);
  _Pragma("unroll") for (int r = 0; r < 16; ++r) pA1[r] = __builtin_amdgcn_exp2f(fsub_s(pA1[r], mhat));
  BLOAD(pB0, pB1, 1);
  WAIT_BAR(0);
  DMA_K(3, 0); DMA_V(1, SLOTB);
  ROT();
  kload8(kf, kp0 + sl_cur);
  WAIT_BAR(2);
  s16x4 vlo[8], vhi[8]; u32x4 pw0, pw1, pw2, pw3;
  #define PKW(P, B) cvtpk_s(P[B], P[B + 1])
  #define PAF(k) __builtin_bit_cast(bf16x8, pw##k)
  #define VFR(i) (bf16x8){vlo[i][0], vlo[i][1], vlo[i][2], vlo[i][3], vhi[i][0], vhi[i][1], vhi[i][2], vhi[i][3]}
  #define PIN(x) asm volatile("" : "+v"(x))
  #define MX3(a, b, c) __builtin_fmaxf(__builtin_fmaxf((a), (b)), (c))
  #define GAPA(MF, A0, A1, A2, A3, W0, W1, PW) do { MF; sacc += A0; sacc += A1; sacc += A2; sacc += A3; PIN(sacc); W0; W1; PIN(PW); SBAR(); } while (0)
  #define EX(v) __builtin_amdgcn_exp2f(v)
  #define GAPB(MF, X, B) do { MF; X[B] = EX(X[B] - mhat); X[B + 1] = EX(X[B + 1] - mhat); X[B + 2] = EX(X[B + 2] - mhat); X[B + 3] = EX(X[B + 3] - mhat); PIN(X); SBAR(); } while (0)
  #define VRD(i) do { vlo[i] = vtr(vp_ + (((i) >> 2) * 4096 + ((i) & 3) * 1024)); vhi[i] = vtr(vp_ + (((i) >> 2) * 4096 + ((i) & 3) * 1024 + 512)); } while (0)
  #define KRD(G, j) do { if (G) { kload2(kf, kp0 + sl_next, j); SBAR(); } } while (0)
  #define STEP(C0, C1, P0, P1, t, GK, GV, GL) do { SBAR(); \
    const lds_cptr vp_ = vp0 + sl_prev; \
    VRD(0); SBAR(); float sacc = (P0[0] + P0[1]); \
    GAPA(C0 = __builtin_amdgcn_mfma_f32_32x32x16_bf16(kf[0], qr[0], C0, 0, 0, 0), P0[2], P0[3], P0[4], P0[5],     pw0[0] = PKW(P0, 0), pw0[1] = PKW(P0, 2), pw0); \
    VRD(4); SBAR(); GAPA(C1 = __builtin_amdgcn_mfma_f32_32x32x16_bf16(kf[1], qr[0], C1, 0, 0, 0), P0[6], P0[7], P0[8], P0[9],     pw0[2] = PKW(P0, 4), pw0[3] = PKW(P0, 6), pw0); \
    VRD(1); SBAR(); GAPA(C0 = __builtin_amdgcn_mfma_f32_32x32x16_bf16(kf[2], qr[1], C0, 0, 0, 0),   P0[10], P0[11], P0[12], P0[13], pw1[0] = PKW(P0, 8), pw1[1] = PKW(P0, 10), pw1); \
    VRD(5); SBAR(); GAPA(C1 = __builtin_amdgcn_mfma_f32_32x32x16_bf16(kf[3], qr[1], C1, 0, 0, 0),   P0[14], P0[15], P1[0], P1[1],   pw1[2] = PKW(P0, 12), pw1[3] = PKW(P0, 14), pw1); \
    VRD(2); SBAR(); GAPA(C0 = __builtin_amdgcn_mfma_f32_32x32x16_bf16(kf[4], qr[2], C0, 0, 0, 0),   P1[2], P1[3], P1[4], P1[5],     pw2[0] = PKW(P1, 0), pw2[1] = PKW(P1, 2), pw2); \
    VRD(6); SBAR(); GAPA(C1 = __builtin_amdgcn_mfma_f32_32x32x16_bf16(kf[5], qr[2], C1, 0, 0, 0),   P1[6], P1[7], P1[8], P1[9],     pw2[2] = PKW(P1, 4), pw2[3] = PKW(P1, 6), pw2); \
    VRD(3); SBAR(); GAPA(C0 = __builtin_amdgcn_mfma_f32_32x32x16_bf16(kf[6], qr[3], C0, 0, 0, 0),   P1[10], P1[11], P1[12], P1[13], pw3[0] = PKW(P1, 8), pw3[1] = PKW(P1, 10), pw3); \
    VRD(7); SBAR(); GAPA(C1 = __builtin_amdgcn_mfma_f32_32x32x16_bf16(kf[7], qr[3], C1, 0, 0, 0),   P1[14], P1[15], 0.f, 0.f,       pw3[2] = PKW(P1, 12), pw3[3] = PKW(P1, 14), pw3); \
    l_reg += sacc; \
    if (GK) { DMA_K((t) + 3, sl_cur); } if (GV) { DMA_V((t) + 1, sl_next); } \
    CMASK(C0, C1, t); \
    { float a = MX3(C0[0], C0[1], C1[0]), b = MX3(C0[2], C0[3], C1[1]); a = MX3(a, C1[2], C1[3]); \
      _Pragma("unroll") for (int r = 4; r < 16; r += 4) { a = MX3(a, C0[r], C0[r + 1]); b = MX3(b, C0[r + 2], C0[r + 3]); a = MX3(a, C1[r], C1[r + 1]); b = MX3(b, C1[r + 2], C1[r + 3]); } \
      float rm = __builtin_fmaxf(a, b); { auto rr = __builtin_amdgcn_permlane32_swap(__float_as_uint(rm), __float_as_uint(rm), false, false); rm = __builtin_fmaxf(__uint_as_float(rr[0]), __uint_as_float(rr[1])); } \
      rm -= mhat; resc = false; \
      if (__builtin_expect(__any(rm > (float)THRL), 0)) { const float dl = __builtin_fmaxf(rm, 0.f); mhat += dl; \
        const float f = __builtin_amdgcn_exp2f(-dl); l_reg *= f; if (hi == 0) wsf[r32] = f; resc = true; } } \
    SBAR(); \
    if ((t) + 1 < NT) { BLOAD(P0, P1, (t) + 1); SBAR(); }        \
    GAPB(o[0] = __builtin_amdgcn_mfma_f32_32x32x16_bf16(PAF(0), VFR(0), o[0], 0, 0, 0), C0, 0); \
    GAPB(o[1] = __builtin_amdgcn_mfma_f32_32x32x16_bf16(PAF(0), VFR(4), o[1], 0, 0, 0), C0, 4); \
    KRD(GL, 0); GAPB(o[0] = __builtin_amdgcn_mfma_f32_32x32x16_bf16(PAF(1), VFR(1), o[0], 0, 0, 0), C0, 8); \
    KRD(GL, 1); GAPB(o[1] = __builtin_amdgcn_mfma_f32_32x32x16_bf16(PAF(1), VFR(5), o[1], 0, 0, 0), C0, 12); \
    KRD(GL, 2); GAPB(o[0] = __builtin_amdgcn_mfma_f32_32x32x16_bf16(PAF(2), VFR(2), o[0], 0, 0, 0), C1, 0); \
    KRD(GL, 3); GAPB(o[1] = __builtin_amdgcn_mfma_f32_32x32x16_bf16(PAF(2), VFR(6), o[1], 0, 0, 0), C1, 4); \
    GAPB(o[0] = __builtin_amdgcn_mfma_f32_32x32x16_bf16(PAF(3), VFR(3), o[0], 0, 0, 0), C1, 8); \
    GAPB(o[1] = __builtin_amdgcn_mfma_f32_32x32x16_bf16(PAF(3), VFR(7), o[1], 0, 0, 0), C1, 12); \
    } while (0)
  int t = 1;
  for (; t + 5 < NT; t += 2) {
    STEP(pB0, pB1, pA0, pA1, t, true, true, true);     WAIT_BAR(2); RESC(); ROT();
    STEP(pA0, pA1, pB0, pB1, t + 1, true, true, true); WAIT_BAR(2); RESC(); ROT();
  }
  #define ENDW(tt) do { if ((tt) + 3 < NT) { WAIT_BAR(2); } else if ((tt) + 2 < NT) { WAIT_BAR(1); } else { WAIT_BAR(0); } } while (0)
  for (; t + 1 < NT; t += 2) {
    STEP(pB0, pB1, pA0, pA1, t, (t + 3 < NT), (t + 1 < NT), (t + 1 < NT));     ENDW(t);     RESC(); ROT();
    STEP(pA0, pA1, pB0, pB1, t + 1, (t + 4 < NT), (t + 2 < NT), (t + 2 < NT)); ENDW(t + 1); RESC(); ROT();
  }
  STEP(pB0, pB1, pA0, pA1, NT - 1, false, false, false); RESC();
  { float sacc = pB0[0] + pB0[1]; _Pragma("unroll") for (int r = 2; r < 16; ++r) sacc += pB0[r]; _Pragma("unroll") for (int r = 0; r < 16; ++r) sacc += pB1[r]; l_reg += sacc;
    pw0 = (u32x4){PKW(pB0, 0), PKW(pB0, 2), PKW(pB0, 4), PKW(pB0, 6)}; pw1 = (u32x4){PKW(pB0, 8), PKW(pB0, 10), PKW(pB0, 12), PKW(pB0, 14)}; pw2 = (u32x4){PKW(pB1, 0), PKW(pB1, 2), PKW(pB1, 4), PKW(pB1, 6)}; pw3 = (u32x4){PKW(pB1, 8), PKW(pB1, 10), PKW(pB1, 12), PKW(pB1, 14)};
    SBAR(); pv(o, vb0 + sl_cur, PAF(0), PAF(1), PAF(2), PAF(3)); }
  #undef PKW
  #undef PAF
  #undef VFR
  #undef PIN
  #undef MX3
  #undef GAPA
  #undef GAPB
  #undef EX
  #undef VRD
  #undef KRD
  #undef STEP
  #undef ENDW
  { auto rr = __builtin_amdgcn_permlane32_swap(__float_as_uint(l_reg), __float_as_uint(l_reg), false, false); l_reg = __uint_as_float(rr[0]) + __uint_as_float(rr[1]); }
  if (lsep != nullptr && hi == 0) lsep[(long)(q0 + qrel) * lse_stride] = mhat + __log2f(l_reg);
  if (hi == 0) wsf[32 + r32] = l_reg; asm volatile("s_waitcnt lgkmcnt(0)" ::: "memory");
  float rli[16];
  #pragma unroll
  for (int r = 0; r < 16; ++r) rli[r] = __builtin_amdgcn_rcpf(wsf[32 + crow(r, hi)]);
  bf16* Ow = Op + (long)(q0 + wid * QBLK) * ORS;
  { bf16* stg = (bf16*)(shm + LDS_OST) + wid * 2048;
    #pragma unroll
    for (int r = 0; r < 16; ++r) { const int orow = crow(r, hi);
      #pragma unroll
      for (int d0 = 0; d0 < 2; ++d0) stg[orow * 64 + d0 * 32 + r32] = __float2bfloat16(o[d0][r] * rli[r]); }
    asm volatile("s_waitcnt lgkmcnt(0)" ::: "memory");
    #pragma unroll
    for (int i = 0; i < 4; ++i) { const int row = i * 8 + (lane >> 3), ch = lane & 7; const u32x4 v = *(const u32x4*)(stg + row * 64 + ch * 8); ATTN_STORE16(Ow + (long)row * ORS + ch * 8, v); } }
  asm volatile("s_waitcnt lgkmcnt(0)\n\ts_barrier" ::: "memory");
  #undef DMA_K
  #undef DMA_V
  #undef CMASK
  #undef BLOAD
  #undef START
  #undef RESC
  #undef ROT
}

constexpr int DL_K = 0, DL_KB = 49152, DL_V = 98304, DL_VPAD = 147456, DL_ZEND = 153600, DL_WS = 153600, DL_TREV = 155648, DL_TOTAL = DL_TREV + 3072;
static_assert(DL_WS + NW * 256 <= DL_TREV, "dilated LDS map");
struct DilSrc { const bf16* K; const bf16* V; long RS; int q0; int first; };
__device__ __forceinline__ void dil_issue_k(const DilSrc& u, unsigned lds0, int kbuf, int lane, int wid) {
  const long kr0 = (long)u.q0 - 128; const bf16* ksrc = u.K + (kr0 + lane) * u.RS + wid * 8; const unsigned kdst = lds0 + kbuf + wid * 1024;
  #pragma unroll
  for (int i = 0; i < 6; ++i) if (i >= 2 || !u.first) glds16(ksrc + (long)i * KVBLK * u.RS, (unsigned)__builtin_amdgcn_readfirstlane(kdst + i * 8192));
}
__device__ __forceinline__ void dil_issue_v(const DilSrc& u, unsigned lds0, int lane, int wid) {
  const long kr0 = (long)u.q0 - 128; const bf16* vsrc = u.V + (kr0 + 16 * (wid & 3) + (lane >> 2)) * u.RS + (wid >> 2) * 32 + (lane & 3) * 8; const unsigned vdst = lds0 + DL_V + wid * 1024;
  #pragma unroll
  for (int i = 0; i < 6; ++i) if (i >= 2 || !u.first) glds16(vsrc + (long)i * KVBLK * u.RS, (unsigned)__builtin_amdgcn_readfirstlane(vdst + i * 8192));
}
template <int THRL> __device__ __forceinline__ void dil_unit(const bf16* Qp, const DilSrc cur, int kb, bool issued, const DilSrc nxt, bool has_next, bf16* Op,
                                                             float* lsep, long lse_stride, char* shm, const float* relb, int dsel, bool build_tab) {
  int tid_ = threadIdx.x; asm volatile("" : "+v"(tid_));
  const int tid = tid_, lane = tid & 63, r32 = lane & 31, hi = lane >> 5; const int wid = __builtin_amdgcn_readfirstlane(tid >> 6);
  const unsigned lds0 = (unsigned)(uintptr_t)shm;
  const long RS = cur.RS; const int q0 = cur.q0; const bool first = cur.first != 0;
  float* wsf = (float*)(shm + DL_WS) + wid * 64;
  LAS float* tr = (LAS float*)(shm + DL_TREV);
  if (build_tab) { for (int u = tid; u < 768; u += 512) { const int j = 383 - u; float v = -INFINITY; if (j >= 0 && j <= 128) v = relb[(int)T5B[dsel][j] * NH] * LOG2E; tr[u] = v; } }
  const LAS float* tbase = tr + (255 - r32 + 4 * hi);
  if (!issued) { dil_issue_k(cur, lds0, kb, lane, wid); dil_issue_v(cur, lds0, lane, wid); }
  const bf16* Qw = Qp + (long)(q0 + wid * QBLK) * RS;
  bf16x8 qr[4];
  #pragma unroll
  for (int d0 = 0; d0 < 4; ++d0) qr[d0] = *reinterpret_cast<const bf16x8*>(&Qw[(long)r32 * RS + d0 * 16 + hi * 8]);
  asm volatile("s_waitcnt vmcnt(0) lgkmcnt(0)\n\ts_barrier" ::: "memory");
  if (has_next) dil_issue_k(nxt, lds0, kb ^ DL_KB, lane, wid);
  const int g = wid;
  const lds_cptr shm3 = (lds_cptr)shm;
  const lds_cptr kl = shm3 + kb + hi * 1024 + r32 * 16;
  const lds_cptr vl = shm3 + DL_V + ((lane >> 4) & 1) * 32 + (lane & 3) * 8 + (4 * hi + ((lane & 15) >> 2)) * 64;
  #define KBO(blk) ((((blk)) >> 1) * 8192 + (((blk)) & 1) * 512)
  #define VBO(blk) ((((blk)) >> 1) * 8192 + (((blk)) & 1) * 2048)
  #define DKLOAD2(s_, j_) do { const int b0_ = g + 2 * (s_); kf[2 * (j_)] = *(const LAS bf16x8*)(kl + KBO(b0_) + (j_) * 2048); kf[2 * (j_) + 1] = *(const LAS bf16x8*)(kl + KBO(b0_ + 1) + (j_) * 2048); } while (0)
  float mhat = 0.f, l_reg = 0.f; f32x16 o[2]; o[0] = f32x16{}; o[1] = f32x16{};
  bf16x8 kf[8];
  #define BLOAD(P0, P1, t) do { const LAS float* tb_ = tbase + 64 * (t); \
      _Pragma("unroll") for (int r_ = 0; r_ < 16; ++r_) { P0[r_] = tb_[(r_ & 3) + 8 * (r_ >> 2)]; P1[r_] = tb_[32 + (r_ & 3) + 8 * (r_ >> 2)]; } } while (0)
  #define PMASK(P0, P1, t) do { if (first && (32 * g + 64 * (t)) < 128) { const int kb_ = 32 * g + 64 * (t) + 4 * hi - 128; \
      _Pragma("unroll") for (int r_ = 0; r_ < 16; ++r_) { const int kp_ = kb_ + (r_ & 3) + 8 * (r_ >> 2); if (kp_ < 0) P0[r_] = -INFINITY; if (kp_ + 32 < 0) P1[r_] = -INFINITY; } } } while (0)
  bool resc = false;
  #define RESC() do { if (resc) { asm volatile("s_waitcnt lgkmcnt(0)" ::: "memory"); \
      _Pragma("unroll") for (int d_ = 0; d_ < 2; ++d_) _Pragma("unroll") for (int r = 0; r < 16; ++r) o[d_][r] *= wsf[crow(r, hi)]; } } while (0)
  f32x16 pA0, pA1, pB0, pB1;
  BLOAD(pA0, pA1, 0);
  DKLOAD2(0, 0); DKLOAD2(0, 1); DKLOAD2(0, 2); DKLOAD2(0, 3);
  #pragma unroll
  for (int d0 = 0; d0 < 4; ++d0) { pA0 = __builtin_amdgcn_mfma_f32_32x32x16_bf16(kf[2 * d0], qr[d0], pA0, 0, 0, 0); pA1 = __builtin_amdgcn_mfma_f32_32x32x16_bf16(kf[2 * d0 + 1], qr[d0], pA1, 0, 0, 0); }
  asm volatile("s_nop 15\n\ts_nop 7" : "+v"(pA0), "+v"(pA1)); PMASK(pA0, pA1, 0);
  asm volatile("s_nop 3" : "+v"(pA0), "+v"(pA1));
  { const float rm = rowmax(pA0, pA1); mhat = max2f(rm, -1000.f);
    _Pragma("unroll") for (int r = 0; r < 16; ++r) pA0[r] = __builtin_amdgcn_exp2f(fsub_s(pA0[r], mhat));
    _Pragma("unroll") for (int r = 0; r < 16; ++r) pA1[r] = __builtin_amdgcn_exp2f(fsub_s(pA1[r], mhat)); }
  BLOAD(pB0, pB1, 1);
  DKLOAD2(1, 0); DKLOAD2(1, 1); DKLOAD2(1, 2); DKLOAD2(1, 3);
  s16x4 vlo[8], vhi[8]; u32x4 pw0, pw1, pw2, pw3;
  #define PKW(P, B) cvtpk_s(P[B], P[B + 1])
  #define PAF(k) __builtin_bit_cast(bf16x8, pw##k)
  #define VFR(i) (bf16x8){vlo[i][0], vlo[i][1], vlo[i][2], vlo[i][3], vhi[i][0], vhi[i][1], vhi[i][2], vhi[i][3]}
  #define PIN(x) asm volatile("" : "+v"(x))
  #define MX3(a, b, c) __builtin_fmaxf(__builtin_fmaxf((a), (b)), (c))
  #define GAPA(MF, A0, A1, A2, A3, W0, W1, PW) do { MF; sacc += A0; sacc += A1; sacc += A2; sacc += A3; PIN(sacc); W0; W1; PIN(PW); SBAR(); } while (0)
  #define EX(v) __builtin_amdgcn_exp2f(v)
  #define GAPB(MF, X, B) do { MF; X[B] = EX(X[B] - mhat); X[B + 1] = EX(X[B + 1] - mhat); X[B + 2] = EX(X[B + 2] - mhat); X[B + 3] = EX(X[B + 3] - mhat); PIN(X); SBAR(); } while (0)
  #define VRD(i) do { const lds_cptr va_ = vl + VBO(g + 2 * tv_ + (((i) & 3) >> 1)) + ((i) >> 2) * 4096 + ((i) & 1) * 1024; vlo[i] = vtr(va_); vhi[i] = vtr(va_ + 512); } while (0)
  #define KRD(G, j) do { if (G) { DKLOAD2(tk_, j); SBAR(); } } while (0)
  #define STEP(C0, C1, P0, P1, t, GL) do { SBAR(); const int tv_ = (t) - 1, tk_ = (t) + 1; \
    VRD(0); SBAR(); float sacc = (P0[0] + P0[1]); \
    GAPA(C0 = __builtin_amdgcn_mfma_f32_32x32x16_bf16(kf[0], qr[0], C0, 0, 0, 0), P0[2], P0[3], P0[4], P0[5],     pw0[0] = PKW(P0, 0), pw0[1] = PKW(P0, 2), pw0); \
    VRD(4); SBAR(); GAPA(C1 = __builtin_amdgcn_mfma_f32_32x32x16_bf16(kf[1], qr[0], C1, 0, 0, 0), P0[6], P0[7], P0[8], P0[9],     pw0[2] = PKW(P0, 4), pw0[3] = PKW(P0, 6), pw0); \
    VRD(1); SBAR(); GAPA(C0 = __builtin_amdgcn_mfma_f32_32x32x16_bf16(kf[2], qr[1], C0, 0, 0, 0),   P0[10], P0[11], P0[12], P0[13], pw1[0] = PKW(P0, 8), pw1[1] = PKW(P0, 10), pw1); \
    VRD(5); SBAR(); GAPA(C1 = __builtin_amdgcn_mfma_f32_32x32x16_bf16(kf[3], qr[1], C1, 0, 0, 0),   P0[14], P0[15], P1[0], P1[1],   pw1[2] = PKW(P0, 12), pw1[3] = PKW(P0, 14), pw1); \
    VRD(2); SBAR(); GAPA(C0 = __builtin_amdgcn_mfma_f32_32x32x16_bf16(kf[4], qr[2], C0, 0, 0, 0),   P1[2], P1[3], P1[4], P1[5],     pw2[0] = PKW(P1, 0), pw2[1] = PKW(P1, 2), pw2); \
    VRD(6); SBAR(); GAPA(C1 = __builtin_amdgcn_mfma_f32_32x32x16_bf16(kf[5], qr[2], C1, 0, 0, 0),   P1[6], P1[7], P1[8], P1[9],     pw2[2] = PKW(P1, 4), pw2[3] = PKW(P1, 6), pw2); \
    VRD(3); SBAR(); GAPA(C0 = __builtin_amdgcn_mfma_f32_32x32x16_bf16(kf[6], qr[3], C0, 0, 0, 0),   P1[10], P1[11], P1[12], P1[13], pw3[0] = PKW(P1, 8), pw3[1] = PKW(P1, 10), pw3); \
    VRD(7); SBAR(); GAPA(C1 = __builtin_amdgcn_mfma_f32_32x32x16_bf16(kf[7], qr[3], C1, 0, 0, 0),   P1[14], P1[15], 0.f, 0.f,       pw3[2] = PKW(P1, 12), pw3[3] = PKW(P1, 14), pw3); \
    l_reg += sacc; \
    PMASK(C0, C1, t); \
    { float a = MX3(C0[0], C0[1], C1[0]), b = MX3(C0[2], C0[3], C1[1]); a = MX3(a, C1[2], C1[3]); \
      _Pragma("unroll") for (int r = 4; r < 16; r += 4) { a = MX3(a, C0[r], C0[r + 1]); b = MX3(b, C0[r + 2], C0[r + 3]); a = MX3(a, C1[r], C1[r + 1]); b = MX3(b, C1[r + 2], C1[r + 3]); } \
      float rm = __builtin_fmaxf(a, b); { auto rr = __builtin_amdgcn_permlane32_swap(__float_as_uint(rm), __float_as_uint(rm), false, false); rm = __builtin_fmaxf(__uint_as_float(rr[0]), __uint_as_float(rr[1])); } \
      rm -= mhat; resc = false; \
      if (__builtin_expect(__any(rm > (float)THRL), 0)) { const float dl = __builtin_fmaxf(rm, 0.f); mhat += dl; \
        const float f = __builtin_amdgcn_exp2f(-dl); l_reg *= f; if (hi == 0) wsf[r32] = f; resc = true; } } \
    SBAR(); \
    if ((t) + 1 < 3) { BLOAD(P0, P1, (t) + 1); SBAR(); } \
    GAPB(o[0] = __builtin_amdgcn_mfma_f32_32x32x16_bf16(PAF(0), VFR(0), o[0], 0, 0, 0), C0, 0); \
    GAPB(o[1] = __builtin_amdgcn_mfma_f32_32x32x16_bf16(PAF(0), VFR(4), o[1], 0, 0, 0), C0, 4); \
    KRD(GL, 0); GAPB(o[0] = __builtin_amdgcn_mfma_f32_32x32x16_bf16(PAF(1), VFR(1), o[0], 0, 0, 0), C0, 8); \
    KRD(GL, 1); GAPB(o[1] = __builtin_amdgcn_mfma_f32_32x32x16_bf16(PAF(1), VFR(5), o[1], 0, 0, 0), C0, 12); \
    KRD(GL, 2); GAPB(o[0] = __builtin_amdgcn_mfma_f32_32x32x16_bf16(PAF(2), VFR(2), o[0], 0, 0, 0), C1, 0); \
    KRD(GL, 3); GAPB(o[1] = __builtin_amdgcn_mfma_f32_32x32x16_bf16(PAF(2), VFR(6), o[1], 0, 0, 0), C1, 4); \
    GAPB(o[0] = __builtin_amdgcn_mfma_f32_32x32x16_bf16(PAF(3), VFR(3), o[0], 0, 0, 0), C1, 8); \
    GAPB(o[1] = __builtin_amdgcn_mfma_f32_32x32x16_bf16(PAF(3), VFR(7), o[1], 0, 0, 0), C1, 12); \
    } while (0)
  STEP(pB0, pB1, pA0, pA1, 1, true);  RESC();
  STEP(pA0, pA1, pB0, pB1, 2, false); RESC();
  { float sacc = pA0[0] + pA0[1]; _Pragma("unroll") for (int r = 2; r < 16; ++r) sacc += pA0[r]; _Pragma("unroll") for (int r = 0; r < 16; ++r) sacc += pA1[r]; l_reg += sacc;
    pw0 = (u32x4){PKW(pA0, 0), PKW(pA0, 2), PKW(pA0, 4), PKW(pA0, 6)}; pw1 = (u32x4){PKW(pA0, 8), PKW(pA0, 10), PKW(pA0, 12), PKW(pA0, 14)}; pw2 = (u32x4){PKW(pA1, 0), PKW(pA1, 2), PKW(pA1, 4), PKW(pA1, 6)}; pw3 = (u32x4){PKW(pA1, 8), PKW(pA1, 10), PKW(pA1, 12), PKW(pA1, 14)};
    SBAR(); const int tv_ = 2;
    VRD(0); VRD(1); VRD(2); VRD(3); VRD(4); VRD(5); VRD(6); VRD(7);
    o[0] = __builtin_amdgcn_mfma_f32_32x32x16_bf16(PAF(0), VFR(0), o[0], 0, 0, 0); o[1] = __builtin_amdgcn_mfma_f32_32x32x16_bf16(PAF(0), VFR(4), o[1], 0, 0, 0);
    o[0] = __builtin_amdgcn_mfma_f32_32x32x16_bf16(PAF(1), VFR(1), o[0], 0, 0, 0); o[1] = __builtin_amdgcn_mfma_f32_32x32x16_bf16(PAF(1), VFR(5), o[1], 0, 0, 0);
    o[0] = __builtin_amdgcn_mfma_f32_32x32x16_bf16(PAF(2), VFR(2), o[0], 0, 0, 0); o[1] = __builtin_amdgcn_mfma_f32_32x32x16_bf16(PAF(2), VFR(6), o[1], 0, 0, 0);
    o[0] = __builtin_amdgcn_mfma_f32_32x32x16_bf16(PAF(3), VFR(3), o[0], 0, 0, 0); o[1] = __builtin_amdgcn_mfma_f32_32x32x16_bf16(PAF(3), VFR(7), o[1], 0, 0, 0); }
  #undef PKW
  #undef PAF
  #undef VFR
  #undef PIN
  #undef MX3
  #undef GAPA
  #undef GAPB
  #undef EX
  #undef VRD
  #undef KRD
  #undef STEP
  const int qrel = wid * QBLK + r32;
  { auto rr = __builtin_amdgcn_permlane32_swap(__float_as_uint(l_reg), __float_as_uint(l_reg), false, false); l_reg = __uint_as_float(rr[0]) + __uint_as_float(rr[1]); }
  if (hi == 0) lsep[(long)(q0 + qrel) * lse_stride] = mhat + __log2f(l_reg);
  if (hi == 0) wsf[32 + r32] = l_reg; asm volatile("s_waitcnt lgkmcnt(0)" ::: "memory");
  float rli[16];
  #pragma unroll
  for (int r = 0; r < 16; ++r) rli[r] = __builtin_amdgcn_rcpf(wsf[32 + crow(r, hi)]);
  asm volatile("s_waitcnt lgkmcnt(0)\n\ts_barrier" ::: "memory");
  if (has_next) dil_issue_v(nxt, lds0, lane, wid);
  bf16* Ow = Op + (long)(q0 + wid * QBLK) * RS;
  { bf16* stg = (bf16*)(shm + kb) + wid * 2048;
    #pragma unroll
    for (int r = 0; r < 16; ++r) { const int orow = crow(r, hi);
      #pragma unroll
      for (int d0 = 0; d0 < 2; ++d0) stg[orow * 64 + d0 * 32 + r32] = __float2bfloat16(o[d0][r] * rli[r]); }
    asm volatile("s_waitcnt lgkmcnt(0)" ::: "memory");
    #pragma unroll
    for (int i = 0; i < 4; ++i) { const int row = i * 8 + (lane >> 3), ch = lane & 7; const u32x4 v = *(const u32x4*)(stg + row * 64 + ch * 8); ATTN_STORE16(Ow + (long)row * RS + ch * 8, v); } }
  if (!has_next) asm volatile("s_waitcnt lgkmcnt(0)\n\ts_barrier" ::: "memory");
  #undef KBO
  #undef VBO
  #undef DKLOAD2
  #undef BLOAD
  #undef PMASK
  #undef RESC
}
#undef SBAR
#undef WAIT_BAR
}
static_assert(attn_body::LDS_TOTAL <= RING_BYTES && attn_body::DL_TOTAL <= PHASE_LDS, "attention LDS");

#define XB_TMO      128
#define XB_XCNT(j)  (256  + 64 * (j))
#define XB_XSUB(j)  (1280 + 64 * (j))
#define XB_XGEN(j)  (2304 + 64 * (j))
#define XB_TOP      3328
#define XB_TOPGEN   3392
#define XCD_BAR_WORDS 3456
#define XB_SPIN_CAP (1u << 18)
__device__ __forceinline__ unsigned xb_ld(unsigned* p)              { return __hip_atomic_load(p, __ATOMIC_RELAXED, __HIP_MEMORY_SCOPE_AGENT); }
__device__ __forceinline__ unsigned xb_add(unsigned* p, unsigned v) { return __hip_atomic_fetch_add(p, v, __ATOMIC_RELAXED, __HIP_MEMORY_SCOPE_AGENT); }
__device__ __forceinline__ unsigned xb_xcc_id() { return (unsigned)__builtin_amdgcn_s_getreg((3 << 11) | 20) & 0xFu; }
#define XB_SPIN(cond, bar) do { unsigned _sp = 0; while (cond) { __builtin_amdgcn_s_sleep(1); \
    if ((++_sp & 255u) == 0u) { if (xb_ld(&(bar)[XB_TMO])) break; if (_sp > XB_SPIN_CAP) { atomicAdd(&(bar)[XB_TMO], 1u); break; } } } } while (0)
struct XcdBarrier { unsigned* bar; unsigned x; volatile LAS unsigned* st; };
__device__ __forceinline__ XcdBarrier xcd_barrier_post(unsigned* bar, volatile LAS unsigned* st) {
    XcdBarrier b; b.bar = bar; b.x = xb_xcc_id(); b.st = st;
    if (threadIdx.x == 0) (void)xb_add(&bar[XB_XCNT(b.x)], 1u);
    return b;
}
__device__ __forceinline__ void xcd_barrier_complete(unsigned* bar, unsigned x, unsigned& nloc, unsigned& nx) {
    const unsigned G = gridDim.x * gridDim.y * gridDim.z;
    unsigned sum, cnt, mine, sp = 0u;
    for (;;) {
        sum = 0u; cnt = 0u; mine = 0u;
#pragma unroll
        for (unsigned j = 0; j < 16; ++j) { const unsigned c = xb_ld(&bar[XB_XCNT(j)]); sum += c; cnt += (c > 0u) ? 1u : 0u; mine = (j == x) ? c : mine; }
        if (sum == G) break;
        __builtin_amdgcn_s_sleep(1);
        if ((++sp & 255u) == 0u) { if (xb_ld(&bar[XB_TMO])) break; if (sp > XB_SPIN_CAP) { atomicAdd(&bar[XB_TMO], 1u); break; } }
    }
    nloc = mine > 0u ? mine : 1u; nx = cnt > 0u ? cnt : 1u;
}
__device__ __forceinline__ void xcd_barrier(const XcdBarrier& b) {
    asm volatile("s_waitcnt vmcnt(0)" ::: "memory");
    __syncthreads();
    if (threadIdx.x == 0) {
        unsigned* bar = b.bar;
        __builtin_amdgcn_s_waitcnt(0);
        unsigned nloc = b.st[0], nx = b.st[1];
        if (nloc == 0u) { xcd_barrier_complete(bar, b.x, nloc, nx); b.st[0] = nloc; b.st[1] = nx; }
        const unsigned old = xb_add(&bar[XB_XSUB(b.x)], 1u);
        const unsigned gen = old / nloc;
        if (old + 1u == (gen + 1u) * nloc) {
            __builtin_amdgcn_fence(__ATOMIC_RELEASE, "agent");
            asm volatile("s_waitcnt vmcnt(0)" ::: "memory");
            const unsigned og = xb_add(&bar[XB_TOP], 1u);
            const unsigned tg = og / nx;
            if (og + 1u == (tg + 1u) * nx) xb_add(&bar[XB_TOPGEN], 1u);
            else XB_SPIN(xb_ld(&bar[XB_TOPGEN]) == tg, bar);
            __builtin_amdgcn_fence(__ATOMIC_ACQUIRE, "agent");
            xb_add(&bar[XB_XGEN(b.x)], 1u);
            asm volatile("s_waitcnt vmcnt(0)" ::: "memory");
        } else {
            XB_SPIN(xb_ld(&bar[XB_XGEN(b.x)]) == gen, bar);
            __builtin_amdgcn_fence(__ATOMIC_ACQUIRE, "agent");
            asm volatile("s_waitcnt vmcnt(0)" ::: "memory");
        }
    }
    __syncthreads();
}

struct Frame {
    LAS unsigned char* lds;
    volatile LAS unsigned* MISC;
    gu32* ctl;
    int tid, lane, wave;
    int vcu, G;
    unsigned char* ws;
    float* out;
};
#define LDS_WAIT() asm volatile("s_waitcnt lgkmcnt(0)" ::: "memory")

__device__ __forceinline__ void p0_mod(Frame& F, const float* c, const float* w_ada, const float* b_ada, float* mod) {
    LAS float* sc = (LAS float*)F.lds;
    LAS float* part = (LAS float*)(F.lds + 65536);
    __syncthreads();
    for (int cg = blockIdx.x; cg < NMOD / 64; cg += F.G) {
        for (int i = F.tid; i < BATCH * DM; i += NWAVES * 64) { const float v = c[i]; sc[i] = v / (1.f + __expf(-v)); }
        __syncthreads();
        const int n = cg * 64 + F.lane; float acc[BATCH];
#pragma unroll
        for (int b = 0; b < BATCH; ++b) acc[b] = 0.f;
        const int kb = F.wave * 128;
        for (int k0 = kb; k0 < kb + 128; k0 += 32) { float wv[32];
#pragma unroll
            for (int i = 0; i < 32; ++i) wv[i] = w_ada[(size_t)(k0 + i) * NMOD + n];
#pragma unroll
            for (int i = 0; i < 32; ++i)
#pragma unroll
                for (int b = 0; b < BATCH; ++b) acc[b] += sc[b * DM + k0 + i] * wv[i]; }
#pragma unroll
        for (int b = 0; b < BATCH; ++b) part[(F.wave * BATCH + b) * 64 + F.lane] = acc[b];
        __syncthreads();
        for (int o = F.tid; o < BATCH * 64; o += NWAVES * 64) { const int b = o >> 6, l = o & 63; float s = b_ada[cg * 64 + l];
#pragma unroll
            for (int w = 0; w < NWAVES; ++w) s += part[(w * BATCH + b) * 64 + l];
            mod[(size_t)b * NMOD + cg * 64 + l] = s; }
        __syncthreads();
    }
}
__device__ __forceinline__ int gu_row(int c, int up) { return (c >> 7) * 256 + up * 128 + (c & 127); }
__device__ __forceinline__ int dn_row(int c) { const int cc = c & 255; return (c & ~255) + ((cc >> 5) & 1) * 128 + (cc >> 6) * 32 + (cc & 31); }
struct P0Ptrs { const float *w_in, *w_out, *w_router, *w_eg, *w_eu, *w_ed, *w_sg, *w_su, *w_sd; };
struct TrItem { const float* src; unsigned char* dst; int ldw, Kd, f8; };
__device__ __forceinline__ TrItem tr_make(const float* W, int ldw, int k0, int c0, void* WT, int drow0, int Kd, int f8 = 0) { TrItem t; t.src = W + (size_t)k0 * ldw + c0; t.dst = (unsigned char*)WT + ((size_t)drow0 * Kd + k0) * (f8 ? 1 : 2); t.ldw = ldw; t.Kd = Kd; t.f8 = f8; return t; }
__device__ __forceinline__ TrItem p0_decode(const P0Ptrs& P, unsigned char* ws, int it) {
    bf16_t* WIN = (bf16_t*)(ws + WS_WIN); bf16_t* WOUT = (bf16_t*)(ws + WS_WOUT); bf16_t* WR = (bf16_t*)(ws + WS_WR);
    bf16_t* WSHGU = (bf16_t*)(ws + WS_WSHGU); bf16_t* WSHD = (bf16_t*)(ws + WS_WSHD); unsigned char* WD = ws + WS_WD; unsigned char* WGU = ws + WS_WGU;
    constexpr int I_EXP = NEXP * 384, I_IN = 768, I_OUT = 512, I_S = 128;
    int r = it;
    if (r < I_EXP) { const int e = r / 384, q = r % 384;
        if (q < 256) { const int up = q >> 7, qq = q & 127, kb = qq >> 3, nb = qq & 7;
            return tr_make((up ? P.w_eu : P.w_eg) + (size_t)e * DM * EH, EH, 64 * kb, 32 * nb, WGU + (size_t)e * 512 * DM, gu_row(32 * nb, up), DM, 1); }
        const int qq = q - 256, kb = qq >> 5, nb = qq & 31;
        return tr_make(P.w_ed + (size_t)e * EH * DM, DM, 64 * kb, 32 * nb, WD + (size_t)e * DM * EH, dn_row(32 * nb), EH, 1); }
    r -= I_EXP;
    if (r < I_IN) { const int kb = r / 48, nb = r % 48; return tr_make(P.w_in, INC, 64 * kb, 32 * nb, WIN, 32 * nb, DM); } r -= I_IN;
    if (r < I_IN) { const int kb = r / 48, nb = r % 48; return tr_make(P.w_in, INC, 64 * kb, 1544 + 32 * nb, WIN, 1536 + 32 * nb, DM); } r -= I_IN;
    if (r < I_OUT) { const int kb = r >> 5, nb = r & 31; return tr_make(P.w_out, DM, 64 * kb, 32 * nb, WOUT, 32 * nb, DM); } r -= I_OUT;
    if (r < I_S) { const int kb = r >> 3, nb = r & 7; return tr_make(P.w_router, NEXP, 64 * kb, 32 * nb, WR, 32 * nb, DM); } r -= I_S;
    if (r < I_S) { const int kb = r >> 3, nb = r & 7; return tr_make(P.w_sg, EH, 64 * kb, 32 * nb, WSHGU, gu_row(32 * nb, 0), DM); } r -= I_S;
    if (r < I_S) { const int kb = r >> 3, nb = r & 7; return tr_make(P.w_su, EH, 64 * kb, 32 * nb, WSHGU, gu_row(32 * nb, 1), DM); } r -= I_S;
    { const int kb = r >> 5, nb = r & 31; return tr_make(P.w_sd, DM, 64 * kb, 32 * nb, WSHD, dn_row(32 * nb), EH); }
}
__device__ __forceinline__ void tr_load(const TrItem& t, int lane, f32x4 (&v)[8]) {
    const float* p = t.src + (size_t)(lane >> 3) * t.ldw + (lane & 7) * 4;
#pragma unroll
    for (int i = 0; i < 8; ++i) v[i] = *(const GAS f32x4*)(p + (size_t)(8 * i) * t.ldw);
}
__device__ __forceinline__ void tr_store(const TrItem& t, int lane, const f32x4 (&v)[8], LAS float* scr) {
    LAS float* w = scr + (lane >> 3) * 33 + (lane & 7) * 4;
#pragma unroll
    for (int i = 0; i < 8; ++i) { w[(8 * i) * 33 + 0] = v[i].x; w[(8 * i) * 33 + 1] = v[i].y; w[(8 * i) * 33 + 2] = v[i].z; w[(8 * i) * 33 + 3] = v[i].w; }
    LDS_WAIT(); asm volatile("" ::: "memory");
    const int c = lane & 7;
#pragma unroll
    for (int j = 0; j < 4; ++j) { const int n = (lane >> 3) + 8 * j; const LAS float* s = scr + (8 * c) * 33 + n;
        if (t.f8) { int w0 = __builtin_amdgcn_cvt_pk_fp8_f32(s[0 * 33], s[1 * 33], 0, false); w0 = __builtin_amdgcn_cvt_pk_fp8_f32(s[2 * 33], s[3 * 33], w0, true);
            int w1 = __builtin_amdgcn_cvt_pk_fp8_f32(s[4 * 33], s[5 * 33], 0, false); w1 = __builtin_amdgcn_cvt_pk_fp8_f32(s[6 * 33], s[7 * 33], w1, true);
            u32x2 o; o.x = (unsigned)w0; o.y = (unsigned)w1; *(GAS u32x2*)(t.dst + (size_t)n * t.Kd + 8 * c) = o; }
        else { u32x4 o; o.x = cvt_pk_bf16(s[0 * 33], s[1 * 33]); o.y = cvt_pk_bf16(s[2 * 33], s[3 * 33]); o.z = cvt_pk_bf16(s[4 * 33], s[5 * 33]); o.w = cvt_pk_bf16(s[6 * 33], s[7 * 33]);
            *(GAS u32x4*)(t.dst + ((size_t)n * t.Kd + 8 * c) * 2) = o; } }
    LDS_WAIT(); asm volatile("" ::: "memory");
}
__device__ __forceinline__ void p0_weights(Frame& F, const P0Ptrs& P, int it_lo, int it_hi) {
    LAS float* scr = (LAS float*)(F.lds + F.wave * 16384);
    const int gw = F.vcu * NWAVES + F.wave, NGW = F.G * NWAVES;
    int it = it_lo + gw; if (it >= it_hi) return;
    TrItem cur = p0_decode(P, F.ws, it); f32x4 v[8]; tr_load(cur, F.lane, v);
    for (;;) {
        const int nit = it + NGW; const bool more = nit < it_hi;
        f32x4 nv[8];
        const TrItem nx = p0_decode(P, F.ws, more ? nit : it); tr_load(nx, F.lane, nv);
        tr_store(cur, F.lane, v, scr);
        if (!more) break;
        cur = nx; it = nit;
#pragma unroll
        for (int i = 0; i < 8; ++i) v[i] = nv[i];
    }
}
constexpr int P0_EXPERT_ITEMS = NEXP * 384, P0_ALL_ITEMS = NEXP * 384 + 2 * 768 + 512 + 4 * 128;
struct CvItem { const float* src; unsigned char* dst; int ldw, Kd, rowbase, down, n0; };
__device__ __forceinline__ CvItem cv_decode(const P0Ptrs& P, unsigned char* ws, int sit) {
    const int e = sit / 24, q = sit % 24; CvItem c;
    if (q < 16) { const int up = q >> 3, kb = q & 7;
        c.src = (up ? P.w_eu : P.w_eg) + (size_t)e * DM * EH + (size_t)(128 * kb) * EH; c.ldw = EH; c.dst = ws + WS_WGU + (size_t)e * 512 * DM + 128 * kb; c.Kd = DM; c.rowbase = up * 128; c.down = 0; c.n0 = 0; }
    else { const int qq = q - 16, kb = qq >> 2, nb = qq & 3;
        c.src = P.w_ed + (size_t)e * EH * DM + (size_t)(128 * kb) * DM + 256 * nb; c.ldw = DM; c.dst = ws + WS_WD + (size_t)e * DM * EH + 128 * kb; c.Kd = EH; c.rowbase = 0; c.down = 1; c.n0 = 256 * nb; }
    return c;
}
__device__ __forceinline__ void cv_issue(Frame& F, const CvItem& c, int sub, int buf) {
    const float* g = c.src + (size_t)(32 * sub + 4 * F.wave) * c.ldw + F.lane * 4;
#pragma unroll
    for (int i = 0; i < 4; ++i) __builtin_amdgcn_global_load_lds((const unsigned*)(g + (size_t)i * c.ldw), (LAS unsigned*)(F.lds + buf * 32768 + (4 * F.wave + i) * 1024), 16, 0, 2);
}
__device__ __forceinline__ void conv_experts(Frame& F, const P0Ptrs& P) {
    constexpr int NSI = NEXP * 24;
    const int G = F.G; const int si0 = F.vcu; if (si0 >= NSI) return;
    const int nmine = (NSI - si0 + G - 1) / G;
    const int NT = nmine * 4;
    int tid_ = threadIdx.x; asm volatile("" : "+v"(tid_)); const int tid = tid_;
    LAS unsigned char* Bb = F.lds + 3 * 32768;
#define CV_SUB(t_) do { const int tt_ = (t_) < NT ? (t_) : NT - 1; const CvItem c_ = cv_decode(P, F.ws, si0 + (tt_ >> 2) * G); cv_issue(F, c_, tt_ & 3, (t_) % 3); } while (0)
    CV_SUB(0); CV_SUB(1);
    CvItem cur = cv_decode(P, F.ws, si0);
    for (int t = 0; t < NT; ++t) { const int sub = t & 3;
        asm volatile("s_waitcnt vmcnt(4)" ::: "memory");
        __builtin_amdgcn_s_barrier(); asm volatile("" ::: "memory");
        CV_SUB(t + 2);
        { const int n = tid & 255, kq = tid >> 8; const LAS float* a = (const LAS float*)(F.lds + (t % 3) * 32768) + (16 * kq) * 256 + n; unsigned w[4];
#pragma unroll
          for (int j = 0; j < 4; ++j) { const float f0 = a[(4 * j) * 256], f1 = a[(4 * j + 1) * 256], f2 = a[(4 * j + 2) * 256], f3 = a[(4 * j + 3) * 256];
              int q0 = __builtin_amdgcn_cvt_pk_fp8_f32(f0, f1, 0, false); q0 = __builtin_amdgcn_cvt_pk_fp8_f32(f2, f3, q0, true); w[j] = (unsigned)q0; }
          *(LAS u32x4*)(Bb + n * 144 + 32 * sub + 16 * kq) = (u32x4){w[0], w[1], w[2], w[3]}; }
        if (sub == 3) {
            asm volatile("s_waitcnt lgkmcnt(0)" ::: "memory"); __builtin_amdgcn_s_barrier(); asm volatile("" ::: "memory");
#pragma unroll
            for (int j = 0; j < 4; ++j) { const int nl = (tid >> 3) + 64 * j, ch = tid & 7; const u32x4 v = *(const LAS u32x4*)(Bb + nl * 144 + 16 * ch);
                const int drow = cur.down ? dn_row(cur.n0 + nl) : (nl >> 7) * 256 + cur.rowbase + (nl & 127);
                *(GAS u32x4*)(cur.dst + (size_t)drow * cur.Kd + 16 * ch) = v; }
            asm volatile("s_waitcnt lgkmcnt(0)" ::: "memory");
            if (t + 1 < NT) cur = cv_decode(P, F.ws, si0 + ((t + 1) >> 2) * G);
        }
    }
#undef CV_SUB
    asm volatile("s_waitcnt vmcnt(0)" ::: "memory");
    __builtin_amdgcn_s_barrier();
}
template <bool FL> __device__ __forceinline__ void norm_rows(Frame& F, const float* src  , bf16_t* dst, const float* mod, int shift_off, int scale_off, const float* w_in, const float* b_forget, float* lf, unsigned char* dst8) {
    LAS float* wf = (LAS float*)F.lds;
    if (FL) { for (int i = F.tid; i < DM * NH; i += NWAVES * 64) wf[(i & 7) * DM + (i >> 3)] = w_in[(size_t)(i >> 3) * INC + 1536 + (i & 7)]; __syncthreads(); }
    const int gw = F.vcu * NWAVES + F.wave, NGW = F.G * NWAVES;
    constexpr int CH = 32;
#define NR_ROW(i_) (rowb + 128 * (i_))
#define NR_LD(dst_, row_, j_) do { if (FL) dst_ = ((const GAS f32x4*)(src + (size_t)(row_) * DM) + F.lane)[64 * (j_)]; \
        else { const u32x2 t_ = ((const GAS u32x2*)x1_row(F.ws, (size_t)(row_)) + F.lane)[64 * (j_)]; dst_ = (f32x4){bf_lo(t_.x), bf_hi(t_.x), bf_lo(t_.y), bf_hi(t_.y)}; } } while (0)
    for (int ch = gw; ch < M / CH; ch += NGW) {
        const int b = ch >> 7, rowb = b * SEQ + (ch & 127);
        f32x4 sc[4], sh[4];
#pragma unroll
        for (int j = 0; j < 4; ++j) { sc[j] = *(const f32x4*)(mod + (size_t)b * NMOD + scale_off + 256 * j + 4 * F.lane) + 1.f; sh[j] = *(const f32x4*)(mod + (size_t)b * NMOD + shift_off + 256 * j + 4 * F.lane); }
        f32x4 nv[2][4];
#pragma unroll
        for (int q = 0; q < 2; ++q)
#pragma unroll
            for (int j = 0; j < 4; ++j) NR_LD(nv[q][j], NR_ROW(q), j);
        for (int mm = 0; mm < CH; mm += 2) {
            f32x4 vv[2][4];
#pragma unroll
            for (int q = 0; q < 2; ++q)
#pragma unroll
                for (int j = 0; j < 4; ++j) vv[q][j] = nv[q][j];
            if (mm + 2 < CH) {
#pragma unroll
                for (int q = 0; q < 2; ++q)
#pragma unroll
                    for (int j = 0; j < 4; ++j) NR_LD(nv[q][j], NR_ROW(mm + 2 + q), j); }
#pragma unroll
            for (int q = 0; q < 2; ++q) { const int m = NR_ROW(mm + q); f32x4 (&v)[4] = vv[q];
            float s2 = 0.f;
#pragma unroll
            for (int j = 0; j < 4; ++j) s2 += (v[j].x * v[j].x + v[j].y * v[j].y) + (v[j].z * v[j].z + v[j].w * v[j].w);
            const float r = 1.f / sqrtf(wave_sum(s2) * (1.f / DM) + EPS);
#pragma unroll
            for (int j = 0; j < 4; ++j) v[j] = v[j] * r * sc[j] + sh[j];
            GAS u32x2* o8 = (GAS u32x2*)(dst + (size_t)m * DM) + F.lane;
#pragma unroll
            for (int j = 0; j < 4; ++j) { u32x2 w; w.x = cvt_pk_bf16(v[j].x, v[j].y); w.y = cvt_pk_bf16(v[j].z, v[j].w); o8[64 * j] = w; }
            if (!FL) { GAS unsigned* o4 = (GAS unsigned*)(dst8 + (size_t)m * DM) + F.lane;
#pragma unroll
                for (int j = 0; j < 4; ++j) { int w = __builtin_amdgcn_cvt_pk_fp8_f32(v[j].x, v[j].y, 0, false); w = __builtin_amdgcn_cvt_pk_fp8_f32(v[j].z, v[j].w, w, true); o4[64 * j] = (unsigned)w; } }
            if (FL) { float fl[NH];
#pragma unroll
                for (int h = 0; h < NH; ++h) fl[h] = 0.f;
#pragma unroll
                for (int j = 0; j < 4; ++j)
#pragma unroll
                    for (int h = 0; h < NH; ++h) { const f32x4 w4 = *(const LAS f32x4*)(wf + h * DM + 256 * j + 4 * F.lane); fl[h] += (v[j].x * w4.x + v[j].y * w4.y) + (v[j].z * w4.z + v[j].w * w4.w); }
                const float mine = reduce8_heads(fl, F.lane); const int hh = F.lane >> 3;
                if ((F.lane & 7) == 0) { const float z = mine + b_forget[hh]; const float ls = fminf(z, 0.f) - log1pf(__expf(-fabsf(z))); lf[((size_t)b * NH + hh) * SEQ + (m & (SEQ - 1))] = ls; } }
            }
        }
    }
}
#undef NR_ROW
#undef NR_LD
__device__ __forceinline__ void scan_rows(Frame& F, const float* lf, float* kb, int* t0tab) {
    LAS float* wt = (LAS float*)F.lds; LAS float* kl = wt + 16;
    for (int s = blockIdx.x; s < BATCH * NH; s += F.G) {
        const float* src = lf + (size_t)s * SEQ + F.tid * 8; float v[8];
        { const f32x4 a = *(const f32x4*)src, b2 = *(const f32x4*)(src + 4); v[0] = a.x; v[1] = a.y; v[2] = a.z; v[3] = a.w; v[4] = b2.x; v[5] = b2.y; v[6] = b2.z; v[7] = b2.w; }
#pragma unroll
        for (int i = 1; i < 8; ++i) v[i] += v[i - 1];
        float incl = v[7];
#pragma unroll
        for (int o = 1; o < 64; o <<= 1) { const float t = __shfl_up(incl, o); if (F.lane >= o) incl += t; }
        if (F.lane == 63) wt[F.wave] = incl;
        __syncthreads();
        float base = incl - v[7];
        for (int w = 0; w < F.wave; ++w) base += wt[w];
        float* dst = kb + (size_t)s * SEQ + F.tid * 8;
        f32x4 a, b2; a.x = -(v[0] + base) * LOG2E; a.y = -(v[1] + base) * LOG2E; a.z = -(v[2] + base) * LOG2E; a.w = -(v[3] + base) * LOG2E;
        b2.x = -(v[4] + base) * LOG2E; b2.y = -(v[5] + base) * LOG2E; b2.z = -(v[6] + base) * LOG2E; b2.w = -(v[7] + base) * LOG2E;
        *(f32x4*)dst = a; *(f32x4*)(dst + 4) = b2;
        *(LAS f32x4*)(kl + F.tid * 8) = a; *(LAS f32x4*)(kl + F.tid * 8 + 4) = b2;
        __syncthreads();
        if (F.tid < 16) { const int q0 = 256 * F.tid; const float target = kl[q0] - FOX_SKIP_LOG2; int lo = 0, hi = q0;
            while (lo < hi) { const int mid = (lo + hi) >> 1; if (kl[mid] <= target) lo = mid + 1; else hi = mid; }
            t0tab[s * 16 + F.tid] = (lo >> 6) & ~1; }
        __syncthreads();
    }
}
__device__ __forceinline__ void unpack8(const u32x4 w, float* f) { f[0] = bf_lo(w.x); f[1] = bf_hi(w.x); f[2] = bf_lo(w.y); f[3] = bf_hi(w.y); f[4] = bf_lo(w.z); f[5] = bf_hi(w.z); f[6] = bf_lo(w.w); f[7] = bf_hi(w.w); }
__device__ __forceinline__ void merge_rows(Frame& F, const float* g_fox, const float* g_dil) {
    const bf16_t* OF = (const bf16_t*)(F.ws + WS_OF); const bf16_t* O1 = (const bf16_t*)(F.ws + WS_O1); const bf16_t* O2 = (const bf16_t*)(F.ws + WS_O2); const bf16_t* O3 = (const bf16_t*)(F.ws + WS_O3);
    const float* LSE = (const float*)(F.ws + WS_LSE); bf16_t* YM = (bf16_t*)(F.ws + WS_YM);
    const int gw = F.vcu * NWAVES + F.wave, NGW = F.G * NWAVES;
    float gf[8], gd[8];
    { const f32x4 a = *(const f32x4*)(g_fox + 8 * F.lane), b = *(const f32x4*)(g_fox + 8 * F.lane + 4), c = *(const f32x4*)(g_dil + 8 * F.lane), d = *(const f32x4*)(g_dil + 8 * F.lane + 4);
      gf[0] = a.x; gf[1] = a.y; gf[2] = a.z; gf[3] = a.w; gf[4] = b.x; gf[5] = b.y; gf[6] = b.z; gf[7] = b.w; gd[0] = c.x; gd[1] = c.y; gd[2] = c.z; gd[3] = c.w; gd[4] = d.x; gd[5] = d.y; gd[6] = d.z; gd[7] = d.w; }
    struct Row { u32x4 wf, w1, w2, w3; float l1, l2, l3; };
    const int hd = F.lane >> 3;
#define MR_LOAD(R, m_) do { const size_t eo_ = (size_t)(m_) * HW + 8 * F.lane; R.wf = *(const GAS u32x4*)(OF + eo_); R.w1 = *(const GAS u32x4*)(O1 + eo_); R.w2 = *(const GAS u32x4*)(O2 + eo_); R.w3 = *(const GAS u32x4*)(O3 + eo_); \
        R.l1 = LSE[(size_t)(m_) * NH + hd]; R.l2 = LSE[(size_t)M * NH + (size_t)(m_) * NH + hd]; R.l3 = LSE[(size_t)2 * M * NH + (size_t)(m_) * NH + hd]; } while (0)
    for (int ch = gw; ch < M / 32; ch += NGW) {
        const size_t rowb = (size_t)(ch >> 7) * SEQ + (ch & 127);
        Row nr[2]; MR_LOAD(nr[0], rowb); MR_LOAD(nr[1], rowb + 128);
        for (int mm = 0; mm < 32; mm += 2) {
            Row cr[2]; cr[0] = nr[0]; cr[1] = nr[1];
            if (mm + 2 < 32) { MR_LOAD(nr[0], rowb + 128 * (mm + 2)); MR_LOAD(nr[1], rowb + 128 * (mm + 3)); }
#pragma unroll
            for (int q = 0; q < 2; ++q) { const size_t m = rowb + 128 * (mm + q); const Row& R = cr[q];
            const float mx = fmaxf(R.l1, fmaxf(R.l2, R.l3)); float e1 = __builtin_amdgcn_exp2f(R.l1 - mx), e2 = __builtin_amdgcn_exp2f(R.l2 - mx), e3 = __builtin_amdgcn_exp2f(R.l3 - mx);
            const float inv = 1.f / (e1 + e2 + e3); e1 *= inv; e2 *= inv; e3 *= inv;
            float yf[8], a1[8], a2[8], a3[8], yd[8]; unpack8(R.wf, yf); unpack8(R.w1, a1); unpack8(R.w2, a2); unpack8(R.w3, a3);
            float sf = 0.f, sd = 0.f;
#pragma unroll
            for (int i = 0; i < 8; ++i) { yd[i] = e1 * a1[i] + e2 * a2[i] + e3 * a3[i]; sf += yf[i] * yf[i]; sd += yd[i] * yd[i]; }
            const float rf = 1.f / sqrtf(wave_sum(sf) * (1.f / HW) + EPS), rd = 1.f / sqrtf(wave_sum(sd) * (1.f / HW) + EPS);
            u32x4 of, od;
            of.x = cvt_pk_bf16(yf[0] * rf * gf[0], yf[1] * rf * gf[1]); of.y = cvt_pk_bf16(yf[2] * rf * gf[2], yf[3] * rf * gf[3]); of.z = cvt_pk_bf16(yf[4] * rf * gf[4], yf[5] * rf * gf[5]); of.w = cvt_pk_bf16(yf[6] * rf * gf[6], yf[7] * rf * gf[7]);
            od.x = cvt_pk_bf16(yd[0] * rd * gd[0], yd[1] * rd * gd[1]); od.y = cvt_pk_bf16(yd[2] * rd * gd[2], yd[3] * rd * gd[3]); od.z = cvt_pk_bf16(yd[4] * rd * gd[4], yd[5] * rd * gd[5]); od.w = cvt_pk_bf16(yd[6] * rd * gd[6], yd[7] * rd * gd[7]);
            *(GAS u32x4*)(YM + m * DM + 8 * F.lane) = of; *(GAS u32x4*)(YM + m * DM + HW + 8 * F.lane) = od; }
        }
    }
#undef MR_LOAD
}
__device__ __forceinline__ void route_rows(Frame& F, int pm, const float* logits, const float* rbias, unsigned* list, float* wts, unsigned* pose) {
    LAS unsigned* lcount = (LAS unsigned*)F.lds;
    LAS unsigned* lbase = lcount + 256;
    LAS unsigned* lsel = lbase + 256;
    LAS unsigned* lwt = lsel + 2048;
    if (F.tid < 256) lcount[F.tid] = 0u;
    __syncthreads();
    const f32x4 rb = *(const f32x4*)(rbias + 4 * F.lane);
#define DPPF(x, ctrl) __int_as_float(__builtin_amdgcn_update_dpp(0, __float_as_int(x), ctrl, 0xF, 0xF, false))
#define DPPUMAX(v, ctrl, rm) v = max(v, (unsigned)__builtin_amdgcn_update_dpp(0, (int)v, ctrl, rm, 0xF, false))
    f32x4 lgn = *(const GAS f32x4*)(logits + ((size_t)pm * 256 + F.wave * 32) * NEXP + 4 * F.lane);
    for (int i = 0; i < 32; ++i) { const int rl = F.wave * 32 + i; const size_t row = (size_t)pm * 256 + rl;
        const f32x4 lg = lgn;
        if (i + 1 < 32) lgn = *(const GAS f32x4*)(logits + (row + 1) * NEXP + 4 * F.lane);
        float s[4], sel[4];
#pragma unroll
        for (int q = 0; q < 4; ++q) { s[q] = 1.f / (1.f + __expf(-lg[q])); sel[q] = s[q] + rb[q]; }
        float m1 = -INFINITY, m2 = -INFINITY;
#pragma unroll
        for (int q = 0; q < 4; ++q) { if (sel[q] > m1) { m2 = m1; m1 = sel[q]; } else if (sel[q] > m2) m2 = sel[q]; }
        { float b1 = DPPF(m1, 0xB1), b2 = DPPF(m2, 0xB1); float n1 = fmaxf(m1, b1), n2 = fmaxf(fminf(m1, b1), fmaxf(m2, b2)); m1 = n1; m2 = n2;
          b1 = DPPF(m1, 0x4E); b2 = DPPF(m2, 0x4E); n1 = fmaxf(m1, b1); n2 = fmaxf(fminf(m1, b1), fmaxf(m2, b2)); m1 = n1; m2 = n2;
          b1 = DPPF(m1, 0x141); b2 = DPPF(m2, 0x141); n1 = fmaxf(m1, b1); n2 = fmaxf(fminf(m1, b1), fmaxf(m2, b2)); m1 = n1; m2 = n2; }
        const float gs = m1 + m2; const int g = F.lane >> 3; int rank = 0;
#pragma unroll
        for (int gg = 0; gg < 8; ++gg) { const float og = __int_as_float(__builtin_amdgcn_readlane(__float_as_int(gs), gg * 8)); rank += (og > gs || (og == gs && gg < g)) ? 1 : 0; }
        const bool gsel = rank < 4;
        unsigned key[4];
#pragma unroll
        for (int q = 0; q < 4; ++q) { const unsigned bq = __float_as_uint(sel[q]); key[q] = gsel ? (bq ^ ((bq >> 31) ? 0xffffffffu : 0x80000000u)) : 0u; }
        int myE = 0; float myS = 0.f, ssum = 0.f;
#pragma unroll 1
        for (int k = 0; k < TOPK; ++k) {
            unsigned v = max(max(key[0], key[1]), max(key[2], key[3]));
            DPPUMAX(v, 0xB1, 0xF); DPPUMAX(v, 0x4E, 0xF); DPPUMAX(v, 0x141, 0xF); DPPUMAX(v, 0x140, 0xF); DPPUMAX(v, 0x142, 0xA); DPPUMAX(v, 0x143, 0xC);
            const unsigned best = (unsigned)__builtin_amdgcn_readlane((int)v, 63);
            const int myq = (key[0] == best) ? 0 : (key[1] == best) ? 1 : (key[2] == best) ? 2 : (key[3] == best) ? 3 : 4;
            const unsigned long long bal = __ballot(myq < 4);
            const int L = __builtin_amdgcn_readfirstlane((int)__ffsll((long long)bal) - 1);
            const int q = __builtin_amdgcn_readlane(myq, L);
            const float mys = (q == 0) ? s[0] : (q == 1) ? s[1] : (q == 2) ? s[2] : s[3];
            const float sk = __int_as_float(__builtin_amdgcn_readlane(__float_as_int(mys), L));
            if (F.lane == L) {
#pragma unroll
                for (int qq = 0; qq < 4; ++qq) if (qq == q) key[qq] = 0u; }
            if (F.lane == k) { myE = 4 * L + q; myS = sk; }
            ssum += sk;
        }
        if (F.lane < TOPK) { const unsigned lp = atomicAdd((unsigned*)(lcount + myE), 1u); lsel[rl * 8 + F.lane] = (unsigned)myE | (lp << 8); lwt[rl * 8 + F.lane] = __float_as_uint(myS / ssum * 2.5f); }
    }
#undef DPPF
#undef DPPUMAX
    __syncthreads();
    if (F.tid < 256) { const unsigned n = lcount[F.tid]; lbase[F.tid] = n ? __hip_atomic_fetch_add((unsigned*)(F.ctl + CW_CNT + F.tid), n, RLX_AGENT) : 0u; }
    __syncthreads();
    for (int a = F.tid; a < 2048; a += NWAVES * 64) { const unsigned se = lsel[a]; const unsigned e = se & 255u, lp = se >> 8; const unsigned pos = lbase[e] + lp; const unsigned tok = (unsigned)(pm * 256 + (a >> 3));
        wts[(size_t)tok * TOPK + (a & 7)] = __uint_as_float(lwt[a]); pose[(size_t)tok * TOPK + (a & 7)] = (e << 16) | (pos & 0xffffu);
        if (pos < (unsigned)LCAP) list[(size_t)e * LCAP + pos] = tok | ((unsigned)(a & 7) << 16); }
    __syncthreads();
}
__device__ __forceinline__ void build_tables(Frame& F) {
    LAS unsigned* tp = (LAS unsigned*)(F.lds + TAB_OFF); LAS unsigned* cn = tp + 260; LAS unsigned* cp = cn + 256; LAS unsigned* wt = cp + 256;
    __syncthreads();
    unsigned cnt = 0u, tiles = 0u, incl = 0u, cincl = 0u;
    if (F.tid < 256) { cnt = __hip_atomic_load((unsigned*)(F.ctl + CW_CNT + F.tid), RLX_AGENT); if (cnt > (unsigned)LCAP) cnt = LCAP; tiles = (cnt + 255u) >> 8; incl = tiles; cincl = cnt;
#pragma unroll
        for (int o = 1; o < 64; o <<= 1) { const unsigned t = __shfl_up(incl, o), t2 = __shfl_up(cincl, o); if (F.lane >= o) { incl += t; cincl += t2; } }
        if (F.lane == 63) { wt[F.wave] = incl; wt[8 + F.wave] = cincl; } }
    __syncthreads();
    if (F.tid < 256) { unsigned base = 0u, cbase = 0u; for (int w = 0; w < F.wave; ++w) { base += wt[w]; cbase += wt[8 + w]; } tp[F.tid + 1] = base + incl; cn[F.tid] = cnt; cp[F.tid] = cbase + cincl - cnt; if (F.tid == 0) tp[0] = 0u;
        LAS unsigned short* mt2e = (LAS unsigned short*)(F.lds + MT2E_OFF); const unsigned t0 = base + incl - tiles; for (unsigned t = 0; t < tiles; ++t) mt2e[t0 + t] = (unsigned short)F.tid; }
    __syncthreads();
}
__device__ __forceinline__ void combine_rows(Frame& F, const float* gate2, const float* g_final, float* dst) {
    const unsigned char* Y = (const unsigned char*)(F.ws + WS_YBUF); const float* WT = (const float*)(F.ws + WS_WTS); const unsigned* PE = (const unsigned*)(F.ws + WS_POSE);
    const LAS unsigned* cp = (const LAS unsigned*)(F.lds + TAB_OFF) + 260 + 256;
    const int gw = F.vcu * NWAVES + F.wave, NGW = F.G * NWAVES; const int c0 = 16 * F.lane;
    const unsigned char* YS = (const unsigned char*)(F.ws + WS_YSH);
    struct CRow { u32x4 yv[8]; u32x4 ys, xb[2]; f32x4 w0, w1; };
#define CR_LOAD(R, m_) do { const size_t mq_ = (size_t)(m_); const unsigned pe_ = PE[mq_ * TOPK + (F.lane & 7)]; const unsigned myrow_ = cp[pe_ >> 16] + (pe_ & 0xffffu); \
        _Pragma("unroll") for (int k = 0; k < 8; ++k) { const size_t yr_ = (size_t)(unsigned)__builtin_amdgcn_readlane((int)myrow_, k); R.yv[k] = *(const GAS u32x4*)(Y + yr_ * DM + c0); } \
        R.ys = *(const GAS u32x4*)(YS + mq_ * DM + c0); const GAS u32x4* or_ = (const GAS u32x4*)(x1_row(F.ws, mq_) + c0); R.xb[0] = or_[0]; R.xb[1] = or_[1]; R.w0 = *(const GAS f32x4*)(WT + mq_ * TOPK); R.w1 = *(const GAS f32x4*)(WT + mq_ * TOPK + 4); } while (0)
    f32x4 gf[4];
#pragma unroll
    for (int j = 0; j < 4; ++j) gf[j] = *(const f32x4*)(g_final + c0 + 4 * j);
    for (int ch = gw; ch < M / 32; ch += NGW) {
        const int b = ch >> 7; const size_t rowb = (size_t)b * SEQ + (ch & 127);
        f32x4 g2[4];
#pragma unroll
        for (int j = 0; j < 4; ++j) g2[j] = *(const f32x4*)(gate2 + (size_t)b * NMOD + c0 + 4 * j) * (1.f / YSCALE);
        CRow nr; CR_LOAD(nr, rowb);
        for (int mm = 0; mm < 32; ++mm) { const size_t m = rowb + 128 * mm;
            CRow R = nr;
            if (mm + 1 < 32) CR_LOAD(nr, m + 128);
            const float wk[8] = {R.w0.x, R.w0.y, R.w0.z, R.w0.w, R.w1.x, R.w1.y, R.w1.z, R.w1.w};
            f32x4 acc[4];
#pragma unroll
            for (int j = 0; j < 4; ++j) { const int wv = (int)R.ys[j]; const f32x2 lo = __builtin_amdgcn_cvt_pk_f32_fp8(wv, false), hi = __builtin_amdgcn_cvt_pk_f32_fp8(wv, true); f32x4 a = (f32x4){lo.x, lo.y, hi.x, hi.y};
#pragma unroll
                for (int k = 0; k < 8; ++k) { const int wk_ = (int)R.yv[k][j]; const f32x2 l2 = __builtin_amdgcn_cvt_pk_f32_fp8(wk_, false), h2 = __builtin_amdgcn_cvt_pk_f32_fp8(wk_, true);
                    a.x += wk[k] * l2.x; a.y += wk[k] * l2.y; a.z += wk[k] * h2.x; a.w += wk[k] * h2.y; }
                acc[j] = a; __builtin_amdgcn_sched_barrier(0); }
            float s2 = 0.f; f32x4 v[4];
#pragma unroll
            for (int j = 0; j < 4; ++j) { const unsigned xa = R.xb[j >> 1][(j & 1) * 2], xc = R.xb[j >> 1][(j & 1) * 2 + 1]; const f32x4 xj = (f32x4){bf_lo(xa), bf_hi(xa), bf_lo(xc), bf_hi(xc)}; v[j] = xj + g2[j] * acc[j]; s2 += (v[j].x * v[j].x + v[j].y * v[j].y) + (v[j].z * v[j].z + v[j].w * v[j].w); }
            const float r = 1.f / sqrtf(wave_sum(s2) * (1.f / DM) + EPS);
            GAS f32x4* orow = (GAS f32x4*)(dst + m * DM + c0);
#pragma unroll
            for (int j = 0; j < 4; ++j) orow[j] = v[j] * r * gf[j];
        }
    }
#undef CR_LOAD
}

struct Args { const float* in[19]; float* out; unsigned char* ws; int ph_lo, ph_hi, li, pad; };
__global__ void __launch_bounds__(NWAVES * 64, 2) fwd_kernel(Args args) {
    extern __shared__ __attribute__((aligned(16))) unsigned char lds[];
    Frame F;
    F.lds = (LAS unsigned char*)lds;
    F.MISC = (volatile LAS unsigned*)(F.lds + MISC_OFF);
    F.tid = threadIdx.x; F.lane = F.tid & 63; F.wave = __builtin_amdgcn_readfirstlane(F.tid >> 6);
    F.G = gridDim.x; { const int bx = blockIdx.x; F.vcu = (F.G % 8 == 0) ? (bx % 8) * (F.G / 8) + bx / 8 : bx; }
    F.ws = args.ws; F.out = args.out; F.ctl = (gu32*)(args.ws + WS_CTL);
    unsigned char* ws = args.ws;
    typedef const __attribute__((address_space(4))) Args* KArgP;
#define KA(i) ({ KArgP p_ = (KArgP)__builtin_amdgcn_kernarg_segment_ptr(); asm volatile("" : "+s"(p_)); p_->in[i]; })
#define MOD ((float*)(ws + WS_MOD))
#define LF ((float*)(ws + WS_LF))
#define KB ((float*)(ws + WS_KB))
#define LSE ((float*)(ws + WS_LSE))
#define HB ((bf16_t*)(ws + WS_H))
#define QKV ((bf16_t*)(ws + WS_QKV))
#define LIST ((unsigned*)(ws + WS_LIST))
    for (int u = F.tid; u < (LDS_BYTES - LDSCTL_OFF) / 4; u += NWAVES * 64) ((LAS unsigned*)(F.lds + LDSCTL_OFF))[u] = 0u;
    __syncthreads();
    XcdBarrier bar; bar.bar = (unsigned*)(F.ctl + CW_BAR); bar.x = 0; bar.st = nullptr;
    if (N_LAUNCHES == 1) bar = xcd_barrier_post((unsigned*)(F.ctl + CW_BAR), F.MISC + 8);
#define GRID_BAR() do { if (N_LAUNCHES == 1) xcd_barrier(bar); } while (0)
#define REFRESH() do { int t_ = threadIdx.x; asm volatile("" : "+v"(t_)); F.tid = t_; F.lane = t_ & 63; } while (0)
    const int lo = args.ph_lo, hi = args.ph_hi;
#ifndef ONLY_PHASE
#define ONLY_PHASE -1
#endif
#define IN(k) ((ONLY_PHASE < 0 || ONLY_PHASE == (k)) && lo <= (k) && (k) < hi)
#define BOTH(k) (IN(k) && IN((k) + 1))

    if (IN(0)) {
        REFRESH();
        _Pragma("unroll") for (int rep_ = 0; rep_ < DUPN(0); ++rep_) {
        p0_mod(F, KA(1), KA(7), KA(8), MOD);
        P0Ptrs P{KA(2), KA(6), KA(9), KA(11), KA(12), KA(13), KA(14), KA(15), KA(16)};
        p0_weights(F, P, P0_EXPERT_ITEMS, P0_ALL_ITEMS); }
        if (BOTH(0)) GRID_BAR();
    }
    if (IN(1)) {
        REFRESH();
        _Pragma("unroll") for (int rep_ = 0; rep_ < DUPN(1); ++rep_) norm_rows<true>(F, KA(0), HB, MOD, 0, DM, KA(2), KA(3), LF, nullptr);
        if (BOTH(1)) GRID_BAR();
    }
    if (IN(2)) {
        REFRESH();
        _Pragma("unroll") for (int rep_ = 0; rep_ < DUPN(2); ++rep_) {
        scan_rows(F, LF, KB, (int*)(ws + WS_T0));
        pg8::Gemm g{HB, (const bf16_t*)(ws + WS_WIN), DM, nullptr}; pg8::StaticOrder S; S.init(M, 3072, F.G, (int)blockIdx.x);
        pg8::EpiQKV E{QKV, (size_t)M * HW, attn_body::C2};
        pg8::gemm_phase<pg8::EpiQKV, pg8::StaticOrder, false>(F.lds, g, S, E); }
        if (BOTH(2)) GRID_BAR();
    }
    if (IN(3)) {
        REFRESH();
        using attn_body::bf16; const float* rel_bias = KA(17);
        const bf16* Qf = (const bf16*)QKV; const bf16* Kf = Qf + (size_t)M * HW; const bf16* Vf = Kf + (size_t)M * HW;
        const bf16* Qd = Vf + (size_t)M * HW; const bf16* Kd = Qd + (size_t)M * HW; const bf16* Vd = Kd + (size_t)M * HW;
        bf16* OF = (bf16*)(ws + WS_OF);
        bool conv_done = false;
        const P0Ptrs PW{KA(2), KA(6), KA(9), KA(11), KA(12), KA(13), KA(14), KA(15), KA(16)};
        for (int cu = F.vcu; cu < 16 * BATCH; cu += F.G) {
            const int b = cu >> 4, j = cu & 15;
            int hc = 2 * (F.vcu % 5); asm volatile("" : "+s"(hc));
            for (int part = 0; part < 2; ++part) {
            if (part == 1 && !conv_done) { __syncthreads(); conv_experts(F, PW); __syncthreads(); conv_done = true; }
            const int h_lo = part ? hc : 0, h_hi = part ? NH : hc;
            for (int h = h_lo; h < h_hi; ++h) { const int q = (j + 4 * (h >> 1)) & 15; const int qb = (h & 1) ? 15 - q : q; const int bh = b * NH + h;
                const size_t hb = (size_t)b * SEQ * HW + h * HD; const int T0 = ((const int*)(ws + WS_T0))[bh * 16 + qb];
                if (DUPN(3) == 2) attn_body::attn_unit<8, 0>(Qf + hb, Kf + hb, Vf + hb, (bf16*)(ws + WS_SS0), (long)HW, 0L, qb * 256, T0, 4 * qb + 4 - T0, 0, nullptr, 0, (char*)lds, KB + (size_t)bh * SEQ, nullptr, 0);
                attn_body::attn_unit<8, 0>(Qf + hb, Kf + hb, Vf + hb, OF + hb, (long)HW, (long)HW, qb * 256, T0, 4 * qb + 4 - T0, 0, nullptr, 0, (char*)lds, KB + (size_t)bh * SEQ, nullptr, 0); }
            }
        }
        if (!conv_done) { __syncthreads(); conv_experts(F, PW); __syncthreads(); }
        for (int job = F.vcu; job < 2 * BATCH * NH; job += F.G) {
            const int bh = job >> 1, sub = job & 1, b = bh >> 3, h = bh & 7;
            const size_t hb = (size_t)b * SEQ * HW + h * HD;
            const int nd = sub ? 25 : 23; int tabkey = -1;
            { __syncthreads(); for (int i = F.tid; i < attn_body::DL_ZEND / 16; i += NWAVES * 64) *(LAS f32x4*)(F.lds + i * 16) = (f32x4){0.f, 0.f, 0.f, 0.f}; __syncthreads(); }
#define DIL_PARAMS(i_, dsel_, d_, r_, qb_) do { if ((i_) < 16) { if (sub == 0) { dsel_ = 0; d_ = 1; r_ = 0; qb_ = (i_); } else { dsel_ = 1; d_ = 4; r_ = (i_) >> 2; qb_ = (i_) & 3; } } \
                else { dsel_ = 2; d_ = 16; r_ = ((i_) - 16) + (sub ? 7 : 0); qb_ = 0; } } while (0)
            for (int i = 0; i < nd; ++i) {
                int dsel, d, r, qb; DIL_PARAMS(i, dsel, d, r, qb);
                int dseln = 0, dn = 1, rn = 0, qbn = 0; const bool has_next = (i + 1 < nd); if (has_next) DIL_PARAMS(i + 1, dseln, dn, rn, qbn);
                bf16* OB = (bf16*)(ws + (dsel == 0 ? WS_O1 : dsel == 1 ? WS_O2 : WS_O3));
                const size_t sb = hb + (size_t)r * HW, sbn = hb + (size_t)rn * HW;
                float* lsep = LSE + (size_t)dsel * M * NH + ((size_t)b * SEQ + r) * NH + h;
                const bool bt = (tabkey != dsel); tabkey = dsel;
                const attn_body::DilSrc cu{Kd + sb, Vd + sb, (long)d * HW, qb * 256, qb == 0}, nx{Kd + sbn, Vd + sbn, (long)dn * HW, qbn * 256, qbn == 0};
                _Pragma("unroll") for (int rep_ = 0; rep_ < DUPN(3); ++rep_)
                attn_body::dil_unit<8>(Qd + sb, cu, (i & 1) ? attn_body::DL_KB : attn_body::DL_K, i > 0 && DUPN(3) == 1, nx, has_next && DUPN(3) == 1, OB + sb, lsep, (long)d * NH, (char*)lds, rel_bias + h, dsel, bt); }
#undef DIL_PARAMS
        }
        if (BOTH(3)) GRID_BAR();
    }
    if (IN(4)) {
        REFRESH();
        _Pragma("unroll") for (int rep_ = 0; rep_ < DUPN(4); ++rep_) merge_rows(F, KA(4), KA(5));
        if (BOTH(4)) GRID_BAR();
    }
    if (IN(5)) {
        REFRESH();
        _Pragma("unroll") for (int rep_ = 0; rep_ < DUPN(5); ++rep_) {
        pg8::Gemm g{(const bf16_t*)(ws + WS_YM), (const bf16_t*)(ws + WS_WOUT), DM, nullptr}; pg8::StaticOrder S; S.init(M, DM, F.G, (int)blockIdx.x);
        pg8::EpiX1N E{KA(0), ws, MOD, F.lds, (float*)(ws + WS_EX), (unsigned*)(F.ctl + CW_X1)};
        pg8::gemm_phase<pg8::EpiX1N, pg8::StaticOrder, false>(F.lds, g, S, E); }
        if (BOTH(5)) GRID_BAR();
    }
    if (IN(6)) {
        REFRESH();
        (void)0;
    }
    if (IN(7)) {
        REFRESH();
        float* LOGITS = (float*)(ws + WS_LOGITS); const float* rbias_ = KA(10);
        { pg8::Gemm g{HB, (const bf16_t*)(ws + WS_WR), DM, nullptr}; pg8::StaticOrder S; S.init(M, NEXP, F.G, (int)blockIdx.x);
          pg8::EpiF32 E{LOGITS, NEXP};
          pg8::gemm_phase<pg8::EpiF32, pg8::StaticOrder, false>(F.lds, g, S, E);
          asm volatile("s_waitcnt vmcnt(0)" ::: "memory"); __syncthreads();
          pg8::Unit u; for (int i = 0; S.next(i, u); ++i) route_rows(F, u.pm, LOGITS, rbias_, LIST, (float*)(ws + WS_WTS), (unsigned*)(ws + WS_POSE)); }
        _Pragma("unroll") for (int rep_ = 0; rep_ < DUPN(7); ++rep_)
        { pg8::Gemm g{HB, (const bf16_t*)(ws + WS_WSHGU), DM, nullptr}; pg8::StaticOrder S; S.init(M, 512, F.G, (int)blockIdx.x);
          pg8::EpiSwiglu E{(bf16_t*)(ws + WS_ACTSH)};
          pg8::gemm_phase<pg8::EpiSwiglu, pg8::StaticOrder, false>(F.lds, g, S, E); }
        if (BOTH(7)) GRID_BAR();
    }
    if (IN(8)) {
        REFRESH();
        { pg8::Gemm g{(const bf16_t*)(ws + WS_ACTSH), (const bf16_t*)(ws + WS_WSHD), EH, nullptr}; pg8::StaticOrder S; S.init(M, DM, F.G, (int)blockIdx.x);
          pg8::EpiYbuf E{ws + WS_YSH, ws + WS_DUMP};
          pg8::gemm_phase<pg8::EpiYbuf, pg8::StaticOrder, false, false, true, 0, HOIST_SD>(F.lds, g, S, E); }
        build_tables(F);
#if PROBE_G1
        { pg8::Gemm g{(const bf16_t*)(ws + WS_H8), (const bf16_t*)(ws + WS_WGU), DM / 2, LIST};
          pg8::GroupedOrder S{(const LAS unsigned*)(F.lds + TAB_OFF), (const LAS unsigned*)(F.lds + TAB_OFF) + 260, 2, F.G, F.vcu, 2, 0, 0, (const LAS unsigned short*)(F.lds + MT2E_OFF)}; S.total = __builtin_amdgcn_readfirstlane((int)S.tp[256]) * 2;
          pg8::EpiSwiglu8 E{ws + WS_ACT};
          pg8::gemm_phase<pg8::EpiSwiglu8, pg8::GroupedOrder, true, true, true, PROBE_G1>(F.lds, g, S, E); }
#endif
        _Pragma("unroll") for (int rep_ = 0; rep_ < DUPN(8); ++rep_)
        { pg8::Gemm g{(const bf16_t*)(ws + WS_H8), (const bf16_t*)(ws + WS_WGU), DM / 2, LIST};
          pg8::GroupedOrder S{(const LAS unsigned*)(F.lds + TAB_OFF), (const LAS unsigned*)(F.lds + TAB_OFF) + 260, 2, F.G, F.vcu, 2, 0, 0, (const LAS unsigned short*)(F.lds + MT2E_OFF)}; S.total = __builtin_amdgcn_readfirstlane((int)S.tp[256]) * 2;
          pg8::EpiSwiglu8 E{ws + WS_ACT};
          pg8::gemm_phase<pg8::EpiSwiglu8, pg8::GroupedOrder, true, true, true, 0, HOIST_G1>(F.lds, g, S, E); }
        if (BOTH(8)) GRID_BAR();
    }
    if (IN(9)) {
        REFRESH();
        build_tables(F);
#if PROBE_G2
        { pg8::Gemm g{(const bf16_t*)(ws + WS_ACT), (const bf16_t*)(ws + WS_WD), EH / 2, LIST};
          pg8::GroupedOrder S{(const LAS unsigned*)(F.lds + TAB_OFF), (const LAS unsigned*)(F.lds + TAB_OFF) + 260, 4, F.G, F.vcu, 4, 0, 0, (const LAS unsigned short*)(F.lds + MT2E_OFF)}; S.total = __builtin_amdgcn_readfirstlane((int)S.tp[256]) * 4;
          pg8::EpiYbuf E{(unsigned char*)(ws + WS_YBUF), ws + WS_DUMP};
          pg8::gemm_phase<pg8::EpiYbuf, pg8::GroupedOrder, false, true, true, PROBE_G2>(F.lds, g, S, E); }
#endif
        _Pragma("unroll") for (int rep_ = 0; rep_ < DUPN(9); ++rep_)
        { pg8::Gemm g{(const bf16_t*)(ws + WS_ACT), (const bf16_t*)(ws + WS_WD), EH / 2, LIST};
          pg8::GroupedOrder S{(const LAS unsigned*)(F.lds + TAB_OFF), (const LAS unsigned*)(F.lds + TAB_OFF) + 260, 4, F.G, F.vcu, 4, 0, 0, (const LAS unsigned short*)(F.lds + MT2E_OFF)}; S.total = __builtin_amdgcn_readfirstlane((int)S.tp[256]) * 4;
          pg8::EpiYbuf E{(unsigned char*)(ws + WS_YBUF), ws + WS_DUMP};
          pg8::gemm_phase<pg8::EpiYbuf, pg8::GroupedOrder, false, true, true, 0, HOIST_G2>(F.lds, g, S, E); }
        if (BOTH(9)) GRID_BAR();
    }
    if (IN(10)) {
        REFRESH();
        build_tables(F);
        if (DUPN(10) == 2) combine_rows(F, MOD + 5 * DM, KA(18), (float*)(ws + WS_ACT));
        combine_rows(F, MOD + 5 * DM, KA(18), F.out);
    }
#undef KA
#undef MOD
#undef LF
#undef KB
#undef LSE
#undef HB
#undef QKV
#undef LIST
#undef REFRESH
#undef IN
#undef BOTH
#undef GRID_BAR
}

extern "C" void kernel_launch(void* const* d_in, const int* in_sizes, int n_in, void* d_out, int out_size, void* d_ws, size_t ws_size, hipStream_t stream) {
    static int grid = 0;
    if (grid == 0) {
        if (n_in != 19 || in_sizes[0] != M * DM || out_size != M * DM || ws_size < WS_NEED) {
            fprintf(stderr, "kernel_launch: unexpected shapes: n_in %d in0 %d out %d ws %zu (need %zu); nothing launched\n", n_in, n_in > 0 ? in_sizes[0] : -1, out_size, ws_size, (size_t)WS_NEED); grid = -1; return; }
        int dev = 0, cus = 0, per_cu = 0;
        if (hipGetDevice(&dev) != hipSuccess || hipDeviceGetAttribute(&cus, hipDeviceAttributeMultiprocessorCount, dev) != hipSuccess) { fprintf(stderr, "kernel_launch: device query failed\n"); grid = -1; return; }
        if (hipFuncSetAttribute((const void*)fwd_kernel, hipFuncAttributeMaxDynamicSharedMemorySize, LDS_BYTES) != hipSuccess) { fprintf(stderr, "kernel_launch: hipFuncSetAttribute failed\n"); grid = -1; return; }
        if (hipOccupancyMaxActiveBlocksPerMultiprocessor(&per_cu, (const void*)fwd_kernel, NWAVES * 64, LDS_BYTES) != hipSuccess || per_cu < 1)
            fprintf(stderr, "kernel_launch: note: occupancy query reports %d workgroups per CU\n", per_cu);
        (void)hipGetLastError();
        grid = cus;
    }
    if (grid < 0) return;
    if (hipMemsetAsync((char*)d_ws + WS_CTL, 0, CTL_ZERO_BYTES, stream) != hipSuccess) { fprintf(stderr, "kernel_launch: memset failed\n"); return; }
    Args a{};
    for (int i = 0; i < 19; ++i) a.in[i] = (const float*)d_in[i];
    a.out = (float*)d_out; a.ws = (unsigned char*)d_ws; a.pad = 0;
    for (int li = 0; li < N_LAUNCHES; ++li) {
        a.ph_lo = (N_LAUNCHES == 1) ? 0 : li; a.ph_hi = (N_LAUNCHES == 1) ? NPHASE : li + 1; a.li = li;
        hipLaunchKernelGGL(fwd_kernel, dim3(grid), dim3(NWAVES * 64), LDS_BYTES, stream, a);
        const hipError_t le = hipPeekAtLastError();
        if (le != hipSuccess) { fprintf(stderr, "kernel_launch: launch %d failed: %s\n", li, hipGetErrorName(le)); break; }
    }
}
```

```cpp
#include <hip/hip_runtime.h>
#include <hip/hip_bf16.h>
#include <cstdio>
#include <cstdint>

#ifndef DUP_MASK
#define DUP_MASK 0
#endif
#ifndef CONV_PROBE
#define CONV_PROBE 0
#endif
#ifndef HOIST_SD
#define HOIST_SD false
#endif
#ifndef HOIST_G1
#define HOIST_G1 false
#endif
#ifndef HOIST_G2
#define HOIST_G2 true
#endif
#ifndef PROBE_G1
#define PROBE_G1 0
#endif
#ifndef PROBE_G2
#define PROBE_G2 0
#endif
#define DUPN(k) (((DUP_MASK >> (k)) & 1) ? 2 : 1)
#ifndef MK_N_LAUNCHES
#define MK_N_LAUNCHES 1
#endif

#define GAS __attribute__((address_space(1)))
#define LAS __attribute__((address_space(3)))

constexpr int BATCH = 16, SEQ = 4096, DM = 1024, M = BATCH * SEQ;
constexpr int NH = 8, HD = 64, HW = NH * HD;
constexpr int INC = 3080;
constexpr int NEXP = 256, TOPK = 8, EH = 256;
constexpr int NMOD = 6 * DM;
constexpr int LCAP = 65536;
constexpr float LOG2E = 1.4426950408889634f;
constexpr float EPS = 1e-6f;
constexpr float FOX_SKIP_LOG2 = 80.f;
constexpr float YSCALE = 16.f;
constexpr int NWAVES = 8;
constexpr int NPHASE = 11;
constexpr int N_LAUNCHES = MK_N_LAUNCHES;

constexpr size_t MiB = 1u << 20;
constexpr size_t WS_CTL = 0, CTL_ZERO_BYTES = 1 * MiB;
constexpr size_t WS_DUMP = 512 * 1024;
constexpr size_t WS_MOD = 1 * MiB;
constexpr size_t WS_LF = 2 * MiB;
constexpr size_t WS_KB = 4 * MiB;
constexpr size_t WS_LSE = 6 * MiB;
constexpr size_t WS_WIN = 12 * MiB;
constexpr size_t WS_WOUT = 18 * MiB;
constexpr size_t WS_WR = 20 * MiB;
constexpr size_t WS_WSHGU = WS_WR + MiB / 2;
constexpr size_t WS_WSHD = WS_WSHGU + MiB;
constexpr size_t WS_WTS = 22 * MiB;
constexpr size_t WS_SS0 = WS_MOD + MiB / 2;
constexpr size_t WS_T0 = WS_MOD + MiB / 2 + 65536;
constexpr size_t WS_WD = 24 * MiB;
constexpr size_t WS_WGU = 88 * MiB;
constexpr size_t WS_LIST = 216 * MiB;
constexpr size_t WS_O3 = WS_LIST;
constexpr size_t WS_H = 280 * MiB;
constexpr size_t WS_H8 = 408 * MiB;
constexpr size_t WS_QKV = 472 * MiB;
constexpr size_t WS_ACT = 856 * MiB;
constexpr size_t WS_YSH = 792 * MiB;
constexpr size_t WS_X1A = 728 * MiB;
constexpr size_t WS_X1B = 1000 * MiB;
constexpr size_t WS_END = 1000 * MiB, WS_NEED = 1064 * MiB;
constexpr size_t WS_YBUF = WS_LIST;
constexpr size_t WS_EX = WS_LSE + 4 * MiB;
constexpr size_t WS_POSE = WS_LSE;
constexpr size_t WS_OF = WS_QKV;
constexpr size_t WS_O1 = WS_H, WS_O2 = WS_H + 64 * MiB;
constexpr size_t WS_YM = WS_QKV + 64 * MiB;
constexpr size_t WS_LOGITS = WS_QKV;
constexpr size_t WS_ACTSH = WS_QKV + 64 * MiB;
static_assert(WS_ACT + (size_t)(M * TOPK + NEXP * 256) * EH <= WS_END, "act fits");
static_assert(WS_YBUF + (size_t)M * TOPK * DM <= WS_X1A && WS_X1A + 64 * MiB <= WS_YSH && WS_YSH + (size_t)M * DM <= WS_ACT && WS_X1B + 64 * MiB <= WS_NEED, "ybuf (unpadded rows), x1, ysh fit below act");
static_assert(WS_QKV + 6 * 64 * MiB <= WS_ACT, "qkv below act");
constexpr int CW_TMO = 0, CW_BAR = 4096, CW_CNT = 8192, CW_X1 = 12288;

constexpr int RING_BYTES = 131072;
constexpr int PHASE_LDS = 158720;
constexpr int LDSCTL_OFF = PHASE_LDS, MISC_OFF = LDSCTL_OFF + 320;
constexpr int TAB_OFF = MISC_OFF + 128;
constexpr int RLIST_OFF = RING_BYTES + 2304 * 2;
constexpr int MT2E_OFF = RING_BYTES;
constexpr int LDS_BYTES = 163840;
static_assert(TAB_OFF + 800 * 4 <= LDS_BYTES, "LDS map");

typedef unsigned short bf16_t;
typedef short bf16x8 __attribute__((ext_vector_type(8)));
typedef float f32x4 __attribute__((ext_vector_type(4)));
typedef float f32x2 __attribute__((ext_vector_type(2)));
typedef unsigned u32x4 __attribute__((ext_vector_type(4)));
typedef unsigned u32x2 __attribute__((ext_vector_type(2)));
typedef GAS unsigned gu32;
typedef int v4i_t __attribute__((ext_vector_type(4)));
typedef int v8i_t __attribute__((ext_vector_type(8)));
#define RLX_AGENT __ATOMIC_RELAXED, __HIP_MEMORY_SCOPE_AGENT

__device__ __forceinline__ unsigned cvt_pk_bf16(float lo, float hi) { unsigned r; asm volatile("v_cvt_pk_bf16_f32 %0, %1, %2" : "=v"(r) : "v"(lo), "v"(hi)); return r; }
__device__ __forceinline__ float bf_lo(unsigned w) { return __uint_as_float(w << 16); }
__device__ __forceinline__ float bf_hi(unsigned w) { return __uint_as_float(w & 0xffff0000u); }
__device__ __forceinline__ bf16_t* x1_row(unsigned char* ws, size_t m) { return (bf16_t*)(ws + (m < 32768 ? WS_X1A + m * 2048 : WS_X1B + (m - 32768) * 2048)); }
#define DPPF_(x, ctrl, rm) __int_as_float(__builtin_amdgcn_update_dpp(0, __float_as_int(x), ctrl, rm, 0xF, false))
__device__ __forceinline__ float wave_sum(float v) {
    v += DPPF_(v, 0xB1, 0xF); v += DPPF_(v, 0x4E, 0xF); v += DPPF_(v, 0x141, 0xF); v += DPPF_(v, 0x140, 0xF);
    v += DPPF_(v, 0x142, 0xA); v += DPPF_(v, 0x143, 0xC);
    return __int_as_float(__builtin_amdgcn_readlane(__float_as_int(v), 63));
}
__device__ __forceinline__ float reduce8_heads(const float (&f)[8], int lane) {
    float a[4], b[2];
#pragma unroll
    for (int i = 0; i < 4; ++i) { auto rr = __builtin_amdgcn_permlane32_swap(__float_as_uint(f[i]), __float_as_uint(f[i + 4]), false, false); a[i] = __uint_as_float(rr[0]) + __uint_as_float(rr[1]); }
#pragma unroll
    for (int i = 0; i < 2; ++i) { auto rr = __builtin_amdgcn_permlane16_swap(__float_as_uint(a[i]), __float_as_uint(a[i + 2]), false, false); b[i] = __uint_as_float(rr[0]) + __uint_as_float(rr[1]); }
    const bool b3 = (lane & 8) != 0; const float mine = b3 ? b[1] : b[0], give = b3 ? b[0] : b[1];
    float v = mine + DPPF_(give, 0x128, 0xF);
    v += DPPF_(v, 0xB1, 0xF); v += DPPF_(v, 0x4E, 0xF); v += DPPF_(v, 0x141, 0xF);
    return v;
}

__device__ const unsigned char T5B[3][132] = {
 {0,1,2,3,4,5,6,7,8,9,10,11,12,13,14,15,16,16,16,16,16,16,17,17,17,17,17,17,17,17,18,18,18,18,18,18,18,18,18,18,19,19,19,19,19,19,19,19,19,19,19,19,19,19,20,20,20,20,20,20,20,20,20,20,20,20,20,20,20,20,20,20,20,21,21,21,21,21,21,21,21,21,21,21,21,21,21,21,21,21,21,21,21,21,21,21,21,21,21,22,22,22,22,22,22,22,22,22,22,22,22,22,22,22,22,22,22,22,22,22,22,22,22,22,22,22,22,22,22,0,0,0},
 {0,4,8,12,16,16,17,17,18,18,19,19,19,19,20,20,20,20,20,21,21,21,21,21,21,22,22,22,22,22,22,22,22,22,23,23,23,23,23,23,23,23,23,23,23,23,24,24,24,24,24,24,24,24,24,24,24,24,24,24,24,24,25,25,25,25,25,25,25,25,25,25,25,25,25,25,25,25,25,25,25,25,25,26,26,26,26,26,26,26,26,26,26,26,26,26,26,26,26,26,26,26,26,26,26,26,26,26,26,26,26,26,26,27,27,27,27,27,27,27,27,27,27,27,27,27,27,27,27,0,0,0},
 {0,16,18,19,20,21,21,22,22,23,23,23,24,24,24,24,25,25,25,25,25,26,26,26,26,26,26,26,26,27,27,27,27,27,27,27,27,27,27,28,28,28,28,28,28,28,28,28,28,28,28,28,29,29,29,29,29,29,29,29,29,29,29,29,29,29,29,29,29,29,30,30,30,30,30,30,30,30,30,30,30,30,30,30,30,30,30,30,30,30,30,30,30,30,30,31,31,31,31,31,31,31,31,31,31,31,31,31,31,31,31,31,31,31,31,31,31,31,31,31,31,31,31,31,31,31,31,31,31,0,0,0}};

namespace pg8 {
constexpr int BM = 256, BK = 64, HALF = 128, HTB = HALF * BK * 2, STAGE_BYTES = 8 * HTB, NXCD = 8, WGM = 8;
__host__ __device__ __forceinline__ int lds_byte(int r, int c) { const int st = (r >> 4) * 2 + (c >> 5), rr = r & 15, cc = c & 31, ob = rr * 64 + cc * 2; return st * 1024 + (ob ^ (((ob >> 9) & 1) << 5)); }
__host__ __device__ __forceinline__ void stage_rc(int b, int& R, int& C) { const int st = b / 1024, sb = b % 1024, swz = sb ^ (((sb >> 9) & 1) << 5); R = (st >> 1) * 16 + swz / 64; C = (st & 1) * 32 + (swz % 64) / 2; }
__host__ __device__ __forceinline__ int perm32(int rho) { const int n = rho >> 4, i = rho & 15; return 8 * (i >> 2) + 4 * n + (i & 3); }

struct Unit { int pm, pn, pb, e, tile, cnt, yrow; };
struct Gemm { const bf16_t* A; const bf16_t* Bt; int K; const unsigned* list; };

struct StaticOrder {
    int nM, nN, nwg, G, c;
    __device__ void init(int Mr, int N, int G_, int c_) { nM = Mr / BM; nN = N / BM; nwg = nM * nN; G = G_; c = c_; }
    __device__ bool next(int i, Unit& u) const {
        const int L = i * G + c; if (L >= nwg) return false;
        int wgid = L; { const int q = nwg / NXCD, r = nwg % NXCD, xcd = wgid % NXCD, off = wgid / NXCD; wgid = (xcd < r ? xcd * (q + 1) : r * (q + 1) + (xcd - r) * q) + off; }
        const int nig = WGM * nN, gid = wgid / nig, fm = gid * WGM, gsz = (nM - fm) < WGM ? (nM - fm) : WGM;
        u.pm = fm + ((wgid % nig) % gsz); u.pn = (wgid % nig) / gsz; u.pb = u.pn; u.e = 0; u.tile = 0; u.cnt = 1 << 30; u.yrow = u.pm * BM; return true;
    }
};
struct GroupedOrder {
    const LAS unsigned* tp; const LAS unsigned* cn; int NT, G, c, NTB, pn0, total;
    const LAS unsigned short* mt2e;
    __device__ bool next(int i, Unit& u) const {
        const int L = i * G + c; if (L >= total) return false;
        const int mt = L / NT; u.pn = L % NT;
        const int lo = __builtin_amdgcn_readfirstlane((int)mt2e[mt]);
        u.e = lo; u.pm = mt; u.tile = mt - __builtin_amdgcn_readfirstlane((int)tp[lo]); u.pb = lo * NTB + pn0 + u.pn; u.cnt = __builtin_amdgcn_readfirstlane((int)cn[lo]); u.yrow = __builtin_amdgcn_readfirstlane((int)cn[256 + lo]) + u.tile * BM; return true;
    }
};

struct EpiQKV {
    static constexpr bool PERM = true; static constexpr int NVM = 16;
    bf16_t* O; size_t split_stride; float scale0;
    __device__ __forceinline__ void operator()(const f32x4 (&acc)[2][2][4][2], const Unit& u, int wr, int wc, int fr, int fq) const {
        const int row0 = u.pm * BM + wr * 64 + fr; int colt = u.pn * BM; const int t = colt / 512; bf16_t* base = O + (size_t)t * split_stride; colt -= t * 512;
        const float sc = (t == 0 || t == 3) ? scale0 : 1.f;
        const int col0 = colt + wc * 32 + 8 * fq;
#pragma unroll
        for (int ai = 0; ai < 2; ++ai)
#pragma unroll
            for (int m = 0; m < 4; ++m) { bf16_t* rowp = base + (size_t)(row0 + ai * HALF + m * 16) * 512 + col0;
#pragma unroll
                for (int bj = 0; bj < 2; ++bj) { const f32x4 v0 = acc[ai][bj][m][0] * sc, v1 = acc[ai][bj][m][1] * sc;
                    u32x4 w; w.x = cvt_pk_bf16(v0[0], v0[1]); w.y = cvt_pk_bf16(v0[2], v0[3]); w.z = cvt_pk_bf16(v1[0], v1[1]); w.w = cvt_pk_bf16(v1[2], v1[3]);
                    *(u32x4*)(rowp + bj * HALF) = w; } }
    }
};
struct EpiSwiglu {
    static constexpr bool PERM = true; static constexpr int NVM = 8;
    bf16_t* O;
    __device__ __forceinline__ void operator()(const f32x4 (&acc)[2][2][4][2], const Unit& u, int wr, int wc, int fr, int fq) const {
        const int row0 = u.pm * BM + wr * 64 + fr; const int col0 = u.pn * HALF + wc * 32 + 8 * fq;
#pragma unroll
        for (int ai = 0; ai < 2; ++ai)
#pragma unroll
            for (int m = 0; m < 4; ++m) { bf16_t* rowp = O + (size_t)(row0 + ai * HALF + m * 16) * EH + col0; float r[8];
#pragma unroll
                for (int n = 0; n < 2; ++n)
#pragma unroll
                    for (int i = 0; i < 4; ++i) { const float g = acc[ai][0][m][n][i], up = acc[ai][1][m][n][i]; r[n * 4 + i] = g * __builtin_amdgcn_rcpf(1.f + __expf(-g)) * up; }
                u32x4 w; w.x = cvt_pk_bf16(r[0], r[1]); w.y = cvt_pk_bf16(r[2], r[3]); w.z = cvt_pk_bf16(r[4], r[5]); w.w = cvt_pk_bf16(r[6], r[7]);
                *(u32x4*)rowp = w; }
    }
};
struct EpiSwiglu8 {
    static constexpr bool PERM = true; static constexpr int NVM = 4;
    unsigned char* O;
    __device__ __forceinline__ void operator()(const f32x4 (&acc)[2][2][4][2], const Unit& u, int wr, int wc, int fr, int fq) const {
        const size_t row0 = (size_t)u.pm * BM + wr * 64 + fr + (fq & 1) * HALF; const int col0 = u.pn * HALF + wc * 32 + 8 * (fq & 2);
#pragma unroll
        for (int m = 0; m < 4; ++m) { unsigned w[2][2];
#pragma unroll
            for (int ai = 0; ai < 2; ++ai) { float r[8];
#pragma unroll
                for (int n = 0; n < 2; ++n)
#pragma unroll
                    for (int i = 0; i < 4; ++i) { const float g = acc[ai][0][m][n][i], up = acc[ai][1][m][n][i]; r[n * 4 + i] = g * __builtin_amdgcn_rcpf(1.f + __expf(-g)) * up; }
                int w0 = __builtin_amdgcn_cvt_pk_fp8_f32(r[0], r[1], 0, false); w0 = __builtin_amdgcn_cvt_pk_fp8_f32(r[2], r[3], w0, true);
                int w1 = __builtin_amdgcn_cvt_pk_fp8_f32(r[4], r[5], 0, false); w1 = __builtin_amdgcn_cvt_pk_fp8_f32(r[6], r[7], w1, true);
                w[ai][0] = (unsigned)w0; w[ai][1] = (unsigned)w1; }
            const auto s0 = __builtin_amdgcn_permlane16_swap(w[0][0], w[1][0], false, false); const auto s1 = __builtin_amdgcn_permlane16_swap(w[0][1], w[1][1], false, false);
            u32x4 o; o.x = s0[0]; o.y = s1[0]; o.z = s0[1]; o.w = s1[1];
            *(u32x4*)(O + (row0 + m * 16) * EH + col0) = o; }
    }
};
struct EpiRes {
    static constexpr bool PERM = true; static constexpr int NVM = 0;
    const float* base; float* out; const float* gate;
    __device__ __forceinline__ void operator()(const f32x4 (&acc)[2][2][4][2], const Unit& u, int wr, int wc, int fr, int fq) const {
        const int b = u.pm >> 4; const int col0 = u.pn * BM + wc * 32 + 8 * fq; f32x4 gv[2][2];
#pragma unroll
        for (int bj = 0; bj < 2; ++bj)
#pragma unroll
            for (int n = 0; n < 2; ++n) gv[bj][n] = *(const f32x4*)(gate + (size_t)b * NMOD + col0 + bj * HALF + n * 4);
#pragma unroll
        for (int ai = 0; ai < 2; ++ai)
#pragma unroll
            for (int m = 0; m < 4; ++m) { const size_t off = (size_t)(u.pm * BM + ai * HALF + wr * 64 + m * 16 + fr) * DM + col0;
#pragma unroll
                for (int bj = 0; bj < 2; ++bj)
#pragma unroll
                    for (int n = 0; n < 2; ++n) { const f32x4 bs = *(const f32x4*)(base + off + bj * HALF + n * 4); *(f32x4*)(out + off + bj * HALF + n * 4) = bs + gv[bj][n] * acc[ai][bj][m][n]; } }
    }
};
struct EpiX1 {
    static constexpr bool PERM = true; static constexpr int NVM = 8;
    const float* base; unsigned char* ws; const float* gate;
    __device__ __forceinline__ void operator()(const f32x4 (&acc)[2][2][4][2], const Unit& u, int wr, int wc, int fr, int fq) const {
        const int b = u.pm >> 4; const int col0 = u.pn * BM + wc * 32 + 8 * fq; f32x4 gv[2][2];
#pragma unroll
        for (int bj = 0; bj < 2; ++bj)
#pragma unroll
            for (int n = 0; n < 2; ++n) gv[bj][n] = *(const f32x4*)(gate + (size_t)b * NMOD + col0 + bj * HALF + n * 4);
#pragma unroll
        for (int ai = 0; ai < 2; ++ai) { f32x4 pre[4][2][2];
#pragma unroll
            for (int m = 0; m < 4; ++m) { const size_t off = ((size_t)u.pm * BM + ai * HALF + wr * 64 + m * 16 + fr) * DM + col0;
#pragma unroll
                for (int bj = 0; bj < 2; ++bj) { pre[m][bj][0] = *(const f32x4*)(base + off + bj * HALF); pre[m][bj][1] = *(const f32x4*)(base + off + bj * HALF + 4); } }
            asm volatile("" ::: "memory");
#pragma unroll
            for (int m = 0; m < 4; ++m) { const size_t row = (size_t)u.pm * BM + ai * HALF + wr * 64 + m * 16 + fr; bf16_t* orow = x1_row(ws, row) + col0;
#pragma unroll
                for (int bj = 0; bj < 2; ++bj) { const f32x4 v0 = pre[m][bj][0] + gv[bj][0] * acc[ai][bj][m][0], v1 = pre[m][bj][1] + gv[bj][1] * acc[ai][bj][m][1];
                    u32x4 w; w.x = cvt_pk_bf16(v0[0], v0[1]); w.y = cvt_pk_bf16(v0[2], v0[3]); w.z = cvt_pk_bf16(v1[0], v1[1]); w.w = cvt_pk_bf16(v1[2], v1[3]);
                    *(u32x4*)(orow + bj * HALF) = w; } }
            asm volatile("" ::: "memory"); }
    }
};
struct EpiX1N {
    static constexpr bool PERM = true; static constexpr int NVM = 0;
    const float* base; unsigned char* ws; const float* mod; LAS unsigned char* lds; float* ex; unsigned* cnt;
    __device__ __forceinline__ void operator()(f32x4 (&acc)[2][2][4][2], const Unit& u, int wr, int wc, int fr, int fq) const {
        const int b = u.pm >> 4; const int col0 = u.pn * BM + wc * 32 + 8 * fq; const float* mb = mod + (size_t)b * NMOD;
        LAS float* red = (LAS float*)(lds + RING_BYTES); LAS float* rr = red + 4 * BM;
        float ss[2][4];
        { f32x4 gv[2][2];
#pragma unroll
          for (int bj = 0; bj < 2; ++bj)
#pragma unroll
            for (int n = 0; n < 2; ++n) gv[bj][n] = *(const f32x4*)(mb + 2 * DM + col0 + bj * HALF + n * 4);
#pragma unroll
          for (int am = 0; am < 4; ++am) { const int ai = am >> 1, m0 = (am & 1) * 2; f32x4 pre[2][2][2];
#pragma unroll
            for (int mm = 0; mm < 2; ++mm) { const size_t off = ((size_t)u.pm * BM + ai * HALF + wr * 64 + (m0 + mm) * 16 + fr) * DM + col0;
#pragma unroll
                for (int bj = 0; bj < 2; ++bj) { pre[mm][bj][0] = *(const f32x4*)(base + off + bj * HALF); pre[mm][bj][1] = *(const f32x4*)(base + off + bj * HALF + 4); } }
            asm volatile("" ::: "memory");
#pragma unroll
            for (int mm = 0; mm < 2; ++mm) { const int m = m0 + mm; const size_t row = (size_t)u.pm * BM + ai * HALF + wr * 64 + m * 16 + fr; bf16_t* orow = x1_row(ws, row) + col0; float s2 = 0.f;
#pragma unroll
                for (int bj = 0; bj < 2; ++bj) { const f32x4 v0 = pre[mm][bj][0] + gv[bj][0] * acc[ai][bj][m][0], v1 = pre[mm][bj][1] + gv[bj][1] * acc[ai][bj][m][1];
                    acc[ai][bj][m][0] = v0; acc[ai][bj][m][1] = v1;
                    s2 += ((v0[0] * v0[0] + v0[1] * v0[1]) + (v0[2] * v0[2] + v0[3] * v0[3])) + ((v1[0] * v1[0] + v1[1] * v1[1]) + (v1[2] * v1[2] + v1[3] * v1[3]));
                    u32x4 w; w.x = cvt_pk_bf16(v0[0], v0[1]); w.y = cvt_pk_bf16(v0[2], v0[3]); w.z = cvt_pk_bf16(v1[0], v1[1]); w.w = cvt_pk_bf16(v1[2], v1[3]);
                    *(u32x4*)(orow + bj * HALF) = w; }
                s2 += __shfl_xor(s2, 16); s2 += __shfl_xor(s2, 32); ss[ai][m] = s2; }
            asm volatile("" ::: "memory"); } }
        if (fq == 0) {
#pragma unroll
            for (int ai = 0; ai < 2; ++ai)
#pragma unroll
                for (int m = 0; m < 4; ++m) red[wc * BM + ai * HALF + wr * 64 + m * 16 + fr] = ss[ai][m]; }
        __syncthreads();
        const int tid = threadIdx.x; unsigned* slot = (unsigned*)ex + ((size_t)u.pm * 4) * BM;
        if (tid < BM) { const float tot = (red[tid] + red[BM + tid]) + (red[2 * BM + tid] + red[3 * BM + tid]);
            __hip_atomic_store(slot + u.pn * BM + tid, __float_as_uint(tot), __ATOMIC_RELAXED, __HIP_MEMORY_SCOPE_AGENT); }
        asm volatile("s_waitcnt vmcnt(0)" ::: "memory");
        __syncthreads();
        if (tid == 0) { (void)__hip_atomic_fetch_add(cnt + u.pm, 1u, __ATOMIC_RELAXED, __HIP_MEMORY_SCOPE_AGENT); unsigned sp = 0;
            while (__hip_atomic_load(cnt + u.pm, __ATOMIC_RELAXED, __HIP_MEMORY_SCOPE_AGENT) < 4u) { __builtin_amdgcn_s_sleep(1); if (++sp > (1u << 22)) break; } }
        __syncthreads();
        if (tid < BM) { float t4 = 0.f;
#pragma unroll
            for (int q = 0; q < 4; ++q) t4 += __uint_as_float(__hip_atomic_load(slot + q * BM + tid, __ATOMIC_RELAXED, __HIP_MEMORY_SCOPE_AGENT));
            rr[tid] = 1.f / sqrtf(t4 * (1.f / DM) + EPS); }
        __syncthreads();
        f32x4 sc[2][2], sh[2][2];
#pragma unroll
        for (int bj = 0; bj < 2; ++bj)
#pragma unroll
            for (int n = 0; n < 2; ++n) { sc[bj][n] = *(const f32x4*)(mb + 4 * DM + col0 + bj * HALF + n * 4) + 1.f; sh[bj][n] = *(const f32x4*)(mb + 3 * DM + col0 + bj * HALF + n * 4); }
        bf16_t* H2 = (bf16_t*)(ws + WS_H); unsigned char* H8 = ws + WS_H8;
        const int col8 = u.pn * BM + (fq & 1) * HALF + wc * 32 + 8 * (fq & 2);
#pragma unroll
        for (int ai = 0; ai < 2; ++ai)
#pragma unroll
            for (int m = 0; m < 4; ++m) { const int rl = ai * HALF + wr * 64 + m * 16 + fr; const size_t row = (size_t)u.pm * BM + rl; const float r = rr[rl]; unsigned w8[2][2];
#pragma unroll
                for (int bj = 0; bj < 2; ++bj) { const f32x4 h0 = acc[ai][bj][m][0] * r * sc[bj][0] + sh[bj][0], h1 = acc[ai][bj][m][1] * r * sc[bj][1] + sh[bj][1];
                    u32x4 w; w.x = cvt_pk_bf16(h0[0], h0[1]); w.y = cvt_pk_bf16(h0[2], h0[3]); w.z = cvt_pk_bf16(h1[0], h1[1]); w.w = cvt_pk_bf16(h1[2], h1[3]);
                    *(u32x4*)(H2 + row * DM + col0 + bj * HALF) = w;
                    int q0 = __builtin_amdgcn_cvt_pk_fp8_f32(h0[0], h0[1], 0, false); q0 = __builtin_amdgcn_cvt_pk_fp8_f32(h0[2], h0[3], q0, true);
                    int q1 = __builtin_amdgcn_cvt_pk_fp8_f32(h1[0], h1[1], 0, false); q1 = __builtin_amdgcn_cvt_pk_fp8_f32(h1[2], h1[3], q1, true);
                    w8[bj][0] = (unsigned)q0; w8[bj][1] = (unsigned)q1; }
                const auto s0 = __builtin_amdgcn_permlane16_swap(w8[0][0], w8[1][0], false, false); const auto s1 = __builtin_amdgcn_permlane16_swap(w8[0][1], w8[1][1], false, false);
                u32x4 o; o.x = s0[0]; o.y = s1[0]; o.z = s0[1]; o.w = s1[1];
                *(u32x4*)(H8 + row * DM + col8) = o; }
    }
};
struct EpiF32 {
    static constexpr bool PERM = false; static constexpr int NVM = 16;
    float* out; int ldc;
    __device__ __forceinline__ void operator()(const f32x4 (&acc)[2][2][4][2], const Unit& u, int wr, int wc, int fr, int fq) const {
        const int col0 = u.pn * BM + wc * 32 + 4 * fq;
#pragma unroll
        for (int ai = 0; ai < 2; ++ai)
#pragma unroll
            for (int m = 0; m < 4; ++m) { const size_t off = (size_t)(u.pm * BM + ai * HALF + wr * 64 + m * 16 + fr) * ldc + col0;
#pragma unroll
                for (int bj = 0; bj < 2; ++bj)
#pragma unroll
                    for (int n = 0; n < 2; ++n) *(f32x4*)(out + off + bj * HALF + n * 16) = acc[ai][bj][m][n]; }
    }
};
struct EpiYbuf {
    static constexpr bool PERM = true; static constexpr int NVM = 8;
    unsigned char* Y; unsigned char* dump;
    __device__ __forceinline__ void operator()(const f32x4 (&acc)[2][2][4][2], const Unit& u, int wr, int wc, int fr, int fq) const {
        const int colb = u.pn * BM + wc * 64 + (fq & 1) * 32 + 8 * (fq & 2);
#pragma unroll
        for (int ai = 0; ai < 2; ++ai)
#pragma unroll
            for (int m = 0; m < 4; ++m) { const int rl = ai * HALF + wr * 64 + m * 16 + fr; const size_t row = (size_t)u.yrow + rl; const bool live = u.tile * BM + rl < u.cnt;
                unsigned w[2][2];
#pragma unroll
                for (int bj = 0; bj < 2; ++bj) { f32x4 v0 = acc[ai][bj][m][0] * YSCALE, v1 = acc[ai][bj][m][1] * YSCALE;
#pragma unroll
                    for (int i = 0; i < 4; ++i) { v0[i] = __builtin_amdgcn_fmed3f(v0[i], -440.f, 440.f); v1[i] = __builtin_amdgcn_fmed3f(v1[i], -440.f, 440.f); }
                    int w0 = __builtin_amdgcn_cvt_pk_fp8_f32(v0[0], v0[1], 0, false); w0 = __builtin_amdgcn_cvt_pk_fp8_f32(v0[2], v0[3], w0, true);
                    int w1 = __builtin_amdgcn_cvt_pk_fp8_f32(v1[0], v1[1], 0, false); w1 = __builtin_amdgcn_cvt_pk_fp8_f32(v1[2], v1[3], w1, true);
                    w[bj][0] = (unsigned)w0; w[bj][1] = (unsigned)w1; }
                const auto s0 = __builtin_amdgcn_permlane16_swap(w[0][0], w[1][0], false, false); const auto s1 = __builtin_amdgcn_permlane16_swap(w[0][1], w[1][1], false, false);
                u32x4 o; o.x = s0[0]; o.y = s1[0]; o.z = s0[1]; o.w = s1[1];
                __builtin_nontemporal_store(o, (u32x4*)(live ? Y + row * DM + colb : dump + (size_t)rl * DM + colb)); }
    }
};

template <class Epi, class Sched, bool GATHER, bool FP8 = false, bool SHORTK = false, int VAR = 0, bool HOIST = false>
__device__ __forceinline__ void gemm_phase(LAS unsigned char* lds, const Gemm g, const Sched& S, const Epi& E) {
    int tid_ = threadIdx.x; asm volatile("" : "+v"(tid_));
    const int tid = tid_, wid = __builtin_amdgcn_readfirstlane(tid >> 6), lane = tid & 63, wr = wid >> 2, wc = wid & 3, fr = lane & 15, fq = lane >> 4;
    int K_ = g.K; if constexpr (SHORTK) asm volatile("" : "+s"(K_));
    const int K = K_, nt = K / BK;
    unsigned voffA[2], voffB[2];
#pragma unroll
    for (int i = 0; i < 2; ++i) { int R, C; stage_rc(tid * 16 + i * 8192, R, C); const int Rb = Epi::PERM ? ((R & ~31) + perm32(R & 31)) : R;
        voffA[i] = (unsigned)(R * K + C) * 2u; voffB[i] = (unsigned)(Rb * K + C) * 2u; }
    const size_t kstep = (size_t)(BK * 2);
    const size_t hstep = (size_t)HALF * K * 2;
    const size_t tstep = 2 * hstep;
    const unsigned ldsw = (unsigned)wid * 1024u;
    const int aoff = lds_byte(wr * 64 + fr, fq * 8), boff = lds_byte(wc * 32 + fr, fq * 8);
#define PG8_SA(b, h) (((b) * 2 + (h)) * HTB)
#define PG8_SB(b, h) ((4 + (b) * 2 + (h)) * HTB)
#define PG8_GLDS(src, bufoff, i) if constexpr (!(VAR & 1)) __builtin_amdgcn_global_load_lds((const unsigned*)(src), (LAS unsigned*)(lds + (bufoff) + ldsw + (i) * 8192), 16, 0, 0)
#define PG8_STAGE(bufoff, gbase, voff) do { _Pragma("unroll") for (int _i = 0; _i < 2; ++_i) PG8_GLDS((const char*)(gbase) + (voff)[_i], bufoff, _i); } while (0)
#define PG8_STA(bufoff, aptr, h, SEL) do { if constexpr (GATHER) { const unsigned _p = (SEL) ? gvn[h] : gvc[h]; _Pragma("unroll") for (int _i = 0; _i < 2; ++_i) { unsigned _c = voffB[_i]; asm volatile("" : "+v"(_c)); \
            const unsigned _o = ((_i ? (_p >> 16) : (_p & 0xffffu)) * (unsigned)(K * 2)) + (_c & (unsigned)(K * 2 - 1)); PG8_GLDS((const char*)(aptr) + _o, bufoff, _i); } } \
        else { PG8_STAGE(bufoff, (const char*)(aptr) + (h) * hstep, voffA); } } while (0)
#define PG8_LDA(dst, b, h) do { _Pragma("unroll") for (int m = 0; m < 4; ++m) _Pragma("unroll") for (int k = 0; k < 2; ++k) dst[m][k] = *(const LAS bf16x8*)(lds + PG8_SA(b, h) + aoff + m * 2048 + k * 1024); } while (0)
#define PG8_LDB(dst, b, h) do { _Pragma("unroll") for (int n = 0; n < 2; ++n) _Pragma("unroll") for (int k = 0; k < 2; ++k) dst[n][k] = *(const LAS bf16x8*)(lds + PG8_SB(b, h) + boff + n * 2048 + k * 1024); } while (0)
#define PG8_CAT8(lo, hi) ({ const v4i_t a_ = __builtin_bit_cast(v4i_t, lo), b_ = __builtin_bit_cast(v4i_t, hi); (v8i_t){a_.x, a_.y, a_.z, a_.w, b_.x, b_.y, b_.z, b_.w}; })
#define PG8_MMA(ai, bj, At, Bt) do { __builtin_amdgcn_s_setprio(1); if constexpr (VAR & 2) { asm volatile("" :: "v"(At[0][0]), "v"(At[3][1]), "v"(Bt[0][0]), "v"(Bt[1][1])); } else if constexpr (FP8) { _Pragma("unroll") for (int m = 0; m < 4; ++m) _Pragma("unroll") for (int n = 0; n < 2; ++n) \
        acc[ai][bj][m][n] = __builtin_amdgcn_mfma_scale_f32_16x16x128_f8f6f4(PG8_CAT8(Bt[n][0], Bt[n][1]), PG8_CAT8(At[m][0], At[m][1]), acc[ai][bj][m][n], 0, 0, 0, 0x7F7F7F7F, 0, 0x7F7F7F7F); } \
      else { _Pragma("unroll") for (int m = 0; m < 4; ++m) _Pragma("unroll") for (int n = 0; n < 2; ++n) _Pragma("unroll") for (int k = 0; k < 2; ++k) \
        acc[ai][bj][m][n] = __builtin_amdgcn_mfma_f32_16x16x32_bf16(Bt[n][k], At[m][k], acc[ai][bj][m][n], 0, 0, 0); } \
      if constexpr (SHORTK) { _Pragma("unroll") for (int m = 0; m < 4; ++m) _Pragma("unroll") for (int n = 0; n < 2; ++n) asm volatile("" : "+v"(acc[ai][bj][m][n])); }     \
      __builtin_amdgcn_s_setprio(0); } while (0)
#define PG8_WAIT_V(n) asm volatile("s_waitcnt vmcnt(" #n ")" ::: "memory")
#define PG8_WAIT_VF() do { if (fst) asm volatile("s_waitcnt vmcnt(%0)" :: "n"(8 + NQ) : "memory"); else asm volatile("s_waitcnt vmcnt(8)" ::: "memory"); } while (0)
#define PG8_WAIT_L(n) asm volatile("s_waitcnt lgkmcnt(" #n ")" ::: "memory")
#define PG8_BAR __builtin_amdgcn_s_barrier()
#define PG8_SCHED __builtin_amdgcn_sched_barrier(0)
#define PG8_ROWS_LOAD(u, ld) do { _Pragma("unroll") for (int _h = 0; _h < 2; ++_h) _Pragma("unroll") for (int _i = 0; _i < 2; ++_i) { int _R, _C; stage_rc(tid * 16 + _i * 8192, _R, _C); const int _idx = (u).tile * BM + _h * HALF + _R; \
            const int _ic = _idx < (u).cnt ? _idx : (u).cnt - 1; ld[_h][_i] = g.list[(size_t)(u).e * LCAP + _ic]; } } while (0)
#define PG8_ROWS_USE(u, ld, gv) do { asm volatile("" : "+v"(ld[0][0]), "+v"(ld[0][1]), "+v"(ld[1][0]), "+v"(ld[1][1])); \
        _Pragma("unroll") for (int _h = 0; _h < 2; ++_h) { unsigned _t2[2]; _Pragma("unroll") for (int _i = 0; _i < 2; ++_i) { int _R, _C; stage_rc(tid * 16 + _i * 8192, _R, _C); const int _idx = (u).tile * BM + _h * HALF + _R; \
            _t2[_i] = (_idx < (u).cnt) ? (ld[_h][_i] & 0xffffu) : 0u; } gv[_h] = _t2[0] | (_t2[1] << 16); } } while (0)
    constexpr int NQ = Epi::NVM + (GATHER ? 1 : 0);
#define PG8_ROWS_DMA(u) __builtin_amdgcn_global_load_lds((const unsigned*)(g.list + (size_t)(u).e * LCAP + (u).tile * BM + (wid & 3) * 64 + lane), (LAS unsigned*)(lds + RLIST_OFF + (wid & 3) * 256), 4, 0, 0)
#define PG8_ROWS_USE_LDS(u, gv) do { _Pragma("unroll") for (int _h = 0; _h < 2; ++_h) { unsigned _t2[2]; _Pragma("unroll") for (int _i = 0; _i < 2; ++_i) { int _R, _C; stage_rc(tid * 16 + _i * 8192, _R, _C); const int _idx = (u).tile * BM + _h * HALF + _R; \
            const unsigned _v = *(const LAS unsigned*)(lds + RLIST_OFF + (_h * HALF + _R) * 4); _t2[_i] = (_idx < (u).cnt) ? (_v & 0xffffu) : 0u; } gv[_h] = _t2[0] | (_t2[1] << 16); } } while (0)
    Unit cur, nxt; int ui = 0;
    if (!S.next(0, cur)) return;
    f32x4 acc[2][2][4][2];
#pragma unroll
    for (int a = 0; a < 2; ++a)
#pragma unroll
        for (int b = 0; b < 2; ++b)
#pragma unroll
            for (int m = 0; m < 4; ++m)
#pragma unroll
                for (int n = 0; n < 2; ++n) acc[a][b][m][n] = (f32x4){0.f, 0.f, 0.f, 0.f};
    bf16x8 At[4][2], B0[2][2], B1[2][2];
    unsigned gvc[2] = {0u, 0u}, gvn[2] = {0u, 0u};
    if constexpr (GATHER) { unsigned rld[2][2]; PG8_ROWS_LOAD(cur, rld); PG8_ROWS_USE(cur, rld, gvc); }
    const char* cA = GATHER ? (const char*)g.A : (const char*)g.A + (size_t)cur.pm * tstep; const char* cB = (const char*)g.Bt + (size_t)cur.pb * tstep;
    PG8_STAGE(PG8_SB(0, 0), cB, voffB); PG8_STAGE(PG8_SB(0, 1), cB + hstep, voffB); PG8_STA(PG8_SA(0, 0), cA, 0, false); PG8_STA(PG8_SA(0, 1), cA, 1, false);
    if (wr == 1) PG8_BAR;
    PG8_WAIT_V(2); PG8_BAR;
    PG8_STAGE(PG8_SB(1, 0), cB + kstep, voffB); PG8_STA(PG8_SA(1, 0), cA + kstep, 0, false); PG8_STAGE(PG8_SB(1, 1), cB + hstep + kstep, voffB);
    PG8_WAIT_V(6); PG8_BAR;
    for (;;) {
        const bool has_next = S.next(ui + 1, nxt);
        const char* nA = has_next ? (GATHER ? (const char*)g.A : (const char*)g.A + (size_t)nxt.pm * tstep) : cA; const char* nB = has_next ? (const char*)g.Bt + (size_t)nxt.pb * tstep : cB;
        if constexpr (GATHER) { if (!has_next) { nxt = cur; gvn[0] = gvc[0]; gvn[1] = gvc[1]; } PG8_ROWS_DMA(nxt); }
        int t = 0;
        do {
            const bool last = (t == nt - 2);
            const bool fst = HOIST && (t == 0) && (ui > 0);
            if constexpr (GATHER) { if (last && has_next) { PG8_ROWS_USE_LDS(nxt, gvn); } }
            const char* a1 = cA + (size_t)(t + 1) * kstep;
            const char* a2 = last ? nA : cA + (size_t)(t + 2) * kstep; const char* b2 = last ? nB : cB + (size_t)(t + 2) * kstep;
            const char* a3 = a2 + kstep; const char* b3 = b2 + kstep;
            PG8_LDB(B0, 0, 0); PG8_LDB(B1, 0, 1); PG8_SCHED; PG8_LDA(At, 0, 0); if (!fst) PG8_STA(PG8_SA(1, 1), a1, 1, false);
            PG8_WAIT_VF(); PG8_WAIT_L(0); PG8_BAR; PG8_MMA(0, 0, At, B0); PG8_MMA(0, 1, At, B1); PG8_BAR; PG8_SCHED;
            PG8_LDA(At, 0, 1); PG8_STAGE(PG8_SB(0, 0), b2, voffB); PG8_STAGE(PG8_SB(0, 1), b2 + hstep, voffB); PG8_STA(PG8_SA(0, 0), a2, 0, last);
            PG8_WAIT_VF(); PG8_WAIT_L(0); PG8_BAR; PG8_MMA(1, 0, At, B0); PG8_MMA(1, 1, At, B1); PG8_BAR; PG8_SCHED;
            PG8_LDB(B0, 1, 0); PG8_LDB(B1, 1, 1); PG8_SCHED; PG8_LDA(At, 1, 0); PG8_STA(PG8_SA(0, 1), a2, 1, last);
            PG8_WAIT_VF(); PG8_WAIT_L(0); PG8_BAR; PG8_MMA(0, 0, At, B0); PG8_MMA(0, 1, At, B1); PG8_BAR; PG8_SCHED;
            PG8_LDA(At, 1, 1); PG8_STAGE(PG8_SB(1, 0), b3, voffB); PG8_STAGE(PG8_SB(1, 1), b3 + hstep, voffB); PG8_STA(PG8_SA(1, 0), a3, 0, last);
            PG8_WAIT_V(8); PG8_WAIT_L(0); PG8_BAR; PG8_MMA(1, 0, At, B0); PG8_MMA(1, 1, At, B1); PG8_BAR; PG8_SCHED;
            t += 2;
        } while (t < nt);
        if constexpr (HOIST) PG8_STA(PG8_SA(1, 1), nA + kstep, 1, true);
        if (wr == 0) PG8_BAR;
        { int te_ = threadIdx.x; asm volatile("" : "+v"(te_)); int fr_ = te_ & 15, fq_ = (te_ >> 4) & 3; asm volatile("" : "+v"(fr_), "+v"(fq_));
          if constexpr (!(VAR & 4)) E(acc, cur, wr, wc, fr_, fq_); else { _Pragma("unroll") for (int a = 0; a < 2; ++a) _Pragma("unroll") for (int b = 0; b < 2; ++b) _Pragma("unroll") for (int m = 0; m < 4; ++m) _Pragma("unroll") for (int n = 0; n < 2; ++n) asm volatile("" :: "v"(acc[a][b][m][n])); } }
        if (!has_next) break;
#pragma unroll
        for (int a = 0; a < 2; ++a)
#pragma unroll
            for (int b = 0; b < 2; ++b)
#pragma unroll
                for (int m = 0; m < 4; ++m)
#pragma unroll
                    for (int n = 0; n < 2; ++n) acc[a][b][m][n] = (f32x4){0.f, 0.f, 0.f, 0.f};
        cur = nxt; cA = nA; cB = nB; ++ui;
        if constexpr (GATHER) { gvc[0] = gvn[0]; gvc[1] = gvn[1]; }
        if (wr == 1) PG8_BAR;
    }
    PG8_WAIT_V(0);
    PG8_BAR;
#undef PG8_SA
#undef PG8_SB
#undef PG8_GLDS
#undef PG8_STAGE
#undef PG8_STA
#undef PG8_LDA
#undef PG8_LDB
#undef PG8_MMA
#undef PG8_CAT8
#undef PG8_WAIT_V
#undef PG8_WAIT_VF
#undef PG8_WAIT_L
#undef PG8_BAR
#undef PG8_SCHED
#undef PG8_ROWS_LOAD
#undef PG8_ROWS_USE
#undef PG8_ROWS_DMA
#undef PG8_ROWS_USE_LDS
}
}

namespace attn_body {
using bf16 = __hip_bfloat16;
using s16x4 = __attribute__((ext_vector_type(4))) short;
using f32x16 = __attribute__((ext_vector_type(16))) float;
constexpr int D = 64, NW = 8, QBLK = 32, QB = QBLK * NW, KVBLK = 64;
__device__ __forceinline__ int crow(int r, int hi) { return (r & 3) + 8 * (r >> 2) + 4 * hi; }
#define SBAR() __builtin_amdgcn_sched_barrier(0)
__device__ __forceinline__ void cmask(f32x16& p0, f32x16& p1, int jb, int qrel, int hi) {
  const float NEG = -INFINITY; int kb = 64 * jb + 4 * hi;
  #pragma unroll
  for (int r = 0; r < 16; ++r) { int kv = kb + (r & 3) + 8 * (r >> 2); if (kv > qrel) p0[r] = NEG; if (kv + 32 > qrel) p1[r] = NEG; }
}
constexpr int NSLOT = 3, SLOTB = 8192;
constexpr int LDS_K = 0, LDS_V = NSLOT * SLOTB, LDS_WS = 2 * NSLOT * SLOTB, LDS_OST = LDS_WS + NW * 64 * 4, LDS_BYTES = LDS_OST + NW * 4096;
constexpr int LDS_KBT = LDS_BYTES;
constexpr int LDS_TREV = LDS_KBT + 16384;
constexpr int LDS_TOTAL = LDS_TREV + 3072;
constexpr float C2 = 0.125f * 1.4426950408889634f;
__device__ __forceinline__ void glds16(const void* gsrc, unsigned lds_dst) { unsigned keep;
  asm volatile("s_mov_b32 %0, m0\n\ts_mov_b32 m0, %2\n\ts_nop 0\n\tglobal_load_lds_dwordx4 %1, off\n\ts_mov_b32 m0, %0" : "=&s"(keep) : "v"(gsrc), "s"(lds_dst) : "memory"); }
__device__ __forceinline__ float max3f(float a, float b, float c) { float r; asm("v_max3_f32 %0, %1, %2, %3" : "=v"(r) : "v"(a), "v"(b), "v"(c)); return r; }
__device__ __forceinline__ float max2f(float a, float b) { float r; asm("v_max_f32_e32 %0, %1, %2" : "=v"(r) : "v"(a), "v"(b)); return r; }
__device__ __forceinline__ float fadd_s(float a, float b) { float r; asm("v_add_f32_e32 %0, %1, %2" : "=v"(r) : "v"(a), "v"(b)); return r; }
__device__ __forceinline__ float fsub_s(float a, float b) { float r; asm("v_sub_f32_e32 %0, %1, %2" : "=v"(r) : "v"(a), "v"(b)); return r; }
typedef float f32x2_t __attribute__((ext_vector_type(2))); typedef __bf16 bf16x2_t __attribute__((ext_vector_type(2)));
__device__ __forceinline__ unsigned cvtpk_s(float lo, float hi) { f32x2_t v = {lo, hi}; bf16x2_t b = __builtin_convertvector(v, bf16x2_t); return __builtin_bit_cast(unsigned, b); }
#define WAIT_BAR(N) asm volatile("s_waitcnt vmcnt(" #N ") lgkmcnt(0)\n\ts_barrier" ::: "memory")

__device__ __forceinline__ void qkt(f32x16& p0, f32x16& p1, const char* Kslot, const bf16x8* qr, int r32, int hi) {
  const char* kb = Kslot + hi * 1024 + r32 * 16;
  #pragma unroll
  for (int d0 = 0; d0 < 4; ++d0) {
    const bf16x8 b0 = *reinterpret_cast<const bf16x8*>(kb + d0 * 2048);
    const bf16x8 b1 = *reinterpret_cast<const bf16x8*>(kb + d0 * 2048 + 512);
    p0 = __builtin_amdgcn_mfma_f32_32x32x16_bf16(b0, qr[d0], p0, 0, 0, 0); p1 = __builtin_amdgcn_mfma_f32_32x32x16_bf16(b1, qr[d0], p1, 0, 0, 0); }
}
typedef __attribute__((address_space(3))) const char* lds_cptr;
typedef short v4i16_t __attribute__((ext_vector_type(4)));
__device__ __forceinline__ void kload8(bf16x8* kf, lds_cptr kp) {
  kf[0] = *(const LAS bf16x8*)(kp);        kf[1] = *(const LAS bf16x8*)(kp + 512);
  kf[2] = *(const LAS bf16x8*)(kp + 2048); kf[3] = *(const LAS bf16x8*)(kp + 2560);
  kf[4] = *(const LAS bf16x8*)(kp + 4096); kf[5] = *(const LAS bf16x8*)(kp + 4608);
  kf[6] = *(const LAS bf16x8*)(kp + 6144); kf[7] = *(const LAS bf16x8*)(kp + 6656);
}
__device__ __forceinline__ void kload2(bf16x8* kf, lds_cptr kp, int j) { kf[2 * j] = *(const LAS bf16x8*)(kp + j * 2048); kf[2 * j + 1] = *(const LAS bf16x8*)(kp + j * 2048 + 512); }
__device__ __forceinline__ s16x4 vtr(lds_cptr p) { return __builtin_bit_cast(s16x4, __builtin_amdgcn_ds_read_tr16_b64_v4i16((LAS v4i16_t*)p)); }
__device__ __forceinline__ float rowmax(const f32x16& p0, const f32x16& p1) {
  float a = max3f(p0[0], p0[1], p1[0]), b = max3f(p0[2], p0[3], p1[1]); a = max3f(a, p1[2], p1[3]);
  #pragma unroll
  for (int r = 4; r < 16; r += 4) { a = max3f(a, p0[r], p0[r + 1]); b = max3f(b, p0[r + 2], p0[r + 3]); a = max3f(a, p1[r], p1[r + 1]); b = max3f(b, p1[r + 2], p1[r + 3]); }
  const float m = max2f(a, b);
  auto rr = __builtin_amdgcn_permlane32_swap(__float_as_uint(m), __float_as_uint(m), false, false);
  return max2f(__uint_as_float(rr[0]), __uint_as_float(rr[1]));
}
__device__ __forceinline__ void pv(f32x16* o, int vb, bf16x8 pa0, bf16x8 pa1, bf16x8 pa2, bf16x8 pa3) {
  #pragma unroll
  for (int d0 = 0; d0 < 2; ++d0) { s16x4 lo[4], hi[4];
    #pragma unroll
    for (int ks = 0; ks < 4; ++ks) {
      asm volatile("ds_read_b64_tr_b16 %0,%1 offset:%c2" : "=&v"(lo[ks]) : "v"(vb), "i"(d0 * 4096 + ks * 1024) : "memory");
      asm volatile("ds_read_b64_tr_b16 %0,%1 offset:%c2" : "=&v"(hi[ks]) : "v"(vb), "i"(d0 * 4096 + ks * 1024 + 512) : "memory"); }
    asm volatile("s_waitcnt lgkmcnt(0)" ::: "memory"); SBAR();
    #define PK(k) (bf16x8){lo[k][0], lo[k][1], lo[k][2], lo[k][3], hi[k][0], hi[k][1], hi[k][2], hi[k][3]}
    o[d0] = __builtin_amdgcn_mfma_f32_32x32x16_bf16(pa0, PK(0), o[d0], 0, 0, 0);
    o[d0] = __builtin_amdgcn_mfma_f32_32x32x16_bf16(pa1, PK(1), o[d0], 0, 0, 0);
    o[d0] = __builtin_amdgcn_mfma_f32_32x32x16_bf16(pa2, PK(2), o[d0], 0, 0, 0);
    o[d0] = __builtin_amdgcn_mfma_f32_32x32x16_bf16(pa3, PK(3), o[d0], 0, 0, 0);
    #undef PK
  }
}
#define ATTN_STORE16(p, v) (*(u32x4*)(p) = (v))
template <int THRL, int MODE> __device__ __forceinline__ void attn_unit(const bf16* Qp, const bf16* __restrict__ Kp, const bf16* __restrict__ Vp, bf16* Op, long RS, long ORS, int q0, int T0, int NT, int off,
                                                                        float* lsep, long lse_stride, char* shm, const float* kbsrc, const float* relb, int dsel) {
  int tid_ = threadIdx.x; asm volatile("" : "+v"(tid_));
  const int tid = tid_, lane = tid & 63, r32 = lane & 31, hi = lane >> 5; const int wid = __builtin_amdgcn_readfirstlane(tid >> 6);
  const bf16* Qw = Qp + (long)(q0 + wid * QBLK) * RS;
  const bf16* Kh = Kp + (long)T0 * KVBLK * RS, *Vh = Vp + (long)T0 * KVBLK * RS;
  const unsigned lds0 = (unsigned)(uintptr_t)shm;
  float* wsf = (float*)(shm + LDS_WS) + wid * 64;
  const int qrel = wid * QBLK + r32;
  const LAS float* tbase;
  if (MODE == 0) { LAS float* kbt = (LAS float*)(shm + LDS_KBT); const int nk = q0 + QB;
    for (int i = 64 * T0 + tid * 4; i < nk; i += 2048) *(LAS f32x4*)(kbt + i) = *(const f32x4*)(kbsrc + i);
    tbase = kbt + 4 * hi + 64 * T0;
  } else { LAS float* tr = (LAS float*)(shm + LDS_TREV);
    for (int u = tid; u < 768; u += 512) { const int j = 383 - u; float v = -INFINITY; if (j >= 0 && j <= 128) v = relb[(int)T5B[dsel][j] * NH] * LOG2E; tr[u] = v; }
    tbase = tr + (383 - off - qrel + 4 * hi);
  }
  const bf16* ksrc = Kh + (long)lane * RS + wid * 8;
  const bf16* vsrc = Vh + (long)(16 * (wid & 3) + (lane >> 2)) * RS + (wid >> 2) * 32 + (lane & 3) * 8;
  const unsigned kdst = lds0 + LDS_K + wid * 1024, vdst = lds0 + LDS_V + wid * 1024;
  #define DMA_K(t, slot) glds16(ksrc + (long)(t) * KVBLK * RS, (unsigned)__builtin_amdgcn_readfirstlane(kdst + (slot)))
  #define DMA_V(t, slot) glds16(vsrc + (long)(t) * KVBLK * RS, (unsigned)__builtin_amdgcn_readfirstlane(vdst + (slot)))
  const int vb0 = (int)(lds0 + LDS_V) + ((lane >> 4) & 1) * 32 + (lane & 3) * 8 + (4 * hi + ((lane & 15) >> 2)) * 64;
  const char* Kbase = shm + LDS_K; bf16x8 kf[8];
  const lds_cptr shm3 = (lds_cptr)shm; const lds_cptr kp0 = shm3 + LDS_K + hi * 1024 + r32 * 16; const lds_cptr vp0 = shm3 + LDS_V + ((lane >> 4) & 1) * 32 + (lane & 3) * 8 + (4 * hi + ((lane & 15) >> 2)) * 64;
  DMA_K(0, 0); DMA_V(0, 0); DMA_K(1, SLOTB);
  bf16x8 qr[4];
  #pragma unroll
  for (int d0 = 0; d0 < 4; ++d0) qr[d0] = *reinterpret_cast<const bf16x8*>(&Qw[(long)r32 * RS + d0 * 16 + hi * 8]);
  float mhat = 0.f, l_reg = 0.f; f32x16 o[2]; o[0] = f32x16{}; o[1] = f32x16{};
  #define BLOAD(P0, P1, t) do { const LAS float* tb_ = tbase + 64 * (t); \
      if (MODE == 0) { _Pragma("unroll") for (int g_ = 0; g_ < 4; ++g_) { const f32x4 b0_ = *(const LAS f32x4*)(tb_ + 8 * g_), b1_ = *(const LAS f32x4*)(tb_ + 32 + 8 * g_); \
          _Pragma("unroll") for (int i_ = 0; i_ < 4; ++i_) { P0[4 * g_ + i_] = b0_[i_]; P1[4 * g_ + i_] = b1_[i_]; } } } \
      else { _Pragma("unroll") for (int r_ = 0; r_ < 16; ++r_) { P0[r_] = tb_[(r_ & 3) + 8 * (r_ >> 2)]; P1[r_] = tb_[32 + (r_ & 3) + 8 * (r_ >> 2)]; } } } while (0)
  #define CMASK(P0, P1, t) do { if (MODE == 0) { int jb_ = (t) - (NT - 4); if (jb_ >= 0) cmask(P0, P1, jb_, qrel, hi); } } while (0)
  bool resc = false;
  #define START(P0, P1) do { const float rm = rowmax(P0, P1); resc = false; mhat = max2f(rm, -1000.f); \
    _Pragma("unroll") for (int r = 0; r < 16; ++r) P0[r] = __builtin_amdgcn_exp2f(fsub_s(P0[r], mhat)); } while (0)
  #define RESC() do { if (resc) { asm volatile("s_waitcnt lgkmcnt(0)" ::: "memory"); \
      _Pragma("unroll") for (int d_ = 0; d_ < 2; ++d_) _Pragma("unroll") for (int r = 0; r < 16; ++r) o[d_][r] *= wsf[crow(r, hi)]; } } while (0)
  f32x16 pA0, pA1, pB0, pB1;
  int sl_prev = 0, sl_cur = 0, sl_next = SLOTB;
  #define ROT() do { sl_prev = sl_cur; sl_cur = sl_next; sl_next = (sl_next == (NSLOT - 1) * SLOTB) ? 0 : sl_next + SLOTB; } while (0)
  DMA_K(2, 2 * SLOTB);
  WAIT_BAR(3);
  BLOAD(pA0, pA1, 0);
  qkt(pA0, pA1, Kbase, qr, r32, hi); asm volatile("s_nop 15\n\ts_nop 7" : "+v"(pA0), "+v"(pA1)); CMASK(pA0, pA1, 0);
  START(pA0, pA1);
  _Pragma("unroll") for (int r = 0; r < 16; ++r) pA1[r] = __builtin_amdgcn_exp2f(fsub_s(pA1[r], mhat));
  BLOAD(pB0, pB1, 1);
  WAIT_BAR(0);
  DMA_K(3, 0); DMA_V(1, SLOTB);
  ROT();
  kload8(kf, kp0 + sl_cur);
  WAIT_BAR(2);
  s16x4 vlo[8], vhi[8]; u32x4 pw0, pw1, pw2, pw3;
  #define PKW(P, B) cvtpk_s(P[B], P[B + 1])
  #define PAF(k) __builtin_bit_cast(bf16x8, pw##k)
  #define VFR(i) (bf16x8){vlo[i][0], vlo[i][1], vlo[i][2], vlo[i][3], vhi[i][0], vhi[i][1], vhi[i][2], vhi[i][3]}
  #define PIN(x) asm volatile("" : "+v"(x))
  #define MX3(a, b, c) __builtin_fmaxf(__builtin_fmaxf((a), (b)), (c))
  #define GAPA(MF, A0, A1, A2, A3, W0, W1, PW) do { MF; sacc += A0; sacc += A1; sacc += A2; sacc += A3; PIN(sacc); W0; W1; PIN(PW); SBAR(); } while (0)
  #define EX(v) __builtin_amdgcn_exp2f(v)
  #define GAPB(MF, X, B) do { MF; X[B] = EX(X[B] - mhat); X[B + 1] = EX(X[B + 1] - mhat); X[B + 2] = EX(X[B + 2] - mhat); X[B + 3] = EX(X[B + 3] - mhat); PIN(X); SBAR(); } while (0)
  #define VRD(i) do { vlo[i] = vtr(vp_ + (((i) >> 2) * 4096 + ((i) & 3) * 1024)); vhi[i] = vtr(vp_ + (((i) >> 2) * 4096 + ((i) & 3) * 1024 + 512)); } while (0)
  #define KRD(G, j) do { if (G) { kload2(kf, kp0 + sl_next, j); SBAR(); } } while (0)
  #define STEP(C0, C1, P0, P1, t, GK, GV, GL) do { SBAR(); \
    const lds_cptr vp_ = vp0 + sl_prev; \
    VRD(0); SBAR(); float sacc = (P0[0] + P0[1]); \
    GAPA(C0 = __builtin_amdgcn_mfma_f32_32x32x16_bf16(kf[0], qr[0], C0, 0, 0, 0), P0[2], P0[3], P0[4], P0[5],     pw0[0] = PKW(P0, 0), pw0[1] = PKW(P0, 2), pw0); \
    VRD(4); SBAR(); GAPA(C1 = __builtin_amdgcn_mfma_f32_32x32x16_bf16(kf[1], qr[0], C1, 0, 0, 0), P0[6], P0[7], P0[8], P0[9],     pw0[2] = PKW(P0, 4), pw0[3] = PKW(P0, 6), pw0); \
    VRD(1); SBAR(); GAPA(C0 = __builtin_amdgcn_mfma_f32_32x32x16_bf16(kf[2], qr[1], C0, 0, 0, 0),   P0[10], P0[11], P0[12], P0[13], pw1[0] = PKW(P0, 8), pw1[1] = PKW(P0, 10), pw1); \
    VRD(5); SBAR(); GAPA(C1 = __builtin_amdgcn_mfma_f32_32x32x16_bf16(kf[3], qr[1], C1, 0, 0, 0),   P0[14], P0[15], P1[0], P1[1],   pw1[2] = PKW(P0, 12), pw1[3] = PKW(P0, 14), pw1); \
    VRD(2); SBAR(); GAPA(C0 = __builtin_amdgcn_mfma_f32_32x32x16_bf16(kf[4], qr[2], C0, 0, 0, 0),   P1[2], P1[3], P1[4], P1[5],     pw2[0] = PKW(P1, 0), pw2[1] = PKW(P1, 2), pw2); \
    VRD(6); SBAR(); GAPA(C1 = __builtin_amdgcn_mfma_f32_32x32x16_bf16(kf[5], qr[2], C1, 0, 0, 0),   P1[6], P1[7], P1[8], P1[9],     pw2[2] = PKW(P1, 4), pw2[3] = PKW(P1, 6), pw2); \
    VRD(3); SBAR(); GAPA(C0 = __builtin_amdgcn_mfma_f32_32x32x16_bf16(kf[6], qr[3], C0, 0, 0, 0),   P1[10], P1[11], P1[12], P1[13], pw3[0] = PKW(P1, 8), pw3[1] = PKW(P1, 10), pw3); \
    VRD(7); SBAR(); GAPA(C1 = __builtin_amdgcn_mfma_f32_32x32x16_bf16(kf[7], qr[3], C1, 0, 0, 0),   P1[14], P1[15], 0.f, 0.f,       pw3[2] = PKW(P1, 12), pw3[3] = PKW(P1, 14), pw3); \
    l_reg += sacc; \
    if (GK) { DMA_K((t) + 3, sl_cur); } if (GV) { DMA_V((t) + 1, sl_next); } \
    CMASK(C0, C1, t); \
    { float a = MX3(C0[0], C0[1], C1[0]), b = MX3(C0[2], C0[3], C1[1]); a = MX3(a, C1[2], C1[3]); \
      _Pragma("unroll") for (int r = 4; r < 16; r += 4) { a = MX3(a, C0[r], C0[r + 1]); b = MX3(b, C0[r + 2], C0[r + 3]); a = MX3(a, C1[r], C1[r + 1]); b = MX3(b, C1[r + 2], C1[r + 3]); } \
      float rm = __builtin_fmaxf(a, b); { auto rr = __builtin_amdgcn_permlane32_swap(__float_as_uint(rm), __float_as_uint(rm), false, false); rm = __builtin_fmaxf(__uint_as_float(rr[0]), __uint_as_float(rr[1])); } \
      rm -= mhat; resc = false; \
      if (__builtin_expect(__any(rm > (float)THRL), 0)) { const float dl = __builtin_fmaxf(rm, 0.f); mhat += dl; \
        const float f = __builtin_amdgcn_exp2f(-dl); l_reg *= f; if (hi == 0) wsf[r32] = f; resc = true; } } \
    SBAR(); \
    if ((t) + 1 < NT) { BLOAD(P0, P1, (t) + 1); SBAR(); }        \
    GAPB(o[0] = __builtin_amdgcn_mfma_f32_32x32x16_bf16(PAF(0), VFR(0), o[0], 0, 0, 0), C0, 0); \
    GAPB(o[1] = __builtin_amdgcn_mfma_f32_32x32x16_bf16(PAF(0), VFR(4), o[1], 0, 0, 0), C0, 4); \
    KRD(GL, 0); GAPB(o[0] = __builtin_amdgcn_mfma_f32_32x32x16_bf16(PAF(1), VFR(1), o[0], 0, 0, 0), C0, 8); \
    KRD(GL, 1); GAPB(o[1] = __builtin_amdgcn_mfma_f32_32x32x16_bf16(PAF(1), VFR(5), o[1], 0, 0, 0), C0, 12); \
    KRD(GL, 2); GAPB(o[0] = __builtin_amdgcn_mfma_f32_32x32x16_bf16(PAF(2), VFR(2), o[0], 0, 0, 0), C1, 0); \
    KRD(GL, 3); GAPB(o[1] = __builtin_amdgcn_mfma_f32_32x32x16_bf16(PAF(2), VFR(6), o[1], 0, 0, 0), C1, 4); \
    GAPB(o[0] = __builtin_amdgcn_mfma_f32_32x32x16_bf16(PAF(3), VFR(3), o[0], 0, 0, 0), C1, 8); \
    GAPB(o[1] = __builtin_amdgcn_mfma_f32_32x32x16_bf16(PAF(3), VFR(7), o[1], 0, 0, 0), C1, 12); \
    } while (0)
  int t = 1;
  for (; t + 5 < NT; t += 2) {
    STEP(pB0, pB1, pA0, pA1, t, true, true, true);     WAIT_BAR(2); RESC(); ROT();
    STEP(pA0, pA1, pB0, pB1, t + 1, true, true, true); WAIT_BAR(2); RESC(); ROT();
  }
  #define ENDW(tt) do { if ((tt) + 3 < NT) { WAIT_BAR(2); } else if ((tt) + 2 < NT) { WAIT_BAR(1); } else { WAIT_BAR(0); } } while (0)
  for (; t + 1 < NT; t += 2) {
    STEP(pB0, pB1, pA0, pA1, t, (t + 3 < NT), (t + 1 < NT), (t + 1 < NT));     ENDW(t);     RESC(); ROT();
    STEP(pA0, pA1, pB0, pB1, t + 1, (t + 4 < NT), (t + 2 < NT), (t + 2 < NT)); ENDW(t + 1); RESC(); ROT();
  }
  STEP(pB0, pB1, pA0, pA1, NT - 1, false, false, false); RESC();
  { float sacc = pB0[0] + pB0[1]; _Pragma("unroll") for (int r = 2; r < 16; ++r) sacc += pB0[r]; _Pragma("unroll") for (int r = 0; r < 16; ++r) sacc += pB1[r]; l_reg += sacc;
    pw0 = (u32x4){PKW(pB0, 0), PKW(pB0, 2), PKW(pB0, 4), PKW(pB0, 6)}; pw1 = (u32x4){PKW(pB0, 8), PKW(pB0, 10), PKW(pB0, 12), PKW(pB0, 14)}; pw2 = (u32x4){PKW(pB1, 0), PKW(pB1, 2), PKW(pB1, 4), PKW(pB1, 6)}; pw3 = (u32x4){PKW(pB1, 8), PKW(pB1, 10), PKW(pB1, 12), PKW(pB1, 14)};
    SBAR(); pv(o, vb0 + sl_cur, PAF(0), PAF(1), PAF(2), PAF(3)); }
  #undef PKW
  #undef PAF
  #undef VFR
  #undef PIN
  #undef MX3
  #undef GAPA
  #undef GAPB
  #undef EX
  #undef VRD
  #undef KRD
  #undef STEP
  #undef ENDW
  { auto rr = __builtin_amdgcn_permlane32_swap(__float_as_uint(l_reg), __float_as_uint(l_reg), false, false); l_reg = __uint_as_float(rr[0]) + __uint_as_float(rr[1]); }
  if (lsep != nullptr && hi == 0) lsep[(long)(q0 + qrel) * lse_stride] = mhat + __log2f(l_reg);
  if (hi == 0) wsf[32 + r32] = l_reg; asm volatile("s_waitcnt lgkmcnt(0)" ::: "memory");
  float rli[16];
  #pragma unroll
  for (int r = 0; r < 16; ++r) rli[r] = __builtin_amdgcn_rcpf(wsf[32 + crow(r, hi)]);
  bf16* Ow = Op + (long)(q0 + wid * QBLK) * ORS;
  { bf16* stg = (bf16*)(shm + LDS_OST) + wid * 2048;
    #pragma unroll
    for (int r = 0; r < 16; ++r) { const int orow = crow(r, hi);
      #pragma unroll
      for (int d0 = 0; d0 < 2; ++d0) stg[orow * 64 + d0 * 32 + r32] = __float2bfloat16(o[d0][r] * rli[r]); }
    asm volatile("s_waitcnt lgkmcnt(0)" ::: "memory");
    #pragma unroll
    for (int i = 0; i < 4; ++i) { const int row = i * 8 + (lane >> 3), ch = lane & 7; const u32x4 v = *(const u32x4*)(stg + row * 64 + ch * 8); ATTN_STORE16(Ow + (long)row * ORS + ch * 8, v); } }
  asm volatile("s_waitcnt lgkmcnt(0)\n\ts_barrier" ::: "memory");
  #undef DMA_K
  #undef DMA_V
  #undef CMASK
  #undef BLOAD
  #undef START
  #undef RESC
  #undef ROT
}

constexpr int DL_K = 0, DL_KB = 49152, DL_V = 98304, DL_VPAD = 147456, DL_ZEND = 153600, DL_WS = 153600, DL_TREV = 155648, DL_TOTAL = DL_TREV + 3072;
static_assert(DL_WS + NW * 256 <= DL_TREV, "dilated LDS map");
struct DilSrc { const bf16* K; const bf16* V; long RS; int q0; int first; };
__device__ __forceinline__ void dil_issue_k(const DilSrc& u, unsigned lds0, int kbuf, int lane, int wid) {
  const long kr0 = (long)u.q0 - 128; const bf16* ksrc = u.K + (kr0 + lane) * u.RS + wid * 8; const unsigned kdst = lds0 + kbuf + wid * 1024;
  #pragma unroll
  for (int i = 0; i < 6; ++i) if (i >= 2 || !u.first) glds16(ksrc + (long)i * KVBLK * u.RS, (unsigned)__builtin_amdgcn_readfirstlane(kdst + i * 8192));
}
__device__ __forceinline__ void dil_issue_v(const DilSrc& u, unsigned lds0, int lane, int wid) {
  const long kr0 = (long)u.q0 - 128; const bf16* vsrc = u.V + (kr0 + 16 * (wid & 3) + (lane >> 2)) * u.RS + (wid >> 2) * 32 + (lane & 3) * 8; const unsigned vdst = lds0 + DL_V + wid * 1024;
  #pragma unroll
  for (int i = 0; i < 6; ++i) if (i >= 2 || !u.first) glds16(vsrc + (long)i * KVBLK * u.RS, (unsigned)__builtin_amdgcn_readfirstlane(vdst + i * 8192));
}
template <int THRL> __device__ __forceinline__ void dil_unit(const bf16* Qp, const DilSrc cur, int kb, bool issued, const DilSrc nxt, bool has_next, bf16* Op,
                                                             float* lsep, long lse_stride, char* shm, const float* relb, int dsel, bool build_tab) {
  int tid_ = threadIdx.x; asm volatile("" : "+v"(tid_));
  const int tid = tid_, lane = tid & 63, r32 = lane & 31, hi = lane >> 5; const int wid = __builtin_amdgcn_readfirstlane(tid >> 6);
  const unsigned lds0 = (unsigned)(uintptr_t)shm;
  const long RS = cur.RS; const int q0 = cur.q0; const bool first = cur.first != 0;
  float* wsf = (float*)(shm + DL_WS) + wid * 64;
  LAS float* tr = (LAS float*)(shm + DL_TREV);
  if (build_tab) { for (int u = tid; u < 768; u += 512) { const int j = 383 - u; float v = -INFINITY; if (j >= 0 && j <= 128) v = relb[(int)T5B[dsel][j] * NH] * LOG2E; tr[u] = v; } }
  const LAS float* tbase = tr + (255 - r32 + 4 * hi);
  if (!issued) { dil_issue_k(cur, lds0, kb, lane, wid); dil_issue_v(cur, lds0, lane, wid); }
  const bf16* Qw = Qp + (long)(q0 + wid * QBLK) * RS;
  bf16x8 qr[4];
  #pragma unroll
  for (int d0 = 0; d0 < 4; ++d0) qr[d0] = *reinterpret_cast<const bf16x8*>(&Qw[(long)r32 * RS + d0 * 16 + hi * 8]);
  asm volatile("s_waitcnt vmcnt(0) lgkmcnt(0)\n\ts_barrier" ::: "memory");
  if (has_next) dil_issue_k(nxt, lds0, kb ^ DL_KB, lane, wid);
  const int g = wid;
  const lds_cptr shm3 = (lds_cptr)shm;
  const lds_cptr kl = shm3 + kb + hi * 1024 + r32 * 16;
  const lds_cptr vl = shm3 + DL_V + ((lane >> 4) & 1) * 32 + (lane & 3) * 8 + (4 * hi + ((lane & 15) >> 2)) * 64;
  #define KBO(blk) ((((blk)) >> 1) * 8192 + (((blk)) & 1) * 512)
  #define VBO(blk) ((((blk)) >> 1) * 8192 + (((blk)) & 1) * 2048)
  #define DKLOAD2(s_, j_) do { const int b0_ = g + 2 * (s_); kf[2 * (j_)] = *(const LAS bf16x8*)(kl + KBO(b0_) + (j_) * 2048); kf[2 * (j_) + 1] = *(const LAS bf16x8*)(kl + KBO(b0_ + 1) + (j_) * 2048); } while (0)
  float mhat = 0.f, l_reg = 0.f; f32x16 o[2]; o[0] = f32x16{}; o[1] = f32x16{};
  bf16x8 kf[8];
  #define BLOAD(P0, P1, t) do { const LAS float* tb_ = tbase + 64 * (t); \
      _Pragma("unroll") for (int r_ = 0; r_ < 16; ++r_) { P0[r_] = tb_[(r_ & 3) + 8 * (r_ >> 2)]; P1[r_] = tb_[32 + (r_ & 3) + 8 * (r_ >> 2)]; } } while (0)
  #define PMASK(P0, P1, t) do { if (first && (32 * g + 64 * (t)) < 128) { const int kb_ = 32 * g + 64 * (t) + 4 * hi - 128; \
      _Pragma("unroll") for (int r_ = 0; r_ < 16; ++r_) { const int kp_ = kb_ + (r_ & 3) + 8 * (r_ >> 2); if (kp_ < 0) P0[r_] = -INFINITY; if (kp_ + 32 < 0) P1[r_] = -INFINITY; } } } while (0)
  bool resc = false;
  #define RESC() do { if (resc) { asm volatile("s_waitcnt lgkmcnt(0)" ::: "memory"); \
      _Pragma("unroll") for (int d_ = 0; d_ < 2; ++d_) _Pragma("unroll") for (int r = 0; r < 16; ++r) o[d_][r] *= wsf[crow(r, hi)]; } } while (0)
  f32x16 pA0, pA1, pB0, pB1;
  BLOAD(pA0, pA1, 0);
  DKLOAD2(0, 0); DKLOAD2(0, 1); DKLOAD2(0, 2); DKLOAD2(0, 3);
  #pragma unroll
  for (int d0 = 0; d0 < 4; ++d0) { pA0 = __builtin_amdgcn_mfma_f32_32x32x16_bf16(kf[2 * d0], qr[d0], pA0, 0, 0, 0); pA1 = __builtin_amdgcn_mfma_f32_32x32x16_bf16(kf[2 * d0 + 1], qr[d0], pA1, 0, 0, 0); }
  asm volatile("s_nop 15\n\ts_nop 7" : "+v"(pA0), "+v"(pA1)); PMASK(pA0, pA1, 0);
  asm volatile("s_nop 3" : "+v"(pA0), "+v"(pA1));
  { const float rm = rowmax(pA0, pA1); mhat = max2f(rm, -1000.f);
    _Pragma("unroll") for (int r = 0; r < 16; ++r) pA0[r] = __builtin_amdgcn_exp2f(fsub_s(pA0[r], mhat));
    _Pragma("unroll") for (int r = 0; r < 16; ++r) pA1[r] = __builtin_amdgcn_exp2f(fsub_s(pA1[r], mhat)); }
  BLOAD(pB0, pB1, 1);
  DKLOAD2(1, 0); DKLOAD2(1, 1); DKLOAD2(1, 2); DKLOAD2(1, 3);
  s16x4 vlo[8], vhi[8]; u32x4 pw0, pw1, pw2, pw3;
  #define PKW(P, B) cvtpk_s(P[B], P[B + 1])
  #define PAF(k) __builtin_bit_cast(bf16x8, pw##k)
  #define VFR(i) (bf16x8){vlo[i][0], vlo[i][1], vlo[i][2], vlo[i][3], vhi[i][0], vhi[i][1], vhi[i][2], vhi[i][3]}
  #define PIN(x) asm volatile("" : "+v"(x))
  #define MX3(a, b, c) __builtin_fmaxf(__builtin_fmaxf((a), (b)), (c))
  #define GAPA(MF, A0, A1, A2, A3, W0, W1, PW) do { MF; sacc += A0; sacc += A1; sacc += A2; sacc += A3; PIN(sacc); W0; W1; PIN(PW); SBAR(); } while (0)
  #define EX(v) __builtin_amdgcn_exp2f(v)
  #define GAPB(MF, X, B) do { MF; X[B] = EX(X[B] - mhat); X[B + 1] = EX(X[B + 1] - mhat); X[B + 2] = EX(X[B + 2] - mhat); X[B + 3] = EX(X[B + 3] - mhat); PIN(X); SBAR(); } while (0)
  #define VRD(i) do { const lds_cptr va_ = vl + VBO(g + 2 * tv_ + (((i) & 3) >> 1)) + ((i) >> 2) * 4096 + ((i) & 1) * 1024; vlo[i] = vtr(va_); vhi[i] = vtr(va_ + 512); } while (0)
  #define KRD(G, j) do { if (G) { DKLOAD2(tk_, j); SBAR(); } } while (0)
  #define STEP(C0, C1, P0, P1, t, GL) do { SBAR(); const int tv_ = (t) - 1, tk_ = (t) + 1; \
    VRD(0); SBAR(); float sacc = (P0[0] + P0[1]); \
    GAPA(C0 = __builtin_amdgcn_mfma_f32_32x32x16_bf16(kf[0], qr[0], C0, 0, 0, 0), P0[2], P0[3], P0[4], P0[5],     pw0[0] = PKW(P0, 0), pw0[1] = PKW(P0, 2), pw0); \
    VRD(4); SBAR(); GAPA(C1 = __builtin_amdgcn_mfma_f32_32x32x16_bf16(kf[1], qr[0], C1, 0, 0, 0), P0[6], P0[7], P0[8], P0[9],     pw0[2] = PKW(P0, 4), pw0[3] = PKW(P0, 6), pw0); \
    VRD(1); SBAR(); GAPA(C0 = __builtin_amdgcn_mfma_f32_32x32x16_bf16(kf[2], qr[1], C0, 0, 0, 0),   P0[10], P0[11], P0[12], P0[13], pw1[0] = PKW(P0, 8), pw1[1] = PKW(P0, 10), pw1); \
    VRD(5); SBAR(); GAPA(C1 = __builtin_amdgcn_mfma_f32_32x32x16_bf16(kf[3], qr[1], C1, 0, 0, 0),   P0[14], P0[15], P1[0], P1[1],   pw1[2] = PKW(P0, 12), pw1[3] = PKW(P0, 14), pw1); \
    VRD(2); SBAR(); GAPA(C0 = __builtin_amdgcn_mfma_f32_32x32x16_bf16(kf[4], qr[2], C0, 0, 0, 0),   P1[2], P1[3], P1[4], P1[5],     pw2[0] = PKW(P1, 0), pw2[1] = PKW(P1, 2), pw2); \
    VRD(6); SBAR(); GAPA(C1 = __builtin_amdgcn_mfma_f32_32x32x16_bf16(kf[5], qr[2], C1, 0, 0, 0),   P1[6], P1[7], P1[8], P1[9],     pw2[2] = PKW(P1, 4), pw2[3] = PKW(P1, 6), pw2); \
    VRD(3); SBAR(); GAPA(C0 = __builtin_amdgcn_mfma_f32_32x32x16_bf16(kf[6], qr[3], C0, 0, 0, 0),   P1[10], P1[11], P1[12], P1[13], pw3[0] = PKW(P1, 8), pw3[1] = PKW(P1, 10), pw3); \
    VRD(7); SBAR(); GAPA(C1 = __builtin_amdgcn_mfma_f32_32x32x16_bf16(kf[7], qr[3], C1, 0, 0, 0),   P1[14], P1[15], 0.f, 0.f,       pw3[2] = PKW(P1, 12), pw3[3] = PKW(P1, 14), pw3); \
    l_reg += sacc; \
    PMASK(C0, C1, t); \
    { float a = MX3(C0[0], C0[1], C1[0]), b = MX3(C0[2], C0[3], C1[1]); a = MX3(a, C1[2], C1[3]); \
      _Pragma("unroll") for (int r = 4; r < 16; r += 4) { a = MX3(a, C0[r], C0[r + 1]); b = MX3(b, C0[r + 2], C0[r + 3]); a = MX3(a, C1[r], C1[r + 1]); b = MX3(b, C1[r + 2], C1[r + 3]); } \
      float rm = __builtin_fmaxf(a, b); { auto rr = __builtin_amdgcn_permlane32_swap(__float_as_uint(rm), __float_as_uint(rm), false, false); rm = __builtin_fmaxf(__uint_as_float(rr[0]), __uint_as_float(rr[1])); } \
      rm -= mhat; resc = false; \
      if (__builtin_expect(__any(rm > (float)THRL), 0)) { const float dl = __builtin_fmaxf(rm, 0.f); mhat += dl; \
        const float f = __builtin_amdgcn_exp2f(-dl); l_reg *= f; if (hi == 0) wsf[r32] = f; resc = true; } } \
    SBAR(); \
    if ((t) + 1 < 3) { BLOAD(P0, P1, (t) + 1); SBAR(); } \
    GAPB(o[0] = __builtin_amdgcn_mfma_f32_32x32x16_bf16(PAF(0), VFR(0), o[0], 0, 0, 0), C0, 0); \
    GAPB(o[1] = __builtin_amdgcn_mfma_f32_32x32x16_bf16(PAF(0), VFR(4), o[1], 0, 0, 0), C0, 4); \
    KRD(GL, 0); GAPB(o[0] = __builtin_amdgcn_mfma_f32_32x32x16_bf16(PAF(1), VFR(1), o[0], 0, 0, 0), C0, 8); \
    KRD(GL, 1); GAPB(o[1] = __builtin_amdgcn_mfma_f32_32x32x16_bf16(PAF(1), VFR(5), o[1], 0, 0, 0), C0, 12); \
    KRD(GL, 2); GAPB(o[0] = __builtin_amdgcn_mfma_f32_32x32x16_bf16(PAF(2), VFR(2), o[0], 0, 0, 0), C1, 0); \
    KRD(GL, 3); GAPB(o[1] = __builtin_amdgcn_mfma_f32_32x32x16_bf16(PAF(2), VFR(6), o[1], 0, 0, 0), C1, 4); \
    GAPB(o[0] = __builtin_amdgcn_mfma_f32_32x32x16_bf16(PAF(3), VFR(3), o[0], 0, 0, 0), C1, 8); \
    GAPB(o[1] = __builtin_amdgcn_mfma_f32_32x32x16_bf16(PAF(3), VFR(7), o[1], 0, 0, 0), C1, 12); \
    } while (0)
  STEP(pB0, pB1, pA0, pA1, 1, true);  RESC();
  STEP(pA0, pA1, pB0, pB1, 2, false); RESC();
  { float sacc = pA0[0] + pA0[1]; _Pragma("unroll") for (int r = 2; r < 16; ++r) sacc += pA0[r]; _Pragma("unroll") for (int r = 0; r < 16; ++r) sacc += pA1[r]; l_reg += sacc;
    pw0 = (u32x4){PKW(pA0, 0), PKW(pA0, 2), PKW(pA0, 4), PKW(pA0, 6)}; pw1 = (u32x4){PKW(pA0, 8), PKW(pA0, 10), PKW(pA0, 12), PKW(pA0, 14)}; pw2 = (u32x4){PKW(pA1, 0), PKW(pA1, 2), PKW(pA1, 4), PKW(pA1, 6)}; pw3 = (u32x4){PKW(pA1, 8), PKW(pA1, 10), PKW(pA1, 12), PKW(pA1, 14)};
    SBAR(); const int tv_ = 2;
    VRD(0); VRD(1); VRD(2); VRD(3); VRD(4); VRD(5); VRD(6); VRD(7);
    o[0] = __builtin_amdgcn_mfma_f32_32x32x16_bf16(PAF(0), VFR(0), o[0], 0, 0, 0); o[1] = __builtin_amdgcn_mfma_f32_32x32x16_bf16(PAF(0), VFR(4), o[1], 0, 0, 0);
    o[0] = __builtin_amdgcn_mfma_f32_32x32x16_bf16(PAF(1), VFR(1), o[0], 0, 0, 0); o[1] = __builtin_amdgcn_mfma_f32_32x32x16_bf16(PAF(1), VFR(5), o[1], 0, 0, 0);
    o[0] = __builtin_amdgcn_mfma_f32_32x32x16_bf16(PAF(2), VFR(2), o[0], 0, 0, 0); o[1] = __builtin_amdgcn_mfma_f32_32x32x16_bf16(PAF(2), VFR(6), o[1], 0, 0, 0);
    o[0] = __builtin_amdgcn_mfma_f32_32x32x16_bf16(PAF(3), VFR(3), o[0], 0, 0, 0); o[1] = __builtin_amdgcn_mfma_f32_32x32x16_bf16(PAF(3), VFR(7), o[1], 0, 0, 0); }
  #undef PKW
  #undef PAF
  #undef VFR
  #undef PIN
  #undef MX3
  #undef GAPA
  #undef GAPB
  #undef EX
  #undef VRD
  #undef KRD
  #undef STEP
  const int qrel = wid * QBLK + r32;
  { auto rr = __builtin_amdgcn_permlane32_swap(__float_as_uint(l_reg), __float_as_uint(l_reg), false, false); l_reg = __uint_as_float(rr[0]) + __uint_as_float(rr[1]); }
  if (hi == 0) lsep[(long)(q0 + qrel) * lse_stride] = mhat + __log2f(l_reg);
  if (hi == 0) wsf[32 + r32] = l_reg; asm volatile("s_waitcnt lgkmcnt(0)" ::: "memory");
  float rli[16];
  #pragma unroll
  for (int r = 0; r < 16; ++r) rli[r] = __builtin_amdgcn_rcpf(wsf[32 + crow(r, hi)]);
  asm volatile("s_waitcnt lgkmcnt(0)\n\ts_barrier" ::: "memory");
  if (has_next) dil_issue_v(nxt, lds0, lane, wid);
  bf16* Ow = Op + (long)(q0 + wid * QBLK) * RS;
  { bf16* stg = (bf16*)(shm + kb) + wid * 2048;
    #pragma unroll
    for (int r = 0; r < 16; ++r) { const int orow = crow(r, hi);
      #pragma unroll
      for (int d0 = 0; d0 < 2; ++d0) stg[orow * 64 + d0 * 32 + r32] = __float2bfloat16(o[d0][r] * rli[r]); }
    asm volatile("s_waitcnt lgkmcnt(0)" ::: "memory");
    #pragma unroll
    for (int i = 0; i < 4; ++i) { const int row = i * 8 + (lane >> 3), ch = lane & 7; const u32x4 v = *(const u32x4*)(stg + row * 64 + ch * 8); ATTN_STORE16(Ow + (long)row * RS + ch * 8, v); } }
  if (!has_next) asm volatile("s_waitcnt lgkmcnt(0)\n\ts_barrier" ::: "memory");
  #undef KBO
  #undef VBO
  #undef DKLOAD2
  #undef BLOAD
  #undef PMASK
  #undef RESC
}
#undef SBAR
#undef WAIT_BAR
}
static_assert(attn_body::LDS_TOTAL <= RING_BYTES && attn_body::DL_TOTAL <= PHASE_LDS, "attention LDS");

#define XB_TMO      128
#define XB_XCNT(j)  (256  + 64 * (j))
#define XB_XSUB(j)  (1280 + 64 * (j))
#define XB_XGEN(j)  (2304 + 64 * (j))
#define XB_TOP      3328
#define XB_TOPGEN   3392
#define XCD_BAR_WORDS 3456
#define XB_SPIN_CAP (1u << 18)
__device__ __forceinline__ unsigned xb_ld(unsigned* p)              { return __hip_atomic_load(p, __ATOMIC_RELAXED, __HIP_MEMORY_SCOPE_AGENT); }
__device__ __forceinline__ unsigned xb_add(unsigned* p, unsigned v) { return __hip_atomic_fetch_add(p, v, __ATOMIC_RELAXED, __HIP_MEMORY_SCOPE_AGENT); }
__device__ __forceinline__ unsigned xb_xcc_id() { return (unsigned)__builtin_amdgcn_s_getreg((3 << 11) | 20) & 0xFu; }
#define XB_SPIN(cond, bar) do { unsigned _sp = 0; while (cond) { __builtin_amdgcn_s_sleep(1); \
    if ((++_sp & 255u) == 0u) { if (xb_ld(&(bar)[XB_TMO])) break; if (_sp > XB_SPIN_CAP) { atomicAdd(&(bar)[XB_TMO], 1u); break; } } } } while (0)
struct XcdBarrier { unsigned* bar; unsigned x; volatile LAS unsigned* st; };
__device__ __forceinline__ XcdBarrier xcd_barrier_post(unsigned* bar, volatile LAS unsigned* st) {
    XcdBarrier b; b.bar = bar; b.x = xb_xcc_id(); b.st = st;
    if (threadIdx.x == 0) (void)xb_add(&bar[XB_XCNT(b.x)], 1u);
    return b;
}
__device__ __forceinline__ void xcd_barrier_complete(unsigned* bar, unsigned x, unsigned& nloc, unsigned& nx) {
    const unsigned G = gridDim.x * gridDim.y * gridDim.z;
    unsigned sum, cnt, mine, sp = 0u;
    for (;;) {
        sum = 0u; cnt = 0u; mine = 0u;
#pragma unroll
        for (unsigned j = 0; j < 16; ++j) { const unsigned c = xb_ld(&bar[XB_XCNT(j)]); sum += c; cnt += (c > 0u) ? 1u : 0u; mine = (j == x) ? c : mine; }
        if (sum == G) break;
        __builtin_amdgcn_s_sleep(1);
        if ((++sp & 255u) == 0u) { if (xb_ld(&bar[XB_TMO])) break; if (sp > XB_SPIN_CAP) { atomicAdd(&bar[XB_TMO], 1u); break; } }
    }
    nloc = mine > 0u ? mine : 1u; nx = cnt > 0u ? cnt : 1u;
}
__device__ __forceinline__ void xcd_barrier(const XcdBarrier& b) {
    asm volatile("s_waitcnt vmcnt(0)" ::: "memory");
    __syncthreads();
    if (threadIdx.x == 0) {
        unsigned* bar = b.bar;
        __builtin_amdgcn_s_waitcnt(0);
        unsigned nloc = b.st[0], nx = b.st[1];
        if (nloc == 0u) { xcd_barrier_complete(bar, b.x, nloc, nx); b.st[0] = nloc; b.st[1] = nx; }
        const unsigned old = xb_add(&bar[XB_XSUB(b.x)], 1u);
        const unsigned gen = old / nloc;
        if (old + 1u == (gen + 1u) * nloc) {
            __builtin_amdgcn_fence(__ATOMIC_RELEASE, "agent");
            asm volatile("s_waitcnt vmcnt(0)" ::: "memory");
            const unsigned og = xb_add(&bar[XB_TOP], 1u);
            const unsigned tg = og / nx;
            if (og + 1u == (tg + 1u) * nx) xb_add(&bar[XB_TOPGEN], 1u);
            else XB_SPIN(xb_ld(&bar[XB_TOPGEN]) == tg, bar);
            __builtin_amdgcn_fence(__ATOMIC_ACQUIRE, "agent");
            xb_add(&bar[XB_XGEN(b.x)], 1u);
            asm volatile("s_waitcnt vmcnt(0)" ::: "memory");
        } else {
            XB_SPIN(xb_ld(&bar[XB_XGEN(b.x)]) == gen, bar);
            __builtin_amdgcn_fence(__ATOMIC_ACQUIRE, "agent");
            asm volatile("s_waitcnt vmcnt(0)" ::: "memory");
        }
    }
    __syncthreads();
}

struct Frame {
    LAS unsigned char* lds;
    volatile LAS unsigned* MISC;
    gu32* ctl;
    int tid, lane, wave;
    int vcu, G;
    unsigned char* ws;
    float* out;
};
#define LDS_WAIT() asm volatile("s_waitcnt lgkmcnt(0)" ::: "memory")

__device__ __forceinline__ void p0_mod(Frame& F, const float* c, const float* w_ada, const float* b_ada, float* mod) {
    LAS float* sc = (LAS float*)F.lds;
    LAS float* part = (LAS float*)(F.lds + 65536);
    __syncthreads();
    for (int cg = blockIdx.x; cg < NMOD / 64; cg += F.G) {
        for (int i = F.tid; i < BATCH * DM; i += NWAVES * 64) { const float v = c[i]; sc[i] = v / (1.f + __expf(-v)); }
        __syncthreads();
        const int n = cg * 64 + F.lane; float acc[BATCH];
#pragma unroll
        for (int b = 0; b < BATCH; ++b) acc[b] = 0.f;
        const int kb = F.wave * 128;
        for (int k0 = kb; k0 < kb + 128; k0 += 32) { float wv[32];
#pragma unroll
            for (int i = 0; i < 32; ++i) wv[i] = w_ada[(size_t)(k0 + i) * NMOD + n];
#pragma unroll
            for (int i = 0; i < 32; ++i)
#pragma unroll
                for (int b = 0; b < BATCH; ++b) acc[b] += sc[b * DM + k0 + i] * wv[i]; }
#pragma unroll
        for (int b = 0; b < BATCH; ++b) part[(F.wave * BATCH + b) * 64 + F.lane] = acc[b];
        __syncthreads();
        for (int o = F.tid; o < BATCH * 64; o += NWAVES * 64) { const int b = o >> 6, l = o & 63; float s = b_ada[cg * 64 + l];
#pragma unroll
            for (int w = 0; w < NWAVES; ++w) s += part[(w * BATCH + b) * 64 + l];
            mod[(size_t)b * NMOD + cg * 64 + l] = s; }
        __syncthreads();
    }
}
__device__ __forceinline__ int gu_row(int c, int up) { return (c >> 7) * 256 + up * 128 + (c & 127); }
__device__ __forceinline__ int dn_row(int c) { const int cc = c & 255; return (c & ~255) + ((cc >> 5) & 1) * 128 + (cc >> 6) * 32 + (cc & 31); }
struct P0Ptrs { const float *w_in, *w_out, *w_router, *w_eg, *w_eu, *w_ed, *w_sg, *w_su, *w_sd; };
struct TrItem { const float* src; unsigned char* dst; int ldw, Kd, f8; };
__device__ __forceinline__ TrItem tr_make(const float* W, int ldw, int k0, int c0, void* WT, int drow0, int Kd, int f8 = 0) { TrItem t; t.src = W + (size_t)k0 * ldw + c0; t.dst = (unsigned char*)WT + ((size_t)drow0 * Kd + k0) * (f8 ? 1 : 2); t.ldw = ldw; t.Kd = Kd; t.f8 = f8; return t; }
__device__ __forceinline__ TrItem p0_decode(const P0Ptrs& P, unsigned char* ws, int it) {
    bf16_t* WIN = (bf16_t*)(ws + WS_WIN); bf16_t* WOUT = (bf16_t*)(ws + WS_WOUT); bf16_t* WR = (bf16_t*)(ws + WS_WR);
    bf16_t* WSHGU = (bf16_t*)(ws + WS_WSHGU); bf16_t* WSHD = (bf16_t*)(ws + WS_WSHD); unsigned char* WD = ws + WS_WD; unsigned char* WGU = ws + WS_WGU;
    constexpr int I_EXP = NEXP * 384, I_IN = 768, I_OUT = 512, I_S = 128;
    int r = it;
    if (r < I_EXP) { const int e = r / 384, q = r % 384;
        if (q < 256) { const int up = q >> 7, qq = q & 127, kb = qq >> 3, nb = qq & 7;
            return tr_make((up ? P.w_eu : P.w_eg) + (size_t)e * DM * EH, EH, 64 * kb, 32 * nb, WGU + (size_t)e * 512 * DM, gu_row(32 * nb, up), DM, 1); }
        const int qq = q - 256, kb = qq >> 5, nb = qq & 31;
        return tr_make(P.w_ed + (size_t)e * EH * DM, DM, 64 * kb, 32 * nb, WD + (size_t)e * DM * EH, dn_row(32 * nb), EH, 1); }
    r -= I_EXP;
    if (r < I_IN) { const int kb = r / 48, nb = r % 48; return tr_make(P.w_in, INC, 64 * kb, 32 * nb, WIN, 32 * nb, DM); } r -= I_IN;
    if (r < I_IN) { const int kb = r / 48, nb = r % 48; return tr_make(P.w_in, INC, 64 * kb, 1544 + 32 * nb, WIN, 1536 + 32 * nb, DM); } r -= I_IN;
    if (r < I_OUT) { const int kb = r >> 5, nb = r & 31; return tr_make(P.w_out, DM, 64 * kb, 32 * nb, WOUT, 32 * nb, DM); } r -= I_OUT;
    if (r < I_S) { const int kb = r >> 3, nb = r & 7; return tr_make(P.w_router, NEXP, 64 * kb, 32 * nb, WR, 32 * nb, DM); } r -= I_S;
    if (r < I_S) { const int kb = r >> 3, nb = r & 7; return tr_make(P.w_sg, EH, 64 * kb, 32 * nb, WSHGU, gu_row(32 * nb, 0), DM); } r -= I_S;
    if (r < I_S) { const int kb = r >> 3, nb = r & 7; return tr_make(P.w_su, EH, 64 * kb, 32 * nb, WSHGU, gu_row(32 * nb, 1), DM); } r -= I_S;
    { const int kb = r >> 5, nb = r & 31; return tr_make(P.w_sd, DM, 64 * kb, 32 * nb, WSHD, dn_row(32 * nb), EH); }
}
__device__ __forceinline__ void tr_load(const TrItem& t, int lane, f32x4 (&v)[8]) {
    const float* p = t.src + (size_t)(lane >> 3) * t.ldw + (lane & 7) * 4;
#pragma unroll
    for (int i = 0; i < 8; ++i) v[i] = *(const GAS f32x4*)(p + (size_t)(8 * i) * t.ldw);
}
__device__ __forceinline__ void tr_store(const TrItem& t, int lane, const f32x4 (&v)[8], LAS float* scr) {
    LAS float* w = scr + (lane >> 3) * 33 + (lane & 7) * 4;
#pragma unroll
    for (int i = 0; i < 8; ++i) { w[(8 * i) * 33 + 0] = v[i].x; w[(8 * i) * 33 + 1] = v[i].y; w[(8 * i) * 33 + 2] = v[i].z; w[(8 * i) * 33 + 3] = v[i].w; }
    LDS_WAIT(); asm volatile("" ::: "memory");
    const int c = lane & 7;
#pragma unroll
    for (int j = 0; j < 4; ++j) { const int n = (lane >> 3) + 8 * j; const LAS float* s = scr + (8 * c) * 33 + n;
        if (t.f8) { int w0 = __builtin_amdgcn_cvt_pk_fp8_f32(s[0 * 33], s[1 * 33], 0, false); w0 = __builtin_amdgcn_cvt_pk_fp8_f32(s[2 * 33], s[3 * 33], w0, true);
            int w1 = __builtin_amdgcn_cvt_pk_fp8_f32(s[4 * 33], s[5 * 33], 0, false); w1 = __builtin_amdgcn_cvt_pk_fp8_f32(s[6 * 33], s[7 * 33], w1, true);
            u32x2 o; o.x = (unsigned)w0; o.y = (unsigned)w1; *(GAS u32x2*)(t.dst + (size_t)n * t.Kd + 8 * c) = o; }
        else { u32x4 o; o.x = cvt_pk_bf16(s[0 * 33], s[1 * 33]); o.y = cvt_pk_bf16(s[2 * 33], s[3 * 33]); o.z = cvt_pk_bf16(s[4 * 33], s[5 * 33]); o.w = cvt_pk_bf16(s[6 * 33], s[7 * 33]);
            *(GAS u32x4*)(t.dst + ((size_t)n * t.Kd + 8 * c) * 2) = o; } }
    LDS_WAIT(); asm volatile("" ::: "memory");
}
__device__ __forceinline__ void p0_weights(Frame& F, const P0Ptrs& P, int it_lo, int it_hi) {
    LAS float* scr = (LAS float*)(F.lds + F.wave * 16384);
    const int gw = F.vcu * NWAVES + F.wave, NGW = F.G * NWAVES;
    int it = it_lo + gw; if (it >= it_hi) return;
    TrItem cur = p0_decode(P, F.ws, it); f32x4 v[8]; tr_load(cur, F.lane, v);
    for (;;) {
        const int nit = it + NGW; const bool more = nit < it_hi;
        f32x4 nv[8];
        const TrItem nx = p0_decode(P, F.ws, more ? nit : it); tr_load(nx, F.lane, nv);
        tr_store(cur, F.lane, v, scr);
        if (!more) break;
        cur = nx; it = nit;
#pragma unroll
        for (int i = 0; i < 8; ++i) v[i] = nv[i];
    }
}
constexpr int P0_EXPERT_ITEMS = NEXP * 384, P0_ALL_ITEMS = NEXP * 384 + 2 * 768 + 512 + 4 * 128;
struct CvItem { const float* src; unsigned char* dst; int ldw, Kd, rowbase, down, n0; };
__device__ __forceinline__ CvItem cv_decode(const P0Ptrs& P, unsigned char* ws, int sit) {
    const int e = sit / 24, q = sit % 24; CvItem c;
    if (q < 16) { const int up = q >> 3, kb = q & 7;
        c.src = (up ? P.w_eu : P.w_eg) + (size_t)e * DM * EH + (size_t)(128 * kb) * EH; c.ldw = EH; c.dst = ws + WS_WGU + (size_t)e * 512 * DM + 128 * kb; c.Kd = DM; c.rowbase = up * 128; c.down = 0; c.n0 = 0; }
    else { const int qq = q - 16, kb = qq >> 2, nb = qq & 3;
        c.src = P.w_ed + (size_t)e * EH * DM + (size_t)(128 * kb) * DM + 256 * nb; c.ldw = DM; c.dst = ws + WS_WD + (size_t)e * DM * EH + 128 * kb; c.Kd = EH; c.rowbase = 0; c.down = 1; c.n0 = 256 * nb; }
    return c;
}
__device__ __forceinline__ void cv_issue(Frame& F, const CvItem& c, int sub, int buf) {
    const float* g = c.src + (size_t)(32 * sub + 4 * F.wave) * c.ldw + F.lane * 4;
#pragma unroll
    for (int i = 0; i < 4; ++i) __builtin_amdgcn_global_load_lds((const unsigned*)(g + (size_t)i * c.ldw), (LAS unsigned*)(F.lds + buf * 32768 + (4 * F.wave + i) * 1024), 16, 0, 2);
}
__device__ __forceinline__ void conv_experts(Frame& F, const P0Ptrs& P) {
    constexpr int NSI = NEXP * 24;
    const int G = F.G; const int si0 = F.vcu; if (si0 >= NSI) return;
    const int nmine = (NSI - si0 + G - 1) / G;
    const int NT = nmine * 4;
    int tid_ = threadIdx.x; asm volatile("" : "+v"(tid_)); const int tid = tid_;
    LAS unsigned char* Bb = F.lds + 3 * 32768;
#define CV_SUB(t_) do { const int tt_ = (t_) < NT ? (t_) : NT - 1; const CvItem c_ = cv_decode(P, F.ws, si0 + (tt_ >> 2) * G); cv_issue(F, c_, tt_ & 3, (t_) % 3); } while (0)
    CV_SUB(0); CV_SUB(1);
    CvItem cur = cv_decode(P, F.ws, si0);
    for (int t = 0; t < NT; ++t) { const int sub = t & 3;
        asm volatile("s_waitcnt vmcnt(4)" ::: "memory");
        __builtin_amdgcn_s_barrier(); asm volatile("" ::: "memory");
        CV_SUB(t + 2);
        { const int n = tid & 255, kq = tid >> 8; const LAS float* a = (const LAS float*)(F.lds + (t % 3) * 32768) + (16 * kq) * 256 + n; unsigned w[4];
#pragma unroll
          for (int j = 0; j < 4; ++j) { const float f0 = a[(4 * j) * 256], f1 = a[(4 * j + 1) * 256], f2 = a[(4 * j + 2) * 256], f3 = a[(4 * j + 3) * 256];
              int q0 = __builtin_amdgcn_cvt_pk_fp8_f32(f0, f1, 0, false); q0 = __builtin_amdgcn_cvt_pk_fp8_f32(f2, f3, q0, true); w[j] = (unsigned)q0; }
          *(LAS u32x4*)(Bb + n * 144 + 32 * sub + 16 * kq) = (u32x4){w[0], w[1], w[2], w[3]}; }
        if (sub == 3) {
            asm volatile("s_waitcnt lgkmcnt(0)" ::: "memory"); __builtin_amdgcn_s_barrier(); asm volatile("" ::: "memory");
#pragma unroll
            for (int j = 0; j < 4; ++j) { const int nl = (tid >> 3) + 64 * j, ch = tid & 7; const u32x4 v = *(const LAS u32x4*)(Bb + nl * 144 + 16 * ch);
                const int drow = cur.down ? dn_row(cur.n0 + nl) : (nl >> 7) * 256 + cur.rowbase + (nl & 127);
                *(GAS u32x4*)(cur.dst + (size_t)drow * cur.Kd + 16 * ch) = v; }
            asm volatile("s_waitcnt lgkmcnt(0)" ::: "memory");
            if (t + 1 < NT) cur = cv_decode(P, F.ws, si0 + ((t + 1) >> 2) * G);
        }
    }
#undef CV_SUB
    asm volatile("s_waitcnt vmcnt(0)" ::: "memory");
    __builtin_amdgcn_s_barrier();
}
template <bool FL> __device__ __forceinline__ void norm_rows(Frame& F, const float* src  , bf16_t* dst, const float* mod, int shift_off, int scale_off, const float* w_in, const float* b_forget, float* lf, unsigned char* dst8) {
    LAS float* wf = (LAS float*)F.lds;
    if (FL) { for (int i = F.tid; i < DM * NH; i += NWAVES * 64) wf[(i & 7) * DM + (i >> 3)] = w_in[(size_t)(i >> 3) * INC + 1536 + (i & 7)]; __syncthreads(); }
    const int gw = F.vcu * NWAVES + F.wave, NGW = F.G * NWAVES;
    constexpr int CH = 32;
#define NR_ROW(i_) (rowb + 128 * (i_))
#define NR_LD(dst_, row_, j_) do { if (FL) dst_ = ((const GAS f32x4*)(src + (size_t)(row_) * DM) + F.lane)[64 * (j_)]; \
        else { const u32x2 t_ = ((const GAS u32x2*)x1_row(F.ws, (size_t)(row_)) + F.lane)[64 * (j_)]; dst_ = (f32x4){bf_lo(t_.x), bf_hi(t_.x), bf_lo(t_.y), bf_hi(t_.y)}; } } while (0)
    for (int ch = gw; ch < M / CH; ch += NGW) {
        const int b = ch >> 7, rowb = b * SEQ + (ch & 127);
        f32x4 sc[4], sh[4];
#pragma unroll
        for (int j = 0; j < 4; ++j) { sc[j] = *(const f32x4*)(mod + (size_t)b * NMOD + scale_off + 256 * j + 4 * F.lane) + 1.f; sh[j] = *(const f32x4*)(mod + (size_t)b * NMOD + shift_off + 256 * j + 4 * F.lane); }
        f32x4 nv[2][4];
#pragma unroll
        for (int q = 0; q < 2; ++q)
#pragma unroll
            for (int j = 0; j < 4; ++j) NR_LD(nv[q][j], NR_ROW(q), j);
        for (int mm = 0; mm < CH; mm += 2) {
            f32x4 vv[2][4];
#pragma unroll
            for (int q = 0; q < 2; ++q)
#pragma unroll
                for (int j = 0; j < 4; ++j) vv[q][j] = nv[q][j];
            if (mm + 2 < CH) {
#pragma unroll
                for (int q = 0; q < 2; ++q)
#pragma unroll
                    for (int j = 0; j < 4; ++j) NR_LD(nv[q][j], NR_ROW(mm + 2 + q), j); }
#pragma unroll
            for (int q = 0; q < 2; ++q) { const int m = NR_ROW(mm + q); f32x4 (&v)[4] = vv[q];
            float s2 = 0.f;
#pragma unroll
            for (int j = 0; j < 4; ++j) s2 += (v[j].x * v[j].x + v[j].y * v[j].y) + (v[j].z * v[j].z + v[j].w * v[j].w);
            const float r = 1.f / sqrtf(wave_sum(s2) * (1.f / DM) + EPS);
#pragma unroll
            for (int j = 0; j < 4; ++j) v[j] = v[j] * r * sc[j] + sh[j];
            GAS u32x2* o8 = (GAS u32x2*)(dst + (size_t)m * DM) + F.lane;
#pragma unroll
            for (int j = 0; j < 4; ++j) { u32x2 w; w.x = cvt_pk_bf16(v[j].x, v[j].y); w.y = cvt_pk_bf16(v[j].z, v[j].w); o8[64 * j] = w; }
            if (!FL) { GAS unsigned* o4 = (GAS unsigned*)(dst8 + (size_t)m * DM) + F.lane;
#pragma unroll
                for (int j = 0; j < 4; ++j) { int w = __builtin_amdgcn_cvt_pk_fp8_f32(v[j].x, v[j].y, 0, false); w = __builtin_amdgcn_cvt_pk_fp8_f32(v[j].z, v[j].w, w, true); o4[64 * j] = (unsigned)w; } }
            if (FL) { float fl[NH];
#pragma unroll
                for (int h = 0; h < NH; ++h) fl[h] = 0.f;
#pragma unroll
                for (int j = 0; j < 4; ++j)
#pragma unroll
                    for (int h = 0; h < NH; ++h) { const f32x4 w4 = *(const LAS f32x4*)(wf + h * DM + 256 * j + 4 * F.lane); fl[h] += (v[j].x * w4.x + v[j].y * w4.y) + (v[j].z * w4.z + v[j].w * w4.w); }
                const float mine = reduce8_heads(fl, F.lane); const int hh = F.lane >> 3;
                if ((F.lane & 7) == 0) { const float z = mine + b_forget[hh]; const float ls = fminf(z, 0.f) - log1pf(__expf(-fabsf(z))); lf[((size_t)b * NH + hh) * SEQ + (m & (SEQ - 1))] = ls; } }
            }
        }
    }
}
#undef NR_ROW
#undef NR_LD
__device__ __forceinline__ void scan_rows(Frame& F, const float* lf, float* kb, int* t0tab) {
    LAS float* wt = (LAS float*)F.lds; LAS float* kl = wt + 16;
    for (int s = blockIdx.x; s < BATCH * NH; s += F.G) {
        const float* src = lf + (size_t)s * SEQ + F.tid * 8; float v[8];
        { const f32x4 a = *(const f32x4*)src, b2 = *(const f32x4*)(src + 4); v[0] = a.x; v[1] = a.y; v[2] = a.z; v[3] = a.w; v[4] = b2.x; v[5] = b2.y; v[6] = b2.z; v[7] = b2.w; }
#pragma unroll
        for (int i = 1; i < 8; ++i) v[i] += v[i - 1];
        float incl = v[7];
#pragma unroll
        for (int o = 1; o < 64; o <<= 1) { const float t = __shfl_up(incl, o); if (F.lane >= o) incl += t; }
        if (F.lane == 63) wt[F.wave] = incl;
        __syncthreads();
        float base = incl - v[7];
        for (int w = 0; w < F.wave; ++w) base += wt[w];
        float* dst = kb + (size_t)s * SEQ + F.tid * 8;
        f32x4 a, b2; a.x = -(v[0] + base) * LOG2E; a.y = -(v[1] + base) * LOG2E; a.z = -(v[2] + base) * LOG2E; a.w = -(v[3] + base) * LOG2E;
        b2.x = -(v[4] + base) * LOG2E; b2.y = -(v[5] + base) * LOG2E; b2.z = -(v[6] + base) * LOG2E; b2.w = -(v[7] + base) * LOG2E;
        *(f32x4*)dst = a; *(f32x4*)(dst + 4) = b2;
        *(LAS f32x4*)(kl + F.tid * 8) = a; *(LAS f32x4*)(kl + F.tid * 8 + 4) = b2;
        __syncthreads();
        if (F.tid < 16) { const int q0 = 256 * F.tid; const float target = kl[q0] - FOX_SKIP_LOG2; int lo = 0, hi = q0;
            while (lo < hi) { const int mid = (lo + hi) >> 1; if (kl[mid] <= target) lo = mid + 1; else hi = mid; }
            t0tab[s * 16 + F.tid] = (lo >> 6) & ~1; }
        __syncthreads();
    }
}
__device__ __forceinline__ void unpack8(const u32x4 w, float* f) { f[0] = bf_lo(w.x); f[1] = bf_hi(w.x); f[2] = bf_lo(w.y); f[3] = bf_hi(w.y); f[4] = bf_lo(w.z); f[5] = bf_hi(w.z); f[6] = bf_lo(w.w); f[7] = bf_hi(w.w); }
__device__ __forceinline__ void merge_rows(Frame& F, const float* g_fox, const float* g_dil) {
    const bf16_t* OF = (const bf16_t*)(F.ws + WS_OF); const bf16_t* O1 = (const bf16_t*)(F.ws + WS_O1); const bf16_t* O2 = (const bf16_t*)(F.ws + WS_O2); const bf16_t* O3 = (const bf16_t*)(F.ws + WS_O3);
    const float* LSE = (const float*)(F.ws + WS_LSE); bf16_t* YM = (bf16_t*)(F.ws + WS_YM);
    const int gw = F.vcu * NWAVES + F.wave, NGW = F.G * NWAVES;
    float gf[8], gd[8];
    { const f32x4 a = *(const f32x4*)(g_fox + 8 * F.lane), b = *(const f32x4*)(g_fox + 8 * F.lane + 4), c = *(const f32x4*)(g_dil + 8 * F.lane), d = *(const f32x4*)(g_dil + 8 * F.lane + 4);
      gf[0] = a.x; gf[1] = a.y; gf[2] = a.z; gf[3] = a.w; gf[4] = b.x; gf[5] = b.y; gf[6] = b.z; gf[7] = b.w; gd[0] = c.x; gd[1] = c.y; gd[2] = c.z; gd[3] = c.w; gd[4] = d.x; gd[5] = d.y; gd[6] = d.z; gd[7] = d.w; }
    struct Row { u32x4 wf, w1, w2, w3; float l1, l2, l3; };
    const int hd = F.lane >> 3;
#define MR_LOAD(R, m_) do { const size_t eo_ = (size_t)(m_) * HW + 8 * F.lane; R.wf = *(const GAS u32x4*)(OF + eo_); R.w1 = *(const GAS u32x4*)(O1 + eo_); R.w2 = *(const GAS u32x4*)(O2 + eo_); R.w3 = *(const GAS u32x4*)(O3 + eo_); \
        R.l1 = LSE[(size_t)(m_) * NH + hd]; R.l2 = LSE[(size_t)M * NH + (size_t)(m_) * NH + hd]; R.l3 = LSE[(size_t)2 * M * NH + (size_t)(m_) * NH + hd]; } while (0)
    for (int ch = gw; ch < M / 32; ch += NGW) {
        const size_t rowb = (size_t)(ch >> 7) * SEQ + (ch & 127);
        Row nr[2]; MR_LOAD(nr[0], rowb); MR_LOAD(nr[1], rowb + 128);
        for (int mm = 0; mm < 32; mm += 2) {
            Row cr[2]; cr[0] = nr[0]; cr[1] = nr[1];
            if (mm + 2 < 32) { MR_LOAD(nr[0], rowb + 128 * (mm + 2)); MR_LOAD(nr[1], rowb + 128 * (mm + 3)); }
#pragma unroll
            for (int q = 0; q < 2; ++q) { const size_t m = rowb + 128 * (mm + q); const Row& R = cr[q];
            const float mx = fmaxf(R.l1, fmaxf(R.l2, R.l3)); float e1 = __builtin_amdgcn_exp2f(R.l1 - mx), e2 = __builtin_amdgcn_exp2f(R.l2 - mx), e3 = __builtin_amdgcn_exp2f(R.l3 - mx);
            const float inv = 1.f / (e1 + e2 + e3); e1 *= inv; e2 *= inv; e3 *= inv;
            float yf[8], a1[8], a2[8], a3[8], yd[8]; unpack8(R.wf, yf); unpack8(R.w1, a1); unpack8(R.w2, a2); unpack8(R.w3, a3);
            float sf = 0.f, sd = 0.f;
#pragma unroll
            for (int i = 0; i < 8; ++i) { yd[i] = e1 * a1[i] + e2 * a2[i] + e3 * a3[i]; sf += yf[i] * yf[i]; sd += yd[i] * yd[i]; }
            const float rf = 1.f / sqrtf(wave_sum(sf) * (1.f / HW) + EPS), rd = 1.f / sqrtf(wave_sum(sd) * (1.f / HW) + EPS);
            u32x4 of, od;
            of.x = cvt_pk_bf16(yf[0] * rf * gf[0], yf[1] * rf * gf[1]); of.y = cvt_pk_bf16(yf[2] * rf * gf[2], yf[3] * rf * gf[3]); of.z = cvt_pk_bf16(yf[4] * rf * gf[4], yf[5] * rf * gf[5]); of.w = cvt_pk_bf16(yf[6] * rf * gf[6], yf[7] * rf * gf[7]);
            od.x = cvt_pk_bf16(yd[0] * rd * gd[0], yd[1] * rd * gd[1]); od.y = cvt_pk_bf16(yd[2] * rd * gd[2], yd[3] * rd * gd[3]); od.z = cvt_pk_bf16(yd[4] * rd * gd[4], yd[5] * rd * gd[5]); od.w = cvt_pk_bf16(yd[6] * rd * gd[6], yd[7] * rd * gd[7]);
            *(GAS u32x4*)(YM + m * DM + 8 * F.lane) = of; *(GAS u32x4*)(YM + m * DM + HW + 8 * F.lane) = od; }
        }
    }
#undef MR_LOAD
}
__device__ __forceinline__ void route_rows(Frame& F, int pm, const float* logits, const float* rbias, unsigned* list, float* wts, unsigned* pose) {
    LAS unsigned* lcount = (LAS unsigned*)F.lds;
    LAS unsigned* lbase = lcount + 256;
    LAS unsigned* lsel = lbase + 256;
    LAS unsigned* lwt = lsel + 2048;
    if (F.tid < 256) lcount[F.tid] = 0u;
    __syncthreads();
    const f32x4 rb = *(const f32x4*)(rbias + 4 * F.lane);
#define DPPF(x, ctrl) __int_as_float(__builtin_amdgcn_update_dpp(0, __float_as_int(x), ctrl, 0xF, 0xF, false))
#define DPPUMAX(v, ctrl, rm) v = max(v, (unsigned)__builtin_amdgcn_update_dpp(0, (int)v, ctrl, rm, 0xF, false))
    f32x4 lgn = *(const GAS f32x4*)(logits + ((size_t)pm * 256 + F.wave * 32) * NEXP + 4 * F.lane);
    for (int i = 0; i < 32; ++i) { const int rl = F.wave * 32 + i; const size_t row = (size_t)pm * 256 + rl;
        const f32x4 lg = lgn;
        if (i + 1 < 32) lgn = *(const GAS f32x4*)(logits + (row + 1) * NEXP + 4 * F.lane);
        float s[4], sel[4];
#pragma unroll
        for (int q = 0; q < 4; ++q) { s[q] = 1.f / (1.f + __expf(-lg[q])); sel[q] = s[q] + rb[q]; }
        float m1 = -INFINITY, m2 = -INFINITY;
#pragma unroll
        for (int q = 0; q < 4; ++q) { if (sel[q] > m1) { m2 = m1; m1 = sel[q]; } else if (sel[q] > m2) m2 = sel[q]; }
        { float b1 = DPPF(m1, 0xB1), b2 = DPPF(m2, 0xB1); float n1 = fmaxf(m1, b1), n2 = fmaxf(fminf(m1, b1), fmaxf(m2, b2)); m1 = n1; m2 = n2;
          b1 = DPPF(m1, 0x4E); b2 = DPPF(m2, 0x4E); n1 = fmaxf(m1, b1); n2 = fmaxf(fminf(m1, b1), fmaxf(m2, b2)); m1 = n1; m2 = n2;
          b1 = DPPF(m1, 0x141); b2 = DPPF(m2, 0x141); n1 = fmaxf(m1, b1); n2 = fmaxf(fminf(m1, b1), fmaxf(m2, b2)); m1 = n1; m2 = n2; }
        const float gs = m1 + m2; const int g = F.lane >> 3; int rank = 0;
#pragma unroll
        for (int gg = 0; gg < 8; ++gg) { const float og = __int_as_float(__builtin_amdgcn_readlane(__float_as_int(gs), gg * 8)); rank += (og > gs || (og == gs && gg < g)) ? 1 : 0; }
        const bool gsel = rank < 4;
        unsigned key[4];
#pragma unroll
        for (int q = 0; q < 4; ++q) { const unsigned bq = __float_as_uint(sel[q]); key[q] = gsel ? (bq ^ ((bq >> 31) ? 0xffffffffu : 0x80000000u)) : 0u; }
        int myE = 0; float myS = 0.f, ssum = 0.f;
#pragma unroll 1
        for (int k = 0; k < TOPK; ++k) {
            unsigned v = max(max(key[0], key[1]), max(key[2], key[3]));
            DPPUMAX(v, 0xB1, 0xF); DPPUMAX(v, 0x4E, 0xF); DPPUMAX(v, 0x141, 0xF); DPPUMAX(v, 0x140, 0xF); DPPUMAX(v, 0x142, 0xA); DPPUMAX(v, 0x143, 0xC);
            const unsigned best = (unsigned)__builtin_amdgcn_readlane((int)v, 63);
            const int myq = (key[0] == best) ? 0 : (key[1] == best) ? 1 : (key[2] == best) ? 2 : (key[3] == best) ? 3 : 4;
            const unsigned long long bal = __ballot(myq < 4);
            const int L = __builtin_amdgcn_readfirstlane((int)__ffsll((long long)bal) - 1);
            const int q = __builtin_amdgcn_readlane(myq, L);
            const float mys = (q == 0) ? s[0] : (q == 1) ? s[1] : (q == 2) ? s[2] : s[3];
            const float sk = __int_as_float(__builtin_amdgcn_readlane(__float_as_int(mys), L));
            if (F.lane == L) {
#pragma unroll
                for (int qq = 0; qq < 4; ++qq) if (qq == q) key[qq] = 0u; }
            if (F.lane == k) { myE = 4 * L + q; myS = sk; }
            ssum += sk;
        }
        if (F.lane < TOPK) { const unsigned lp = atomicAdd((unsigned*)(lcount + myE), 1u); lsel[rl * 8 + F.lane] = (unsigned)myE | (lp << 8); lwt[rl * 8 + F.lane] = __float_as_uint(myS / ssum * 2.5f); }
    }
#undef DPPF
#undef DPPUMAX
    __syncthreads();
    if (F.tid < 256) { const unsigned n = lcount[F.tid]; lbase[F.tid] = n ? __hip_atomic_fetch_add((unsigned*)(F.ctl + CW_CNT + F.tid), n, RLX_AGENT) : 0u; }
    __syncthreads();
    for (int a = F.tid; a < 2048; a += NWAVES * 64) { const unsigned se = lsel[a]; const unsigned e = se & 255u, lp = se >> 8; const unsigned pos = lbase[e] + lp; const unsigned tok = (unsigned)(pm * 256 + (a >> 3));
        wts[(size_t)tok * TOPK + (a & 7)] = __uint_as_float(lwt[a]); pose[(size_t)tok * TOPK + (a & 7)] = (e << 16) | (pos & 0xffffu);
        if (pos < (unsigned)LCAP) list[(size_t)e * LCAP + pos] = tok | ((unsigned)(a & 7) << 16); }
    __syncthreads();
}
__device__ __forceinline__ void build_tables(Frame& F) {
    LAS unsigned* tp = (LAS unsigned*)(F.lds + TAB_OFF); LAS unsigned* cn = tp + 260; LAS unsigned* cp = cn + 256; LAS unsigned* wt = cp + 256;
    __syncthreads();
    unsigned cnt = 0u, tiles = 0u, incl = 0u, cincl = 0u;
    if (F.tid < 256) { cnt = __hip_atomic_load((unsigned*)(F.ctl + CW_CNT + F.tid), RLX_AGENT); if (cnt > (unsigned)LCAP) cnt = LCAP; tiles = (cnt + 255u) >> 8; incl = tiles; cincl = cnt;
#pragma unroll
        for (int o = 1; o < 64; o <<= 1) { const unsigned t = __shfl_up(incl, o), t2 = __shfl_up(cincl, o); if (F.lane >= o) { incl += t; cincl += t2; } }
        if (F.lane == 63) { wt[F.wave] = incl; wt[8 + F.wave] = cincl; } }
    __syncthreads();
    if (F.tid < 256) { unsigned base = 0u, cbase = 0u; for (int w = 0; w < F.wave; ++w) { base += wt[w]; cbase += wt[8 + w]; } tp[F.tid + 1] = base + incl; cn[F.tid] = cnt; cp[F.tid] = cbase + cincl - cnt; if (F.tid == 0) tp[0] = 0u;
        LAS unsigned short* mt2e = (LAS unsigned short*)(F.lds + MT2E_OFF); const unsigned t0 = base + incl - tiles; for (unsigned t = 0; t < tiles; ++t) mt2e[t0 + t] = (unsigned short)F.tid; }
    __syncthreads();
}
__device__ __forceinline__ void combine_rows(Frame& F, const float* gate2, const float* g_final, float* dst) {
    const unsigned char* Y = (const unsigned char*)(F.ws + WS_YBUF); const float* WT = (const float*)(F.ws + WS_WTS); const unsigned* PE = (const unsigned*)(F.ws + WS_POSE);
    const LAS unsigned* cp = (const LAS unsigned*)(F.lds + TAB_OFF) + 260 + 256;
    const int gw = F.vcu * NWAVES + F.wave, NGW = F.G * NWAVES; const int c0 = 16 * F.lane;
    const unsigned char* YS = (const unsigned char*)(F.ws + WS_YSH);
    struct CRow { u32x4 yv[8]; u32x4 ys, xb[2]; f32x4 w0, w1; };
#define CR_LOAD(R, m_) do { const size_t mq_ = (size_t)(m_); const unsigned pe_ = PE[mq_ * TOPK + (F.lane & 7)]; const unsigned myrow_ = cp[pe_ >> 16] + (pe_ & 0xffffu); \
        _Pragma("unroll") for (int k = 0; k < 8; ++k) { const size_t yr_ = (size_t)(unsigned)__builtin_amdgcn_readlane((int)myrow_, k); R.yv[k] = *(const GAS u32x4*)(Y + yr_ * DM + c0); } \
        R.ys = *(const GAS u32x4*)(YS + mq_ * DM + c0); const GAS u32x4* or_ = (const GAS u32x4*)(x1_row(F.ws, mq_) + c0); R.xb[0] = or_[0]; R.xb[1] = or_[1]; R.w0 = *(const GAS f32x4*)(WT + mq_ * TOPK); R.w1 = *(const GAS f32x4*)(WT + mq_ * TOPK + 4); } while (0)
    f32x4 gf[4];
#pragma unroll
    for (int j = 0; j < 4; ++j) gf[j] = *(const f32x4*)(g_final + c0 + 4 * j);
    for (int ch = gw; ch < M / 32; ch += NGW) {
        const int b = ch >> 7; const size_t rowb = (size_t)b * SEQ + (ch & 127);
        f32x4 g2[4];
#pragma unroll
        for (int j = 0; j < 4; ++j) g2[j] = *(const f32x4*)(gate2 + (size_t)b * NMOD + c0 + 4 * j) * (1.f / YSCALE);
        CRow nr; CR_LOAD(nr, rowb);
        for (int mm = 0; mm < 32; ++mm) { const size_t m = rowb + 128 * mm;
            CRow R = nr;
            if (mm + 1 < 32) CR_LOAD(nr, m + 128);
            const float wk[8] = {R.w0.x, R.w0.y, R.w0.z, R.w0.w, R.w1.x, R.w1.y, R.w1.z, R.w1.w};
            f32x4 acc[4];
#pragma unroll
            for (int j = 0; j < 4; ++j) { const int wv = (int)R.ys[j]; const f32x2 lo = __builtin_amdgcn_cvt_pk_f32_fp8(wv, false), hi = __builtin_amdgcn_cvt_pk_f32_fp8(wv, true); f32x4 a = (f32x4){lo.x, lo.y, hi.x, hi.y};
#pragma unroll
                for (int k = 0; k < 8; ++k) { const int wk_ = (int)R.yv[k][j]; const f32x2 l2 = __builtin_amdgcn_cvt_pk_f32_fp8(wk_, false), h2 = __builtin_amdgcn_cvt_pk_f32_fp8(wk_, true);
                    a.x += wk[k] * l2.x; a.y += wk[k] * l2.y; a.z += wk[k] * h2.x; a.w += wk[k] * h2.y; }
                acc[j] = a; __builtin_amdgcn_sched_barrier(0); }
            float s2 = 0.f; f32x4 v[4];
#pragma unroll
            for (int j = 0; j < 4; ++j) { const unsigned xa = R.xb[j >> 1][(j & 1) * 2], xc = R.xb[j >> 1][(j & 1) * 2 + 1]; const f32x4 xj = (f32x4){bf_lo(xa), bf_hi(xa), bf_lo(xc), bf_hi(xc)}; v[j] = xj + g2[j] * acc[j]; s2 += (v[j].x * v[j].x + v[j].y * v[j].y) + (v[j].z * v[j].z + v[j].w * v[j].w); }
            const float r = 1.f / sqrtf(wave_sum(s2) * (1.f / DM) + EPS);
            GAS f32x4* orow = (GAS f32x4*)(dst + m * DM + c0);
#pragma unroll
            for (int j = 0; j < 4; ++j) orow[j] = v[j] * r * gf[j];
        }
    }
#undef CR_LOAD
}

struct Args { const float* in[19]; float* out; unsigned char* ws; int ph_lo, ph_hi, li, pad; };
__global__ void __launch_bounds__(NWAVES * 64, 2) fwd_kernel(Args args) {
    extern __shared__ __attribute__((aligned(16))) unsigned char lds[];
    Frame F;
    F.lds = (LAS unsigned char*)lds;
    F.MISC = (volatile LAS unsigned*)(F.lds + MISC_OFF);
    F.tid = threadIdx.x; F.lane = F.tid & 63; F.wave = __builtin_amdgcn_readfirstlane(F.tid >> 6);
    F.G = gridDim.x; { const int bx = blockIdx.x; F.vcu = (F.G % 8 == 0) ? (bx % 8) * (F.G / 8) + bx / 8 : bx; }
    F.ws = args.ws; F.out = args.out; F.ctl = (gu32*)(args.ws + WS_CTL);
    unsigned char* ws = args.ws;
    typedef const __attribute__((address_space(4))) Args* KArgP;
#define KA(i) ({ KArgP p_ = (KArgP)__builtin_amdgcn_kernarg_segment_ptr(); asm volatile("" : "+s"(p_)); p_->in[i]; })
#define MOD ((float*)(ws + WS_MOD))
#define LF ((float*)(ws + WS_LF))
#define KB ((float*)(ws + WS_KB))
#define LSE ((float*)(ws + WS_LSE))
#define HB ((bf16_t*)(ws + WS_H))
#define QKV ((bf16_t*)(ws + WS_QKV))
#define LIST ((unsigned*)(ws + WS_LIST))
    for (int u = F.tid; u < (LDS_BYTES - LDSCTL_OFF) / 4; u += NWAVES * 64) ((LAS unsigned*)(F.lds + LDSCTL_OFF))[u] = 0u;
    __syncthreads();
    XcdBarrier bar; bar.bar = (unsigned*)(F.ctl + CW_BAR); bar.x = 0; bar.st = nullptr;
    if (N_LAUNCHES == 1) bar = xcd_barrier_post((unsigned*)(F.ctl + CW_BAR), F.MISC + 8);
#define GRID_BAR() do { if (N_LAUNCHES == 1) xcd_barrier(bar); } while (0)
#define REFRESH() do { int t_ = threadIdx.x; asm volatile("" : "+v"(t_)); F.tid = t_; F.lane = t_ & 63; } while (0)
    const int lo = args.ph_lo, hi = args.ph_hi;
#ifndef ONLY_PHASE
#define ONLY_PHASE -1
#endif
#define IN(k) ((ONLY_PHASE < 0 || ONLY_PHASE == (k)) && lo <= (k) && (k) < hi)
#define BOTH(k) (IN(k) && IN((k) + 1))

    if (IN(0)) {
        REFRESH();
        _Pragma("unroll") for (int rep_ = 0; rep_ < DUPN(0); ++rep_) {
        p0_mod(F, KA(1), KA(7), KA(8), MOD);
        P0Ptrs P{KA(2), KA(6), KA(9), KA(11), KA(12), KA(13), KA(14), KA(15), KA(16)};
        p0_weights(F, P, P0_EXPERT_ITEMS, P0_ALL_ITEMS); }
        if (BOTH(0)) GRID_BAR();
    }
    if (IN(1)) {
        REFRESH();
        _Pragma("unroll") for (int rep_ = 0; rep_ < DUPN(1); ++rep_) norm_rows<true>(F, KA(0), HB, MOD, 0, DM, KA(2), KA(3), LF, nullptr);
        if (BOTH(1)) GRID_BAR();
    }
    if (IN(2)) {
        REFRESH();
        _Pragma("unroll") for (int rep_ = 0; rep_ < DUPN(2); ++rep_) {
        scan_rows(F, LF, KB, (int*)(ws + WS_T0));
        pg8::Gemm g{HB, (const bf16_t*)(ws + WS_WIN), DM, nullptr}; pg8::StaticOrder S; S.init(M, 3072, F.G, (int)blockIdx.x);
        pg8::EpiQKV E{QKV, (size_t)M * HW, attn_body::C2};
        pg8::gemm_phase<pg8::EpiQKV, pg8::StaticOrder, false>(F.lds, g, S, E); }
        if (BOTH(2)) GRID_BAR();
    }
    if (IN(3)) {
        REFRESH();
        using attn_body::bf16; const float* rel_bias = KA(17);
        const bf16* Qf = (const bf16*)QKV; const bf16* Kf = Qf + (size_t)M * HW; const bf16* Vf = Kf + (size_t)M * HW;
        const bf16* Qd = Vf + (size_t)M * HW; const bf16* Kd = Qd + (size_t)M * HW; const bf16* Vd = Kd + (size_t)M * HW;
        bf16* OF = (bf16*)(ws + WS_OF);
        bool conv_done = false;
        const P0Ptrs PW{KA(2), KA(6), KA(9), KA(11), KA(12), KA(13), KA(14), KA(15), KA(16)};
        for (int cu = F.vcu; cu < 16 * BATCH; cu += F.G) {
            const int b = cu >> 4, j = cu & 15;
            int hc = 2 * (F.vcu % 5); asm volatile("" : "+s"(hc));
            for (int part = 0; part < 2; ++part) {
            if (part == 1 && !conv_done) { __syncthreads(); conv_experts(F, PW); __syncthreads(); conv_done = true; }
            const int h_lo = part ? hc : 0, h_hi = part ? NH : hc;
            for (int h = h_lo; h < h_hi; ++h) { const int q = (j + 4 * (h >> 1)) & 15; const int qb = (h & 1) ? 15 - q : q; const int bh = b * NH + h;
                const size_t hb = (size_t)b * SEQ * HW + h * HD; const int T0 = ((const int*)(ws + WS_T0))[bh * 16 + qb];
                if (DUPN(3) == 2) attn_body::attn_unit<8, 0>(Qf + hb, Kf + hb, Vf + hb, (bf16*)(ws + WS_SS0), (long)HW, 0L, qb * 256, T0, 4 * qb + 4 - T0, 0, nullptr, 0, (char*)lds, KB + (size_t)bh * SEQ, nullptr, 0);
                attn_body::attn_unit<8, 0>(Qf + hb, Kf + hb, Vf + hb, OF + hb, (long)HW, (long)HW, qb * 256, T0, 4 * qb + 4 - T0, 0, nullptr, 0, (char*)lds, KB + (size_t)bh * SEQ, nullptr, 0); }
            }
        }
        if (!conv_done) { __syncthreads(); conv_experts(F, PW); __syncthreads(); }
        for (int job = F.vcu; job < 2 * BATCH * NH; job += F.G) {
            const int bh = job >> 1, sub = job & 1, b = bh >> 3, h = bh & 7;
            const size_t hb = (size_t)b * SEQ * HW + h * HD;
            const int nd = sub ? 25 : 23; int tabkey = -1;
            { __syncthreads(); for (int i = F.tid; i < attn_body::DL_ZEND / 16; i += NWAVES * 64) *(LAS f32x4*)(F.lds + i * 16) = (f32x4){0.f, 0.f, 0.f, 0.f}; __syncthreads(); }
#define DIL_PARAMS(i_, dsel_, d_, r_, qb_) do { if ((i_) < 16) { if (sub == 0) { dsel_ = 0; d_ = 1; r_ = 0; qb_ = (i_); } else { dsel_ = 1; d_ = 4; r_ = (i_) >> 2; qb_ = (i_) & 3; } } \
                else { dsel_ = 2; d_ = 16; r_ = ((i_) - 16) + (sub ? 7 : 0); qb_ = 0; } } while (0)
            for (int i = 0; i < nd; ++i) {
                int dsel, d, r, qb; DIL_PARAMS(i, dsel, d, r, qb);
                int dseln = 0, dn = 1, rn = 0, qbn = 0; const bool has_next = (i + 1 < nd); if (has_next) DIL_PARAMS(i + 1, dseln, dn, rn, qbn);
                bf16* OB = (bf16*)(ws + (dsel == 0 ? WS_O1 : dsel == 1 ? WS_O2 : WS_O3));
                const size_t sb = hb + (size_t)r * HW, sbn = hb + (size_t)rn * HW;
                float* lsep = LSE + (size_t)dsel * M * NH + ((size_t)b * SEQ + r) * NH + h;
                const bool bt = (tabkey != dsel); tabkey = dsel;
                const attn_body::DilSrc cu{Kd + sb, Vd + sb, (long)d * HW, qb * 256, qb == 0}, nx{Kd + sbn, Vd + sbn, (long)dn * HW, qbn * 256, qbn == 0};
                _Pragma("unroll") for (int rep_ = 0; rep_ < DUPN(3); ++rep_)
                attn_body::dil_unit<8>(Qd + sb, cu, (i & 1) ? attn_body::DL_KB : attn_body::DL_K, i > 0 && DUPN(3) == 1, nx, has_next && DUPN(3) == 1, OB + sb, lsep, (long)d * NH, (char*)lds, rel_bias + h, dsel, bt); }
#undef DIL_PARAMS
        }
        if (BOTH(3)) GRID_BAR();
    }
    if (IN(4)) {
        REFRESH();
        _Pragma("unroll") for (int rep_ = 0; rep_ < DUPN(4); ++rep_) merge_rows(F, KA(4), KA(5));
        if (BOTH(4)) GRID_BAR();
    }
    if (IN(5)) {
        REFRESH();
        _Pragma("unroll") for (int rep_ = 0; rep_ < DUPN(5); ++rep_) {
        pg8::Gemm g{(const bf16_t*)(ws + WS_YM), (const bf16_t*)(ws + WS_WOUT), DM, nullptr}; pg8::StaticOrder S; S.init(M, DM, F.G, (int)blockIdx.x);
        pg8::EpiX1N E{KA(0), ws, MOD, F.lds, (float*)(ws + WS_EX), (unsigned*)(F.ctl + CW_X1)};
        pg8::gemm_phase<pg8::EpiX1N, pg8::StaticOrder, false>(F.lds, g, S, E); }
        if (BOTH(5)) GRID_BAR();
    }
    if (IN(6)) {
        REFRESH();
        (void)0;
    }
    if (IN(7)) {
        REFRESH();
        float* LOGITS = (float*)(ws + WS_LOGITS); const float* rbias_ = KA(10);
        { pg8::Gemm g{HB, (const bf16_t*)(ws + WS_WR), DM, nullptr}; pg8::StaticOrder S; S.init(M, NEXP, F.G, (int)blockIdx.x);
          pg8::EpiF32 E{LOGITS, NEXP};
          pg8::gemm_phase<pg8::EpiF32, pg8::StaticOrder, false>(F.lds, g, S, E);
          asm volatile("s_waitcnt vmcnt(0)" ::: "memory"); __syncthreads();
          pg8::Unit u; for (int i = 0; S.next(i, u); ++i) route_rows(F, u.pm, LOGITS, rbias_, LIST, (float*)(ws + WS_WTS), (unsigned*)(ws + WS_POSE)); }
        _Pragma("unroll") for (int rep_ = 0; rep_ < DUPN(7); ++rep_)
        { pg8::Gemm g{HB, (const bf16_t*)(ws + WS_WSHGU), DM, nullptr}; pg8::StaticOrder S; S.init(M, 512, F.G, (int)blockIdx.x);
          pg8::EpiSwiglu E{(bf16_t*)(ws + WS_ACTSH)};
          pg8::gemm_phase<pg8::EpiSwiglu, pg8::StaticOrder, false>(F.lds, g, S, E); }
        if (BOTH(7)) GRID_BAR();
    }
    if (IN(8)) {
        REFRESH();
        { pg8::Gemm g{(const bf16_t*)(ws + WS_ACTSH), (const bf16_t*)(ws + WS_WSHD), EH, nullptr}; pg8::StaticOrder S; S.init(M, DM, F.G, (int)blockIdx.x);
          pg8::EpiYbuf E{ws + WS_YSH, ws + WS_DUMP};
          pg8::gemm_phase<pg8::EpiYbuf, pg8::StaticOrder, false, false, true, 0, HOIST_SD>(F.lds, g, S, E); }
        build_tables(F);
#if PROBE_G1
        { pg8::Gemm g{(const bf16_t*)(ws + WS_H8), (const bf16_t*)(ws + WS_WGU), DM / 2, LIST};
          pg8::GroupedOrder S{(const LAS unsigned*)(F.lds + TAB_OFF), (const LAS unsigned*)(F.lds + TAB_OFF) + 260, 2, F.G, F.vcu, 2, 0, 0, (const LAS unsigned short*)(F.lds + MT2E_OFF)}; S.total = __builtin_amdgcn_readfirstlane((int)S.tp[256]) * 2;
          pg8::EpiSwiglu8 E{ws + WS_ACT};
          pg8::gemm_phase<pg8::EpiSwiglu8, pg8::GroupedOrder, true, true, true, PROBE_G1>(F.lds, g, S, E); }
#endif
        _Pragma("unroll") for (int rep_ = 0; rep_ < DUPN(8); ++rep_)
        { pg8::Gemm g{(const bf16_t*)(ws + WS_H8), (const bf16_t*)(ws + WS_WGU), DM / 2, LIST};
          pg8::GroupedOrder S{(const LAS unsigned*)(F.lds + TAB_OFF), (const LAS unsigned*)(F.lds + TAB_OFF) + 260, 2, F.G, F.vcu, 2, 0, 0, (const LAS unsigned short*)(F.lds + MT2E_OFF)}; S.total = __builtin_amdgcn_readfirstlane((int)S.tp[256]) * 2;
          pg8::EpiSwiglu8 E{ws + WS_ACT};
          pg8::gemm_phase<pg8::EpiSwiglu8, pg8::GroupedOrder, true, true, true, 0, HOIST_G1>(F.lds, g, S, E); }
        if (BOTH(8)) GRID_BAR();
    }
    if (IN(9)) {
        REFRESH();
        build_tables(F);
#if PROBE_G2
        { pg8::Gemm g{(const bf16_t*)(ws + WS_ACT), (const bf16_t*)(ws + WS_WD), EH / 2, LIST};
          pg8::GroupedOrder S{(const LAS unsigned*)(F.lds + TAB_OFF), (const LAS unsigned*)(F.lds + TAB_OFF) + 260, 4, F.G, F.vcu, 4, 0, 0, (const LAS unsigned short*)(F.lds + MT2E_OFF)}; S.total = __builtin_amdgcn_readfirstlane((int)S.tp[256]) * 4;
          pg8::EpiYbuf E{(unsigned char*)(ws + WS_YBUF), ws + WS_DUMP};
          pg8::gemm_phase<pg8::EpiYbuf, pg8::GroupedOrder, false, true, true, PROBE_G2>(F.lds, g, S, E); }
#endif
        _Pragma("unroll") for (int rep_ = 0; rep_ < DUPN(9); ++rep_)
        { pg8::Gemm g{(const bf16_t*)(ws + WS_ACT), (const bf16_t*)(ws + WS_WD), EH / 2, LIST};
          pg8::GroupedOrder S{(const LAS unsigned*)(F.lds + TAB_OFF), (const LAS unsigned*)(F.lds + TAB_OFF) + 260, 4, F.G, F.vcu, 4, 0, 0, (const LAS unsigned short*)(F.lds + MT2E_OFF)}; S.total = __builtin_amdgcn_readfirstlane((int)S.tp[256]) * 4;
          pg8::EpiYbuf E{(unsigned char*)(ws + WS_YBUF), ws + WS_DUMP};
          pg8::gemm_phase<pg8::EpiYbuf, pg8::GroupedOrder, false, true, true, 0, HOIST_G2>(F.lds, g, S, E); }
        if (BOTH(9)) GRID_BAR();
    }
    if (IN(10)) {
        REFRESH();
        build_tables(F);
        if (DUPN(10) == 2) combine_rows(F, MOD + 5 * DM, KA(18), (float*)(ws + WS_ACT));
        combine_rows(F, MOD + 5 * DM, KA(18), F.out);
    }
#undef KA
#undef MOD
#undef LF
#undef KB
#undef LSE
#undef HB
#undef QKV
#undef LIST
#undef REFRESH
#undef IN
#undef BOTH
#undef GRID_BAR
}

extern "C" void kernel_launch(void* const* d_in, const int* in_sizes, int n_in, void* d_out, int out_size, void* d_ws, size_t ws_size, hipStream_t stream) {
    static int grid = 0;
    if (grid == 0) {
        if (n_in != 19 || in_sizes[0] != M * DM || out_size != M * DM || ws_size < WS_NEED) {
            fprintf(stderr, "kernel_launch: unexpected shapes: n_in %d in0 %d out %d ws %zu (need %zu); nothing launched\n", n_in, n_in > 0 ? in_sizes[0] : -1, out_size, ws_size, (size_t)WS_NEED); grid = -1; return; }
        int dev = 0, cus = 0, per_cu = 0;
        if (hipGetDevice(&dev) != hipSuccess || hipDeviceGetAttribute(&cus, hipDeviceAttributeMultiprocessorCount, dev) != hipSuccess) { fprintf(stderr, "kernel_launch: device query failed\n"); grid = -1; return; }
        if (hipFuncSetAttribute((const void*)fwd_kernel, hipFuncAttributeMaxDynamicSharedMemorySize, LDS_BYTES) != hipSuccess) { fprintf(stderr, "kernel_launch: hipFuncSetAttribute failed\n"); grid = -1; return; }
        if (hipOccupancyMaxActiveBlocksPerMultiprocessor(&per_cu, (const void*)fwd_kernel, NWAVES * 64, LDS_BYTES) != hipSuccess || per_cu < 1)
            fprintf(stderr, "kernel_launch: note: occupancy query reports %d workgroups per CU\n", per_cu);
        (void)hipGetLastError();
        grid = cus;
    }
    if (grid < 0) return;
    if (hipMemsetAsync((char*)d_ws + WS_CTL, 0, CTL_ZERO_BYTES, stream) != hipSuccess) { fprintf(stderr, "kernel_launch: memset failed\n"); return; }
    Args a{};
    for (int i = 0; i < 19; ++i) a.in[i] = (const float*)d_in[i];
    a.out = (float*)d_out; a.ws = (unsigned char*)d_ws; a.pad = 0;
    for (int li = 0; li < N_LAUNCHES; ++li) {
        a.ph_lo = (N_LAUNCHES == 1) ? 0 : li; a.ph_hi = (N_LAUNCHES == 1) ? NPHASE : li + 1; a.li = li;
        hipLaunchKernelGGL(fwd_kernel, dim3(grid), dim3(NWAVES * 64), LDS_BYTES, stream, a);
        const hipError_t le = hipPeekAtLastError();
        if (le != hipSuccess) { fprintf(stderr, "kernel_launch: launch %d failed: %s\n", li, hipGetErrorName(le)); break; }
    }
}
```

```cpp
#include <hip/hip_runtime.h>
#include <hip/hip_bf16.h>
#include <cstdio>
#include <cstdint>

#ifndef DUP_MASK
#define DUP_MASK 0
#endif
#ifndef CONV_PROBE
#define CONV_PROBE 0
#endif
#ifndef OUT8
#define OUT8 1
#endif
#ifndef SH8
#define SH8 1
#endif
#ifndef HOIST_SD
#define HOIST_SD false
#endif
#ifndef HOIST_G1
#define HOIST_G1 false
#endif
#ifndef HOIST_G2
#define HOIST_G2 true
#endif
#ifndef PROBE_G1
#define PROBE_G1 0
#endif
#ifndef PROBE_G2
#define PROBE_G2 0
#endif
#define DUPN(k) (((DUP_MASK >> (k)) & 1) ? 2 : 1)
#ifndef MK_N_LAUNCHES
#define MK_N_LAUNCHES 1
#endif

#define GAS __attribute__((address_space(1)))
#define LAS __attribute__((address_space(3)))

constexpr int BATCH = 16, SEQ = 4096, DM = 1024, M = BATCH * SEQ;
constexpr int NH = 8, HD = 64, HW = NH * HD;
constexpr int INC = 3080;
constexpr int NEXP = 256, TOPK = 8, EH = 256;
constexpr int NMOD = 6 * DM;
constexpr int LCAP = 65536;
constexpr float LOG2E = 1.4426950408889634f;
constexpr float EPS = 1e-6f;
constexpr float FOX_SKIP_LOG2 = 80.f;
constexpr float YSCALE = 16.f;
constexpr int NWAVES = 8;
constexpr int NPHASE = 11;
constexpr int N_LAUNCHES = MK_N_LAUNCHES;

constexpr size_t MiB = 1u << 20;
constexpr size_t WS_CTL = 0, CTL_ZERO_BYTES = 1 * MiB;
constexpr size_t WS_DUMP = 512 * 1024;
constexpr size_t WS_MOD = 1 * MiB;
constexpr size_t WS_LF = 2 * MiB;
constexpr size_t WS_KB = 4 * MiB;
constexpr size_t WS_LSE = 6 * MiB;
constexpr size_t WS_WIN = 12 * MiB;
constexpr size_t WS_WOUT = 18 * MiB;
constexpr size_t WS_WR = 20 * MiB;
constexpr size_t WS_WSHGU = WS_WR + MiB / 2;
constexpr size_t WS_WSHD = WS_WSHGU + MiB;
constexpr size_t WS_WTS = 22 * MiB;
constexpr size_t WS_SS0 = WS_MOD + MiB / 2;
constexpr size_t WS_T0 = WS_MOD + MiB / 2 + 65536;
constexpr size_t WS_WD = 24 * MiB;
constexpr size_t WS_WGU = 88 * MiB;
constexpr size_t WS_LIST = 216 * MiB;
constexpr size_t WS_O3 = WS_LIST;
constexpr size_t WS_H = 280 * MiB;
constexpr size_t WS_H8 = 408 * MiB;
constexpr size_t WS_QKV = 472 * MiB;
constexpr size_t WS_ACT = 856 * MiB;
constexpr size_t WS_YSH = 792 * MiB;
constexpr size_t WS_X1A = 728 * MiB;
constexpr size_t WS_X1B = 1000 * MiB;
constexpr size_t WS_END = 1000 * MiB, WS_NEED = 1064 * MiB;
constexpr size_t WS_YBUF = WS_LIST;
constexpr size_t WS_EX = WS_LSE + 4 * MiB;
constexpr size_t WS_POSE = WS_LSE;
constexpr size_t WS_OF = WS_QKV;
constexpr size_t WS_O1 = WS_H, WS_O2 = WS_H + 64 * MiB;
constexpr size_t WS_YM = WS_QKV + 64 * MiB;
constexpr size_t WS_LOGITS = WS_QKV;
constexpr size_t WS_ACTSH = WS_QKV + 64 * MiB;
static_assert(WS_ACT + (size_t)(M * TOPK + NEXP * 256) * EH <= WS_END, "act fits");
static_assert(WS_YBUF + (size_t)M * TOPK * DM <= WS_X1A && WS_X1A + 64 * MiB <= WS_YSH && WS_YSH + (size_t)M * DM <= WS_ACT && WS_X1B + 64 * MiB <= WS_NEED, "ybuf (unpadded rows), x1, ysh fit below act");
static_assert(WS_QKV + 6 * 64 * MiB <= WS_ACT, "qkv below act");
constexpr int CW_TMO = 0, CW_BAR = 4096, CW_CNT = 8192, CW_X1 = 12288;

constexpr int RING_BYTES = 131072;
constexpr int PHASE_LDS = 158720;
constexpr int LDSCTL_OFF = PHASE_LDS, MISC_OFF = LDSCTL_OFF + 320;
constexpr int TAB_OFF = MISC_OFF + 128;
constexpr int RLIST_OFF = RING_BYTES + 2304 * 2;
constexpr int MT2E_OFF = RING_BYTES;
constexpr int LDS_BYTES = 163840;
static_assert(TAB_OFF + 800 * 4 <= LDS_BYTES, "LDS map");

typedef unsigned short bf16_t;
typedef short bf16x8 __attribute__((ext_vector_type(8)));
typedef float f32x4 __attribute__((ext_vector_type(4)));
typedef float f32x2 __attribute__((ext_vector_type(2)));
typedef unsigned u32x4 __attribute__((ext_vector_type(4)));
typedef unsigned u32x2 __attribute__((ext_vector_type(2)));
typedef GAS unsigned gu32;
typedef int v4i_t __attribute__((ext_vector_type(4)));
typedef int v8i_t __attribute__((ext_vector_type(8)));
#define RLX_AGENT __ATOMIC_RELAXED, __HIP_MEMORY_SCOPE_AGENT

__device__ __forceinline__ unsigned cvt_pk_bf16(float lo, float hi) { unsigned r; asm volatile("v_cvt_pk_bf16_f32 %0, %1, %2" : "=v"(r) : "v"(lo), "v"(hi)); return r; }
__device__ __forceinline__ float bf_lo(unsigned w) { return __uint_as_float(w << 16); }
__device__ __forceinline__ float bf_hi(unsigned w) { return __uint_as_float(w & 0xffff0000u); }
__device__ __forceinline__ bf16_t* x1_row(unsigned char* ws, size_t m) { return (bf16_t*)(ws + (m < 32768 ? WS_X1A + m * 2048 : WS_X1B + (m - 32768) * 2048)); }
#define DPPF_(x, ctrl, rm) __int_as_float(__builtin_amdgcn_update_dpp(0, __float_as_int(x), ctrl, rm, 0xF, false))
__device__ __forceinline__ float wave_sum(float v) {
    v += DPPF_(v, 0xB1, 0xF); v += DPPF_(v, 0x4E, 0xF); v += DPPF_(v, 0x141, 0xF); v += DPPF_(v, 0x140, 0xF);
    v += DPPF_(v, 0x142, 0xA); v += DPPF_(v, 0x143, 0xC);
    return __int_as_float(__builtin_amdgcn_readlane(__float_as_int(v), 63));
}
__device__ __forceinline__ float reduce8_heads(const float (&f)[8], int lane) {
    float a[4], b[2];
#pragma unroll
    for (int i = 0; i < 4; ++i) { auto rr = __builtin_amdgcn_permlane32_swap(__float_as_uint(f[i]), __float_as_uint(f[i + 4]), false, false); a[i] = __uint_as_float(rr[0]) + __uint_as_float(rr[1]); }
#pragma unroll
    for (int i = 0; i < 2; ++i) { auto rr = __builtin_amdgcn_permlane16_swap(__float_as_uint(a[i]), __float_as_uint(a[i + 2]), false, false); b[i] = __uint_as_float(rr[0]) + __uint_as_float(rr[1]); }
    const bool b3 = (lane & 8) != 0; const float mine = b3 ? b[1] : b[0], give = b3 ? b[0] : b[1];
    float v = mine + DPPF_(give, 0x128, 0xF);
    v += DPPF_(v, 0xB1, 0xF); v += DPPF_(v, 0x4E, 0xF); v += DPPF_(v, 0x141, 0xF);
    return v;
}

__device__ const unsigned char T5B[3][132] = {
 {0,1,2,3,4,5,6,7,8,9,10,11,12,13,14,15,16,16,16,16,16,16,17,17,17,17,17,17,17,17,18,18,18,18,18,18,18,18,18,18,19,19,19,19,19,19,19,19,19,19,19,19,19,19,20,20,20,20,20,20,20,20,20,20,20,20,20,20,20,20,20,20,20,21,21,21,21,21,21,21,21,21,21,21,21,21,21,21,21,21,21,21,21,21,21,21,21,21,21,22,22,22,22,22,22,22,22,22,22,22,22,22,22,22,22,22,22,22,22,22,22,22,22,22,22,22,22,22,22,0,0,0},
 {0,4,8,12,16,16,17,17,18,18,19,19,19,19,20,20,20,20,20,21,21,21,21,21,21,22,22,22,22,22,22,22,22,22,23,23,23,23,23,23,23,23,23,23,23,23,24,24,24,24,24,24,24,24,24,24,24,24,24,24,24,24,25,25,25,25,25,25,25,25,25,25,25,25,25,25,25,25,25,25,25,25,25,26,26,26,26,26,26,26,26,26,26,26,26,26,26,26,26,26,26,26,26,26,26,26,26,26,26,26,26,26,26,27,27,27,27,27,27,27,27,27,27,27,27,27,27,27,27,0,0,0},
 {0,16,18,19,20,21,21,22,22,23,23,23,24,24,24,24,25,25,25,25,25,26,26,26,26,26,26,26,26,27,27,27,27,27,27,27,27,27,27,28,28,28,28,28,28,28,28,28,28,28,28,28,29,29,29,29,29,29,29,29,29,29,29,29,29,29,29,29,29,29,30,30,30,30,30,30,30,30,30,30,30,30,30,30,30,30,30,30,30,30,30,30,30,30,30,31,31,31,31,31,31,31,31,31,31,31,31,31,31,31,31,31,31,31,31,31,31,31,31,31,31,31,31,31,31,31,31,31,31,0,0,0}};

namespace pg8 {
constexpr int BM = 256, BK = 64, HALF = 128, HTB = HALF * BK * 2, STAGE_BYTES = 8 * HTB, NXCD = 8, WGM = 8;
__host__ __device__ __forceinline__ int lds_byte(int r, int c) { const int st = (r >> 4) * 2 + (c >> 5), rr = r & 15, cc = c & 31, ob = rr * 64 + cc * 2; return st * 1024 + (ob ^ (((ob >> 9) & 1) << 5)); }
__host__ __device__ __forceinline__ void stage_rc(int b, int& R, int& C) { const int st = b / 1024, sb = b % 1024, swz = sb ^ (((sb >> 9) & 1) << 5); R = (st >> 1) * 16 + swz / 64; C = (st & 1) * 32 + (swz % 64) / 2; }
__host__ __device__ __forceinline__ int perm32(int rho) { const int n = rho >> 4, i = rho & 15; return 8 * (i >> 2) + 4 * n + (i & 3); }

struct Unit { int pm, pn, pb, e, tile, cnt, yrow; };
struct Gemm { const bf16_t* A; const bf16_t* Bt; int K; const unsigned* list; };

struct StaticOrder {
    int nM, nN, nwg, G, c;
    __device__ void init(int Mr, int N, int G_, int c_) { nM = Mr / BM; nN = N / BM; nwg = nM * nN; G = G_; c = c_; }
    __device__ bool next(int i, Unit& u) const {
        const int L = i * G + c; if (L >= nwg) return false;
        int wgid = L; { const int q = nwg / NXCD, r = nwg % NXCD, xcd = wgid % NXCD, off = wgid / NXCD; wgid = (xcd < r ? xcd * (q + 1) : r * (q + 1) + (xcd - r) * q) + off; }
        const int nig = WGM * nN, gid = wgid / nig, fm = gid * WGM, gsz = (nM - fm) < WGM ? (nM - fm) : WGM;
        u.pm = fm + ((wgid % nig) % gsz); u.pn = (wgid % nig) / gsz; u.pb = u.pn; u.e = 0; u.tile = 0; u.cnt = 1 << 30; u.yrow = u.pm * BM; return true;
    }
};
struct GroupedOrder {
    const LAS unsigned* tp; const LAS unsigned* cn; int NT, G, c, NTB, pn0, total;
    const LAS unsigned short* mt2e;
    int rev = 0;
    __device__ bool next(int i, Unit& u) const {
        const int L = i * G + c; if (L >= total) return false;
        const int mt = rev ? (total / NT - 1 - L / NT) : L / NT; u.pn = L % NT;
        const int lo = __builtin_amdgcn_readfirstlane((int)mt2e[mt]);
        u.e = lo; u.pm = mt; u.tile = mt - __builtin_amdgcn_readfirstlane((int)tp[lo]); u.pb = lo * NTB + pn0 + u.pn; u.cnt = __builtin_amdgcn_readfirstlane((int)cn[lo]); u.yrow = __builtin_amdgcn_readfirstlane((int)cn[256 + lo]) + u.tile * BM; return true;
    }
};

struct EpiQKV {
    static constexpr bool PERM = true; static constexpr int NVM = 16;
    bf16_t* O; size_t split_stride; float scale0;
    __device__ __forceinline__ void operator()(const f32x4 (&acc)[2][2][4][2], const Unit& u, int wr, int wc, int fr, int fq) const {
        const int row0 = u.pm * BM + wr * 64 + fr; int colt = u.pn * BM; const int t = colt / 512; bf16_t* base = O + (size_t)t * split_stride; colt -= t * 512;
        const float sc = (t == 0 || t == 3) ? scale0 : 1.f;
        const int col0 = colt + wc * 32 + 8 * fq;
#pragma unroll
        for (int ai = 0; ai < 2; ++ai)
#pragma unroll
            for (int m = 0; m < 4; ++m) { bf16_t* rowp = base + (size_t)(row0 + ai * HALF + m * 16) * 512 + col0;
#pragma unroll
                for (int bj = 0; bj < 2; ++bj) { const f32x4 v0 = acc[ai][bj][m][0] * sc, v1 = acc[ai][bj][m][1] * sc;
                    u32x4 w; w.x = cvt_pk_bf16(v0[0], v0[1]); w.y = cvt_pk_bf16(v0[2], v0[3]); w.z = cvt_pk_bf16(v1[0], v1[1]); w.w = cvt_pk_bf16(v1[2], v1[3]);
                    *(u32x4*)(rowp + bj * HALF) = w; } }
    }
};
struct EpiSwiglu {
    static constexpr bool PERM = true; static constexpr int NVM = 8;
    bf16_t* O;
    __device__ __forceinline__ void operator()(const f32x4 (&acc)[2][2][4][2], const Unit& u, int wr, int wc, int fr, int fq) const {
        const int row0 = u.pm * BM + wr * 64 + fr; const int col0 = u.pn * HALF + wc * 32 + 8 * fq;
#pragma unroll
        for (int ai = 0; ai < 2; ++ai)
#pragma unroll
            for (int m = 0; m < 4; ++m) { bf16_t* rowp = O + (size_t)(row0 + ai * HALF + m * 16) * EH + col0; float r[8];
#pragma unroll
                for (int n = 0; n < 2; ++n)
#pragma unroll
                    for (int i = 0; i < 4; ++i) { const float g = acc[ai][0][m][n][i], up = acc[ai][1][m][n][i]; r[n * 4 + i] = g * __builtin_amdgcn_rcpf(1.f + __expf(-g)) * up; }
                u32x4 w; w.x = cvt_pk_bf16(r[0], r[1]); w.y = cvt_pk_bf16(r[2], r[3]); w.z = cvt_pk_bf16(r[4], r[5]); w.w = cvt_pk_bf16(r[6], r[7]);
                *(u32x4*)rowp = w; }
    }
};
struct EpiSwiglu8 {
    static constexpr bool PERM = true; static constexpr int NVM = 4;
    unsigned char* O;
    __device__ __forceinline__ void operator()(const f32x4 (&acc)[2][2][4][2], const Unit& u, int wr, int wc, int fr, int fq) const {
        const size_t row0 = (size_t)u.pm * BM + wr * 64 + fr + (fq & 1) * HALF; const int col0 = u.pn * HALF + wc * 32 + 8 * (fq & 2);
#pragma unroll
        for (int m = 0; m < 4; ++m) { unsigned w[2][2];
#pragma unroll
            for (int ai = 0; ai < 2; ++ai) { float r[8];
#pragma unroll
                for (int n = 0; n < 2; ++n)
#pragma unroll
                    for (int i = 0; i < 4; ++i) { const float g = acc[ai][0][m][n][i], up = acc[ai][1][m][n][i]; r[n * 4 + i] = g * __builtin_amdgcn_rcpf(1.f + __expf(-g)) * up; }
                int w0 = __builtin_amdgcn_cvt_pk_fp8_f32(r[0], r[1], 0, false); w0 = __builtin_amdgcn_cvt_pk_fp8_f32(r[2], r[3], w0, true);
                int w1 = __builtin_amdgcn_cvt_pk_fp8_f32(r[4], r[5], 0, false); w1 = __builtin_amdgcn_cvt_pk_fp8_f32(r[6], r[7], w1, true);
                w[ai][0] = (unsigned)w0; w[ai][1] = (unsigned)w1; }
            const auto s0 = __builtin_amdgcn_permlane16_swap(w[0][0], w[1][0], false, false); const auto s1 = __builtin_amdgcn_permlane16_swap(w[0][1], w[1][1], false, false);
            u32x4 o; o.x = s0[0]; o.y = s1[0]; o.z = s0[1]; o.w = s1[1];
            *(u32x4*)(O + (row0 + m * 16) * EH + col0) = o; }
    }
};
struct EpiRes {
    static constexpr bool PERM = true; static constexpr int NVM = 0;
    const float* base; float* out; const float* gate;
    __device__ __forceinline__ void operator()(const f32x4 (&acc)[2][2][4][2], const Unit& u, int wr, int wc, int fr, int fq) const {
        const int b = u.pm >> 4; const int col0 = u.pn * BM + wc * 32 + 8 * fq; f32x4 gv[2][2];
#pragma unroll
        for (int bj = 0; bj < 2; ++bj)
#pragma unroll
            for (int n = 0; n < 2; ++n) gv[bj][n] = *(const f32x4*)(gate + (size_t)b * NMOD + col0 + bj * HALF + n * 4);
#pragma unroll
        for (int ai = 0; ai < 2; ++ai)
#pragma unroll
            for (int m = 0; m < 4; ++m) { const size_t off = (size_t)(u.pm * BM + ai * HALF + wr * 64 + m * 16 + fr) * DM + col0;
#pragma unroll
                for (int bj = 0; bj < 2; ++bj)
#pragma unroll
                    for (int n = 0; n < 2; ++n) { const f32x4 bs = *(const f32x4*)(base + off + bj * HALF + n * 4); *(f32x4*)(out + off + bj * HALF + n * 4) = bs + gv[bj][n] * acc[ai][bj][m][n]; } }
    }
};
struct EpiX1 {
    static constexpr bool PERM = true; static constexpr int NVM = 8;
    const float* base; unsigned char* ws; const float* gate;
    __device__ __forceinline__ void operator()(const f32x4 (&acc)[2][2][4][2], const Unit& u, int wr, int wc, int fr, int fq) const {
        const int b = u.pm >> 4; const int col0 = u.pn * BM + wc * 32 + 8 * fq; f32x4 gv[2][2];
#pragma unroll
        for (int bj = 0; bj < 2; ++bj)
#pragma unroll
            for (int n = 0; n < 2; ++n) gv[bj][n] = *(const f32x4*)(gate + (size_t)b * NMOD + col0 + bj * HALF + n * 4);
#pragma unroll
        for (int ai = 0; ai < 2; ++ai) { f32x4 pre[4][2][2];
#pragma unroll
            for (int m = 0; m < 4; ++m) { const size_t off = ((size_t)u.pm * BM + ai * HALF + wr * 64 + m * 16 + fr) * DM + col0;
#pragma unroll
                for (int bj = 0; bj < 2; ++bj) { pre[m][bj][0] = *(const f32x4*)(base + off + bj * HALF); pre[m][bj][1] = *(const f32x4*)(base + off + bj * HALF + 4); } }
            asm volatile("" ::: "memory");
#pragma unroll
            for (int m = 0; m < 4; ++m) { const size_t row = (size_t)u.pm * BM + ai * HALF + wr * 64 + m * 16 + fr; bf16_t* orow = x1_row(ws, row) + col0;
#pragma unroll
                for (int bj = 0; bj < 2; ++bj) { const f32x4 v0 = pre[m][bj][0] + gv[bj][0] * acc[ai][bj][m][0], v1 = pre[m][bj][1] + gv[bj][1] * acc[ai][bj][m][1];
                    u32x4 w; w.x = cvt_pk_bf16(v0[0], v0[1]); w.y = cvt_pk_bf16(v0[2], v0[3]); w.z = cvt_pk_bf16(v1[0], v1[1]); w.w = cvt_pk_bf16(v1[2], v1[3]);
                    *(u32x4*)(orow + bj * HALF) = w; } }
            asm volatile("" ::: "memory"); }
    }
};
struct EpiX1N {
    static constexpr bool PERM = true; static constexpr int NVM = 0;
    const float* base; unsigned char* ws; const float* mod; LAS unsigned char* lds; float* ex; unsigned* cnt;
    __device__ __forceinline__ void operator()(f32x4 (&acc)[2][2][4][2], const Unit& u, int wr, int wc, int fr, int fq) const {
        const int b = u.pm >> 4; const int col0 = u.pn * BM + wc * 32 + 8 * fq; const float* mb = mod + (size_t)b * NMOD;
        LAS float* red = (LAS float*)(lds + RING_BYTES); LAS float* rr = red + 4 * BM;
        float ss[2][4];
        { f32x4 gv[2][2];
#pragma unroll
          for (int bj = 0; bj < 2; ++bj)
#pragma unroll
            for (int n = 0; n < 2; ++n) gv[bj][n] = *(const f32x4*)(mb + 2 * DM + col0 + bj * HALF + n * 4);
#pragma unroll
          for (int ai = 0; ai < 2; ++ai)
#pragma unroll
            for (int bj = 0; bj < 2; ++bj)
#pragma unroll
              for (int m = 0; m < 4; ++m) { acc[ai][bj][m][0] *= gv[bj][0]; acc[ai][bj][m][1] *= gv[bj][1]; }
          asm volatile("" ::: "memory");
#pragma unroll
          for (int bt = 0; bt < 3; ++bt) { constexpr int RB = 3; const int r0 = RB * bt; f32x4 pre[RB][2][2];
#pragma unroll
            for (int rr_ = 0; rr_ < RB; ++rr_) { const int r = r0 + rr_; if (r < 8) { const int ai = r >> 2, m = r & 3; const size_t off = ((size_t)u.pm * BM + ai * HALF + wr * 64 + m * 16 + fr) * DM + col0;
#pragma unroll
                for (int bj = 0; bj < 2; ++bj) { pre[rr_][bj][0] = *(const f32x4*)(base + off + bj * HALF); pre[rr_][bj][1] = *(const f32x4*)(base + off + bj * HALF + 4); } } }
            asm volatile("" ::: "memory");
#pragma unroll
            for (int rr_ = 0; rr_ < RB; ++rr_) { const int r = r0 + rr_; if (r < 8) { const int ai = r >> 2, m = r & 3; float s2 = 0.f;
#pragma unroll
                for (int bj = 0; bj < 2; ++bj) { const f32x4 v0 = pre[rr_][bj][0] + acc[ai][bj][m][0], v1 = pre[rr_][bj][1] + acc[ai][bj][m][1];
                    acc[ai][bj][m][0] = v0; acc[ai][bj][m][1] = v1;
                    s2 += ((v0[0] * v0[0] + v0[1] * v0[1]) + (v0[2] * v0[2] + v0[3] * v0[3])) + ((v1[0] * v1[0] + v1[1] * v1[1]) + (v1[2] * v1[2] + v1[3] * v1[3])); }
                { const auto p_ = __builtin_amdgcn_permlane16_swap(__float_as_uint(s2), __float_as_uint(s2), false, false); s2 = __uint_as_float(p_[0]) + __uint_as_float(p_[1]); }
                { const auto p_ = __builtin_amdgcn_permlane32_swap(__float_as_uint(s2), __float_as_uint(s2), false, false); s2 = __uint_as_float(p_[0]) + __uint_as_float(p_[1]); }
                ss[ai][m] = s2; } }
            asm volatile("" ::: "memory"); } }
        if (fq == 0) {
#pragma unroll
            for (int ai = 0; ai < 2; ++ai)
#pragma unroll
                for (int m = 0; m < 4; ++m) red[wc * BM + ai * HALF + wr * 64 + m * 16 + fr] = ss[ai][m]; }
        __syncthreads();
        int tid_ = threadIdx.x; asm volatile("" : "+v"(tid_)); const int tid = tid_; unsigned* slot = (unsigned*)ex + ((size_t)u.pm * 4) * BM;
        if (tid < BM) { const float tot = (red[tid] + red[BM + tid]) + (red[2 * BM + tid] + red[3 * BM + tid]);
            __hip_atomic_store(slot + u.pn * BM + tid, __float_as_uint(tot), __ATOMIC_RELAXED, __HIP_MEMORY_SCOPE_AGENT); }
        asm volatile("s_waitcnt vmcnt(0)" ::: "memory");
        __syncthreads();
        if (tid == 0) (void)__hip_atomic_fetch_add(cnt + u.pm, 1u, __ATOMIC_RELAXED, __HIP_MEMORY_SCOPE_AGENT);
#pragma unroll
        for (int ai = 0; ai < 2; ++ai)
#pragma unroll
            for (int m = 0; m < 4; ++m) { const size_t row = (size_t)u.pm * BM + ai * HALF + wr * 64 + m * 16 + fr; bf16_t* orow = x1_row(ws, row) + col0;
#pragma unroll
                for (int bj = 0; bj < 2; ++bj) { const f32x4 v0 = acc[ai][bj][m][0], v1 = acc[ai][bj][m][1];
                    u32x4 w; w.x = cvt_pk_bf16(v0[0], v0[1]); w.y = cvt_pk_bf16(v0[2], v0[3]); w.z = cvt_pk_bf16(v1[0], v1[1]); w.w = cvt_pk_bf16(v1[2], v1[3]);
                    __builtin_nontemporal_store(w, (u32x4*)(orow + bj * HALF)); }
                __builtin_amdgcn_sched_barrier(0); }
        f32x4 sc[2][2], sh[2][2];
#pragma unroll
        for (int bj = 0; bj < 2; ++bj)
#pragma unroll
            for (int n = 0; n < 2; ++n) { sc[bj][n] = *(const f32x4*)(mb + 4 * DM + col0 + bj * HALF + n * 4) + 1.f; sh[bj][n] = *(const f32x4*)(mb + 3 * DM + col0 + bj * HALF + n * 4); }
        if (tid == 0) { unsigned sp = 0; while (__hip_atomic_load(cnt + u.pm, __ATOMIC_RELAXED, __HIP_MEMORY_SCOPE_AGENT) < 4u) { __builtin_amdgcn_s_sleep(1); if (++sp > (1u << 22)) break; } }
        __syncthreads();
        if (tid < BM) { float t4 = 0.f;
#pragma unroll
            for (int q = 0; q < 4; ++q) t4 += __uint_as_float(__hip_atomic_load(slot + q * BM + tid, __ATOMIC_RELAXED, __HIP_MEMORY_SCOPE_AGENT));
            rr[tid] = 1.f / sqrtf(t4 * (1.f / DM) + EPS); }
        __syncthreads();
        bf16_t* H2 = (bf16_t*)(ws + WS_H); unsigned char* H8 = ws + WS_H8;
        const int col8 = u.pn * BM + (fq & 1) * HALF + wc * 32 + 8 * (fq & 2);
#pragma unroll
        for (int ai = 0; ai < 2; ++ai)
#pragma unroll
            for (int m = 0; m < 4; ++m) { const int rl = ai * HALF + wr * 64 + m * 16 + fr; const size_t row = (size_t)u.pm * BM + rl; const float r = rr[rl]; unsigned w8[2][2];
#pragma unroll
                for (int bj = 0; bj < 2; ++bj) { const f32x4 h0 = acc[ai][bj][m][0] * r * sc[bj][0] + sh[bj][0], h1 = acc[ai][bj][m][1] * r * sc[bj][1] + sh[bj][1];
                    u32x4 w; w.x = cvt_pk_bf16(h0[0], h0[1]); w.y = cvt_pk_bf16(h0[2], h0[3]); w.z = cvt_pk_bf16(h1[0], h1[1]); w.w = cvt_pk_bf16(h1[2], h1[3]);
                    *(u32x4*)(H2 + row * DM + col0 + bj * HALF) = w;
                    int q0 = __builtin_amdgcn_cvt_pk_fp8_f32(h0[0], h0[1], 0, false); q0 = __builtin_amdgcn_cvt_pk_fp8_f32(h0[2], h0[3], q0, true);
                    int q1 = __builtin_amdgcn_cvt_pk_fp8_f32(h1[0], h1[1], 0, false); q1 = __builtin_amdgcn_cvt_pk_fp8_f32(h1[2], h1[3], q1, true);
                    w8[bj][0] = (unsigned)q0; w8[bj][1] = (unsigned)q1; }
                const auto s0 = __builtin_amdgcn_permlane16_swap(w8[0][0], w8[1][0], false, false); const auto s1 = __builtin_amdgcn_permlane16_swap(w8[0][1], w8[1][1], false, false);
                u32x4 o; o.x = s0[0]; o.y = s1[0]; o.z = s0[1]; o.w = s1[1];
                *(u32x4*)(H8 + row * DM + col8) = o; }
    }
};
struct EpiF32 {
    static constexpr bool PERM = false; static constexpr int NVM = 16;
    float* out; int ldc;
    __device__ __forceinline__ void operator()(const f32x4 (&acc)[2][2][4][2], const Unit& u, int wr, int wc, int fr, int fq) const {
        const int col0 = u.pn * BM + wc * 32 + 4 * fq;
#pragma unroll
        for (int ai = 0; ai < 2; ++ai)
#pragma unroll
            for (int m = 0; m < 4; ++m) { const size_t off = (size_t)(u.pm * BM + ai * HALF + wr * 64 + m * 16 + fr) * ldc + col0;
#pragma unroll
                for (int bj = 0; bj < 2; ++bj)
#pragma unroll
                    for (int n = 0; n < 2; ++n) *(f32x4*)(out + off + bj * HALF + n * 16) = acc[ai][bj][m][n]; }
    }
};
struct EpiYbuf {
    static constexpr bool PERM = true; static constexpr int NVM = 8;
    unsigned char* Y; unsigned char* dump;
    __device__ __forceinline__ void operator()(const f32x4 (&acc)[2][2][4][2], const Unit& u, int wr, int wc, int fr, int fq) const {
        const int colb = u.pn * BM + wc * 64 + (fq & 1) * 32 + 8 * (fq & 2);
#pragma unroll
        for (int ai = 0; ai < 2; ++ai)
#pragma unroll
            for (int m = 0; m < 4; ++m) { const int rl = ai * HALF + wr * 64 + m * 16 + fr; const size_t row = (size_t)u.yrow + rl; const bool live = u.tile * BM + rl < u.cnt;
                unsigned w[2][2];
#pragma unroll
                for (int bj = 0; bj < 2; ++bj) { f32x4 v0 = acc[ai][bj][m][0] * YSCALE, v1 = acc[ai][bj][m][1] * YSCALE;
#pragma unroll
                    for (int i = 0; i < 4; ++i) { v0[i] = __builtin_amdgcn_fmed3f(v0[i], -440.f, 440.f); v1[i] = __builtin_amdgcn_fmed3f(v1[i], -440.f, 440.f); }
                    int w0 = __builtin_amdgcn_cvt_pk_fp8_f32(v0[0], v0[1], 0, false); w0 = __builtin_amdgcn_cvt_pk_fp8_f32(v0[2], v0[3], w0, true);
                    int w1 = __builtin_amdgcn_cvt_pk_fp8_f32(v1[0], v1[1], 0, false); w1 = __builtin_amdgcn_cvt_pk_fp8_f32(v1[2], v1[3], w1, true);
                    w[bj][0] = (unsigned)w0; w[bj][1] = (unsigned)w1; }
                const auto s0 = __builtin_amdgcn_permlane16_swap(w[0][0], w[1][0], false, false); const auto s1 = __builtin_amdgcn_permlane16_swap(w[0][1], w[1][1], false, false);
                u32x4 o; o.x = s0[0]; o.y = s1[0]; o.z = s0[1]; o.w = s1[1];
                __builtin_nontemporal_store(o, (u32x4*)(live ? Y + row * DM + colb : dump + (size_t)rl * DM + colb)); }
    }
};

template <class Epi, class Sched, bool GATHER, bool FP8 = false, bool SHORTK = false, int VAR = 0, bool HOIST = false>
__device__ __forceinline__ void gemm_phase(LAS unsigned char* lds, const Gemm g, const Sched& S, const Epi& E) {
    int tid_ = threadIdx.x; asm volatile("" : "+v"(tid_));
    const int tid = tid_, wid = __builtin_amdgcn_readfirstlane(tid >> 6), lane = tid & 63, wr = wid >> 2, wc = wid & 3, fr = lane & 15, fq = lane >> 4;
    int K_ = g.K; if constexpr (SHORTK) asm volatile("" : "+s"(K_));
    const int K = K_, nt = K / BK;
    unsigned voffA[2], voffB[2];
#pragma unroll
    for (int i = 0; i < 2; ++i) { int R, C; stage_rc(tid * 16 + i * 8192, R, C); const int Rb = Epi::PERM ? ((R & ~31) + perm32(R & 31)) : R;
        voffA[i] = (unsigned)(R * K + C) * 2u; voffB[i] = (unsigned)(Rb * K + C) * 2u; }
    const size_t kstep = (size_t)(BK * 2);
    const size_t hstep = (size_t)HALF * K * 2;
    const size_t tstep = 2 * hstep;
    const unsigned ldsw = (unsigned)wid * 1024u;
    const int aoff = lds_byte(wr * 64 + fr, fq * 8), boff = lds_byte(wc * 32 + fr, fq * 8);
#define PG8_SA(b, h) (((b) * 2 + (h)) * HTB)
#define PG8_SB(b, h) ((4 + (b) * 2 + (h)) * HTB)
#define PG8_GLDS(src, bufoff, i) if constexpr (!(VAR & 1)) __builtin_amdgcn_global_load_lds((const unsigned*)(src), (LAS unsigned*)(lds + (bufoff) + ldsw + (i) * 8192), 16, 0, 0)
#define PG8_STAGE(bufoff, gbase, voff) do { _Pragma("unroll") for (int _i = 0; _i < 2; ++_i) PG8_GLDS((const char*)(gbase) + (voff)[_i], bufoff, _i); } while (0)
#define PG8_STA(bufoff, aptr, h, SEL) do { if constexpr (GATHER) { const unsigned _p = (SEL) ? gvn[h] : gvc[h]; _Pragma("unroll") for (int _i = 0; _i < 2; ++_i) { unsigned _c = voffB[_i]; asm volatile("" : "+v"(_c)); \
            const unsigned _o = ((_i ? (_p >> 16) : (_p & 0xffffu)) * (unsigned)(K * 2)) + (_c & (unsigned)(K * 2 - 1)); PG8_GLDS((const char*)(aptr) + _o, bufoff, _i); } } \
        else { PG8_STAGE(bufoff, (const char*)(aptr) + (h) * hstep, voffA); } } while (0)
#define PG8_LDA(dst, b, h) do { _Pragma("unroll") for (int m = 0; m < 4; ++m) _Pragma("unroll") for (int k = 0; k < 2; ++k) dst[m][k] = *(const LAS bf16x8*)(lds + PG8_SA(b, h) + aoff + m * 2048 + k * 1024); } while (0)
#define PG8_LDB(dst, b, h) do { _Pragma("unroll") for (int n = 0; n < 2; ++n) _Pragma("unroll") for (int k = 0; k < 2; ++k) dst[n][k] = *(const LAS bf16x8*)(lds + PG8_SB(b, h) + boff + n * 2048 + k * 1024); } while (0)
#define PG8_CAT8(lo, hi) ({ const v4i_t a_ = __builtin_bit_cast(v4i_t, lo), b_ = __builtin_bit_cast(v4i_t, hi); (v8i_t){a_.x, a_.y, a_.z, a_.w, b_.x, b_.y, b_.z, b_.w}; })
#define PG8_MMA(ai, bj, At, Bt) do { __builtin_amdgcn_s_setprio(1); if constexpr (VAR & 2) { asm volatile("" :: "v"(At[0][0]), "v"(At[3][1]), "v"(Bt[0][0]), "v"(Bt[1][1])); } else if constexpr (FP8) { _Pragma("unroll") for (int m = 0; m < 4; ++m) _Pragma("unroll") for (int n = 0; n < 2; ++n) \
        acc[ai][bj][m][n] = __builtin_amdgcn_mfma_scale_f32_16x16x128_f8f6f4(PG8_CAT8(Bt[n][0], Bt[n][1]), PG8_CAT8(At[m][0], At[m][1]), acc[ai][bj][m][n], 0, 0, 0, 0x7F7F7F7F, 0, 0x7F7F7F7F); } \
      else { _Pragma("unroll") for (int m = 0; m < 4; ++m) _Pragma("unroll") for (int n = 0; n < 2; ++n) _Pragma("unroll") for (int k = 0; k < 2; ++k) \
        acc[ai][bj][m][n] = __builtin_amdgcn_mfma_f32_16x16x32_bf16(Bt[n][k], At[m][k], acc[ai][bj][m][n], 0, 0, 0); } \
      if constexpr (SHORTK) { _Pragma("unroll") for (int m = 0; m < 4; ++m) _Pragma("unroll") for (int n = 0; n < 2; ++n) asm volatile("" : "+v"(acc[ai][bj][m][n])); }     \
      __builtin_amdgcn_s_setprio(0); } while (0)
#define PG8_WAIT_V(n) asm volatile("s_waitcnt vmcnt(" #n ")" ::: "memory")
#define PG8_WAIT_VF() do { if (fst) asm volatile("s_waitcnt vmcnt(%0)" :: "n"(8 + NQ) : "memory"); else asm volatile("s_waitcnt vmcnt(8)" ::: "memory"); } while (0)
#define PG8_WAIT_L(n) asm volatile("s_waitcnt lgkmcnt(" #n ")" ::: "memory")
#define PG8_BAR __builtin_amdgcn_s_barrier()
#define PG8_SCHED __builtin_amdgcn_sched_barrier(0)
#define PG8_ROWS_LOAD(u, ld) do { _Pragma("unroll") for (int _h = 0; _h < 2; ++_h) _Pragma("unroll") for (int _i = 0; _i < 2; ++_i) { int _R, _C; stage_rc(tid * 16 + _i * 8192, _R, _C); const int _idx = (u).tile * BM + _h * HALF + _R; \
            const int _ic = _idx < (u).cnt ? _idx : (u).cnt - 1; ld[_h][_i] = g.list[(size_t)(u).e * LCAP + _ic]; } } while (0)
#define PG8_ROWS_USE(u, ld, gv) do { asm volatile("" : "+v"(ld[0][0]), "+v"(ld[0][1]), "+v"(ld[1][0]), "+v"(ld[1][1])); \
        _Pragma("unroll") for (int _h = 0; _h < 2; ++_h) { unsigned _t2[2]; _Pragma("unroll") for (int _i = 0; _i < 2; ++_i) { int _R, _C; stage_rc(tid * 16 + _i * 8192, _R, _C); const int _idx = (u).tile * BM + _h * HALF + _R; \
            _t2[_i] = (_idx < (u).cnt) ? (ld[_h][_i] & 0xffffu) : 0u; } gv[_h] = _t2[0] | (_t2[1] << 16); } } while (0)
    constexpr int NQ = Epi::NVM + (GATHER ? 1 : 0);
#define PG8_ROWS_DMA(u) __builtin_amdgcn_global_load_lds((const unsigned*)(g.list + (size_t)(u).e * LCAP + (u).tile * BM + (wid & 3) * 64 + lane), (LAS unsigned*)(lds + RLIST_OFF + (wid & 3) * 256), 4, 0, 0)
#define PG8_ROWS_USE_LDS(u, gv) do { _Pragma("unroll") for (int _h = 0; _h < 2; ++_h) { unsigned _t2[2]; _Pragma("unroll") for (int _i = 0; _i < 2; ++_i) { int _R, _C; stage_rc(tid * 16 + _i * 8192, _R, _C); const int _idx = (u).tile * BM + _h * HALF + _R; \
            const unsigned _v = *(const LAS unsigned*)(lds + RLIST_OFF + (_h * HALF + _R) * 4); _t2[_i] = (_idx < (u).cnt) ? (_v & 0xffffu) : 0u; } gv[_h] = _t2[0] | (_t2[1] << 16); } } while (0)
    Unit cur, nxt; int ui = 0;
    if (!S.next(0, cur)) return;
    f32x4 acc[2][2][4][2];
#pragma unroll
    for (int a = 0; a < 2; ++a)
#pragma unroll
        for (int b = 0; b < 2; ++b)
#pragma unroll
            for (int m = 0; m < 4; ++m)
#pragma unroll
                for (int n = 0; n < 2; ++n) acc[a][b][m][n] = (f32x4){0.f, 0.f, 0.f, 0.f};
    bf16x8 At[4][2], B0[2][2], B1[2][2];
    unsigned gvc[2] = {0u, 0u}, gvn[2] = {0u, 0u};
    if constexpr (GATHER) { unsigned rld[2][2]; PG8_ROWS_LOAD(cur, rld); PG8_ROWS_USE(cur, rld, gvc); }
    const char* cA = GATHER ? (const char*)g.A : (const char*)g.A + (size_t)cur.pm * tstep; const char* cB = (const char*)g.Bt + (size_t)cur.pb * tstep;
    PG8_STAGE(PG8_SB(0, 0), cB, voffB); PG8_STAGE(PG8_SB(0, 1), cB + hstep, voffB); PG8_STA(PG8_SA(0, 0), cA, 0, false); PG8_STA(PG8_SA(0, 1), cA, 1, false);
    if (wr == 1) PG8_BAR;
    PG8_WAIT_V(2); PG8_BAR;
    PG8_STAGE(PG8_SB(1, 0), cB + kstep, voffB); PG8_STA(PG8_SA(1, 0), cA + kstep, 0, false); PG8_STAGE(PG8_SB(1, 1), cB + hstep + kstep, voffB);
    PG8_WAIT_V(6); PG8_BAR;
    for (;;) {
        const bool has_next = S.next(ui + 1, nxt);
        const char* nA = has_next ? (GATHER ? (const char*)g.A : (const char*)g.A + (size_t)nxt.pm * tstep) : cA; const char* nB = has_next ? (const char*)g.Bt + (size_t)nxt.pb * tstep : cB;
        if constexpr (GATHER) { if (!has_next) { nxt = cur; gvn[0] = gvc[0]; gvn[1] = gvc[1]; } PG8_ROWS_DMA(nxt); }
        int t = 0;
        do {
            const bool last = (t == nt - 2);
            const bool fst = HOIST && (t == 0) && (ui > 0);
            if constexpr (GATHER) { if (last && has_next) { PG8_ROWS_USE_LDS(nxt, gvn); } }
            const char* a1 = cA + (size_t)(t + 1) * kstep;
            const char* a2 = last ? nA : cA + (size_t)(t + 2) * kstep; const char* b2 = last ? nB : cB + (size_t)(t + 2) * kstep;
            const char* a3 = a2 + kstep; const char* b3 = b2 + kstep;
            PG8_LDB(B0, 0, 0); PG8_LDB(B1, 0, 1); PG8_SCHED; PG8_LDA(At, 0, 0); if (!fst) PG8_STA(PG8_SA(1, 1), a1, 1, false);
            PG8_WAIT_VF(); PG8_WAIT_L(0); PG8_BAR; PG8_MMA(0, 0, At, B0); PG8_MMA(0, 1, At, B1); PG8_BAR; PG8_SCHED;
            PG8_LDA(At, 0, 1); PG8_STAGE(PG8_SB(0, 0), b2, voffB); PG8_STAGE(PG8_SB(0, 1), b2 + hstep, voffB); PG8_STA(PG8_SA(0, 0), a2, 0, last);
            PG8_WAIT_VF(); PG8_WAIT_L(0); PG8_BAR; PG8_MMA(1, 0, At, B0); PG8_MMA(1, 1, At, B1); PG8_BAR; PG8_SCHED;
            PG8_LDB(B0, 1, 0); PG8_LDB(B1, 1, 1); PG8_SCHED; PG8_LDA(At, 1, 0); PG8_STA(PG8_SA(0, 1), a2, 1, last);
            PG8_WAIT_VF(); PG8_WAIT_L(0); PG8_BAR; PG8_MMA(0, 0, At, B0); PG8_MMA(0, 1, At, B1); PG8_BAR; PG8_SCHED;
            PG8_LDA(At, 1, 1); PG8_STAGE(PG8_SB(1, 0), b3, voffB); PG8_STAGE(PG8_SB(1, 1), b3 + hstep, voffB); PG8_STA(PG8_SA(1, 0), a3, 0, last);
            PG8_WAIT_V(8); PG8_WAIT_L(0); PG8_BAR; PG8_MMA(1, 0, At, B0); PG8_MMA(1, 1, At, B1); PG8_BAR; PG8_SCHED;
            t += 2;
        } while (t < nt);
        if constexpr (HOIST) PG8_STA(PG8_SA(1, 1), nA + kstep, 1, true);
        if (wr == 0) PG8_BAR;
        { int te_ = threadIdx.x; asm volatile("" : "+v"(te_)); int fr_ = te_ & 15, fq_ = (te_ >> 4) & 3; asm volatile("" : "+v"(fr_), "+v"(fq_));
          if constexpr (!(VAR & 4)) E(acc, cur, wr, wc, fr_, fq_); else { _Pragma("unroll") for (int a = 0; a < 2; ++a) _Pragma("unroll") for (int b = 0; b < 2; ++b) _Pragma("unroll") for (int m = 0; m < 4; ++m) _Pragma("unroll") for (int n = 0; n < 2; ++n) asm volatile("" :: "v"(acc[a][b][m][n])); } }
        if (!has_next) break;
#pragma unroll
        for (int a = 0; a < 2; ++a)
#pragma unroll
            for (int b = 0; b < 2; ++b)
#pragma unroll
                for (int m = 0; m < 4; ++m)
#pragma unroll
                    for (int n = 0; n < 2; ++n) acc[a][b][m][n] = (f32x4){0.f, 0.f, 0.f, 0.f};
        cur = nxt; cA = nA; cB = nB; ++ui;
        if constexpr (GATHER) { gvc[0] = gvn[0]; gvc[1] = gvn[1]; }
        if (wr == 1) PG8_BAR;
    }
    PG8_WAIT_V(0);
    PG8_BAR;
#undef PG8_SA
#undef PG8_SB
#undef PG8_GLDS
#undef PG8_STAGE
#undef PG8_STA
#undef PG8_LDA
#undef PG8_LDB
#undef PG8_MMA
#undef PG8_CAT8
#undef PG8_WAIT_V
#undef PG8_WAIT_VF
#undef PG8_WAIT_L
#undef PG8_BAR
#undef PG8_SCHED
#undef PG8_ROWS_LOAD
#undef PG8_ROWS_USE
#undef PG8_ROWS_DMA
#undef PG8_ROWS_USE_LDS
}
}

namespace attn_body {
using bf16 = __hip_bfloat16;
using s16x4 = __attribute__((ext_vector_type(4))) short;
using f32x16 = __attribute__((ext_vector_type(16))) float;
constexpr int D = 64, NW = 8, QBLK = 32, QB = QBLK * NW, KVBLK = 64;
__device__ __forceinline__ int crow(int r, int hi) { return (r & 3) + 8 * (r >> 2) + 4 * hi; }
#define SBAR() __builtin_amdgcn_sched_barrier(0)
__device__ __forceinline__ void cmask(f32x16& p0, f32x16& p1, int jb, int qrel, int hi) {
  const float NEG = -INFINITY; int kb = 64 * jb + 4 * hi;
  #pragma unroll
  for (int r = 0; r < 16; ++r) { int kv = kb + (r & 3) + 8 * (r >> 2); if (kv > qrel) p0[r] = NEG; if (kv + 32 > qrel) p1[r] = NEG; }
}
constexpr int NSLOT = 3, SLOTB = 8192;
constexpr int LDS_K = 0, LDS_V = NSLOT * SLOTB, LDS_WS = 2 * NSLOT * SLOTB, LDS_OST = LDS_WS + NW * 64 * 4, LDS_BYTES = LDS_OST + NW * 4096;
constexpr int LDS_KBT = LDS_BYTES;
constexpr int LDS_TREV = LDS_KBT + 16384;
constexpr int LDS_TOTAL = LDS_TREV + 3072;
constexpr float C2 = 0.125f * 1.4426950408889634f;
__device__ __forceinline__ void glds16(const void* gsrc, unsigned lds_dst) { unsigned keep;
  asm volatile("s_mov_b32 %0, m0\n\ts_mov_b32 m0, %2\n\ts_nop 0\n\tglobal_load_lds_dwordx4 %1, off\n\ts_mov_b32 m0, %0" : "=&s"(keep) : "v"(gsrc), "s"(lds_dst) : "memory"); }
__device__ __forceinline__ float max3f(float a, float b, float c) { float r; asm("v_max3_f32 %0, %1, %2, %3" : "=v"(r) : "v"(a), "v"(b), "v"(c)); return r; }
__device__ __forceinline__ float max2f(float a, float b) { float r; asm("v_max_f32_e32 %0, %1, %2" : "=v"(r) : "v"(a), "v"(b)); return r; }
__device__ __forceinline__ float fadd_s(float a, float b) { float r; asm("v_add_f32_e32 %0, %1, %2" : "=v"(r) : "v"(a), "v"(b)); return r; }
__device__ __forceinline__ float fsub_s(float a, float b) { float r; asm("v_sub_f32_e32 %0, %1, %2" : "=v"(r) : "v"(a), "v"(b)); return r; }
typedef float f32x2_t __attribute__((ext_vector_type(2))); typedef __bf16 bf16x2_t __attribute__((ext_vector_type(2)));
__device__ __forceinline__ unsigned cvtpk_s(float lo, float hi) { f32x2_t v = {lo, hi}; bf16x2_t b = __builtin_convertvector(v, bf16x2_t); return __builtin_bit_cast(unsigned, b); }
#define WAIT_BAR(N) asm volatile("s_waitcnt vmcnt(" #N ") lgkmcnt(0)\n\ts_barrier" ::: "memory")

__device__ __forceinline__ void qkt(f32x16& p0, f32x16& p1, const char* Kslot, const bf16x8* qr, int r32, int hi) {
  const char* kb = Kslot + hi * 1024 + r32 * 16;
  #pragma unroll
  for (int d0 = 0; d0 < 4; ++d0) {
    const bf16x8 b0 = *reinterpret_cast<const bf16x8*>(kb + d0 * 2048);
    const bf16x8 b1 = *reinterpret_cast<const bf16x8*>(kb + d0 * 2048 + 512);
    p0 = __builtin_amdgcn_mfma_f32_32x32x16_bf16(b0, qr[d0], p0, 0, 0, 0); p1 = __builtin_amdgcn_mfma_f32_32x32x16_bf16(b1, qr[d0], p1, 0, 0, 0); }
}
typedef __attribute__((address_space(3))) const char* lds_cptr;
typedef short v4i16_t __attribute__((ext_vector_type(4)));
__device__ __forceinline__ void kload8(bf16x8* kf, lds_cptr kp) {
  kf[0] = *(const LAS bf16x8*)(kp);        kf[1] = *(const LAS bf16x8*)(kp + 512);
  kf[2] = *(const LAS bf16x8*)(kp + 2048); kf[3] = *(const LAS bf16x8*)(kp + 2560);
  kf[4] = *(const LAS bf16x8*)(kp + 4096); kf[5] = *(const LAS bf16x8*)(kp + 4608);
  kf[6] = *(const LAS bf16x8*)(kp + 6144); kf[7] = *(const LAS bf16x8*)(kp + 6656);
}
__device__ __forceinline__ void kload2(bf16x8* kf, lds_cptr kp, int j) { kf[2 * j] = *(const LAS bf16x8*)(kp + j * 2048); kf[2 * j + 1] = *(const LAS bf16x8*)(kp + j * 2048 + 512); }
__device__ __forceinline__ s16x4 vtr(lds_cptr p) { return __builtin_bit_cast(s16x4, __builtin_amdgcn_ds_read_tr16_b64_v4i16((LAS v4i16_t*)p)); }
__device__ __forceinline__ float rowmax(const f32x16& p0, const f32x16& p1) {
  float a = max3f(p0[0], p0[1], p1[0]), b = max3f(p0[2], p0[3], p1[1]); a = max3f(a, p1[2], p1[3]);
  #pragma unroll
  for (int r = 4; r < 16; r += 4) { a = max3f(a, p0[r], p0[r + 1]); b = max3f(b, p0[r + 2], p0[r + 3]); a = max3f(a, p1[r], p1[r + 1]); b = max3f(b, p1[r + 2], p1[r + 3]); }
  const float m = max2f(a, b);
  auto rr = __builtin_amdgcn_permlane32_swap(__float_as_uint(m), __float_as_uint(m), false, false);
  return max2f(__uint_as_float(rr[0]), __uint_as_float(rr[1]));
}
__device__ __forceinline__ void pv(f32x16* o, int vb, bf16x8 pa0, bf16x8 pa1, bf16x8 pa2, bf16x8 pa3) {
  #pragma unroll
  for (int d0 = 0; d0 < 2; ++d0) { s16x4 lo[4], hi[4];
    #pragma unroll
    for (int ks = 0; ks < 4; ++ks) {
      asm volatile("ds_read_b64_tr_b16 %0,%1 offset:%c2" : "=&v"(lo[ks]) : "v"(vb), "i"(d0 * 4096 + ks * 1024) : "memory");
      asm volatile("ds_read_b64_tr_b16 %0,%1 offset:%c2" : "=&v"(hi[ks]) : "v"(vb), "i"(d0 * 4096 + ks * 1024 + 512) : "memory"); }
    asm volatile("s_waitcnt lgkmcnt(0)" ::: "memory"); SBAR();
    #define PK(k) (bf16x8){lo[k][0], lo[k][1], lo[k][2], lo[k][3], hi[k][0], hi[k][1], hi[k][2], hi[k][3]}
    o[d0] = __builtin_amdgcn_mfma_f32_32x32x16_bf16(pa0, PK(0), o[d0], 0, 0, 0);
    o[d0] = __builtin_amdgcn_mfma_f32_32x32x16_bf16(pa1, PK(1), o[d0], 0, 0, 0);
    o[d0] = __builtin_amdgcn_mfma_f32_32x32x16_bf16(pa2, PK(2), o[d0], 0, 0, 0);
    o[d0] = __builtin_amdgcn_mfma_f32_32x32x16_bf16(pa3, PK(3), o[d0], 0, 0, 0);
    #undef PK
  }
}
#define ATTN_STORE16(p, v) (*(u32x4*)(p) = (v))
template <int THRL, int MODE> __device__ __forceinline__ void attn_unit(const bf16* Qp, const bf16* __restrict__ Kp, const bf16* __restrict__ Vp, bf16* Op, long RS, long ORS, int q0, int T0, int NT, int off,
                                                                        float* lsep, long lse_stride, char* shm, const float* kbsrc, const float* relb, int dsel) {
  int tid_ = threadIdx.x; asm volatile("" : "+v"(tid_));
  const int tid = tid_, lane = tid & 63, r32 = lane & 31, hi = lane >> 5; const int wid = __builtin_amdgcn_readfirstlane(tid >> 6);
  const bf16* Qw = Qp + (long)(q0 + wid * QBLK) * RS;
  const bf16* Kh = Kp + (long)T0 * KVBLK * RS, *Vh = Vp + (long)T0 * KVBLK * RS;
  const unsigned lds0 = (unsigned)(uintptr_t)shm;
  float* wsf = (float*)(shm + LDS_WS) + wid * 64;
  const int qrel = wid * QBLK + r32;
  const LAS float* tbase;
  if (MODE == 0) { LAS float* kbt = (LAS float*)(shm + LDS_KBT); const int nk = q0 + QB;
    for (int i = 64 * T0 + tid * 4; i < nk; i += 2048) *(LAS f32x4*)(kbt + i) = *(const f32x4*)(kbsrc + i);
    tbase = kbt + 4 * hi + 64 * T0;
  } else { LAS float* tr = (LAS float*)(shm + LDS_TREV);
    for (int u = tid; u < 768; u += 512) { const int j = 383 - u; float v = -INFINITY; if (j >= 0 && j <= 128) v = relb[(int)T5B[dsel][j] * NH] * LOG2E; tr[u] = v; }
    tbase = tr + (383 - off - qrel + 4 * hi);
  }
  const bf16* ksrc = Kh + (long)lane * RS + wid * 8;
  const bf16* vsrc = Vh + (long)(16 * (wid & 3) + (lane >> 2)) * RS + (wid >> 2) * 32 + (lane & 3) * 8;
  const unsigned kdst = lds0 + LDS_K + wid * 1024, vdst = lds0 + LDS_V + wid * 1024;
  #define DMA_K(t, slot) glds16(ksrc + (long)(t) * KVBLK * RS, (unsigned)__builtin_amdgcn_readfirstlane(kdst + (slot)))
  #define DMA_V(t, slot) glds16(vsrc + (long)(t) * KVBLK * RS, (unsigned)__builtin_amdgcn_readfirstlane(vdst + (slot)))
  const int vb0 = (int)(lds0 + LDS_V) + ((lane >> 4) & 1) * 32 + (lane & 3) * 8 + (4 * hi + ((lane & 15) >> 2)) * 64;
  const char* Kbase = shm + LDS_K; bf16x8 kf[8];
  const lds_cptr shm3 = (lds_cptr)shm; const lds_cptr kp0 = shm3 + LDS_K + hi * 1024 + r32 * 16; const lds_cptr vp0 = shm3 + LDS_V + ((lane >> 4) & 1) * 32 + (lane & 3) * 8 + (4 * hi + ((lane & 15) >> 2)) * 64;
  DMA_K(0, 0); DMA_V(0, 0); DMA_K(1, SLOTB);
  bf16x8 qr[4];
  #pragma unroll
  for (int d0 = 0; d0 < 4; ++d0) qr[d0] = *reinterpret_cast<const bf16x8*>(&Qw[(long)r32 * RS + d0 * 16 + hi * 8]);
  float mhat = 0.f, l_reg = 0.f; f32x16 o[2]; o[0] = f32x16{}; o[1] = f32x16{};
  #define BLOAD(P0, P1, t) do { const LAS float* tb_ = tbase + 64 * (t); \
      if (MODE == 0) { _Pragma("unroll") for (int g_ = 0; g_ < 4; ++g_) { const f32x4 b0_ = *(const LAS f32x4*)(tb_ + 8 * g_), b1_ = *(const LAS f32x4*)(tb_ + 32 + 8 * g_); \
          _Pragma("unroll") for (int i_ = 0; i_ < 4; ++i_) { P0[4 * g_ + i_] = b0_[i_]; P1[4 * g_ + i_] = b1_[i_]; } } } \
      else { _Pragma("unroll") for (int r_ = 0; r_ < 16; ++r_) { P0[r_] = tb_[(r_ & 3) + 8 * (r_ >> 2)]; P1[r_] = tb_[32 + (r_ & 3) + 8 * (r_ >> 2)]; } } } while (0)
  #define CMASK(P0, P1, t) do { if (MODE == 0) { int jb_ = (t) - (NT - 4); if (jb_ >= 0) cmask(P0, P1, jb_, qrel, hi); } } while (0)
  bool resc = false;
  #define START(P0, P1) do { const float rm = rowmax(P0, P1); resc = false; mhat = max2f(rm, -1000.f); \
    _Pragma("unroll") for (int r = 0; r < 16; ++r) P0[r] = __builtin_amdgcn_exp2f(fsub_s(P0[r], mhat)); } while (0)
  #define RESC() do { if (resc) { asm volatile("s_waitcnt lgkmcnt(0)" ::: "memory"); \
      _Pragma("unroll") for (int d_ = 0; d_ < 2; ++d_) _Pragma("unroll") for (int r = 0; r < 16; ++r) o[d_][r] *= wsf[crow(r, hi)]; } } while (0)
  f32x16 pA0, pA1, pB0, pB1;
  int sl_prev = 0, sl_cur = 0, sl_next = SLOTB;
  #define ROT() do { sl_prev = sl_cur; sl_cur = sl_next; sl_next = (sl_next == (NSLOT - 1) * SLOTB) ? 0 : sl_next + SLOTB; } while (0)
  DMA_K(2, 2 * SLOTB);
  WAIT_BAR(3);
  BLOAD(pA0, pA1, 0);
  qkt(pA0, pA1, Kbase, qr, r32, hi); asm volatile("s_nop 15\n\ts_nop 7" : "+v"(pA0), "+v"(pA1)); CMASK(pA0, pA1, 0);
  START(pA0, pA1);
  _Pragma("unroll") for (int r = 0; r < 16; ++r) pA1[r] = __builtin_amdgcn_exp2f(fsub_s(pA1[r], mhat));
  BLOAD(pB0, pB1, 1);
  WAIT_BAR(0);
  DMA_K(3, 0); DMA_V(1, SLOTB);
  ROT();
  kload8(kf, kp0 + sl_cur);
  WAIT_BAR(2);
  s16x4 vlo[8], vhi[8]; u32x4 pw0, pw1, pw2, pw3;
  #define PKW(P, B) cvtpk_s(P[B], P[B + 1])
  #define PAF(k) __builtin_bit_cast(bf16x8, pw##k)
  #define VFR(i) (bf16x8){vlo[i][0], vlo[i][1], vlo[i][2], vlo[i][3], vhi[i][0], vhi[i][1], vhi[i][2], vhi[i][3]}
  #define PIN(x) asm volatile("" : "+v"(x))
  #define MX3(a, b, c) __builtin_fmaxf(__builtin_fmaxf((a), (b)), (c))
  #define GAPA(MF, A0, A1, A2, A3, W0, W1, PW) do { MF; sacc += A0; sacc += A1; sacc += A2; sacc += A3; PIN(sacc); W0; W1; PIN(PW); SBAR(); } while (0)
  #define EX(v) __builtin_amdgcn_exp2f(v)
  #define GAPB(MF, X, B) do { MF; X[B] = EX(X[B] - mhat); X[B + 1] = EX(X[B + 1] - mhat); X[B + 2] = EX(X[B + 2] - mhat); X[B + 3] = EX(X[B + 3] - mhat); PIN(X); SBAR(); } while (0)
  #define VRD(i) do { vlo[i] = vtr(vp_ + (((i) >> 2) * 4096 + ((i) & 3) * 1024)); vhi[i] = vtr(vp_ + (((i) >> 2) * 4096 + ((i) & 3) * 1024 + 512)); } while (0)
  #define KRD(G, j) do { if (G) { kload2(kf, kp0 + sl_next, j); SBAR(); } } while (0)
  #define STEP(C0, C1, P0, P1, t, GK, GV, GL) do { SBAR(); \
    const lds_cptr vp_ = vp0 + sl_prev; \
    VRD(0); SBAR(); float sacc = (P0[0] + P0[1]); \
    GAPA(C0 = __builtin_amdgcn_mfma_f32_32x32x16_bf16(kf[0], qr[0], C0, 0, 0, 0), P0[2], P0[3], P0[4], P0[5],     pw0[0] = PKW(P0, 0), pw0[1] = PKW(P0, 2), pw0); \
    VRD(4); SBAR(); GAPA(C1 = __builtin_amdgcn_mfma_f32_32x32x16_bf16(kf[1], qr[0], C1, 0, 0, 0), P0[6], P0[7], P0[8], P0[9],     pw0[2] = PKW(P0, 4), pw0[3] = PKW(P0, 6), pw0); \
    VRD(1); SBAR(); GAPA(C0 = __builtin_amdgcn_mfma_f32_32x32x16_bf16(kf[2], qr[1], C0, 0, 0, 0),   P0[10], P0[11], P0[12], P0[13], pw1[0] = PKW(P0, 8), pw1[1] = PKW(P0, 10), pw1); \
    VRD(5); SBAR(); GAPA(C1 = __builtin_amdgcn_mfma_f32_32x32x16_bf16(kf[3], qr[1], C1, 0, 0, 0),   P0[14], P0[15], P1[0], P1[1],   pw1[2] = PKW(P0, 12), pw1[3] = PKW(P0, 14), pw1); \
    VRD(2); SBAR(); GAPA(C0 = __builtin_amdgcn_mfma_f32_32x32x16_bf16(kf[4], qr[2], C0, 0, 0, 0),   P1[2], P1[3], P1[4], P1[5],     pw2[0] = PKW(P1, 0), pw2[1] = PKW(P1, 2), pw2); \
    VRD(6); SBAR(); GAPA(C1 = __builtin_amdgcn_mfma_f32_32x32x16_bf16(kf[5], qr[2], C1, 0, 0, 0),   P1[6], P1[7], P1[8], P1[9],     pw2[2] = PKW(P1, 4), pw2[3] = PKW(P1, 6), pw2); \
    VRD(3); SBAR(); GAPA(C0 = __builtin_amdgcn_mfma_f32_32x32x16_bf16(kf[6], qr[3], C0, 0, 0, 0),   P1[10], P1[11], P1[12], P1[13], pw3[0] = PKW(P1, 8), pw3[1] = PKW(P1, 10), pw3); \
    VRD(7); SBAR(); GAPA(C1 = __builtin_amdgcn_mfma_f32_32x32x16_bf16(kf[7], qr[3], C1, 0, 0, 0),   P1[14], P1[15], 0.f, 0.f,       pw3[2] = PKW(P1, 12), pw3[3] = PKW(P1, 14), pw3); \
    l_reg += sacc; \
    if (GK) { DMA_K((t) + 3, sl_cur); } if (GV) { DMA_V((t) + 1, sl_next); } \
    CMASK(C0, C1, t); \
    { float a = MX3(C0[0], C0[1], C1[0]), b = MX3(C0[2], C0[3], C1[1]); a = MX3(a, C1[2], C1[3]); \
      _Pragma("unroll") for (int r = 4; r < 16; r += 4) { a = MX3(a, C0[r], C0[r + 1]); b = MX3(b, C0[r + 2], C0[r + 3]); a = MX3(a, C1[r], C1[r + 1]); b = MX3(b, C1[r + 2], C1[r + 3]); } \
      float rm = __builtin_fmaxf(a, b); { auto rr = __builtin_amdgcn_permlane32_swap(__float_as_uint(rm), __float_as_uint(rm), false, false); rm = __builtin_fmaxf(__uint_as_float(rr[0]), __uint_as_float(rr[1])); } \
      rm -= mhat; resc = false; \
      if (__builtin_expect(__any(rm > (float)THRL), 0)) { const float dl = __builtin_fmaxf(rm, 0.f); mhat += dl; \
        const float f = __builtin_amdgcn_exp2f(-dl); l_reg *= f; if (hi == 0) wsf[r32] = f; resc = true; } } \
    SBAR(); \
    if ((t) + 1 < NT) { BLOAD(P0, P1, (t) + 1); SBAR(); }        \
    GAPB(o[0] = __builtin_amdgcn_mfma_f32_32x32x16_bf16(PAF(0), VFR(0), o[0], 0, 0, 0), C0, 0); \
    GAPB(o[1] = __builtin_amdgcn_mfma_f32_32x32x16_bf16(PAF(0), VFR(4), o[1], 0, 0, 0), C0, 4); \
    KRD(GL, 0); GAPB(o[0] = __builtin_amdgcn_mfma_f32_32x32x16_bf16(PAF(1), VFR(1), o[0], 0, 0, 0), C0, 8); \
    KRD(GL, 1); GAPB(o[1] = __builtin_amdgcn_mfma_f32_32x32x16_bf16(PAF(1), VFR(5), o[1], 0, 0, 0), C0, 12); \
    KRD(GL, 2); GAPB(o[0] = __builtin_amdgcn_mfma_f32_32x32x16_bf16(PAF(2), VFR(2), o[0], 0, 0, 0), C1, 0); \
    KRD(GL, 3); GAPB(o[1] = __builtin_amdgcn_mfma_f32_32x32x16_bf16(PAF(2), VFR(6), o[1], 0, 0, 0), C1, 4); \
    GAPB(o[0] = __builtin_amdgcn_mfma_f32_32x32x16_bf16(PAF(3), VFR(3), o[0], 0, 0, 0), C1, 8); \
    GAPB(o[1] = __builtin_amdgcn_mfma_f32_32x32x16_bf16(PAF(3), VFR(7), o[1], 0, 0, 0), C1, 12); \
    } while (0)
  int t = 1;
  for (; t + 5 < NT; t += 2) {
    STEP(pB0, pB1, pA0, pA1, t, true, true, true);     WAIT_BAR(2); RESC(); ROT();
    STEP(pA0, pA1, pB0, pB1, t + 1, true, true, true); WAIT_BAR(2); RESC(); ROT();
  }
  #define ENDW(tt) do { if ((tt) + 3 < NT) { WAIT_BAR(2); } else if ((tt) + 2 < NT) { WAIT_BAR(1); } else { WAIT_BAR(0); } } while (0)
  for (; t + 1 < NT; t += 2) {
    STEP(pB0, pB1, pA0, pA1, t, (t + 3 < NT), (t + 1 < NT), (t + 1 < NT));     ENDW(t);     RESC(); ROT();
    STEP(pA0, pA1, pB0, pB1, t + 1, (t + 4 < NT), (t + 2 < NT), (t + 2 < NT)); ENDW(t + 1); RESC(); ROT();
  }
  STEP(pB0, pB1, pA0, pA1, NT - 1, false, false, false); RESC();
  { float sacc = pB0[0] + pB0[1]; _Pragma("unroll") for (int r = 2; r < 16; ++r) sacc += pB0[r]; _Pragma("unroll") for (int r = 0; r < 16; ++r) sacc += pB1[r]; l_reg += sacc;
    pw0 = (u32x4){PKW(pB0, 0), PKW(pB0, 2), PKW(pB0, 4), PKW(pB0, 6)}; pw1 = (u32x4){PKW(pB0, 8), PKW(pB0, 10), PKW(pB0, 12), PKW(pB0, 14)}; pw2 = (u32x4){PKW(pB1, 0), PKW(pB1, 2), PKW(pB1, 4), PKW(pB1, 6)}; pw3 = (u32x4){PKW(pB1, 8), PKW(pB1, 10), PKW(pB1, 12), PKW(pB1, 14)};
    SBAR(); pv(o, vb0 + sl_cur, PAF(0), PAF(1), PAF(2), PAF(3)); }
  #undef PKW
  #undef PAF
  #undef VFR
  #undef PIN
  #undef MX3
  #undef GAPA
  #undef GAPB
  #undef EX
  #undef VRD
  #undef KRD
  #undef STEP
  #undef ENDW
  { auto rr = __builtin_amdgcn_permlane32_swap(__float_as_uint(l_reg), __float_as_uint(l_reg), false, false); l_reg = __uint_as_float(rr[0]) + __uint_as_float(rr[1]); }
  if (lsep != nullptr && hi == 0) lsep[(long)(q0 + qrel) * lse_stride] = mhat + __log2f(l_reg);
  if (hi == 0) wsf[32 + r32] = l_reg; asm volatile("s_waitcnt lgkmcnt(0)" ::: "memory");
  float rli[16];
  #pragma unroll
  for (int r = 0; r < 16; ++r) rli[r] = __builtin_amdgcn_rcpf(wsf[32 + crow(r, hi)]);
  bf16* Ow = Op + (long)(q0 + wid * QBLK) * ORS;
  { bf16* stg = (bf16*)(shm + LDS_OST) + wid * 2048;
    #pragma unroll
    for (int r = 0; r < 16; ++r) { const int orow = crow(r, hi);
      #pragma unroll
      for (int d0 = 0; d0 < 2; ++d0) stg[orow * 64 + d0 * 32 + r32] = __float2bfloat16(o[d0][r] * rli[r]); }
    asm volatile("s_waitcnt lgkmcnt(0)" ::: "memory");
    #pragma unroll
    for (int i = 0; i < 4; ++i) { const int row = i * 8 + (lane >> 3), ch = lane & 7; const u32x4 v = *(const u32x4*)(stg + row * 64 + ch * 8); ATTN_STORE16(Ow + (long)row * ORS + ch * 8, v); } }
  asm volatile("s_waitcnt lgkmcnt(0)\n\ts_barrier" ::: "memory");
  #undef DMA_K
  #undef DMA_V
  #undef CMASK
  #undef BLOAD
  #undef START
  #undef RESC
  #undef ROT
}

constexpr int DL_K = 0, DL_KB = 49152, DL_V = 98304, DL_VPAD = 147456, DL_ZEND = 153600, DL_WS = 153600, DL_TREV = 155648, DL_TOTAL = DL_TREV + 3072;
static_assert(DL_WS + NW * 256 <= DL_TREV, "dilated LDS map");
struct DilSrc { const bf16* K; const bf16* V; long RS; int q0; int first; };
__device__ __forceinline__ void dil_issue_k(const DilSrc& u, unsigned lds0, int kbuf, int lane, int wid) {
  const long kr0 = (long)u.q0 - 128; const bf16* ksrc = u.K + (kr0 + lane) * u.RS + wid * 8; const unsigned kdst = lds0 + kbuf + wid * 1024;
  #pragma unroll
  for (int i = 0; i < 6; ++i) if (i >= 2 || !u.first) glds16(ksrc + (long)i * KVBLK * u.RS, (unsigned)__builtin_amdgcn_readfirstlane(kdst + i * 8192));
}
__device__ __forceinline__ void dil_issue_v(const DilSrc& u, unsigned lds0, int lane, int wid) {
  const long kr0 = (long)u.q0 - 128; const bf16* vsrc = u.V + (kr0 + 16 * (wid & 3) + (lane >> 2)) * u.RS + (wid >> 2) * 32 + (lane & 3) * 8; const unsigned vdst = lds0 + DL_V + wid * 1024;
  #pragma unroll
  for (int i = 0; i < 6; ++i) if (i >= 2 || !u.first) glds16(vsrc + (long)i * KVBLK * u.RS, (unsigned)__builtin_amdgcn_readfirstlane(vdst + i * 8192));
}
template <int THRL> __device__ __forceinline__ void dil_unit(const bf16* Qp, const DilSrc cur, int kb, bool issued, const DilSrc nxt, bool has_next, bf16* Op,
                                                             float* lsep, long lse_stride, char* shm, const float* relb, int dsel, bool build_tab) {
  int tid_ = threadIdx.x; asm volatile("" : "+v"(tid_));
  const int tid = tid_, lane = tid & 63, r32 = lane & 31, hi = lane >> 5; const int wid = __builtin_amdgcn_readfirstlane(tid >> 6);
  const unsigned lds0 = (unsigned)(uintptr_t)shm;
  const long RS = cur.RS; const int q0 = cur.q0; const bool first = cur.first != 0;
  float* wsf = (float*)(shm + DL_WS) + wid * 64;
  LAS float* tr = (LAS float*)(shm + DL_TREV);
  if (build_tab) { for (int u = tid; u < 768; u += 512) { const int j = 383 - u; float v = -INFINITY; if (j >= 0 && j <= 128) v = relb[(int)T5B[dsel][j] * NH] * LOG2E; tr[u] = v; } }
  const LAS float* tbase = tr + (255 - r32 + 4 * hi);
  if (!issued) { dil_issue_k(cur, lds0, kb, lane, wid); dil_issue_v(cur, lds0, lane, wid); }
  const bf16* Qw = Qp + (long)(q0 + wid * QBLK) * RS;
  bf16x8 qr[4];
  #pragma unroll
  for (int d0 = 0; d0 < 4; ++d0) qr[d0] = *reinterpret_cast<const bf16x8*>(&Qw[(long)r32 * RS + d0 * 16 + hi * 8]);
  asm volatile("s_waitcnt vmcnt(0) lgkmcnt(0)\n\ts_barrier" ::: "memory");
  if (has_next) dil_issue_k(nxt, lds0, kb ^ DL_KB, lane, wid);
  const int g = wid;
  const lds_cptr shm3 = (lds_cptr)shm;
  const lds_cptr kl = shm3 + kb + hi * 1024 + r32 * 16;
  const lds_cptr vl = shm3 + DL_V + ((lane >> 4) & 1) * 32 + (lane & 3) * 8 + (4 * hi + ((lane & 15) >> 2)) * 64;
  #define KBO(blk) ((((blk)) >> 1) * 8192 + (((blk)) & 1) * 512)
  #define VBO(blk) ((((blk)) >> 1) * 8192 + (((blk)) & 1) * 2048)
  #define DKLOAD2(s_, j_) do { const int b0_ = g + 2 * (s_); kf[2 * (j_)] = *(const LAS bf16x8*)(kl + KBO(b0_) + (j_) * 2048); kf[2 * (j_) + 1] = *(const LAS bf16x8*)(kl + KBO(b0_ + 1) + (j_) * 2048); } while (0)
  float mhat = 0.f, l_reg = 0.f; f32x16 o[2]; o[0] = f32x16{}; o[1] = f32x16{};
  bf16x8 kf[8];
  #define BLOAD(P0, P1, t) do { const LAS float* tb_ = tbase + 64 * (t); \
      _Pragma("unroll") for (int r_ = 0; r_ < 16; ++r_) { P0[r_] = tb_[(r_ & 3) + 8 * (r_ >> 2)]; P1[r_] = tb_[32 + (r_ & 3) + 8 * (r_ >> 2)]; } } while (0)
  #define PMASK(P0, P1, t) do { if (first && (32 * g + 64 * (t)) < 128) { const int kb_ = 32 * g + 64 * (t) + 4 * hi - 128; \
      _Pragma("unroll") for (int r_ = 0; r_ < 16; ++r_) { const int kp_ = kb_ + (r_ & 3) + 8 * (r_ >> 2); if (kp_ < 0) P0[r_] = -INFINITY; if (kp_ + 32 < 0) P1[r_] = -INFINITY; } } } while (0)
  bool resc = false;
  #define RESC() do { if (resc) { asm volatile("s_waitcnt lgkmcnt(0)" ::: "memory"); \
      _Pragma("unroll") for (int d_ = 0; d_ < 2; ++d_) _Pragma("unroll") for (int r = 0; r < 16; ++r) o[d_][r] *= wsf[crow(r, hi)]; } } while (0)
  f32x16 pA0, pA1, pB0, pB1;
  BLOAD(pA0, pA1, 0);
  DKLOAD2(0, 0); DKLOAD2(0, 1); DKLOAD2(0, 2); DKLOAD2(0, 3);
  #pragma unroll
  for (int d0 = 0; d0 < 4; ++d0) { pA0 = __builtin_amdgcn_mfma_f32_32x32x16_bf16(kf[2 * d0], qr[d0], pA0, 0, 0, 0); pA1 = __builtin_amdgcn_mfma_f32_32x32x16_bf16(kf[2 * d0 + 1], qr[d0], pA1, 0, 0, 0); }
  asm volatile("s_nop 15\n\ts_nop 7" : "+v"(pA0), "+v"(pA1)); PMASK(pA0, pA1, 0);
  asm volatile("s_nop 3" : "+v"(pA0), "+v"(pA1));
  { const float rm = rowmax(pA0, pA1); mhat = max2f(rm, -1000.f);
    _Pragma("unroll") for (int r = 0; r < 16; ++r) pA0[r] = __builtin_amdgcn_exp2f(fsub_s(pA0[r], mhat));
    _Pragma("unroll") for (int r = 0; r < 16; ++r) pA1[r] = __builtin_amdgcn_exp2f(fsub_s(pA1[r], mhat)); }
  BLOAD(pB0, pB1, 1);
  DKLOAD2(1, 0); DKLOAD2(1, 1); DKLOAD2(1, 2); DKLOAD2(1, 3);
  s16x4 vlo[8], vhi[8]; u32x4 pw0, pw1, pw2, pw3;
  #define PKW(P, B) cvtpk_s(P[B], P[B + 1])
  #define PAF(k) __builtin_bit_cast(bf16x8, pw##k)
  #define VFR(i) (bf16x8){vlo[i][0], vlo[i][1], vlo[i][2], vlo[i][3], vhi[i][0], vhi[i][1], vhi[i][2], vhi[i][3]}
  #define PIN(x) asm volatile("" : "+v"(x))
  #define MX3(a, b, c) __builtin_fmaxf(__builtin_fmaxf((a), (b)), (c))
  #define GAPA(MF, A0, A1, A2, A3, W0, W1, PW) do { MF; sacc += A0; sacc += A1; sacc += A2; sacc += A3; PIN(sacc); W0; W1; PIN(PW); SBAR(); } while (0)
  #define EX(v) __builtin_amdgcn_exp2f(v)
  #define GAPB(MF, X, B) do { MF; X[B] = EX(X[B] - mhat); X[B + 1] = EX(X[B + 1] - mhat); X[B + 2] = EX(X[B + 2] - mhat); X[B + 3] = EX(X[B + 3] - mhat); PIN(X); SBAR(); } while (0)
  #define VRD(i) do { const lds_cptr va_ = vl + VBO(g + 2 * tv_ + (((i) & 3) >> 1)) + ((i) >> 2) * 4096 + ((i) & 1) * 1024; vlo[i] = vtr(va_); vhi[i] = vtr(va_ + 512); } while (0)
  #define KRD(G, j) do { if (G) { DKLOAD2(tk_, j); SBAR(); } } while (0)
  #define STEP(C0, C1, P0, P1, t, GL) do { SBAR(); const int tv_ = (t) - 1, tk_ = (t) + 1; \
    VRD(0); SBAR(); float sacc = (P0[0] + P0[1]); \
    GAPA(C0 = __builtin_amdgcn_mfma_f32_32x32x16_bf16(kf[0], qr[0], C0, 0, 0, 0), P0[2], P0[3], P0[4], P0[5],     pw0[0] = PKW(P0, 0), pw0[1] = PKW(P0, 2), pw0); \
    VRD(4); SBAR(); GAPA(C1 = __builtin_amdgcn_mfma_f32_32x32x16_bf16(kf[1], qr[0], C1, 0, 0, 0), P0[6], P0[7], P0[8], P0[9],     pw0[2] = PKW(P0, 4), pw0[3] = PKW(P0, 6), pw0); \
    VRD(1); SBAR(); GAPA(C0 = __builtin_amdgcn_mfma_f32_32x32x16_bf16(kf[2], qr[1], C0, 0, 0, 0),   P0[10], P0[11], P0[12], P0[13], pw1[0] = PKW(P0, 8), pw1[1] = PKW(P0, 10), pw1); \
    VRD(5); SBAR(); GAPA(C1 = __builtin_amdgcn_mfma_f32_32x32x16_bf16(kf[3], qr[1], C1, 0, 0, 0),   P0[14], P0[15], P1[0], P1[1],   pw1[2] = PKW(P0, 12), pw1[3] = PKW(P0, 14), pw1); \
    VRD(2); SBAR(); GAPA(C0 = __builtin_amdgcn_mfma_f32_32x32x16_bf16(kf[4], qr[2], C0, 0, 0, 0),   P1[2], P1[3], P1[4], P1[5],     pw2[0] = PKW(P1, 0), pw2[1] = PKW(P1, 2), pw2); \
    VRD(6); SBAR(); GAPA(C1 = __builtin_amdgcn_mfma_f32_32x32x16_bf16(kf[5], qr[2], C1, 0, 0, 0),   P1[6], P1[7], P1[8], P1[9],     pw2[2] = PKW(P1, 4), pw2[3] = PKW(P1, 6), pw2); \
    VRD(3); SBAR(); GAPA(C0 = __builtin_amdgcn_mfma_f32_32x32x16_bf16(kf[6], qr[3], C0, 0, 0, 0),   P1[10], P1[11], P1[12], P1[13], pw3[0] = PKW(P1, 8), pw3[1] = PKW(P1, 10), pw3); \
    VRD(7); SBAR(); GAPA(C1 = __builtin_amdgcn_mfma_f32_32x32x16_bf16(kf[7], qr[3], C1, 0, 0, 0),   P1[14], P1[15], 0.f, 0.f,       pw3[2] = PKW(P1, 12), pw3[3] = PKW(P1, 14), pw3); \
    l_reg += sacc; \
    PMASK(C0, C1, t); \
    { float a = MX3(C0[0], C0[1], C1[0]), b = MX3(C0[2], C0[3], C1[1]); a = MX3(a, C1[2], C1[3]); \
      _Pragma("unroll") for (int r = 4; r < 16; r += 4) { a = MX3(a, C0[r], C0[r + 1]); b = MX3(b, C0[r + 2], C0[r + 3]); a = MX3(a, C1[r], C1[r + 1]); b = MX3(b, C1[r + 2], C1[r + 3]); } \
      float rm = __builtin_fmaxf(a, b); { auto rr = __builtin_amdgcn_permlane32_swap(__float_as_uint(rm), __float_as_uint(rm), false, false); rm = __builtin_fmaxf(__uint_as_float(rr[0]), __uint_as_float(rr[1])); } \
      rm -= mhat; resc = false; \
      if (__builtin_expect(__any(rm > (float)THRL), 0)) { const float dl = __builtin_fmaxf(rm, 0.f); mhat += dl; \
        const float f = __builtin_amdgcn_exp2f(-dl); l_reg *= f; if (hi == 0) wsf[r32] = f; resc = true; } } \
    SBAR(); \
    if ((t) + 1 < 3) { BLOAD(P0, P1, (t) + 1); SBAR(); } \
    GAPB(o[0] = __builtin_amdgcn_mfma_f32_32x32x16_bf16(PAF(0), VFR(0), o[0], 0, 0, 0), C0, 0); \
    GAPB(o[1] = __builtin_amdgcn_mfma_f32_32x32x16_bf16(PAF(0), VFR(4), o[1], 0, 0, 0), C0, 4); \
    KRD(GL, 0); GAPB(o[0] = __builtin_amdgcn_mfma_f32_32x32x16_bf16(PAF(1), VFR(1), o[0], 0, 0, 0), C0, 8); \
    KRD(GL, 1); GAPB(o[1] = __builtin_amdgcn_mfma_f32_32x32x16_bf16(PAF(1), VFR(5), o[1], 0, 0, 0), C0, 12); \
    KRD(GL, 2); GAPB(o[0] = __builtin_amdgcn_mfma_f32_32x32x16_bf16(PAF(2), VFR(2), o[0], 0, 0, 0), C1, 0); \
    KRD(GL, 3); GAPB(o[1] = __builtin_amdgcn_mfma_f32_32x32x16_bf16(PAF(2), VFR(6), o[1], 0, 0, 0), C1, 4); \
    GAPB(o[0] = __builtin_amdgcn_mfma_f32_32x32x16_bf16(PAF(3), VFR(3), o[0], 0, 0, 0), C1, 8); \
    GAPB(o[1] = __builtin_amdgcn_mfma_f32_32x32x16_bf16(PAF(3), VFR(7), o[1], 0, 0, 0), C1, 12); \
    } while (0)
  STEP(pB0, pB1, pA0, pA1, 1, true);  RESC();
  STEP(pA0, pA1, pB0, pB1, 2, false); RESC();
  { float sacc = pA0[0] + pA0[1]; _Pragma("unroll") for (int r = 2; r < 16; ++r) sacc += pA0[r]; _Pragma("unroll") for (int r = 0; r < 16; ++r) sacc += pA1[r]; l_reg += sacc;
    pw0 = (u32x4){PKW(pA0, 0), PKW(pA0, 2), PKW(pA0, 4), PKW(pA0, 6)}; pw1 = (u32x4){PKW(pA0, 8), PKW(pA0, 10), PKW(pA0, 12), PKW(pA0, 14)}; pw2 = (u32x4){PKW(pA1, 0), PKW(pA1, 2), PKW(pA1, 4), PKW(pA1, 6)}; pw3 = (u32x4){PKW(pA1, 8), PKW(pA1, 10), PKW(pA1, 12), PKW(pA1, 14)};
    SBAR(); const int tv_ = 2;
    VRD(0); VRD(1); VRD(2); VRD(3); VRD(4); VRD(5); VRD(6); VRD(7);
    o[0] = __builtin_amdgcn_mfma_f32_32x32x16_bf16(PAF(0), VFR(0), o[0], 0, 0, 0); o[1] = __builtin_amdgcn_mfma_f32_32x32x16_bf16(PAF(0), VFR(4), o[1], 0, 0, 0);
    o[0] = __builtin_amdgcn_mfma_f32_32x32x16_bf16(PAF(1), VFR(1), o[0], 0, 0, 0); o[1] = __builtin_amdgcn_mfma_f32_32x32x16_bf16(PAF(1), VFR(5), o[1], 0, 0, 0);
    o[0] = __builtin_amdgcn_mfma_f32_32x32x16_bf16(PAF(2), VFR(2), o[0], 0, 0, 0); o[1] = __builtin_amdgcn_mfma_f32_32x32x16_bf16(PAF(2), VFR(6), o[1], 0, 0, 0);
    o[0] = __builtin_amdgcn_mfma_f32_32x32x16_bf16(PAF(3), VFR(3), o[0], 0, 0, 0); o[1] = __builtin_amdgcn_mfma_f32_32x32x16_bf16(PAF(3), VFR(7), o[1], 0, 0, 0); }
  #undef PKW
  #undef PAF
  #undef VFR
  #undef PIN
  #undef MX3
  #undef GAPA
  #undef GAPB
  #undef EX
  #undef VRD
  #undef KRD
  #undef STEP
  const int qrel = wid * QBLK + r32;
  { auto rr = __builtin_amdgcn_permlane32_swap(__float_as_uint(l_reg), __float_as_uint(l_reg), false, false); l_reg = __uint_as_float(rr[0]) + __uint_as_float(rr[1]); }
  if (hi == 0) lsep[(long)(q0 + qrel) * lse_stride] = mhat + __log2f(l_reg);
  if (hi == 0) wsf[32 + r32] = l_reg; asm volatile("s_waitcnt lgkmcnt(0)" ::: "memory");
  float rli[16];
  #pragma unroll
  for (int r = 0; r < 16; ++r) rli[r] = __builtin_amdgcn_rcpf(wsf[32 + crow(r, hi)]);
  asm volatile("s_waitcnt lgkmcnt(0)\n\ts_barrier" ::: "memory");
  if (has_next) dil_issue_v(nxt, lds0, lane, wid);
  bf16* Ow = Op + (long)(q0 + wid * QBLK) * RS;
  { bf16* stg = (bf16*)(shm + kb) + wid * 2048;
    #pragma unroll
    for (int r = 0; r < 16; ++r) { const int orow = crow(r, hi);
      #pragma unroll
      for (int d0 = 0; d0 < 2; ++d0) stg[orow * 64 + d0 * 32 + r32] = __float2bfloat16(o[d0][r] * rli[r]); }
    asm volatile("s_waitcnt lgkmcnt(0)" ::: "memory");
    #pragma unroll
    for (int i = 0; i < 4; ++i) { const int row = i * 8 + (lane >> 3), ch = lane & 7; const u32x4 v = *(const u32x4*)(stg + row * 64 + ch * 8); ATTN_STORE16(Ow + (long)row * RS + ch * 8, v); } }
  if (!has_next) asm volatile("s_waitcnt lgkmcnt(0)\n\ts_barrier" ::: "memory");
  #undef KBO
  #undef VBO
  #undef DKLOAD2
  #undef BLOAD
  #undef PMASK
  #undef RESC
}
#undef SBAR
#undef WAIT_BAR
}
static_assert(attn_body::LDS_TOTAL <= RING_BYTES && attn_body::DL_TOTAL <= PHASE_LDS, "attention LDS");

#define XB_TMO      128
#define XB_XCNT(j)  (256  + 64 * (j))
#define XB_XSUB(j)  (1280 + 64 * (j))
#define XB_XGEN(j)  (2304 + 64 * (j))
#define XB_TOP      3328
#define XB_TOPGEN   3392
#define XCD_BAR_WORDS 3456
#define XB_SPIN_CAP (1u << 18)
__device__ __forceinline__ unsigned xb_ld(unsigned* p)              { return __hip_atomic_load(p, __ATOMIC_RELAXED, __HIP_MEMORY_SCOPE_AGENT); }
__device__ __forceinline__ unsigned xb_add(unsigned* p, unsigned v) { return __hip_atomic_fetch_add(p, v, __ATOMIC_RELAXED, __HIP_MEMORY_SCOPE_AGENT); }
__device__ __forceinline__ unsigned xb_xcc_id() { return (unsigned)__builtin_amdgcn_s_getreg((3 << 11) | 20) & 0xFu; }
#define XB_SPIN(cond, bar) do { unsigned _sp = 0; while (cond) { __builtin_amdgcn_s_sleep(1); \
    if ((++_sp & 255u) == 0u) { if (xb_ld(&(bar)[XB_TMO])) break; if (_sp > XB_SPIN_CAP) { atomicAdd(&(bar)[XB_TMO], 1u); break; } } } } while (0)
struct XcdBarrier { unsigned* bar; unsigned x; volatile LAS unsigned* st; };
__device__ __forceinline__ XcdBarrier xcd_barrier_post(unsigned* bar, volatile LAS unsigned* st) {
    XcdBarrier b; b.bar = bar; b.x = xb_xcc_id(); b.st = st;
    if (threadIdx.x == 0) (void)xb_add(&bar[XB_XCNT(b.x)], 1u);
    return b;
}
__device__ __forceinline__ void xcd_barrier_complete(unsigned* bar, unsigned x, unsigned& nloc, unsigned& nx) {
    const unsigned G = gridDim.x * gridDim.y * gridDim.z;
    unsigned sum, cnt, mine, sp = 0u;
    for (;;) {
        sum = 0u; cnt = 0u; mine = 0u;
#pragma unroll
        for (unsigned j = 0; j < 16; ++j) { const unsigned c = xb_ld(&bar[XB_XCNT(j)]); sum += c; cnt += (c > 0u) ? 1u : 0u; mine = (j == x) ? c : mine; }
        if (sum == G) break;
        __builtin_amdgcn_s_sleep(1);
        if ((++sp & 255u) == 0u) { if (xb_ld(&bar[XB_TMO])) break; if (sp > XB_SPIN_CAP) { atomicAdd(&bar[XB_TMO], 1u); break; } }
    }
    nloc = mine > 0u ? mine : 1u; nx = cnt > 0u ? cnt : 1u;
}
__device__ __forceinline__ void xcd_barrier(const XcdBarrier& b) {
    asm volatile("s_waitcnt vmcnt(0)" ::: "memory");
    __syncthreads();
    if (threadIdx.x == 0) {
        unsigned* bar = b.bar;
        __builtin_amdgcn_s_waitcnt(0);
        unsigned nloc = b.st[0], nx = b.st[1];
        if (nloc == 0u) { xcd_barrier_complete(bar, b.x, nloc, nx); b.st[0] = nloc; b.st[1] = nx; }
        const unsigned old = xb_add(&bar[XB_XSUB(b.x)], 1u);
        const unsigned gen = old / nloc;
        if (old + 1u == (gen + 1u) * nloc) {
            __builtin_amdgcn_fence(__ATOMIC_RELEASE, "agent");
            asm volatile("s_waitcnt vmcnt(0)" ::: "memory");
            const unsigned og = xb_add(&bar[XB_TOP], 1u);
            const unsigned tg = og / nx;
            if (og + 1u == (tg + 1u) * nx) xb_add(&bar[XB_TOPGEN], 1u);
            else XB_SPIN(xb_ld(&bar[XB_TOPGEN]) == tg, bar);
            __builtin_amdgcn_fence(__ATOMIC_ACQUIRE, "agent");
            xb_add(&bar[XB_XGEN(b.x)], 1u);
            asm volatile("s_waitcnt vmcnt(0)" ::: "memory");
        } else {
            XB_SPIN(xb_ld(&bar[XB_XGEN(b.x)]) == gen, bar);
            __builtin_amdgcn_fence(__ATOMIC_ACQUIRE, "agent");
            asm volatile("s_waitcnt vmcnt(0)" ::: "memory");
        }
    }
    __syncthreads();
}

struct Frame {
    LAS unsigned char* lds;
    volatile LAS unsigned* MISC;
    gu32* ctl;
    int tid, lane, wave;
    int vcu, G;
    unsigned char* ws;
    float* out;
};
#define LDS_WAIT() asm volatile("s_waitcnt lgkmcnt(0)" ::: "memory")

__device__ __forceinline__ void p0_mod(Frame& F, const float* c, const float* w_ada, const float* b_ada, float* mod) {
    LAS float* sc = (LAS float*)F.lds;
    LAS float* part = (LAS float*)(F.lds + 65536);
    __syncthreads();
    for (int cg = blockIdx.x; cg < NMOD / 64; cg += F.G) {
        for (int i = F.tid; i < BATCH * DM; i += NWAVES * 64) { const float v = c[i]; sc[i] = v / (1.f + __expf(-v)); }
        __syncthreads();
        const int n = cg * 64 + F.lane; float acc[BATCH];
#pragma unroll
        for (int b = 0; b < BATCH; ++b) acc[b] = 0.f;
        const int kb = F.wave * 128;
        for (int k0 = kb; k0 < kb + 128; k0 += 32) { float wv[32];
#pragma unroll
            for (int i = 0; i < 32; ++i) wv[i] = w_ada[(size_t)(k0 + i) * NMOD + n];
#pragma unroll
            for (int i = 0; i < 32; ++i)
#pragma unroll
                for (int b = 0; b < BATCH; ++b) acc[b] += sc[b * DM + k0 + i] * wv[i]; }
#pragma unroll
        for (int b = 0; b < BATCH; ++b) part[(F.wave * BATCH + b) * 64 + F.lane] = acc[b];
        __syncthreads();
        for (int o = F.tid; o < BATCH * 64; o += NWAVES * 64) { const int b = o >> 6, l = o & 63; float s = b_ada[cg * 64 + l];
#pragma unroll
            for (int w = 0; w < NWAVES; ++w) s += part[(w * BATCH + b) * 64 + l];
            mod[(size_t)b * NMOD + cg * 64 + l] = s; }
        __syncthreads();
    }
}
__device__ __forceinline__ int gu_row(int c, int up) { return (c >> 7) * 256 + up * 128 + (c & 127); }
__device__ __forceinline__ int dn_row(int c) { const int cc = c & 255; return (c & ~255) + ((cc >> 5) & 1) * 128 + (cc >> 6) * 32 + (cc & 31); }
struct P0Ptrs { const float *w_in, *w_out, *w_router, *w_eg, *w_eu, *w_ed, *w_sg, *w_su, *w_sd; };
struct TrItem { const float* src; unsigned char* dst; int ldw, Kd, f8; };
__device__ __forceinline__ TrItem tr_make(const float* W, int ldw, int k0, int c0, void* WT, int drow0, int Kd, int f8 = 0) { TrItem t; t.src = W + (size_t)k0 * ldw + c0; t.dst = (unsigned char*)WT + ((size_t)drow0 * Kd + k0) * (f8 ? 1 : 2); t.ldw = ldw; t.Kd = Kd; t.f8 = f8; return t; }
__device__ __forceinline__ TrItem p0_decode(const P0Ptrs& P, unsigned char* ws, int it) {
    bf16_t* WIN = (bf16_t*)(ws + WS_WIN); bf16_t* WOUT = (bf16_t*)(ws + WS_WOUT); bf16_t* WR = (bf16_t*)(ws + WS_WR);
    bf16_t* WSHGU = (bf16_t*)(ws + WS_WSHGU); bf16_t* WSHD = (bf16_t*)(ws + WS_WSHD); unsigned char* WD = ws + WS_WD; unsigned char* WGU = ws + WS_WGU;
    constexpr int I_EXP = NEXP * 384, I_IN = 768, I_OUT = 512, I_S = 128;
    int r = it;
    if (r < I_EXP) { const int e = r / 384, q = r % 384;
        if (q < 256) { const int up = q >> 7, qq = q & 127, kb = qq >> 3, nb = qq & 7;
            return tr_make((up ? P.w_eu : P.w_eg) + (size_t)e * DM * EH, EH, 64 * kb, 32 * nb, WGU + (size_t)e * 512 * DM, gu_row(32 * nb, up), DM, 1); }
        const int qq = q - 256, kb = qq >> 5, nb = qq & 31;
        return tr_make(P.w_ed + (size_t)e * EH * DM, DM, 64 * kb, 32 * nb, WD + (size_t)e * DM * EH, dn_row(32 * nb), EH, 1); }
    r -= I_EXP;
    if (r < I_IN) { const int kb = r / 48, nb = r % 48; return tr_make(P.w_in, INC, 64 * kb, 32 * nb, WIN, 32 * nb, DM); } r -= I_IN;
    if (r < I_IN) { const int kb = r / 48, nb = r % 48; return tr_make(P.w_in, INC, 64 * kb, 1544 + 32 * nb, WIN, 1536 + 32 * nb, DM); } r -= I_IN;
    if (r < I_OUT) { const int kb = r >> 5, nb = r & 31; return tr_make(P.w_out, DM, 64 * kb, 32 * nb, WOUT, 32 * nb, DM, OUT8); } r -= I_OUT;
    if (r < I_S) { const int kb = r >> 3, nb = r & 7; return tr_make(P.w_router, NEXP, 64 * kb, 32 * nb, WR, 32 * nb, DM); } r -= I_S;
    if (r < I_S) { const int kb = r >> 3, nb = r & 7; return tr_make(P.w_sg, EH, 64 * kb, 32 * nb, WSHGU, gu_row(32 * nb, 0), DM, SH8); } r -= I_S;
    if (r < I_S) { const int kb = r >> 3, nb = r & 7; return tr_make(P.w_su, EH, 64 * kb, 32 * nb, WSHGU, gu_row(32 * nb, 1), DM, SH8); } r -= I_S;
    { const int kb = r >> 5, nb = r & 31; return tr_make(P.w_sd, DM, 64 * kb, 32 * nb, WSHD, dn_row(32 * nb), EH, SH8); }
}
__device__ __forceinline__ void tr_load(const TrItem& t, int lane, f32x4 (&v)[8]) {
    const float* p = t.src + (size_t)(lane >> 3) * t.ldw + (lane & 7) * 4;
#pragma unroll
    for (int i = 0; i < 8; ++i) v[i] = *(const GAS f32x4*)(p + (size_t)(8 * i) * t.ldw);
}
__device__ __forceinline__ void tr_store(const TrItem& t, int lane, const f32x4 (&v)[8], LAS float* scr) {
    LAS float* w = scr + (lane >> 3) * 33 + (lane & 7) * 4;
#pragma unroll
    for (int i = 0; i < 8; ++i) { w[(8 * i) * 33 + 0] = v[i].x; w[(8 * i) * 33 + 1] = v[i].y; w[(8 * i) * 33 + 2] = v[i].z; w[(8 * i) * 33 + 3] = v[i].w; }
    LDS_WAIT(); asm volatile("" ::: "memory");
    const int c = lane & 7;
#pragma unroll
    for (int j = 0; j < 4; ++j) { const int n = (lane >> 3) + 8 * j; const LAS float* s = scr + (8 * c) * 33 + n;
        if (t.f8) { int w0 = __builtin_amdgcn_cvt_pk_fp8_f32(s[0 * 33], s[1 * 33], 0, false); w0 = __builtin_amdgcn_cvt_pk_fp8_f32(s[2 * 33], s[3 * 33], w0, true);
            int w1 = __builtin_amdgcn_cvt_pk_fp8_f32(s[4 * 33], s[5 * 33], 0, false); w1 = __builtin_amdgcn_cvt_pk_fp8_f32(s[6 * 33], s[7 * 33], w1, true);
            u32x2 o; o.x = (unsigned)w0; o.y = (unsigned)w1; *(GAS u32x2*)(t.dst + (size_t)n * t.Kd + 8 * c) = o; }
        else { u32x4 o; o.x = cvt_pk_bf16(s[0 * 33], s[1 * 33]); o.y = cvt_pk_bf16(s[2 * 33], s[3 * 33]); o.z = cvt_pk_bf16(s[4 * 33], s[5 * 33]); o.w = cvt_pk_bf16(s[6 * 33], s[7 * 33]);
            *(GAS u32x4*)(t.dst + ((size_t)n * t.Kd + 8 * c) * 2) = o; } }
    LDS_WAIT(); asm volatile("" ::: "memory");
}
__device__ __forceinline__ void p0_weights(Frame& F, const P0Ptrs& P, int it_lo, int it_hi) {
    LAS float* scr = (LAS float*)(F.lds + F.wave * 16384);
    const int gw = F.vcu * NWAVES + F.wave, NGW = F.G * NWAVES;
    int it = it_lo + gw; if (it >= it_hi) return;
    TrItem cur = p0_decode(P, F.ws, it); f32x4 v[8]; tr_load(cur, F.lane, v);
    for (;;) {
        const int nit = it + NGW; const bool more = nit < it_hi;
        f32x4 nv[8];
        const TrItem nx = p0_decode(P, F.ws, more ? nit : it); tr_load(nx, F.lane, nv);
        tr_store(cur, F.lane, v, scr);
        if (!more) break;
        cur = nx; it = nit;
#pragma unroll
        for (int i = 0; i < 8; ++i) v[i] = nv[i];
    }
}
constexpr int P0_EXPERT_ITEMS = NEXP * 384, P0_ALL_ITEMS = NEXP * 384 + 2 * 768 + 512 + 4 * 128;
struct CvItem { const float* src; unsigned char* dst; int ldw, Kd, rowbase, down, n0; };
__device__ __forceinline__ CvItem cv_decode(const P0Ptrs& P, unsigned char* ws, int sit) {
    const int e = sit / 24, q = sit % 24; CvItem c;
    if (q < 16) { const int up = q >> 3, kb = q & 7;
        c.src = (up ? P.w_eu : P.w_eg) + (size_t)e * DM * EH + (size_t)(128 * kb) * EH; c.ldw = EH; c.dst = ws + WS_WGU + (size_t)e * 512 * DM + 128 * kb; c.Kd = DM; c.rowbase = up * 128; c.down = 0; c.n0 = 0; }
    else { const int qq = q - 16, kb = qq >> 2, nb = qq & 3;
        c.src = P.w_ed + (size_t)e * EH * DM + (size_t)(128 * kb) * DM + 256 * nb; c.ldw = DM; c.dst = ws + WS_WD + (size_t)e * DM * EH + 128 * kb; c.Kd = EH; c.rowbase = 0; c.down = 1; c.n0 = 256 * nb; }
    return c;
}
__device__ __forceinline__ void cv_issue(Frame& F, const CvItem& c, int sub, int buf) {
    const float* g = c.src + (size_t)(32 * sub + 4 * F.wave) * c.ldw + F.lane * 4;
#pragma unroll
    for (int i = 0; i < 4; ++i) __builtin_amdgcn_global_load_lds((const unsigned*)(g + (size_t)i * c.ldw), (LAS unsigned*)(F.lds + buf * 32768 + (4 * F.wave + i) * 1024), 16, 0, 2);
}
__device__ __forceinline__ void conv_experts(Frame& F, const P0Ptrs& P) {
    constexpr int NSI = NEXP * 24;
    const int G = F.G; const int si0 = F.vcu; if (si0 >= NSI) return;
    const int nmine = (NSI - si0 + G - 1) / G;
    const int NT = nmine * 4;
    int tid_ = threadIdx.x; asm volatile("" : "+v"(tid_)); const int tid = tid_;
    LAS unsigned char* Bb = F.lds + 3 * 32768;
#define CV_SUB(t_) do { const int tt_ = (t_) < NT ? (t_) : NT - 1; const CvItem c_ = cv_decode(P, F.ws, si0 + (tt_ >> 2) * G); cv_issue(F, c_, tt_ & 3, (t_) % 3); } while (0)
    CV_SUB(0); CV_SUB(1);
    CvItem cur = cv_decode(P, F.ws, si0);
    for (int t = 0; t < NT; ++t) { const int sub = t & 3;
        asm volatile("s_waitcnt vmcnt(4)" ::: "memory");
        __builtin_amdgcn_s_barrier(); asm volatile("" ::: "memory");
        CV_SUB(t + 2);
        { const int n = tid & 255, kq = tid >> 8; const LAS float* a = (const LAS float*)(F.lds + (t % 3) * 32768) + (16 * kq) * 256 + n; unsigned w[4];
#pragma unroll
          for (int j = 0; j < 4; ++j) { const float f0 = a[(4 * j) * 256], f1 = a[(4 * j + 1) * 256], f2 = a[(4 * j + 2) * 256], f3 = a[(4 * j + 3) * 256];
              int q0 = __builtin_amdgcn_cvt_pk_fp8_f32(f0, f1, 0, false); q0 = __builtin_amdgcn_cvt_pk_fp8_f32(f2, f3, q0, true); w[j] = (unsigned)q0; }
          *(LAS u32x4*)(Bb + n * 144 + 32 * sub + 16 * kq) = (u32x4){w[0], w[1], w[2], w[3]}; }
        if (sub == 3) {
            asm volatile("s_waitcnt lgkmcnt(0)" ::: "memory"); __builtin_amdgcn_s_barrier(); asm volatile("" ::: "memory");
#pragma unroll
            for (int j = 0; j < 4; ++j) { const int nl = (tid >> 3) + 64 * j, ch = tid & 7; const u32x4 v = *(const LAS u32x4*)(Bb + nl * 144 + 16 * ch);
                const int drow = cur.down ? dn_row(cur.n0 + nl) : (nl >> 7) * 256 + cur.rowbase + (nl & 127);
                *(GAS u32x4*)(cur.dst + (size_t)drow * cur.Kd + 16 * ch) = v; }
            asm volatile("s_waitcnt lgkmcnt(0)" ::: "memory");
            if (t + 1 < NT) cur = cv_decode(P, F.ws, si0 + ((t + 1) >> 2) * G);
        }
    }
#undef CV_SUB
    asm volatile("s_waitcnt vmcnt(0)" ::: "memory");
    __builtin_amdgcn_s_barrier();
}
template <bool FL> __device__ __forceinline__ void norm_rows(Frame& F, const float* src  , bf16_t* dst, const float* mod, int shift_off, int scale_off, const float* w_in, const float* b_forget, float* lf, unsigned char* dst8) {
    LAS float* wf = (LAS float*)F.lds;
    if (FL) { for (int i = F.tid; i < DM * NH; i += NWAVES * 64) wf[(i & 7) * DM + (i >> 3)] = w_in[(size_t)(i >> 3) * INC + 1536 + (i & 7)]; __syncthreads(); }
    const int gw = F.vcu * NWAVES + F.wave, NGW = F.G * NWAVES;
    constexpr int CH = 32;
#define NR_ROW(i_) (rowb + 128 * (i_))
#define NR_LD(dst_, row_, j_) do { if (FL) dst_ = ((const GAS f32x4*)(src + (size_t)(row_) * DM) + F.lane)[64 * (j_)]; \
        else { const u32x2 t_ = ((const GAS u32x2*)x1_row(F.ws, (size_t)(row_)) + F.lane)[64 * (j_)]; dst_ = (f32x4){bf_lo(t_.x), bf_hi(t_.x), bf_lo(t_.y), bf_hi(t_.y)}; } } while (0)
    for (int ch = gw; ch < M / CH; ch += NGW) {
        const int b = ch >> 7, rowb = b * SEQ + (ch & 127);
        f32x4 sc[4], sh[4];
#pragma unroll
        for (int j = 0; j < 4; ++j) { sc[j] = *(const f32x4*)(mod + (size_t)b * NMOD + scale_off + 256 * j + 4 * F.lane) + 1.f; sh[j] = *(const f32x4*)(mod + (size_t)b * NMOD + shift_off + 256 * j + 4 * F.lane); }
        f32x4 nv[2][4];
#pragma unroll
        for (int q = 0; q < 2; ++q)
#pragma unroll
            for (int j = 0; j < 4; ++j) NR_LD(nv[q][j], NR_ROW(q), j);
        for (int mm = 0; mm < CH; mm += 2) {
            f32x4 vv[2][4];
#pragma unroll
            for (int q = 0; q < 2; ++q)
#pragma unroll
                for (int j = 0; j < 4; ++j) vv[q][j] = nv[q][j];
            if (mm + 2 < CH) {
#pragma unroll
                for (int q = 0; q < 2; ++q)
#pragma unroll
                    for (int j = 0; j < 4; ++j) NR_LD(nv[q][j], NR_ROW(mm + 2 + q), j); }
#pragma unroll
            for (int q = 0; q < 2; ++q) { const int m = NR_ROW(mm + q); f32x4 (&v)[4] = vv[q];
            float s2 = 0.f;
#pragma unroll
            for (int j = 0; j < 4; ++j) s2 += (v[j].x * v[j].x + v[j].y * v[j].y) + (v[j].z * v[j].z + v[j].w * v[j].w);
            const float r = 1.f / sqrtf(wave_sum(s2) * (1.f / DM) + EPS);
#pragma unroll
            for (int j = 0; j < 4; ++j) v[j] = v[j] * r * sc[j] + sh[j];
            GAS u32x2* o8 = (GAS u32x2*)(dst + (size_t)m * DM) + F.lane;
#pragma unroll
            for (int j = 0; j < 4; ++j) { u32x2 w; w.x = cvt_pk_bf16(v[j].x, v[j].y); w.y = cvt_pk_bf16(v[j].z, v[j].w); o8[64 * j] = w; }
            if (!FL) { GAS unsigned* o4 = (GAS unsigned*)(dst8 + (size_t)m * DM) + F.lane;
#pragma unroll
                for (int j = 0; j < 4; ++j) { int w = __builtin_amdgcn_cvt_pk_fp8_f32(v[j].x, v[j].y, 0, false); w = __builtin_amdgcn_cvt_pk_fp8_f32(v[j].z, v[j].w, w, true); o4[64 * j] = (unsigned)w; } }
            if (FL) { float fl[NH];
#pragma unroll
                for (int h = 0; h < NH; ++h) fl[h] = 0.f;
#pragma unroll
                for (int j = 0; j < 4; ++j)
#pragma unroll
                    for (int h = 0; h < NH; ++h) { const f32x4 w4 = *(const LAS f32x4*)(wf + h * DM + 256 * j + 4 * F.lane); fl[h] += (v[j].x * w4.x + v[j].y * w4.y) + (v[j].z * w4.z + v[j].w * w4.w); }
                const float mine = reduce8_heads(fl, F.lane); const int hh = F.lane >> 3;
                if ((F.lane & 7) == 0) { const float z = mine + b_forget[hh]; const float ls = fminf(z, 0.f) - log1pf(__expf(-fabsf(z))); lf[((size_t)b * NH + hh) * SEQ + (m & (SEQ - 1))] = ls; } }
            }
        }
    }
}
#undef NR_ROW
#undef NR_LD
__device__ __forceinline__ void scan_rows(Frame& F, const float* lf, float* kb, int* t0tab) {
    LAS float* wt = (LAS float*)F.lds; LAS float* kl = wt + 16;
    for (int s = blockIdx.x; s < BATCH * NH; s += F.G) {
        const float* src = lf + (size_t)s * SEQ + F.tid * 8; float v[8];
        { const f32x4 a = *(const f32x4*)src, b2 = *(const f32x4*)(src + 4); v[0] = a.x; v[1] = a.y; v[2] = a.z; v[3] = a.w; v[4] = b2.x; v[5] = b2.y; v[6] = b2.z; v[7] = b2.w; }
#pragma unroll
        for (int i = 1; i < 8; ++i) v[i] += v[i - 1];
        float incl = v[7];
#pragma unroll
        for (int o = 1; o < 64; o <<= 1) { const float t = __shfl_up(incl, o); if (F.lane >= o) incl += t; }
        if (F.lane == 63) wt[F.wave] = incl;
        __syncthreads();
        float base = incl - v[7];
        for (int w = 0; w < F.wave; ++w) base += wt[w];
        float* dst = kb + (size_t)s * SEQ + F.tid * 8;
        f32x4 a, b2; a.x = -(v[0] + base) * LOG2E; a.y = -(v[1] + base) * LOG2E; a.z = -(v[2] + base) * LOG2E; a.w = -(v[3] + base) * LOG2E;
        b2.x = -(v[4] + base) * LOG2E; b2.y = -(v[5] + base) * LOG2E; b2.z = -(v[6] + base) * LOG2E; b2.w = -(v[7] + base) * LOG2E;
        *(f32x4*)dst = a; *(f32x4*)(dst + 4) = b2;
        *(LAS f32x4*)(kl + F.tid * 8) = a; *(LAS f32x4*)(kl + F.tid * 8 + 4) = b2;
        __syncthreads();
        if (F.tid < 16) { const int q0 = 256 * F.tid; const float target = kl[q0] - FOX_SKIP_LOG2; int lo = 0, hi = q0;
            while (lo < hi) { const int mid = (lo + hi) >> 1; if (kl[mid] <= target) lo = mid + 1; else hi = mid; }
            t0tab[s * 16 + F.tid] = (lo >> 6) & ~1; }
        __syncthreads();
    }
}
__device__ __forceinline__ void unpack8(const u32x4 w, float* f) { f[0] = bf_lo(w.x); f[1] = bf_hi(w.x); f[2] = bf_lo(w.y); f[3] = bf_hi(w.y); f[4] = bf_lo(w.z); f[5] = bf_hi(w.z); f[6] = bf_lo(w.w); f[7] = bf_hi(w.w); }
__device__ __forceinline__ void merge_rows(Frame& F, const float* g_fox, const float* g_dil) {
    const bf16_t* OF = (const bf16_t*)(F.ws + WS_OF); const bf16_t* O1 = (const bf16_t*)(F.ws + WS_O1); const bf16_t* O2 = (const bf16_t*)(F.ws + WS_O2); const bf16_t* O3 = (const bf16_t*)(F.ws + WS_O3);
    const float* LSE = (const float*)(F.ws + WS_LSE); bf16_t* YM = (bf16_t*)(F.ws + WS_YM);
    const int gw = F.vcu * NWAVES + F.wave, NGW = F.G * NWAVES;
    float gf[8], gd[8];
    { const f32x4 a = *(const f32x4*)(g_fox + 8 * F.lane), b = *(const f32x4*)(g_fox + 8 * F.lane + 4), c = *(const f32x4*)(g_dil + 8 * F.lane), d = *(const f32x4*)(g_dil + 8 * F.lane + 4);
      gf[0] = a.x; gf[1] = a.y; gf[2] = a.z; gf[3] = a.w; gf[4] = b.x; gf[5] = b.y; gf[6] = b.z; gf[7] = b.w; gd[0] = c.x; gd[1] = c.y; gd[2] = c.z; gd[3] = c.w; gd[4] = d.x; gd[5] = d.y; gd[6] = d.z; gd[7] = d.w; }
    struct Row { u32x4 wf, w1, w2, w3; float l1, l2, l3; };
    const int hd = F.lane >> 3;
#define MR_LOAD(R, m_) do { const size_t eo_ = (size_t)(m_) * HW + 8 * F.lane; R.wf = *(const GAS u32x4*)(OF + eo_); R.w1 = *(const GAS u32x4*)(O1 + eo_); R.w2 = *(const GAS u32x4*)(O2 + eo_); R.w3 = *(const GAS u32x4*)(O3 + eo_); \
        R.l1 = LSE[(size_t)(m_) * NH + hd]; R.l2 = LSE[(size_t)M * NH + (size_t)(m_) * NH + hd]; R.l3 = LSE[(size_t)2 * M * NH + (size_t)(m_) * NH + hd]; } while (0)
    for (int ch = gw; ch < M / 32; ch += NGW) {
        const size_t rowb = (size_t)(ch >> 7) * SEQ + (ch & 127);
#define MR_ROW(i_) (rowb + 128 * (size_t)(31 - (i_)))
        Row nr[2]; MR_LOAD(nr[0], MR_ROW(0)); MR_LOAD(nr[1], MR_ROW(1));
        for (int mm = 0; mm < 32; mm += 2) {
            Row cr[2]; cr[0] = nr[0]; cr[1] = nr[1];
            if (mm + 2 < 32) { MR_LOAD(nr[0], MR_ROW(mm + 2)); MR_LOAD(nr[1], MR_ROW(mm + 3)); }
#pragma unroll
            for (int q = 0; q < 2; ++q) { const size_t m = MR_ROW(mm + q); const Row& R = cr[q];
            const float mx = fmaxf(R.l1, fmaxf(R.l2, R.l3)); float e1 = __builtin_amdgcn_exp2f(R.l1 - mx), e2 = __builtin_amdgcn_exp2f(R.l2 - mx), e3 = __builtin_amdgcn_exp2f(R.l3 - mx);
            const float inv = 1.f / (e1 + e2 + e3); e1 *= inv; e2 *= inv; e3 *= inv;
            float yf[8], a1[8], a2[8], a3[8], yd[8]; unpack8(R.wf, yf); unpack8(R.w1, a1); unpack8(R.w2, a2); unpack8(R.w3, a3);
            float sf = 0.f, sd = 0.f;
#pragma unroll
            for (int i = 0; i < 8; ++i) { yd[i] = e1 * a1[i] + e2 * a2[i] + e3 * a3[i]; sf += yf[i] * yf[i]; sd += yd[i] * yd[i]; }
            const float rf = 1.f / sqrtf(wave_sum(sf) * (1.f / HW) + EPS), rd = 1.f / sqrtf(wave_sum(sd) * (1.f / HW) + EPS);
#if OUT8
            { unsigned char* Y8 = (unsigned char*)YM; u32x2 of, od;
              int t0 = __builtin_amdgcn_cvt_pk_fp8_f32(yf[0] * rf * gf[0], yf[1] * rf * gf[1], 0, false); t0 = __builtin_amdgcn_cvt_pk_fp8_f32(yf[2] * rf * gf[2], yf[3] * rf * gf[3], t0, true);
              int t1 = __builtin_amdgcn_cvt_pk_fp8_f32(yf[4] * rf * gf[4], yf[5] * rf * gf[5], 0, false); t1 = __builtin_amdgcn_cvt_pk_fp8_f32(yf[6] * rf * gf[6], yf[7] * rf * gf[7], t1, true);
              int t2 = __builtin_amdgcn_cvt_pk_fp8_f32(yd[0] * rd * gd[0], yd[1] * rd * gd[1], 0, false); t2 = __builtin_amdgcn_cvt_pk_fp8_f32(yd[2] * rd * gd[2], yd[3] * rd * gd[3], t2, true);
              int t3 = __builtin_amdgcn_cvt_pk_fp8_f32(yd[4] * rd * gd[4], yd[5] * rd * gd[5], 0, false); t3 = __builtin_amdgcn_cvt_pk_fp8_f32(yd[6] * rd * gd[6], yd[7] * rd * gd[7], t3, true);
              of.x = (unsigned)t0; of.y = (unsigned)t1; od.x = (unsigned)t2; od.y = (unsigned)t3;
              *(GAS u32x2*)(Y8 + m * DM + 8 * F.lane) = of; *(GAS u32x2*)(Y8 + m * DM + HW + 8 * F.lane) = od; } }
#else
            u32x4 of, od;
            of.x = cvt_pk_bf16(yf[0] * rf * gf[0], yf[1] * rf * gf[1]); of.y = cvt_pk_bf16(yf[2] * rf * gf[2], yf[3] * rf * gf[3]); of.z = cvt_pk_bf16(yf[4] * rf * gf[4], yf[5] * rf * gf[5]); of.w = cvt_pk_bf16(yf[6] * rf * gf[6], yf[7] * rf * gf[7]);
            od.x = cvt_pk_bf16(yd[0] * rd * gd[0], yd[1] * rd * gd[1]); od.y = cvt_pk_bf16(yd[2] * rd * gd[2], yd[3] * rd * gd[3]); od.z = cvt_pk_bf16(yd[4] * rd * gd[4], yd[5] * rd * gd[5]); od.w = cvt_pk_bf16(yd[6] * rd * gd[6], yd[7] * rd * gd[7]);
            *(GAS u32x4*)(YM + m * DM + 8 * F.lane) = of; *(GAS u32x4*)(YM + m * DM + HW + 8 * F.lane) = od; }
#endif
        }
    }
#undef MR_LOAD
#undef MR_ROW
}
__device__ __forceinline__ void route_rows(Frame& F, int pm, const float* logits, const float* rbias, unsigned* list, float* wts, unsigned* pose) {
    LAS unsigned* lcount = (LAS unsigned*)F.lds;
    LAS unsigned* lbase = lcount + 256;
    LAS unsigned* lsel = lbase + 256;
    LAS unsigned* lwt = lsel + 2048;
    if (F.tid < 256) lcount[F.tid] = 0u;
    __syncthreads();
    const f32x4 rb = *(const f32x4*)(rbias + 4 * F.lane);
#define DPPF(x, ctrl) __int_as_float(__builtin_amdgcn_update_dpp(0, __float_as_int(x), ctrl, 0xF, 0xF, false))
#define DPPUMAX(v, ctrl, rm) v = max(v, (unsigned)__builtin_amdgcn_update_dpp(0, (int)v, ctrl, rm, 0xF, false))
    f32x4 lgn = *(const GAS f32x4*)(logits + ((size_t)pm * 256 + F.wave * 32) * NEXP + 4 * F.lane);
    for (int i = 0; i < 32; ++i) { const int rl = F.wave * 32 + i; const size_t row = (size_t)pm * 256 + rl;
        const f32x4 lg = lgn;
        if (i + 1 < 32) lgn = *(const GAS f32x4*)(logits + (row + 1) * NEXP + 4 * F.lane);
        float s[4], sel[4];
#pragma unroll
        for (int q = 0; q < 4; ++q) { s[q] = 1.f / (1.f + __expf(-lg[q])); sel[q] = s[q] + rb[q]; }
        float m1 = -INFINITY, m2 = -INFINITY;
#pragma unroll
        for (int q = 0; q < 4; ++q) { if (sel[q] > m1) { m2 = m1; m1 = sel[q]; } else if (sel[q] > m2) m2 = sel[q]; }
        { float b1 = DPPF(m1, 0xB1), b2 = DPPF(m2, 0xB1); float n1 = fmaxf(m1, b1), n2 = fmaxf(fminf(m1, b1), fmaxf(m2, b2)); m1 = n1; m2 = n2;
          b1 = DPPF(m1, 0x4E); b2 = DPPF(m2, 0x4E); n1 = fmaxf(m1, b1); n2 = fmaxf(fminf(m1, b1), fmaxf(m2, b2)); m1 = n1; m2 = n2;
          b1 = DPPF(m1, 0x141); b2 = DPPF(m2, 0x141); n1 = fmaxf(m1, b1); n2 = fmaxf(fminf(m1, b1), fmaxf(m2, b2)); m1 = n1; m2 = n2; }
        const float gs = m1 + m2; const int g = F.lane >> 3; int rank = 0;
#pragma unroll
        for (int gg = 0; gg < 8; ++gg) { const float og = __int_as_float(__builtin_amdgcn_readlane(__float_as_int(gs), gg * 8)); rank += (og > gs || (og == gs && gg < g)) ? 1 : 0; }
        const bool gsel = rank < 4;
        unsigned key[4];
#pragma unroll
        for (int q = 0; q < 4; ++q) { const unsigned bq = __float_as_uint(sel[q]); key[q] = gsel ? (bq ^ ((bq >> 31) ? 0xffffffffu : 0x80000000u)) : 0u; }
        int myE = 0; float myS = 0.f, ssum = 0.f;
#pragma unroll 1
        for (int k = 0; k < TOPK; ++k) {
            unsigned v = max(max(key[0], key[1]), max(key[2], key[3]));
            DPPUMAX(v, 0xB1, 0xF); DPPUMAX(v, 0x4E, 0xF); DPPUMAX(v, 0x141, 0xF); DPPUMAX(v, 0x140, 0xF); DPPUMAX(v, 0x142, 0xA); DPPUMAX(v, 0x143, 0xC);
            const unsigned best = (unsigned)__builtin_amdgcn_readlane((int)v, 63);
            const int myq = (key[0] == best) ? 0 : (key[1] == best) ? 1 : (key[2] == best) ? 2 : (key[3] == best) ? 3 : 4;
            const unsigned long long bal = __ballot(myq < 4);
            const int L = __builtin_amdgcn_readfirstlane((int)__ffsll((long long)bal) - 1);
            const int q = __builtin_amdgcn_readlane(myq, L);
            const float mys = (q == 0) ? s[0] : (q == 1) ? s[1] : (q == 2) ? s[2] : s[3];
            const float sk = __int_as_float(__builtin_amdgcn_readlane(__float_as_int(mys), L));
            if (F.lane == L) {
#pragma unroll
                for (int qq = 0; qq < 4; ++qq) if (qq == q) key[qq] = 0u; }
            if (F.lane == k) { myE = 4 * L + q; myS = sk; }
            ssum += sk;
        }
        if (F.lane < TOPK) { const unsigned lp = atomicAdd((unsigned*)(lcount + myE), 1u); lsel[rl * 8 + F.lane] = (unsigned)myE | (lp << 8); lwt[rl * 8 + F.lane] = __float_as_uint(myS / ssum * 2.5f); }
    }
#undef DPPF
#undef DPPUMAX
    __syncthreads();
    if (F.tid < 256) { const unsigned n = lcount[F.tid]; lbase[F.tid] = n ? __hip_atomic_fetch_add((unsigned*)(F.ctl + CW_CNT + F.tid), n, RLX_AGENT) : 0u; }
    __syncthreads();
    for (int a = F.tid; a < 2048; a += NWAVES * 64) { const unsigned se = lsel[a]; const unsigned e = se & 255u, lp = se >> 8; const unsigned pos = lbase[e] + lp; const unsigned tok = (unsigned)(pm * 256 + (a >> 3));
        wts[(size_t)tok * TOPK + (a & 7)] = __uint_as_float(lwt[a]); pose[(size_t)tok * TOPK + (a & 7)] = (e << 16) | (pos & 0xffffu);
        if (pos < (unsigned)LCAP) list[(size_t)e * LCAP + pos] = tok | ((unsigned)(a & 7) << 16); }
    __syncthreads();
}
__device__ __forceinline__ void build_tables(Frame& F) {
    LAS unsigned* tp = (LAS unsigned*)(F.lds + TAB_OFF); LAS unsigned* cn = tp + 260; LAS unsigned* cp = cn + 256; LAS unsigned* wt = cp + 256;
    __syncthreads();
    unsigned cnt = 0u, tiles = 0u, incl = 0u, cincl = 0u;
    if (F.tid < 256) { cnt = __hip_atomic_load((unsigned*)(F.ctl + CW_CNT + F.tid), RLX_AGENT); if (cnt > (unsigned)LCAP) cnt = LCAP; tiles = (cnt + 255u) >> 8; incl = tiles; cincl = cnt;
#pragma unroll
        for (int o = 1; o < 64; o <<= 1) { const unsigned t = __shfl_up(incl, o), t2 = __shfl_up(cincl, o); if (F.lane >= o) { incl += t; cincl += t2; } }
        if (F.lane == 63) { wt[F.wave] = incl; wt[8 + F.wave] = cincl; } }
    __syncthreads();
    if (F.tid < 256) { unsigned base = 0u, cbase = 0u; for (int w = 0; w < F.wave; ++w) { base += wt[w]; cbase += wt[8 + w]; } tp[F.tid + 1] = base + incl; cn[F.tid] = cnt; cp[F.tid] = cbase + cincl - cnt; if (F.tid == 0) tp[0] = 0u;
        LAS unsigned short* mt2e = (LAS unsigned short*)(F.lds + MT2E_OFF); const unsigned t0 = base + incl - tiles; for (unsigned t = 0; t < tiles; ++t) mt2e[t0 + t] = (unsigned short)F.tid; }
    __syncthreads();
}
__device__ __forceinline__ void combine_rows(Frame& F, const float* gate2, const float* g_final, float* dst) {
    const unsigned char* Y = (const unsigned char*)(F.ws + WS_YBUF); const float* WT = (const float*)(F.ws + WS_WTS); const unsigned* PE = (const unsigned*)(F.ws + WS_POSE);
    const LAS unsigned* cp = (const LAS unsigned*)(F.lds + TAB_OFF) + 260 + 256;
    const int gw = F.vcu * NWAVES + F.wave, NGW = F.G * NWAVES; const int c0 = 16 * F.lane;
    const unsigned char* YS = (const unsigned char*)(F.ws + WS_YSH);
    struct CRow { u32x4 yv[8]; u32x4 ys, xb[2]; f32x4 w0, w1; };
#define CR_LOAD(R, m_) do { const size_t mq_ = (size_t)(m_); const unsigned pe_ = PE[mq_ * TOPK + (F.lane & 7)]; const unsigned myrow_ = cp[pe_ >> 16] + (pe_ & 0xffffu); \
        _Pragma("unroll") for (int k = 0; k < 8; ++k) { const size_t yr_ = (size_t)(unsigned)__builtin_amdgcn_readlane((int)myrow_, k); R.yv[k] = *(const GAS u32x4*)(Y + yr_ * DM + c0); } \
        R.ys = *(const GAS u32x4*)(YS + mq_ * DM + c0); const GAS u32x4* or_ = (const GAS u32x4*)(x1_row(F.ws, mq_) + c0); R.xb[0] = or_[0]; R.xb[1] = or_[1]; R.w0 = *(const GAS f32x4*)(WT + mq_ * TOPK); R.w1 = *(const GAS f32x4*)(WT + mq_ * TOPK + 4); } while (0)
    f32x4 gf[4];
#pragma unroll
    for (int j = 0; j < 4; ++j) gf[j] = *(const f32x4*)(g_final + c0 + 4 * j);
    for (int ch = gw; ch < M / 32; ch += NGW) {
        const int b = ch >> 7; const size_t rowb = (size_t)b * SEQ + (ch & 127);
        f32x4 g2[4];
#pragma unroll
        for (int j = 0; j < 4; ++j) g2[j] = *(const f32x4*)(gate2 + (size_t)b * NMOD + c0 + 4 * j) * (1.f / YSCALE);
        CRow nr; CR_LOAD(nr, rowb);
        for (int mm = 0; mm < 32; ++mm) { const size_t m = rowb + 128 * mm;
            CRow R = nr;
            if (mm + 1 < 32) CR_LOAD(nr, m + 128);
            const float wk[8] = {R.w0.x, R.w0.y, R.w0.z, R.w0.w, R.w1.x, R.w1.y, R.w1.z, R.w1.w};
            f32x4 acc[4];
#pragma unroll
            for (int j = 0; j < 4; ++j) { const int wv = (int)R.ys[j]; const f32x2 lo = __builtin_amdgcn_cvt_pk_f32_fp8(wv, false), hi = __builtin_amdgcn_cvt_pk_f32_fp8(wv, true); f32x4 a = (f32x4){lo.x, lo.y, hi.x, hi.y};
#pragma unroll
                for (int k = 0; k < 8; ++k) { const int wk_ = (int)R.yv[k][j]; const f32x2 l2 = __builtin_amdgcn_cvt_pk_f32_fp8(wk_, false), h2 = __builtin_amdgcn_cvt_pk_f32_fp8(wk_, true);
                    a.x += wk[k] * l2.x; a.y += wk[k] * l2.y; a.z += wk[k] * h2.x; a.w += wk[k] * h2.y; }
                acc[j] = a; __builtin_amdgcn_sched_barrier(0); }
            float s2 = 0.f; f32x4 v[4];
#pragma unroll
            for (int j = 0; j < 4; ++j) { const unsigned xa = R.xb[j >> 1][(j & 1) * 2], xc = R.xb[j >> 1][(j & 1) * 2 + 1]; const f32x4 xj = (f32x4){bf_lo(xa), bf_hi(xa), bf_lo(xc), bf_hi(xc)}; v[j] = xj + g2[j] * acc[j]; s2 += (v[j].x * v[j].x + v[j].y * v[j].y) + (v[j].z * v[j].z + v[j].w * v[j].w); }
            const float r = 1.f / sqrtf(wave_sum(s2) * (1.f / DM) + EPS);
            GAS f32x4* orow = (GAS f32x4*)(dst + m * DM + c0);
#pragma unroll
            for (int j = 0; j < 4; ++j) orow[j] = v[j] * r * gf[j];
        }
    }
#undef CR_LOAD
}

struct Args { const float* in[19]; float* out; unsigned char* ws; int ph_lo, ph_hi, li, pad; };
__global__ void __launch_bounds__(NWAVES * 64, 2) fwd_kernel(Args args) {
    extern __shared__ __attribute__((aligned(16))) unsigned char lds[];
    Frame F;
    F.lds = (LAS unsigned char*)lds;
    F.MISC = (volatile LAS unsigned*)(F.lds + MISC_OFF);
    F.tid = threadIdx.x; F.lane = F.tid & 63; F.wave = __builtin_amdgcn_readfirstlane(F.tid >> 6);
    F.G = gridDim.x; { const int bx = blockIdx.x; F.vcu = (F.G % 8 == 0) ? (bx % 8) * (F.G / 8) + bx / 8 : bx; }
    F.ws = args.ws; F.out = args.out; F.ctl = (gu32*)(args.ws + WS_CTL);
    unsigned char* ws = args.ws;
    typedef const __attribute__((address_space(4))) Args* KArgP;
#define KA(i) ({ KArgP p_ = (KArgP)__builtin_amdgcn_kernarg_segment_ptr(); asm volatile("" : "+s"(p_)); p_->in[i]; })
#define MOD ((float*)(ws + WS_MOD))
#define LF ((float*)(ws + WS_LF))
#define KB ((float*)(ws + WS_KB))
#define LSE ((float*)(ws + WS_LSE))
#define HB ((bf16_t*)(ws + WS_H))
#define QKV ((bf16_t*)(ws + WS_QKV))
#define LIST ((unsigned*)(ws + WS_LIST))
    for (int u = F.tid; u < (LDS_BYTES - LDSCTL_OFF) / 4; u += NWAVES * 64) ((LAS unsigned*)(F.lds + LDSCTL_OFF))[u] = 0u;
    __syncthreads();
    XcdBarrier bar; bar.bar = (unsigned*)(F.ctl + CW_BAR); bar.x = 0; bar.st = nullptr;
    if (N_LAUNCHES == 1) bar = xcd_barrier_post((unsigned*)(F.ctl + CW_BAR), F.MISC + 8);
#define GRID_BAR() do { if (N_LAUNCHES == 1) xcd_barrier(bar); } while (0)
#define REFRESH() do { int t_ = threadIdx.x; asm volatile("" : "+v"(t_)); F.tid = t_; F.lane = t_ & 63; } while (0)
    const int lo = args.ph_lo, hi = args.ph_hi;
#ifndef ONLY_PHASE
#define ONLY_PHASE -1
#endif
#define IN(k) ((ONLY_PHASE < 0 || ONLY_PHASE == (k)) && lo <= (k) && (k) < hi)
#define BOTH(k) (IN(k) && IN((k) + 1))

    if (IN(0)) {
        REFRESH();
        _Pragma("unroll") for (int rep_ = 0; rep_ < DUPN(0); ++rep_) {
        p0_mod(F, KA(1), KA(7), KA(8), MOD);
        P0Ptrs P{KA(2), KA(6), KA(9), KA(11), KA(12), KA(13), KA(14), KA(15), KA(16)};
        p0_weights(F, P, P0_EXPERT_ITEMS, P0_ALL_ITEMS); }
        if (BOTH(0)) GRID_BAR();
    }
    if (IN(1)) {
        REFRESH();
        _Pragma("unroll") for (int rep_ = 0; rep_ < DUPN(1); ++rep_) norm_rows<true>(F, KA(0), HB, MOD, 0, DM, KA(2), KA(3), LF, nullptr);
        if (BOTH(1)) GRID_BAR();
    }
    if (IN(2)) {
        REFRESH();
        _Pragma("unroll") for (int rep_ = 0; rep_ < DUPN(2); ++rep_) {
        scan_rows(F, LF, KB, (int*)(ws + WS_T0));
        pg8::Gemm g{HB, (const bf16_t*)(ws + WS_WIN), DM, nullptr}; pg8::StaticOrder S; S.init(M, 3072, F.G, (int)blockIdx.x);
        pg8::EpiQKV E{QKV, (size_t)M * HW, attn_body::C2};
        pg8::gemm_phase<pg8::EpiQKV, pg8::StaticOrder, false>(F.lds, g, S, E); }
        if (BOTH(2)) GRID_BAR();
    }
    if (IN(3)) {
        REFRESH();
        using attn_body::bf16; const float* rel_bias = KA(17);
        const bf16* Qf = (const bf16*)QKV; const bf16* Kf = Qf + (size_t)M * HW; const bf16* Vf = Kf + (size_t)M * HW;
        const bf16* Qd = Vf + (size_t)M * HW; const bf16* Kd = Qd + (size_t)M * HW; const bf16* Vd = Kd + (size_t)M * HW;
        bf16* OF = (bf16*)(ws + WS_OF);
        bool conv_done = false;
        const P0Ptrs PW{KA(2), KA(6), KA(9), KA(11), KA(12), KA(13), KA(14), KA(15), KA(16)};
        for (int cu = F.vcu; cu < 16 * BATCH; cu += F.G) {
            const int b = cu >> 4, j = cu & 15;
            const int m16_ = F.vcu & 15; const int cs_ = m16_ < 4 ? 0 : 1 + (m16_ - 4) / 3;        int hc = cs_ == 0 ? 0 : cs_ == 1 ? 4 : cs_ == 2 ? 6 : cs_ == 3 ? 7 : 8;        asm volatile("" : "+s"(hc));
            for (int part = 0; part < 2; ++part) {
            if (part == 1 && !conv_done) { __syncthreads(); conv_experts(F, PW); __syncthreads(); conv_done = true; }
            const int h_lo = part ? hc : 0, h_hi = part ? NH : hc;
            for (int h = h_lo; h < h_hi; ++h) { const int q = (j + 4 * (h >> 1)) & 15; const int qb = (h & 1) ? 15 - q : q; const int bh = b * NH + h;
                const size_t hb = (size_t)b * SEQ * HW + h * HD; const int T0 = ((const int*)(ws + WS_T0))[bh * 16 + qb];
                if (DUPN(3) == 2) attn_body::attn_unit<8, 0>(Qf + hb, Kf + hb, Vf + hb, (bf16*)(ws + WS_SS0), (long)HW, 0L, qb * 256, T0, 4 * qb + 4 - T0, 0, nullptr, 0, (char*)lds, KB + (size_t)bh * SEQ, nullptr, 0);
                attn_body::attn_unit<8, 0>(Qf + hb, Kf + hb, Vf + hb, OF + hb, (long)HW, (long)HW, qb * 256, T0, 4 * qb + 4 - T0, 0, nullptr, 0, (char*)lds, KB + (size_t)bh * SEQ, nullptr, 0); }
            }
        }
        if (!conv_done) { __syncthreads(); conv_experts(F, PW); __syncthreads(); }
        for (int job = F.vcu; job < 2 * BATCH * NH; job += F.G) {
            const int bh = job >> 1, sub = job & 1, b = bh >> 3, h = bh & 7;
            const size_t hb = (size_t)b * SEQ * HW + h * HD;
            const int nd = sub ? 25 : 23; int tabkey = -1;
            { __syncthreads(); for (int i = F.tid; i < attn_body::DL_ZEND / 16; i += NWAVES * 64) *(LAS f32x4*)(F.lds + i * 16) = (f32x4){0.f, 0.f, 0.f, 0.f}; __syncthreads(); }
#define DIL_PARAMS(i_, dsel_, d_, r_, qb_) do { if ((i_) < 16) { if (sub == 0) { dsel_ = 0; d_ = 1; r_ = 0; qb_ = (i_); } else { dsel_ = 1; d_ = 4; r_ = (i_) >> 2; qb_ = (i_) & 3; } } \
                else { dsel_ = 2; d_ = 16; r_ = ((i_) - 16) + (sub ? 7 : 0); qb_ = 0; } } while (0)
            for (int i = 0; i < nd; ++i) {
                int dsel, d, r, qb; DIL_PARAMS(i, dsel, d, r, qb);
                int dseln = 0, dn = 1, rn = 0, qbn = 0; const bool has_next = (i + 1 < nd); if (has_next) DIL_PARAMS(i + 1, dseln, dn, rn, qbn);
                bf16* OB = (bf16*)(ws + (dsel == 0 ? WS_O1 : dsel == 1 ? WS_O2 : WS_O3));
                const size_t sb = hb + (size_t)r * HW, sbn = hb + (size_t)rn * HW;
                float* lsep = LSE + (size_t)dsel * M * NH + ((size_t)b * SEQ + r) * NH + h;
                const bool bt = (tabkey != dsel); tabkey = dsel;
                const attn_body::DilSrc cu{Kd + sb, Vd + sb, (long)d * HW, qb * 256, qb == 0}, nx{Kd + sbn, Vd + sbn, (long)dn * HW, qbn * 256, qbn == 0};
                _Pragma("unroll") for (int rep_ = 0; rep_ < DUPN(3); ++rep_)
                attn_body::dil_unit<8>(Qd + sb, cu, (i & 1) ? attn_body::DL_KB : attn_body::DL_K, i > 0 && DUPN(3) == 1, nx, has_next && DUPN(3) == 1, OB + sb, lsep, (long)d * NH, (char*)lds, rel_bias + h, dsel, bt); }
#undef DIL_PARAMS
        }
        if (BOTH(3)) GRID_BAR();
    }
    if (IN(4)) {
        REFRESH();
        _Pragma("unroll") for (int rep_ = 0; rep_ < DUPN(4); ++rep_) merge_rows(F, KA(4), KA(5));
        if (BOTH(4)) GRID_BAR();
    }
    if (IN(5)) {
        REFRESH();
        _Pragma("unroll") for (int rep_ = 0; rep_ < DUPN(5); ++rep_) {
        pg8::Gemm g{(const bf16_t*)(ws + WS_YM), (const bf16_t*)(ws + WS_WOUT), OUT8 ? DM / 2 : DM, nullptr}; pg8::StaticOrder S; S.init(M, DM, F.G, (int)blockIdx.x);
        pg8::EpiX1N E{KA(0), ws, MOD, F.lds, (float*)(ws + WS_EX), (unsigned*)(F.ctl + CW_X1)};
        pg8::gemm_phase<pg8::EpiX1N, pg8::StaticOrder, false, OUT8 != 0, OUT8 != 0>(F.lds, g, S, E); }
        if (BOTH(5)) GRID_BAR();
    }
    if (IN(6)) {
        REFRESH();
        (void)0;
    }
    if (IN(7)) {
        REFRESH();
        float* LOGITS = (float*)(ws + WS_LOGITS); const float* rbias_ = KA(10);
        { pg8::Gemm g{HB, (const bf16_t*)(ws + WS_WR), DM, nullptr}; pg8::StaticOrder S; S.init(M, NEXP, F.G, (int)blockIdx.x);
          pg8::EpiF32 E{LOGITS, NEXP};
          pg8::gemm_phase<pg8::EpiF32, pg8::StaticOrder, false>(F.lds, g, S, E);
          asm volatile("s_waitcnt vmcnt(0)" ::: "memory"); __syncthreads();
          pg8::Unit u; for (int i = 0; S.next(i, u); ++i) route_rows(F, u.pm, LOGITS, rbias_, LIST, (float*)(ws + WS_WTS), (unsigned*)(ws + WS_POSE)); }
        _Pragma("unroll") for (int rep_ = 0; rep_ < DUPN(7); ++rep_)
#if SH8
        { pg8::Gemm g{(const bf16_t*)(ws + WS_H8), (const bf16_t*)(ws + WS_WSHGU), DM / 2, nullptr}; pg8::StaticOrder S; S.init(M, 512, F.G, (int)blockIdx.x);
          pg8::EpiSwiglu8 E{ws + WS_ACTSH};
          pg8::gemm_phase<pg8::EpiSwiglu8, pg8::StaticOrder, false, true, true>(F.lds, g, S, E); }
#else
        { pg8::Gemm g{HB, (const bf16_t*)(ws + WS_WSHGU), DM, nullptr}; pg8::StaticOrder S; S.init(M, 512, F.G, (int)blockIdx.x);
          pg8::EpiSwiglu E{(bf16_t*)(ws + WS_ACTSH)};
          pg8::gemm_phase<pg8::EpiSwiglu, pg8::StaticOrder, false>(F.lds, g, S, E); }
#endif
        if (BOTH(7)) GRID_BAR();
    }
    if (IN(8)) {
        REFRESH();
        { pg8::Gemm g{(const bf16_t*)(ws + WS_ACTSH), (const bf16_t*)(ws + WS_WSHD), SH8 ? EH / 2 : EH, nullptr}; pg8::StaticOrder S; S.init(M, DM, F.G, (int)blockIdx.x);
          pg8::EpiYbuf E{ws + WS_YSH, ws + WS_DUMP};
          pg8::gemm_phase<pg8::EpiYbuf, pg8::StaticOrder, false, SH8 != 0, true, 0, HOIST_SD>(F.lds, g, S, E); }
        build_tables(F);
#if PROBE_G1
        { pg8::Gemm g{(const bf16_t*)(ws + WS_H8), (const bf16_t*)(ws + WS_WGU), DM / 2, LIST};
          pg8::GroupedOrder S{(const LAS unsigned*)(F.lds + TAB_OFF), (const LAS unsigned*)(F.lds + TAB_OFF) + 260, 2, F.G, F.vcu, 2, 0, 0, (const LAS unsigned short*)(F.lds + MT2E_OFF)}; S.total = __builtin_amdgcn_readfirstlane((int)S.tp[256]) * 2;
          pg8::EpiSwiglu8 E{ws + WS_ACT};
          pg8::gemm_phase<pg8::EpiSwiglu8, pg8::GroupedOrder, true, true, true, PROBE_G1>(F.lds, g, S, E); }
#endif
        _Pragma("unroll") for (int rep_ = 0; rep_ < DUPN(8); ++rep_)
        { pg8::Gemm g{(const bf16_t*)(ws + WS_H8), (const bf16_t*)(ws + WS_WGU), DM / 2, LIST};
          pg8::GroupedOrder S{(const LAS unsigned*)(F.lds + TAB_OFF), (const LAS unsigned*)(F.lds + TAB_OFF) + 260, 2, F.G, F.vcu, 2, 0, 0, (const LAS unsigned short*)(F.lds + MT2E_OFF)}; S.total = __builtin_amdgcn_readfirstlane((int)S.tp[256]) * 2;
          pg8::EpiSwiglu8 E{ws + WS_ACT};
          pg8::gemm_phase<pg8::EpiSwiglu8, pg8::GroupedOrder, true, true, true, 0, HOIST_G1>(F.lds, g, S, E); }
        if (BOTH(8)) GRID_BAR();
    }
    if (IN(9)) {
        REFRESH();
        build_tables(F);
#if PROBE_G2
        { pg8::Gemm g{(const bf16_t*)(ws + WS_ACT), (const bf16_t*)(ws + WS_WD), EH / 2, LIST};
          pg8::GroupedOrder S{(const LAS unsigned*)(F.lds + TAB_OFF), (const LAS unsigned*)(F.lds + TAB_OFF) + 260, 4, F.G, F.vcu, 4, 0, 0, (const LAS unsigned short*)(F.lds + MT2E_OFF)}; S.total = __builtin_amdgcn_readfirstlane((int)S.tp[256]) * 4;
          pg8::EpiYbuf E{(unsigned char*)(ws + WS_YBUF), ws + WS_DUMP};
          pg8::gemm_phase<pg8::EpiYbuf, pg8::GroupedOrder, false, true, true, PROBE_G2>(F.lds, g, S, E); }
#endif
        _Pragma("unroll") for (int rep_ = 0; rep_ < DUPN(9); ++rep_)
        { pg8::Gemm g{(const bf16_t*)(ws + WS_ACT), (const bf16_t*)(ws + WS_WD), EH / 2, LIST};
          pg8::GroupedOrder S{(const LAS unsigned*)(F.lds + TAB_OFF), (const LAS unsigned*)(F.lds + TAB_OFF) + 260, 4, F.G, F.vcu, 4, 0, 0, (const LAS unsigned short*)(F.lds + MT2E_OFF)}; S.total = __builtin_amdgcn_readfirstlane((int)S.tp[256]) * 4;
          S.rev = 1;
          pg8::EpiYbuf E{(unsigned char*)(ws + WS_YBUF), ws + WS_DUMP};
          pg8::gemm_phase<pg8::EpiYbuf, pg8::GroupedOrder, false, true, true, 0, HOIST_G2>(F.lds, g, S, E); }
        if (BOTH(9)) GRID_BAR();
    }
    if (IN(10)) {
        REFRESH();
        build_tables(F);
        if (DUPN(10) == 2) combine_rows(F, MOD + 5 * DM, KA(18), (float*)(ws + WS_ACT));
        combine_rows(F, MOD + 5 * DM, KA(18), F.out);
    }
#undef KA
#undef MOD
#undef LF
#undef KB
#undef LSE
#undef HB
#undef QKV
#undef LIST
#undef REFRESH
#undef IN
#undef BOTH
#undef GRID_BAR
}

extern "C" void kernel_launch(void* const* d_in, const int* in_sizes, int n_in, void* d_out, int out_size, void* d_ws, size_t ws_size, hipStream_t stream) {
    static int grid = 0;
    if (grid == 0) {
        if (n_in != 19 || in_sizes[0] != M * DM || out_size != M * DM || ws_size < WS_NEED) {
            fprintf(stderr, "kernel_launch: unexpected shapes: n_in %d in0 %d out %d ws %zu (need %zu); nothing launched\n", n_in, n_in > 0 ? in_sizes[0] : -1, out_size, ws_size, (size_t)WS_NEED); grid = -1; return; }
        int dev = 0, cus = 0, per_cu = 0;
        if (hipGetDevice(&dev) != hipSuccess || hipDeviceGetAttribute(&cus, hipDeviceAttributeMultiprocessorCount, dev) != hipSuccess) { fprintf(stderr, "kernel_launch: device query failed\n"); grid = -1; return; }
        if (hipFuncSetAttribute((const void*)fwd_kernel, hipFuncAttributeMaxDynamicSharedMemorySize, LDS_BYTES) != hipSuccess) { fprintf(stderr, "kernel_launch: hipFuncSetAttribute failed\n"); grid = -1; return; }
        if (hipOccupancyMaxActiveBlocksPerMultiprocessor(&per_cu, (const void*)fwd_kernel, NWAVES * 64, LDS_BYTES) != hipSuccess || per_cu < 1)
            fprintf(stderr, "kernel_launch: note: occupancy query reports %d workgroups per CU\n", per_cu);
        (void)hipGetLastError();
        grid = cus;
    }
    if (grid < 0) return;
    if (hipMemsetAsync((char*)d_ws + WS_CTL, 0, CTL_ZERO_BYTES, stream) != hipSuccess) { fprintf(stderr, "kernel_launch: memset failed\n"); return; }
    Args a{};
    for (int i = 0; i < 19; ++i) a.in[i] = (const float*)d_in[i];
    a.out = (float*)d_out; a.ws = (unsigned char*)d_ws; a.pad = 0;
    for (int li = 0; li < N_LAUNCHES; ++li) {
        a.ph_lo = (N_LAUNCHES == 1) ? 0 : li; a.ph_hi = (N_LAUNCHES == 1) ? NPHASE : li + 1; a.li = li;
        hipLaunchKernelGGL(fwd_kernel, dim3(grid), dim3(NWAVES * 64), LDS_BYTES, stream, a);
        const hipError_t le = hipPeekAtLastError();
        if (le != hipSuccess) { fprintf(stderr, "kernel_launch: launch %d failed: %s\n", li, hipGetErrorName(le)); break; }
    }
}
```
